# Optimizing an MI355X kernel written in HIP

```python
import math
import jax, jax.numpy as jnp
from jax import lax
import numpy as np

D_MODEL = 1024
BATCH = 4
SEQ = 8192
DEPTH = 2

CHUNK = 64
D_PLE = 256
BRANCH_W = 512
D_MIX = 3 * BRANCH_W
RWKV_HEADS = 8
RWKV_HEAD_DIM = BRANCH_W // RWKV_HEADS
DECAY_LORA = 64
ICLR_LORA = 64
RWKV_GN_EPS = 64e-5
S5_GROUP = 16
S5_GROUPS = BRANCH_W // S5_GROUP
S5_STATE = 64
LRU_BLOCKS = 8
LRU_BLOCK_DIM = BRANCH_W // LRU_BLOCKS
CONV_WIDTH = 4
LRU_C = 8.0
NORM_EPS = 1e-6
RWKV_SHIFT_W = 3 * BRANCH_W + DECAY_LORA + ICLR_LORA
SPLITS = [RWKV_SHIFT_W,
          RWKV_SHIFT_W + BRANCH_W,
          RWKV_SHIFT_W + 2 * BRANCH_W,
          RWKV_SHIFT_W + 3 * BRANCH_W,
          RWKV_SHIFT_W + 4 * BRANCH_W]
D_IN = RWKV_SHIFT_W + 5 * BRANCH_W

kernel_name = "hymba_rwkv7_s5_rglru_ple"


def rmsnorm(x, g):
    xf = x.astype(jnp.float32)
    return xf * lax.rsqrt(jnp.mean(xf * xf, axis=-1, keepdims=True) + NORM_EPS) * g.astype(jnp.float32)


def linear_binop(e1, e2):
    a1, b1 = e1
    a2, b2 = e2
    return a1 * a2, a2 * b1 + b2


def rwkv7_group(z, gate, mu, w0, w2, a0, a2, k_k, k_a, r_k, ln_w, ln_b):
    bsz, seq, _ = z.shape
    z = z.astype(jnp.float32)
    z_prev = jnp.pad(z, ((0, 0), (1, 0), (0, 0)))[:, :-1]
    z = z + mu * (z_prev - z)
    r, k, v, wd, ad = jnp.split(z, [BRANCH_W, 2 * BRANCH_W, 3 * BRANCH_W, 3 * BRANCH_W + DECAY_LORA], axis=-1)
    w = -jax.nn.softplus(-(w0 + jnp.tanh(wd) @ w2)) - 0.5
    log_decay = -jnp.exp(w)
    a = jax.nn.sigmoid(a0 + ad @ a2)
    heads = lambda t: t.reshape(bsz, seq, RWKV_HEADS, RWKV_HEAD_DIM)
    kk = heads(k * k_k)
    kk = kk / jnp.maximum(jnp.sqrt(jnp.sum(kk * kk, axis=-1, keepdims=True)), 1e-12)
    k = k * (1.0 + (a - 1.0) * k_a)
    r_h, k_h, v_h, a_h, dec_h = heads(r), heads(k), heads(v), heads(a), heads(jnp.exp(log_decay))
    b_h = kk * a_h

    def step(S, inp):
        r_t, k_t, v_t, kk_t, b_t, d_t = inp
        S = (S * d_t[:, :, None, :]
             - jnp.einsum('bhvk,bhk->bhv', S, kk_t)[..., None] * b_t[:, :, None, :]
             + v_t[..., None] * k_t[:, :, None, :])
        return S, jnp.einsum('bhvk,bhk->bhv', S, r_t)

    tm = lambda t: jnp.moveaxis(t, 1, 0)
    S0 = jnp.zeros((bsz, RWKV_HEADS, RWKV_HEAD_DIM, RWKV_HEAD_DIM), jnp.float32)
    _, y = lax.scan(step, S0, (tm(r_h), tm(k_h), tm(v_h), tm(kk), tm(b_h), tm(dec_h)))
    y = jnp.moveaxis(y, 0, 1)
    mean = jnp.mean(y, axis=-1, keepdims=True)
    var = jnp.mean(jnp.square(y - mean), axis=-1, keepdims=True)
    y = ((y - mean) * lax.rsqrt(var + RWKV_GN_EPS)).reshape(bsz, seq, BRANCH_W) * ln_w + ln_b
    bonus = jnp.sum(r_h * k_h * r_k, axis=-1, keepdims=True) * v_h
    y = y + bonus.reshape(bsz, seq, BRANCH_W)
    return y * jax.nn.silu(gate.astype(jnp.float32))


def s5_group(u, gate, a_re, a_im, log_dt, b_re, b_im, c_re, c_im, d, glu_w, glu_b):
    bsz, seq, _ = u.shape
    f32 = jnp.float32
    u = u.astype(f32)
    lam = lax.complex(a_re.astype(f32), a_im.astype(f32))
    dt = jnp.exp(log_dt.astype(f32))[:, None]
    lam_bar = jnp.exp(lam * dt)
    b_bar = ((lam_bar - 1.0) / lam)[:, :, None] * lax.complex(b_re.astype(f32), b_im.astype(f32))
    c = lax.complex(c_re.astype(f32), c_im.astype(f32))
    steps = jnp.arange(1, CHUNK + 1, dtype=f32)[:, None, None]
    pows = jnp.exp(lam * dt * steps)
    lam_b = jnp.broadcast_to(lam_bar, (bsz, CHUNK, S5_GROUPS, S5_STATE))
    ug = u.reshape(bsz, seq // CHUNK, CHUNK, S5_GROUPS, S5_GROUP)
    ug = jnp.moveaxis(ug, 1, 0)

    def chunk_step(state, u_c):
        bu = jnp.einsum('bcgh,gph->bcgp', u_c, b_bar)
        _, xs = lax.associative_scan(linear_binop, (lam_b, bu), axis=1)
        xs = xs + pows[None] * state[:, None]
        y = jnp.real(jnp.einsum('bcgp,ghp->bcgh', xs, c))
        return xs[:, -1], y

    state0 = jnp.zeros((bsz, S5_GROUPS, S5_STATE), jnp.complex64)
    _, y = lax.scan(chunk_step, state0, ug)
    y = jnp.moveaxis(y, 0, 1).reshape(bsz, seq, BRANCH_W) + d * u
    zg = jax.nn.gelu(y)
    zg = zg * jax.nn.sigmoid(zg @ glu_w + glu_b)
    return zg * jax.nn.silu(gate.astype(f32))


def rglru_group(xb, gate, conv_w, conv_b, wa, ba, wx, bx, lam):
    bsz, seq, _ = xb.shape
    xb = xb.astype(jnp.float32)
    xp = jnp.pad(xb, ((0, 0), (CONV_WIDTH - 1, 0), (0, 0)))
    xc = conv_b + sum(xp[:, j:j + seq] * conv_w[j] for j in range(CONV_WIDTH))
    xh = xc.reshape(bsz, seq, LRU_BLOCKS, LRU_BLOCK_DIM)
    r = jax.nn.sigmoid(jnp.einsum('blhi,hij->blhj', xh, wa).reshape(bsz, seq, BRANCH_W) + ba)
    i = jax.nn.sigmoid(jnp.einsum('blhi,hij->blhj', xh, wx).reshape(bsz, seq, BRANCH_W) + bx)
    log_a = -LRU_C * r * jax.nn.softplus(-lam)
    a = jnp.exp(log_a)
    mult = jnp.sqrt(-jnp.expm1(2.0 * log_a))
    _, h = lax.associative_scan(linear_binop, (a, mult * (i * xc)), axis=1)
    return h * jax.nn.silu(gate.astype(jnp.float32))


def hybrid_layer(h, p_i, norm_g, w_in,
                 rwkv_mu, rwkv_w0, rwkv_w2, rwkv_a0, rwkv_a2, rwkv_k_k, rwkv_k_a, rwkv_r_k, rwkv_ln_w, rwkv_ln_b,
                 s5_a_re, s5_a_im, s5_log_dt, s5_b_re, s5_b_im, s5_c_re, s5_c_im, s5_d, s5_glu_w, s5_glu_b,
                 lru_conv_w, lru_conv_b, lru_wa, lru_ba, lru_wx, lru_bx, lru_lambda,
                 w_out, ple_w, ple_norm_g, ple_gate_w):
    xn = rmsnorm(h, norm_g)
    zin = xn @ w_in.astype(jnp.float32)
    z_rw, g_rw, u_s5, g_s5, x_lru, g_lru = jnp.split(zin, SPLITS, axis=-1)
    y_rw = rwkv7_group(z_rw, g_rw, rwkv_mu, rwkv_w0, rwkv_w2, rwkv_a0, rwkv_a2,
                       rwkv_k_k, rwkv_k_a, rwkv_r_k, rwkv_ln_w, rwkv_ln_b)
    y_s5 = s5_group(u_s5, g_s5, s5_a_re, s5_a_im, s5_log_dt, s5_b_re, s5_b_im,
                    s5_c_re, s5_c_im, s5_d, s5_glu_w, s5_glu_b)
    y_lru = rglru_group(x_lru, g_lru, lru_conv_w, lru_conv_b, lru_wa, lru_ba, lru_wx, lru_bx, lru_lambda)
    y = jnp.concatenate([y_rw, y_s5, y_lru], axis=-1) @ w_out.astype(jnp.float32)
    h = h + y
    e = rmsnorm(p_i @ ple_w, ple_norm_g)
    return h + e * jax.nn.sigmoid(h @ ple_gate_w.astype(jnp.float32))


def setup_inputs(seed: int = 0) -> dict:
    key = jax.random.key(seed)
    ks = iter(jax.random.split(key, 48))
    f32 = jnp.float32
    L, W = DEPTH, BRANCH_W
    G, P, Hg = S5_GROUPS, S5_STATE, S5_GROUP
    NB, BD = LRU_BLOCKS, LRU_BLOCK_DIM

    def nrm(shape, scale):
        return scale * jax.random.normal(next(ks), shape, f32)

    def uni(shape, lo, hi):
        return jax.random.uniform(next(ks), shape, f32, lo, hi)

    x = nrm((BATCH, SEQ, D_MODEL), 1.0)
    p = nrm((DEPTH, BATCH, SEQ, D_PLE), 1.0)
    norm_g = 1.0 + nrm((L, D_MODEL), 0.02)
    w_in = nrm((L, D_MODEL, D_IN), D_MODEL ** -0.5)
    rwkv_mu = uni((L, RWKV_SHIFT_W), 0.0, 1.0)
    rwkv_w0 = uni((L, W), -4.0, 1.0)
    rwkv_w2 = nrm((L, DECAY_LORA, W), 0.1 * DECAY_LORA ** -0.5)
    rwkv_a0 = nrm((L, W), 0.1)
    rwkv_a2 = nrm((L, ICLR_LORA, W), 0.1 * ICLR_LORA ** -0.5)
    rwkv_k_k = 0.85 + nrm((L, W), 0.02)
    rwkv_k_a = 1.0 + nrm((L, W), 0.02)
    rwkv_r_k = nrm((L, RWKV_HEADS, RWKV_HEAD_DIM), 0.1)
    rwkv_ln_w = 1.0 + nrm((L, W), 0.02)
    rwkv_ln_b = nrm((L, W), 0.02)
    s5_a_re = -0.5 + nrm((L, G, P), 0.01)
    s5_a_im = math.pi * jnp.arange(P, dtype=f32) + nrm((L, G, P), 0.01)
    s5_log_dt = uni((L, G), math.log(1e-3), math.log(1e-1))
    s5_b_re = nrm((L, G, P, Hg), (2 * Hg) ** -0.5)
    s5_b_im = nrm((L, G, P, Hg), (2 * Hg) ** -0.5)
    s5_c_re = nrm((L, G, Hg, P), P ** -0.5)
    s5_c_im = nrm((L, G, Hg, P), P ** -0.5)
    s5_d = nrm((L, W), 1.0)
    s5_glu_w = nrm((L, W, W), W ** -0.5)
    s5_glu_b = nrm((L, W), 0.02)
    lru_conv_w = nrm((L, CONV_WIDTH, W), CONV_WIDTH ** -0.5)
    lru_conv_b = nrm((L, W), 0.02)
    lru_wa = nrm((L, NB, BD, BD), BD ** -0.5)
    lru_ba = nrm((L, W), 0.02)
    lru_wx = nrm((L, NB, BD, BD), BD ** -0.5)
    lru_bx = nrm((L, W), 0.02)
    a_c = uni((L, W), 0.9, 0.999) ** (1.0 / LRU_C)
    lru_lambda = jnp.log(a_c) - jnp.log1p(-a_c)
    w_out = nrm((L, D_MIX, D_MODEL), D_MIX ** -0.5)
    ple_w = nrm((L, D_PLE, D_MODEL), D_PLE ** -0.5)
    ple_norm_g = 1.0 + nrm((L, D_MODEL), 0.02)
    ple_gate_w = nrm((L, D_MODEL, D_MODEL), D_MODEL ** -0.5)
    final_norm_g = 1.0 + nrm((D_MODEL,), 0.02)
    return {"x": x, "p": p, "norm_g": norm_g, "w_in": w_in,
            "rwkv_mu": rwkv_mu, "rwkv_w0": rwkv_w0, "rwkv_w2": rwkv_w2, "rwkv_a0": rwkv_a0,
            "rwkv_a2": rwkv_a2, "rwkv_k_k": rwkv_k_k, "rwkv_k_a": rwkv_k_a, "rwkv_r_k": rwkv_r_k,
            "rwkv_ln_w": rwkv_ln_w, "rwkv_ln_b": rwkv_ln_b,
            "s5_a_re": s5_a_re, "s5_a_im": s5_a_im, "s5_log_dt": s5_log_dt,
            "s5_b_re": s5_b_re, "s5_b_im": s5_b_im, "s5_c_re": s5_c_re, "s5_c_im": s5_c_im,
            "s5_d": s5_d, "s5_glu_w": s5_glu_w, "s5_glu_b": s5_glu_b,
            "lru_conv_w": lru_conv_w, "lru_conv_b": lru_conv_b, "lru_wa": lru_wa, "lru_ba": lru_ba,
            "lru_wx": lru_wx, "lru_bx": lru_bx, "lru_lambda": lru_lambda,
            "w_out": w_out, "ple_w": ple_w, "ple_norm_g": ple_norm_g, "ple_gate_w": ple_gate_w,
            "final_norm_g": final_norm_g}


def reference(x, p, norm_g, w_in,
              rwkv_mu, rwkv_w0, rwkv_w2, rwkv_a0, rwkv_a2, rwkv_k_k, rwkv_k_a, rwkv_r_k, rwkv_ln_w, rwkv_ln_b,
              s5_a_re, s5_a_im, s5_log_dt, s5_b_re, s5_b_im, s5_c_re, s5_c_im, s5_d, s5_glu_w, s5_glu_b,
              lru_conv_w, lru_conv_b, lru_wa, lru_ba, lru_wx, lru_bx, lru_lambda,
              w_out, ple_w, ple_norm_g, ple_gate_w, final_norm_g):
    h = x.astype(jnp.float32)
    for i in range(DEPTH):
        h = hybrid_layer(h, p[i].astype(jnp.float32), norm_g[i], w_in[i],
                         rwkv_mu[i], rwkv_w0[i], rwkv_w2[i], rwkv_a0[i], rwkv_a2[i], rwkv_k_k[i],
                         rwkv_k_a[i], rwkv_r_k[i], rwkv_ln_w[i], rwkv_ln_b[i],
                         s5_a_re[i], s5_a_im[i], s5_log_dt[i], s5_b_re[i], s5_b_im[i], s5_c_re[i],
                         s5_c_im[i], s5_d[i], s5_glu_w[i], s5_glu_b[i],
                         lru_conv_w[i], lru_conv_b[i], lru_wa[i], lru_ba[i], lru_wx[i], lru_bx[i],
                         lru_lambda[i], w_out[i], ple_w[i], ple_norm_g[i], ple_gate_w[i])
    return rmsnorm(h, final_norm_g).astype(x.dtype)
```

```cpp
#include <hip/hip_runtime.h>
#include <hip/hip_cooperative_groups.h>
#include <cstdio>
namespace cg = cooperative_groups;

#ifndef MK_PER_PHASE
#define MK_PER_PHASE 0
#endif

#ifndef MK_PH_MASK
#define MK_PH_MASK 0x1fff
#endif
#ifndef MK_DUP
#define MK_DUP 0
#endif
#ifndef RW_OFF
#define RW_OFF 0
#endif
#ifndef MK_OFF
#define MK_OFF 0
#endif
#define LAS __attribute__((address_space(3)))
typedef unsigned short bf16_t;
typedef short bf16x8 __attribute__((ext_vector_type(8)));
typedef float f32x4 __attribute__((ext_vector_type(4)));
typedef unsigned u32x4 __attribute__((ext_vector_type(4)));
typedef unsigned u32x2 __attribute__((ext_vector_type(2)));

constexpr int T = 32768, D = 1024, SEQ = 8192, NB = 4, BW = 512;
constexpr int DIN = 4224, DINP = 4352, DMIX = 1536, DPLE = 256;
constexpr int ZRW_LD = 1792, G3_LD = 1536, AS_LD = 384, AS_ROWS = 65536;
constexpr int LDS_BYTES = 155648;

constexpr size_t al256(size_t x) { return (x + 255) & ~(size_t)255; }
constexpr size_t SZ_WIN = (size_t)2 * DINP * D * 2, SZ_WOUT = (size_t)2 * D * DMIX * 2, SZ_WG = (size_t)2 * D * D * 2, SZ_WPLE = (size_t)2 * D * DPLE * 2,
                 SZ_WGLU = (size_t)2 * BW * BW * 2, SZ_WLRU = (size_t)2 * 1024 * BW * 2, SZ_S5Y = (size_t)2 * 32 * 256 * AS_LD * 2, SZ_S5E = (size_t)2 * 32 * 256 * 256 * 2,
                 SZ_TBL = (size_t)2 * 32 * 64 * 18 * 8, SZ_PB = (size_t)2 * T * DPLE * 2, SZ_XN = (size_t)T * D * 2, SZ_ZRW = (size_t)T * ZRW_LD * 2, SZ_G3 = (size_t)T * G3_LD * 2,
                 SZ_XL = (size_t)T * BW * 2, SZ_AS = (size_t)AS_ROWS * AS_LD * 2, SZ_LRUAB = (size_t)T * 1024 * 2, SZ_AGG = (size_t)NB * 128 * 1024 * 4, SZ_SS = (size_t)4 * T * 4;
constexpr size_t OFF_WIN = 0, OFF_WOUT = OFF_WIN + SZ_WIN, OFF_WG = OFF_WOUT + SZ_WOUT, OFF_WPLE = OFF_WG + SZ_WG, OFF_WGLU = OFF_WPLE + SZ_WPLE, OFF_WLRU = OFF_WGLU + SZ_WGLU,
                 OFF_S5Y = OFF_WLRU + SZ_WLRU, OFF_S5E = OFF_S5Y + SZ_S5Y, OFF_TBL = OFF_S5E + SZ_S5E, OFF_PB = al256(OFF_TBL + SZ_TBL), OFF_XN = OFF_PB + SZ_PB,
                 OFF_ZRW = OFF_XN + SZ_XN, OFF_G3 = OFF_ZRW + SZ_ZRW, OFF_XL = OFF_G3 + SZ_G3, OFF_AS = OFF_XL + SZ_XL, OFF_LRUAB = OFF_AS + SZ_AS, OFF_AGG = OFF_LRUAB + SZ_LRUAB,
                 OFF_SS = OFF_AGG + SZ_AGG, WS_END = OFF_SS + SZ_SS;
constexpr size_t OFF_BAR = WS_END, CTL_BYTES = 256 + 96 * 256;
constexpr size_t RING_SLOTS = 3, SLOT_IMG = 4 * 18432, SLOT_BYTES = SLOT_IMG + 4 * 256 + 256;
constexpr size_t OFF_RING = OFF_BAR + CTL_BYTES, OFF_CBG = OFF_RING + 32 * RING_SLOTS * SLOT_BYTES, WS_END2 = OFF_CBG + (size_t)T * 8 * 4;
constexpr size_t OFF_E = OFF_XN, OFF_XC = OFF_XN + (size_t)AS_ROWS * 128 * 4, OFF_H1B = OFF_ZRW, OFF_PW = OFF_XN, OFF_ZGS = OFF_XL;
static_assert(OFF_XC + (size_t)T * BW * 2 <= OFF_ZRW, "alias overflow");

struct Params {
    const float* in[36];
    float* out;
    unsigned char* ws;
    int ph_lo, ph_hi;
};

__device__ __forceinline__ float bf2f(bf16_t v) { return __uint_as_float(((unsigned)v) << 16); }
__device__ __forceinline__ bf16_t f2bf_sw(float f) { unsigned u = __float_as_uint(f); u += 0x7FFFu + ((u >> 16) & 1u); return (bf16_t)(u >> 16); }
typedef float f32x2_ __attribute__((ext_vector_type(2)));
typedef __bf16 b16x2_ __attribute__((ext_vector_type(2)));
__device__ __forceinline__ unsigned cvt_pk_bf16(float lo, float hi) { const f32x2_ v = {lo, hi}; return __builtin_bit_cast(unsigned, __builtin_convertvector(v, b16x2_)); }
__device__ __forceinline__ bf16_t f2bf(float f) { return (bf16_t)cvt_pk_bf16(f, f); }
__device__ __forceinline__ float lo16(unsigned u) { return __uint_as_float(u << 16); }
__device__ __forceinline__ float hi16(unsigned u) { return __uint_as_float(u & 0xffff0000u); }
__device__ __forceinline__ float sigmoidf_(float x) { return __builtin_amdgcn_rcpf(1.0f + __expf(-x)); }
__device__ __forceinline__ float siluf_(float x) { return x * sigmoidf_(x); }
__device__ __forceinline__ float softplusf_(float x) { return fmaxf(x, 0.0f) + log1pf(__expf(-fabsf(x))); }
__device__ __forceinline__ float gelu_tanh(float x) { const float u2 = 1.5957691216057308f * (x + 0.044715f * x * x * x); return x * sigmoidf_(u2); }
__device__ __forceinline__ float wave_sum(float v) {
#pragma unroll
    for (int o = 32; o > 0; o >>= 1) v += __shfl_xor(v, o);
    return v;
}
__device__ __forceinline__ void unpack8(const u32x4 w, float (&f)[8]) {
    f[0] = lo16(w.x); f[1] = hi16(w.x); f[2] = lo16(w.y); f[3] = hi16(w.y); f[4] = lo16(w.z); f[5] = hi16(w.z); f[6] = lo16(w.w); f[7] = hi16(w.w);
}
__device__ __forceinline__ u32x4 pack8(const float (&f)[8]) {
    u32x4 w; w.x = cvt_pk_bf16(f[0], f[1]); w.y = cvt_pk_bf16(f[2], f[3]); w.z = cvt_pk_bf16(f[4], f[5]); w.w = cvt_pk_bf16(f[6], f[7]); return w;
}


__device__ __forceinline__ void grid_bar(unsigned* ctr, unsigned& target, unsigned nblk) {
    __syncthreads();
    if (threadIdx.x == 0) {
        target += nblk;
        __threadfence();
        __hip_atomic_fetch_add(ctr, 1u, __ATOMIC_RELAXED, __HIP_MEMORY_SCOPE_AGENT);
        while (__hip_atomic_load(ctr, __ATOMIC_RELAXED, __HIP_MEMORY_SCOPE_AGENT) < target) __builtin_amdgcn_s_sleep(1);
        __threadfence();
    }
    __syncthreads();
}

namespace pg8 {
constexpr int BM = 256, BK = 64, HALF = 128, HTB = HALF * BK * 2, STAGE_BYTES = 8 * HTB, NXCD = 8, WGM = 8;
__host__ __device__ __forceinline__ int lds_byte(int r, int c) { const int st = (r >> 4) * 2 + (c >> 5), rr = r & 15, cc = c & 31, ob = rr * 64 + cc * 2; return st * 1024 + (ob ^ (((ob >> 9) & 1) << 5)); }
__host__ __device__ __forceinline__ void stage_rc(int b, int& R, int& C) { const int st = b / 1024, sb = b % 1024, swz = sb ^ (((sb >> 9) & 1) << 5); R = (st >> 1) * 16 + swz / 64; C = (st & 1) * 32 + (swz % 64) / 2; }
__host__ __device__ __forceinline__ int perm32(int rho) { const int n = rho >> 4, i = rho & 15; return 8 * (i >> 2) + 4 * n + (i & 3); }

struct Unit { int pm, pn, pb; };
struct Gemm { const bf16_t* A; const bf16_t* Bt; int lda, ldb, K; };

struct Sched {
    int nM, nN, nwg, G, c, grp;
    __device__ void init(int M, int N, int G_, int c_, int grp_ = 0) { nM = M / BM; nN = N / BM; nwg = nM * nN; G = G_; c = c_; grp = grp_; }
    __device__ bool next(int i, Unit& u) const {
        const long L = (long)i * G + c; if (L >= nwg) return false;
        int wgid = (int)L; { const int q = nwg / NXCD, r = nwg % NXCD, xcd = wgid % NXCD, off = wgid / NXCD; wgid = (xcd < r ? xcd * (q + 1) : r * (q + 1) + (xcd - r) * q) + off; }
        const int nig = WGM * nN, gid = wgid / nig, fm = gid * WGM, gsz = (nM - fm) < WGM ? (nM - fm) : WGM;
        u.pm = fm + ((wgid % nig) % gsz); u.pn = (wgid % nig) / gsz; u.pb = grp ? (u.pm / grp) * nN + u.pn : u.pn; return true;
    }
};

template <class Epi>
__device__ __forceinline__ void gemm_phase(LAS unsigned char* lds, const Gemm g, const Sched& S, const Epi& E) {
    const int tid = threadIdx.x, wid = __builtin_amdgcn_readfirstlane(tid >> 6), lane = tid & 63, wr = wid >> 2, wc = wid & 3, fr = lane & 15, fq = lane >> 4;
    const int K = g.K, nt = K / BK;
    unsigned voffA[2], voffB[2];
#pragma unroll
    for (int i = 0; i < 2; ++i) { int R, C; stage_rc(tid * 16 + i * 8192, R, C); const int Rb = Epi::PERM ? ((R & ~31) + perm32(R & 31)) : R;
        voffA[i] = (unsigned)(R * g.lda + C) * 2u; voffB[i] = (unsigned)(Rb * g.ldb + C) * 2u; }
    const size_t kstep = (size_t)(BK * 2);
    const size_t hstepA = (size_t)HALF * g.lda * 2, hstepB = (size_t)HALF * g.ldb * 2;
    const size_t tstepA = 2 * hstepA, tstepB = 2 * hstepB;
    const unsigned ldsw = (unsigned)wid * 1024u;
    const int aoff = lds_byte(wr * 64 + fr, fq * 8), boff = lds_byte(wc * 32 + fr, fq * 8);
#define PG8_SA(b, h) (((b) * 2 + (h)) * HTB)
#define PG8_SB(b, h) ((4 + (b) * 2 + (h)) * HTB)
#define PG8_STAGE(bufoff, gbase, voff) do { _Pragma("unroll") for (int _i = 0; _i < 2; ++_i) \
        __builtin_amdgcn_global_load_lds((const unsigned*)((const char*)(gbase) + (voff)[_i]), (LAS unsigned*)(lds + (bufoff) + ldsw + _i * 8192), 16, 0, 0); } while (0)
#define PG8_LDA(dst, b, h) do { _Pragma("unroll") for (int m = 0; m < 4; ++m) _Pragma("unroll") for (int k = 0; k < 2; ++k) dst[m][k] = *(const LAS bf16x8*)(lds + PG8_SA(b, h) + aoff + m * 2048 + k * 1024); } while (0)
#define PG8_LDB(dst, b, h) do { _Pragma("unroll") for (int n = 0; n < 2; ++n) _Pragma("unroll") for (int k = 0; k < 2; ++k) dst[n][k] = *(const LAS bf16x8*)(lds + PG8_SB(b, h) + boff + n * 2048 + k * 1024); } while (0)
#define PG8_MMA(ai, bj, At, Bt) do { __builtin_amdgcn_s_setprio(1); _Pragma("unroll") for (int m = 0; m < 4; ++m) _Pragma("unroll") for (int n = 0; n < 2; ++n) _Pragma("unroll") for (int k = 0; k < 2; ++k) \
        acc[ai][bj][m][n] = __builtin_amdgcn_mfma_f32_16x16x32_bf16(Bt[n][k], At[m][k], acc[ai][bj][m][n], 0, 0, 0); __builtin_amdgcn_s_setprio(0); } while (0)
#define PG8_WAIT_V(n) asm volatile("s_waitcnt vmcnt(" #n ")" ::: "memory")
#define PG8_WAIT_L(n) asm volatile("s_waitcnt lgkmcnt(" #n ")" ::: "memory")
#define PG8_BAR __builtin_amdgcn_s_barrier()
#define PG8_SCHED __builtin_amdgcn_sched_barrier(0)
    Unit cur, nxt; int ui = 0;
    if (!S.next(0, cur)) return;
    f32x4 acc[2][2][4][2];
#pragma unroll
    for (int a = 0; a < 2; ++a)
#pragma unroll
        for (int b = 0; b < 2; ++b)
#pragma unroll
            for (int m = 0; m < 4; ++m)
#pragma unroll
                for (int n = 0; n < 2; ++n) acc[a][b][m][n] = (f32x4){0.f, 0.f, 0.f, 0.f};
    bf16x8 At[4][2], B0[2][2], B1[2][2];
    const char* cA = (const char*)g.A + (size_t)cur.pm * tstepA; const char* cB = (const char*)g.Bt + (size_t)cur.pb * tstepB;
    PG8_STAGE(PG8_SB(0, 0), cB, voffB); PG8_STAGE(PG8_SA(0, 0), cA, voffA); PG8_STAGE(PG8_SB(0, 1), cB + hstepB, voffB); PG8_STAGE(PG8_SA(0, 1), cA + hstepA, voffA);
    if (wr == 1) PG8_BAR;
    PG8_WAIT_V(4); PG8_BAR;
    PG8_STAGE(PG8_SB(1, 0), cB + kstep, voffB); PG8_STAGE(PG8_SA(1, 0), cA + kstep, voffA); PG8_STAGE(PG8_SB(1, 1), cB + hstepB + kstep, voffB);
    PG8_WAIT_V(6); PG8_BAR;
    for (;;) {
        const bool has_next = S.next(ui + 1, nxt);
        const char* nA = has_next ? (const char*)g.A + (size_t)nxt.pm * tstepA : cA; const char* nB = has_next ? (const char*)g.Bt + (size_t)nxt.pb * tstepB : cB;
#pragma unroll 1
        for (int t = 0; t < nt; t += 2) {
            const bool last = (t == nt - 2);
            const char* a1 = cA + (size_t)(t + 1) * kstep;
            const char* a2 = last ? nA : cA + (size_t)(t + 2) * kstep; const char* b2 = last ? nB : cB + (size_t)(t + 2) * kstep;
            const char* a3 = a2 + kstep; const char* b3 = b2 + kstep;
            PG8_LDB(B0, 0, 0); PG8_SCHED; PG8_LDA(At, 0, 0); PG8_STAGE(PG8_SA(1, 1), a1 + hstepA, voffA);
            PG8_WAIT_L(8); PG8_BAR; PG8_WAIT_L(0); PG8_MMA(0, 0, At, B0); PG8_BAR; PG8_SCHED;
            PG8_LDB(B1, 0, 1); PG8_STAGE(PG8_SB(0, 0), b2, voffB);
            PG8_BAR; PG8_WAIT_L(0); PG8_MMA(0, 1, At, B1); PG8_BAR;
            PG8_LDA(At, 0, 1); PG8_STAGE(PG8_SA(0, 0), a2, voffA);
            PG8_BAR; PG8_WAIT_L(0); PG8_MMA(1, 0, At, B0); PG8_BAR; PG8_SCHED;
            PG8_STAGE(PG8_SB(0, 1), b2 + hstepB, voffB);
            PG8_WAIT_V(6); PG8_BAR; PG8_MMA(1, 1, At, B1); PG8_BAR;
            PG8_LDB(B0, 1, 0); PG8_SCHED; PG8_LDA(At, 1, 0); PG8_STAGE(PG8_SA(0, 1), a2 + hstepA, voffA);
            PG8_WAIT_L(8); PG8_BAR; PG8_WAIT_L(0); PG8_MMA(0, 0, At, B0); PG8_BAR; PG8_SCHED;
            PG8_LDB(B1, 1, 1); PG8_STAGE(PG8_SB(1, 0), b3, voffB);
            PG8_BAR; PG8_WAIT_L(0); PG8_MMA(0, 1, At, B1); PG8_BAR;
            PG8_LDA(At, 1, 1); PG8_STAGE(PG8_SA(1, 0), a3, voffA);
            PG8_BAR; PG8_WAIT_L(0); PG8_MMA(1, 0, At, B0); PG8_BAR; PG8_SCHED;
            PG8_STAGE(PG8_SB(1, 1), b3 + hstepB, voffB);
            PG8_WAIT_V(6); PG8_BAR; PG8_MMA(1, 1, At, B1); PG8_BAR;
        }
        { int fr_ = fr, fq_ = fq; asm volatile("" : "+v"(fr_), "+v"(fq_)); E(acc, cur, wr, wc, fr_, fq_); }
        if (!has_next) break;
#pragma unroll
        for (int a = 0; a < 2; ++a)
#pragma unroll
            for (int b = 0; b < 2; ++b)
#pragma unroll
                for (int m = 0; m < 4; ++m)
#pragma unroll
                    for (int n = 0; n < 2; ++n) acc[a][b][m][n] = (f32x4){0.f, 0.f, 0.f, 0.f};
        cur = nxt; cA = nA; cB = nB; ++ui;
    }
    PG8_WAIT_V(0);
    if (wr == 0) PG8_BAR;
    PG8_BAR;
#undef PG8_SA
#undef PG8_SB
#undef PG8_STAGE
#undef PG8_LDA
#undef PG8_LDB
#undef PG8_MMA
#undef PG8_WAIT_V
#undef PG8_WAIT_L
#undef PG8_BAR
#undef PG8_SCHED
}
}
using pg8::Unit; using pg8::HALF;
typedef const f32x4 (&AccRef)[2][2][4][2];

struct EpiZ {
    static constexpr bool PERM = true;
    bf16_t *zrw, *g3, *xl, *as;
    __device__ __forceinline__ void operator()(AccRef acc, const Unit& u, int wr, int wc, int fr, int fq) const {
        const int row0 = u.pm * 256 + wr * 64 + fr, colt = wc * 32 + 8 * fq, pn = u.pn;
        if (pn == 9 || pn == 10) {
#pragma unroll
            for (int ai = 0; ai < 2; ++ai)
#pragma unroll
                for (int m = 0; m < 4; ++m) { const int row = row0 + ai * HALF + m * 16; const int b = row >> 13, l = row & 8191;
#pragma unroll
                    for (int bj = 0; bj < 2; ++bj) { const int c = (pn - 9) * 256 + bj * HALF + colt; const int g = c >> 4, h0 = c & 15;
                        const size_t asrow = (size_t)g * 2048 + b * 512 + (l >> 4);
                        const f32x4 v0 = acc[ai][bj][m][0], v1 = acc[ai][bj][m][1];
                        u32x4 w; w.x = cvt_pk_bf16(v0[0], v0[1]); w.y = cvt_pk_bf16(v0[2], v0[3]); w.z = cvt_pk_bf16(v1[0], v1[1]); w.w = cvt_pk_bf16(v1[2], v1[3]);
                        *(u32x4*)(as + asrow * AS_LD + (l & 15) * 16 + h0) = w; } }
            return;
        }
        bf16_t* base; int ld, c0;
        if (pn < 7) { base = zrw; ld = ZRW_LD; c0 = pn * 256; }
        else if (pn < 9) { base = g3; ld = G3_LD; c0 = (pn - 7) * 256; }
        else if (pn < 13) { base = g3; ld = G3_LD; c0 = 512 + (pn - 11) * 256; }
        else if (pn < 15) { base = xl; ld = BW; c0 = (pn - 13) * 256; }
        else { base = g3; ld = G3_LD; c0 = 1024 + (pn - 15) * 256; }
#pragma unroll
        for (int ai = 0; ai < 2; ++ai)
#pragma unroll
            for (int m = 0; m < 4; ++m) { bf16_t* rowp = base + (size_t)(row0 + ai * HALF + m * 16) * ld + c0 + colt;
#pragma unroll
                for (int bj = 0; bj < 2; ++bj) { const f32x4 v0 = acc[ai][bj][m][0], v1 = acc[ai][bj][m][1];
                    u32x4 w; w.x = cvt_pk_bf16(v0[0], v0[1]); w.y = cvt_pk_bf16(v0[2], v0[3]); w.z = cvt_pk_bf16(v1[0], v1[1]); w.w = cvt_pk_bf16(v1[2], v1[3]);
                    *(u32x4*)(rowp + bj * HALF) = w; } }
    }
};
struct EpiPle {
    static constexpr bool PERM = true;
    bf16_t* pw; float* ss;
    __device__ __forceinline__ void operator()(AccRef acc, const Unit& u, int wr, int wc, int fr, int fq) const {
        const int row0 = u.pm * 256 + wr * 64 + fr, col0 = u.pn * 256 + wc * 32 + 8 * fq;
#pragma unroll
        for (int ai = 0; ai < 2; ++ai)
#pragma unroll
            for (int m = 0; m < 4; ++m) { const int row = row0 + ai * HALF + m * 16; bf16_t* rowp = pw + (size_t)row * D + col0; float s = 0.f;
#pragma unroll
                for (int bj = 0; bj < 2; ++bj) { const f32x4 v0 = acc[ai][bj][m][0], v1 = acc[ai][bj][m][1];
                    s += v0[0] * v0[0] + v0[1] * v0[1] + v0[2] * v0[2] + v0[3] * v0[3] + v1[0] * v1[0] + v1[1] * v1[1] + v1[2] * v1[2] + v1[3] * v1[3];
                    u32x4 w; w.x = cvt_pk_bf16(v0[0], v0[1]); w.y = cvt_pk_bf16(v0[2], v0[3]); w.z = cvt_pk_bf16(v1[0], v1[1]); w.w = cvt_pk_bf16(v1[2], v1[3]);
                    *(u32x4*)(rowp + bj * HALF) = w; }
                s += __shfl_xor(s, 16); s += __shfl_xor(s, 32);
                if (fq == 0) unsafeAtomicAdd(ss + row, s);
                asm volatile("" ::: "memory"); }
    }
};
struct EpiE {
    static constexpr bool PERM = false;
    float* e;
    __device__ __forceinline__ void operator()(AccRef acc, const Unit& u, int wr, int wc, int fr, int fq) const {
        const int row0 = u.pm * 256 + wr * 64 + fr, col0 = wc * 32 + 4 * fq;
#pragma unroll
        for (int ai = 0; ai < 2; ++ai)
#pragma unroll
            for (int m = 0; m < 4; ++m) { float* rowp = e + (size_t)(row0 + ai * HALF + m * 16) * 128 + col0;
#pragma unroll
                for (int n = 0; n < 2; ++n) *(f32x4*)(rowp + n * 16) = acc[ai][0][m][n]; }
    }
};
struct EpiY {
    static constexpr bool PERM = true;
    const bf16_t* as; const float* dvec; bf16_t* zgs;
    __device__ __forceinline__ void operator()(AccRef acc, const Unit& u, int wr, int wc, int fr, int fq) const {
        const int row0 = u.pm * 256 + wr * 64 + fr, colt = wc * 32 + 8 * fq, g = u.pm >> 3, h0 = (8 * fq) & 15;
        const f32x4 d0 = *(const f32x4*)(dvec + g * 16 + h0), d1 = *(const f32x4*)(dvec + g * 16 + h0 + 4);
#pragma unroll
        for (int ai = 0; ai < 2; ++ai)
#pragma unroll
            for (int m = 0; m < 4; ++m) { const int row = row0 + ai * HALF + m * 16; const int b = (row >> 9) & 3, ch = row & 511;
#pragma unroll
                for (int bj = 0; bj < 2; ++bj) { const int c = bj * HALF + colt, tt = c >> 4;
                    float uu[8]; unpack8(*(const u32x4*)(as + (size_t)row * AS_LD + c), uu);
                    const f32x4 v0 = acc[ai][bj][m][0], v1 = acc[ai][bj][m][1];
                    float o[8];
#pragma unroll
                    for (int j = 0; j < 4; ++j) { o[j] = gelu_tanh(v0[j] + d0[j] * uu[j]); o[4 + j] = gelu_tanh(v1[j] + d1[j] * uu[4 + j]); }
                    const size_t tok = (size_t)b * SEQ + ch * 16 + tt;
                    *(u32x4*)(zgs + tok * BW + g * 16 + h0) = pack8(o); }
                asm volatile("" ::: "memory"); }
    }
};
struct EpiGlu {
    static constexpr bool PERM = true;
    const bf16_t* zgs; const float* bias; bf16_t* g3;
    __device__ __forceinline__ void operator()(AccRef acc, const Unit& u, int wr, int wc, int fr, int fq) const {
        const int row0 = u.pm * 256 + wr * 64 + fr, col0 = u.pn * 256 + wc * 32 + 8 * fq;
#pragma unroll
        for (int ai = 0; ai < 2; ++ai)
#pragma unroll
            for (int m = 0; m < 4; ++m) { const size_t row = (size_t)(row0 + ai * HALF + m * 16);
#pragma unroll
                for (int bj = 0; bj < 2; ++bj) { const int c = col0 + bj * HALF;
                    float z[8], gt[8]; unpack8(*(const u32x4*)(zgs + row * BW + c), z); bf16_t* gp = g3 + row * G3_LD + 512 + c; unpack8(*(const u32x4*)gp, gt);
                    const f32x4 b0 = *(const f32x4*)(bias + c), b1 = *(const f32x4*)(bias + c + 4);
                    const f32x4 v0 = acc[ai][bj][m][0], v1 = acc[ai][bj][m][1];
                    float o[8];
#pragma unroll
                    for (int j = 0; j < 4; ++j) { o[j] = z[j] * sigmoidf_(v0[j] + b0[j]) * siluf_(gt[j]); o[4 + j] = z[4 + j] * sigmoidf_(v1[j] + b1[j]) * siluf_(gt[4 + j]); }
                    *(u32x4*)gp = pack8(o); } }
    }
};
struct EpiLru {
    static constexpr bool PERM = true;
    const bf16_t* xc; const float *ba, *bx, *lam; bf16_t* ab;
    __device__ __forceinline__ void operator()(AccRef acc, const Unit& u, int wr, int wc, int fr, int fq) const {
        const int row0 = u.pm * 256 + wr * 64 + fr, ch = u.pn * 128 + wc * 32 + 8 * fq;
        float bav[8], bxv[8], spl[8];
#pragma unroll
        for (int j = 0; j < 8; ++j) { bav[j] = ba[ch + j]; bxv[j] = bx[ch + j]; spl[j] = -8.0f * softplusf_(-lam[ch + j]); }
#pragma unroll
        for (int ai = 0; ai < 2; ++ai)
#pragma unroll
            for (int m = 0; m < 4; ++m) { const size_t row = (size_t)(row0 + ai * HALF + m * 16);
                float x[8]; unpack8(*(const u32x4*)(xc + row * BW + ch), x);
                float la[8], bb[8];
#pragma unroll
                for (int j = 0; j < 8; ++j) { const float za = acc[ai][0][m][j >> 2][j & 3], zx = acc[ai][1][m][j >> 2][j & 3];
                    const float r = sigmoidf_(za + bav[j]), ig = sigmoidf_(zx + bxv[j]);
                    const float l_a = spl[j] * r; la[j] = l_a;
                    bb[j] = sqrtf(fmaxf(-expm1f(2.0f * l_a), 0.0f)) * (ig * x[j]); }
                *(u32x4*)(ab + row * 1024 + ch) = pack8(la); *(u32x4*)(ab + row * 1024 + 512 + ch) = pack8(bb); }
    }
};
struct EpiOut {
    static constexpr bool PERM = false;
    const float* hin; float* h; bf16_t* h1b;
    __device__ __forceinline__ void operator()(AccRef acc, const Unit& u, int wr, int wc, int fr, int fq) const {
        const int row0 = u.pm * 256 + wr * 64 + fr, col0 = u.pn * 256 + wc * 32 + 4 * fq;
#pragma unroll
        for (int ai = 0; ai < 2; ++ai)
#pragma unroll
            for (int m = 0; m < 4; ++m) { const size_t off = (size_t)(row0 + ai * HALF + m * 16) * D + col0;
#pragma unroll
                for (int bj = 0; bj < 2; ++bj)
#pragma unroll
                    for (int n = 0; n < 2; ++n) { const size_t o = off + bj * HALF + n * 16; const f32x4 v = *(const f32x4*)(hin + o) + acc[ai][bj][m][n];
                        *(f32x4*)(h + o) = v; u32x2 w; w.x = cvt_pk_bf16(v[0], v[1]); w.y = cvt_pk_bf16(v[2], v[3]); *(u32x2*)(h1b + o) = w; }
                asm volatile("" ::: "memory"); }
    }
};
struct EpiGate {
    static constexpr bool PERM = false;
    float* h; const bf16_t* pw; const float* ssp; const float* gple; float* ssh;
    __device__ __forceinline__ void operator()(AccRef acc, const Unit& u, int wr, int wc, int fr, int fq) const {
        const int row0 = u.pm * 256 + wr * 64 + fr, col0 = u.pn * 256 + wc * 32 + 4 * fq;
        f32x4 gv[2][2];
#pragma unroll
        for (int bj = 0; bj < 2; ++bj)
#pragma unroll
            for (int n = 0; n < 2; ++n) gv[bj][n] = *(const f32x4*)(gple + col0 + bj * HALF + n * 16);
#pragma unroll
        for (int ai = 0; ai < 2; ++ai)
#pragma unroll
            for (int m = 0; m < 4; ++m) { const int row = row0 + ai * HALF + m * 16; const size_t off = (size_t)row * D + col0;
                const float rs = rsqrtf(ssp[row] * (1.0f / 1024.0f) + 1e-6f); float s = 0.f;
#pragma unroll
                for (int bj = 0; bj < 2; ++bj)
#pragma unroll
                    for (int n = 0; n < 2; ++n) { const size_t o = off + bj * HALF + n * 16; const u32x2 pwv = *(const u32x2*)(pw + o); const f32x4 a = acc[ai][bj][m][n]; f32x4 v = *(const f32x4*)(h + o);
                        v[0] += lo16(pwv.x) * rs * gv[bj][n][0] * sigmoidf_(a[0]); v[1] += hi16(pwv.x) * rs * gv[bj][n][1] * sigmoidf_(a[1]);
                        v[2] += lo16(pwv.y) * rs * gv[bj][n][2] * sigmoidf_(a[2]); v[3] += hi16(pwv.y) * rs * gv[bj][n][3] * sigmoidf_(a[3]);
                        s += v[0] * v[0] + v[1] * v[1] + v[2] * v[2] + v[3] * v[3];
                        *(f32x4*)(h + o) = v; }
                s += __shfl_xor(s, 16); s += __shfl_xor(s, 32);
                if (fq == 0) unsafeAtomicAdd(ssh + row, s); }
    }
};

struct Ctx { const Params* P; unsigned char* ws; LAS unsigned char* lds; unsigned char* ldsg; int tid, lane, wave; size_t gtid, gsz; int vb, vG; };

template <class Map>
__device__ void transpose_w(const Ctx& c, const float* src, bf16_t* dst, int K, int Nsrc, int Npad, Map map) {
    const int K8 = K / 8; const size_t total = (size_t)2 * Npad * K8;
    for (size_t idx = c.gtid; idx < total; idx += c.gsz) {
        const int n = (int)(idx % Npad); const int k8 = (int)((idx / Npad) % K8); const int l = (int)(idx / ((size_t)Npad * K8));
        const int s = map(n); float f[8];
#pragma unroll
        for (int i = 0; i < 8; ++i) f[i] = (s >= 0) ? src[((size_t)l * K + k8 * 8 + i) * Nsrc + s] : 0.0f;
        *(u32x4*)(dst + ((size_t)l * Npad + n) * K + k8 * 8) = pack8(f);
    }
}

__device__ __forceinline__ void s5_lam_pow(const Params& P, int l, int g, int p, int n, float& re, float& im) {
    const float are = P.in[14][(l * 32 + g) * 64 + p], aim = P.in[15][(l * 32 + g) * 64 + p], dt = __expf(P.in[16][l * 32 + g]);
    const float mag = __expf(are * dt * (float)n);
    double rev = (double)aim * (double)dt * (double)n * 0.15915494309189535; rev -= rint(rev);
    const float ang = (float)(rev * 6.283185307179586);
    re = mag * cosf(ang); im = mag * sinf(ang);
}

__device__ void phase_prep(const Ctx& c) {
    const Params& P = *c.P; unsigned char* ws = c.ws;
    transpose_w(c, P.in[3], (bf16_t*)(ws + OFF_WIN), D, DIN, DINP, [](int n) { return n < 1664 ? n : (n < 1792 ? -1 : n - 128); });
    transpose_w(c, P.in[31], (bf16_t*)(ws + OFF_WOUT), DMIX, D, D, [](int n) { return n; });
    transpose_w(c, P.in[34], (bf16_t*)(ws + OFF_WG), D, D, D, [](int n) { return n; });
    transpose_w(c, P.in[32], (bf16_t*)(ws + OFF_WPLE), DPLE, D, D, [](int n) { return n; });
    transpose_w(c, P.in[22], (bf16_t*)(ws + OFF_WGLU), BW, BW, BW, [](int n) { return n; });
    { bf16_t* dst = (bf16_t*)(ws + OFF_WLRU);
      for (size_t idx = c.gtid; idx < (size_t)2 * 1024 * 64; idx += c.gsz) {
          const int n = (int)(idx & 1023), k8 = (int)((idx >> 10) & 63), l = (int)(idx >> 16);
          const int pn = n >> 8, rr = n & 255, ch = 128 * pn + (rr & 127), which = rr >> 7, hb = ch >> 6, j = ch & 63, k0 = k8 * 8;
          const float* W = which ? P.in[28] : P.in[26]; float f[8];
#pragma unroll
          for (int i = 0; i < 8; ++i) f[i] = ((k0 >> 6) == hb) ? W[(((size_t)l * 8 + hb) * 64 + (k0 & 63) + i) * 64 + j] : 0.0f;
          *(u32x4*)(dst + ((size_t)l * 1024 + n) * BW + k0) = pack8(f); } }
    { float* tbl = (float*)(ws + OFF_TBL);
      for (size_t idx = c.gtid; idx < (size_t)2 * 32 * 64 * 18; idx += c.gsz) {
          const int n = (int)(idx % 18), lgp = (int)(idx / 18), p = lgp & 63, g = (lgp >> 6) & 31, l = lgp >> 11; float re, im;
          if (n < 17) s5_lam_pow(P, l, g, p, n, re, im);
          else { float lr, li; s5_lam_pow(P, l, g, p, 1, lr, li); const float ar = P.in[14][(l * 32 + g) * 64 + p], ai = P.in[15][(l * 32 + g) * 64 + p];
                 const float cr = lr - 1.0f, ci = li, den = 1.0f / (ar * ar + ai * ai); re = (cr * ar + ci * ai) * den; im = (ci * ar - cr * ai) * den; }
          tbl[idx * 2] = re; tbl[idx * 2 + 1] = im; } }
    { const float* x = P.in[0]; const float* gg = P.in[2]; bf16_t* xn = (bf16_t*)(ws + OFF_XN);
      for (int row = blockIdx.x * 8 + c.wave; row < T; row += gridDim.x * 8) {
          f32x4 v[4]; float s = 0.f;
#pragma unroll
          for (int i = 0; i < 4; ++i) { v[i] = *(const f32x4*)(x + (size_t)row * D + i * 256 + c.lane * 4); s += v[i][0] * v[i][0] + v[i][1] * v[i][1] + v[i][2] * v[i][2] + v[i][3] * v[i][3]; }
          s = wave_sum(s); const float rs = rsqrtf(s * (1.0f / 1024.0f) + 1e-6f);
#pragma unroll
          for (int i = 0; i < 4; ++i) { const f32x4 gv = *(const f32x4*)(gg + i * 256 + c.lane * 4); u32x2 w; w.x = cvt_pk_bf16(v[i][0] * rs * gv[0], v[i][1] * rs * gv[1]); w.y = cvt_pk_bf16(v[i][2] * rs * gv[2], v[i][3] * rs * gv[3]);
              *(u32x2*)(xn + (size_t)row * D + i * 256 + c.lane * 4) = w; } } }
    { float* ss = (float*)(ws + OFF_SS); for (size_t i = c.gtid; i < (size_t)4 * T; i += c.gsz) ss[i] = 0.0f; }
    { const float* p = P.in[1]; bf16_t* pb = (bf16_t*)(ws + OFF_PB);
      for (size_t i = c.gtid; i < (size_t)2 * T * DPLE / 8; i += c.gsz) { const f32x4 a = *(const f32x4*)(p + i * 8), b = *(const f32x4*)(p + i * 8 + 4);
          u32x4 w; w.x = cvt_pk_bf16(a[0], a[1]); w.y = cvt_pk_bf16(a[2], a[3]); w.z = cvt_pk_bf16(b[0], b[1]); w.w = cvt_pk_bf16(b[2], b[3]); *(u32x4*)(pb + i * 8) = w; } }
}

__device__ void phase_s5_consts(const Ctx& c) {
    const Params& P = *c.P; unsigned char* ws = c.ws;
    const float* tbl = (const float*)(ws + OFF_TBL); bf16_t* by = (bf16_t*)(ws + OFF_S5Y); bf16_t* be = (bf16_t*)(ws + OFF_S5E);
    const float *bre = P.in[17], *bim = P.in[18], *cre = P.in[19], *cim = P.in[20];
    for (size_t idx = c.gtid; idx < (size_t)2 * 32 * 16 * 256; idx += c.gsz) {
        const int hp = (int)(idx & 15), h = (int)((idx >> 4) & 15), tau = (int)((idx >> 8) & 15), g = (int)((idx >> 12) & 31), l = (int)(idx >> 17);
        const int lg = l * 32 + g; float s = 0.f;
        for (int p = 0; p < 64; ++p) { const float* tp = tbl + ((size_t)(lg * 64 + p) * 18) * 2;
            const float pr = tp[tau * 2], pi = tp[tau * 2 + 1], qr = tp[34], qi = tp[35];
            const float br = bre[((size_t)lg * 64 + p) * 16 + hp], bi = bim[((size_t)lg * 64 + p) * 16 + hp];
            const float bbr = qr * br - qi * bi, bbi = qr * bi + qi * br;
            const float zr = pr * bbr - pi * bbi, zi = pr * bbi + pi * bbr;
            const float cr = cre[((size_t)lg * 16 + h) * 64 + p], ci = cim[((size_t)lg * 16 + h) * 64 + p];
            s += cr * zr - ci * zi; }
        const bf16_t kv = f2bf(s); bf16_t* base = by + (size_t)lg * 256 * AS_LD;
        for (int s0 = 0; s0 + tau < 16; ++s0) { const int t = s0 + tau;
            base[(size_t)(t * 16 + h) * AS_LD + s0 * 16 + hp] = kv;
            if (tau > 0) base[(size_t)(s0 * 16 + h) * AS_LD + t * 16 + hp] = 0; }
    }
    for (size_t idx = c.gtid; idx < (size_t)2 * 32 * 256 * 64; idx += c.gsz) {
        const int p = (int)(idx & 63), th = (int)((idx >> 6) & 255), lg = (int)(idx >> 14); const int t = th >> 4, h = th & 15;
        const float* tp = tbl + ((size_t)(lg * 64 + p) * 18) * 2; const float pr = tp[(t + 1) * 2], pi = tp[(t + 1) * 2 + 1];
        const float cr = cre[((size_t)lg * 16 + h) * 64 + p], ci = cim[((size_t)lg * 16 + h) * 64 + p];
        bf16_t* rowp = by + ((size_t)lg * 256 + th) * AS_LD; rowp[256 + p] = f2bf(cr * pr - ci * pi); rowp[320 + p] = f2bf(-(cr * pi + ci * pr));
    }
    for (size_t idx = c.gtid; idx < (size_t)2 * 32 * 256 * 256; idx += c.gsz) {
        const int col = (int)(idx & 255), n = (int)((idx >> 8) & 255), lg = (int)(idx >> 16); float v = 0.f;
        if (n < 128) { const int p = n & 63, s0 = col >> 4, hp = col & 15; const float* tp = tbl + ((size_t)(lg * 64 + p) * 18) * 2;
            const float pr = tp[(15 - s0) * 2], pi = tp[(15 - s0) * 2 + 1], qr = tp[34], qi = tp[35];
            const float br = bre[((size_t)lg * 64 + p) * 16 + hp], bi = bim[((size_t)lg * 64 + p) * 16 + hp];
            const float bbr = qr * br - qi * bi, bbi = qr * bi + qi * br;
            v = (n < 64) ? (pr * bbr - pi * bbi) : (pr * bbi + pi * bbr); }
        be[idx] = f2bf(v);
    }
}

__device__ void phase_lru_conv(const Ctx& c, int l) {
    const Params& P = *c.P; const bf16_t* xl = (const bf16_t*)(c.ws + OFF_XL); bf16_t* xc = (bf16_t*)(c.ws + OFF_XC);
    const float* cw = P.in[24] + (size_t)l * 4 * BW; const float* cb = P.in[25] + (size_t)l * BW;
    for (size_t idx = (size_t)c.vb * 512 + c.tid; idx < (size_t)T * 64; idx += (size_t)c.vG * 512) {
        const int c8 = (int)(idx & 63) * 8; const int row = (int)(idx >> 6), lpos = row & (SEQ - 1);
        float o[8];
#pragma unroll
        for (int i = 0; i < 8; ++i) o[i] = cb[c8 + i];
#pragma unroll
        for (int j = 0; j < 4; ++j) { if (lpos - 3 + j >= 0) { float x[8]; unpack8(*(const u32x4*)(xl + (size_t)(row - 3 + j) * BW + c8), x);
#pragma unroll
                for (int i = 0; i < 8; ++i) o[i] += x[i] * cw[j * BW + c8 + i]; } }
        *(u32x4*)(xc + (size_t)row * BW + c8) = pack8(o);
    }
}

__device__ void phase_s5_carry(const Ctx& c, int l) {
    if (c.wave != 0 || c.vb >= 128) return;
    const int g = c.vb >> 2, b = c.vb & 3, p = c.lane;
    float lr, li; s5_lam_pow(*c.P, l, g, p, 16, lr, li);
    const float* e = (const float*)(c.ws + OFF_E); bf16_t* as = (bf16_t*)(c.ws + OFF_AS);
    const size_t base = (size_t)g * 2048 + b * 512; float xr = 0.f, xi = 0.f;
    for (int c0 = 0; c0 < 512; c0 += 32) {
        float er[32], ei[32];
#pragma unroll
        for (int i = 0; i < 32; ++i) { er[i] = e[(base + c0 + i) * 128 + p]; ei[i] = e[(base + c0 + i) * 128 + 64 + p]; }
#pragma unroll
        for (int i = 0; i < 32; ++i) { bf16_t* rowp = as + (base + c0 + i) * AS_LD; rowp[256 + p] = f2bf(xr); rowp[320 + p] = f2bf(xi);
            const float nr = lr * xr - li * xi + er[i], ni = lr * xi + li * xr + ei[i]; xr = nr; xi = ni; }
    }
}

__device__ void phase_lru_scan(const Ctx& c, int pass) {
    const bf16_t* ab = (const bf16_t*)(c.ws + OFF_LRUAB); float* agg = (float*)(c.ws + OFF_AGG); bf16_t* g3 = (bf16_t*)(c.ws + OFF_G3);
    const int ch = c.tid;
    for (int unit = c.vb; unit < NB * 128; unit += c.vG) {
        const int b = unit >> 7, ck = unit & 127; const size_t t0 = (size_t)b * SEQ + ck * 64;
        float h = 0.f, sl = 0.f;
        if (pass == 1) {
            for (int i0 = 0; i0 < ck; i0 += 16) { float sl_[16], he_[16];
#pragma unroll
                for (int j = 0; j < 16; ++j) { const int ii = (i0 + j < ck) ? i0 + j : ck - 1; const float* a = agg + ((size_t)(b * 128 + ii)) * 1024; sl_[j] = a[ch]; he_[j] = a[512 + ch]; }
#pragma unroll
                for (int j = 0; j < 16; ++j) if (i0 + j < ck) h = __expf(sl_[j]) * h + he_[j]; }
        }
        for (int t8 = 0; t8 < 64; t8 += 16) {
            float la[16], bb[16], gt[16];
#pragma unroll
            for (int i = 0; i < 16; ++i) { la[i] = bf2f(ab[(t0 + t8 + i) * 1024 + ch]); bb[i] = bf2f(ab[(t0 + t8 + i) * 1024 + 512 + ch]); if (pass == 1) gt[i] = bf2f(g3[(t0 + t8 + i) * G3_LD + 1024 + ch]); }
#pragma unroll
            for (int i = 0; i < 16; ++i) { h = __expf(la[i]) * h + bb[i]; sl += la[i];
                if (pass == 1) g3[(t0 + t8 + i) * G3_LD + 1024 + ch] = f2bf(h * siluf_(gt[i])); }
        }
        if (pass == 0) { float* a = agg + ((size_t)(b * 128 + ck)) * 1024; a[ch] = sl; a[512 + ch] = h; }
    }
}

__device__ void phase_norm(const Ctx& c, const float* ss, const float* gg, int fin) {
    float* h = c.P->out; bf16_t* xn = (bf16_t*)(c.ws + OFF_XN);
    for (int row = blockIdx.x * 8 + c.wave; row < T; row += gridDim.x * 8) {
        const float rs = rsqrtf(ss[row] * (1.0f / 1024.0f) + 1e-6f);
#pragma unroll
        for (int i = 0; i < 4; ++i) { const size_t o = (size_t)row * D + i * 256 + c.lane * 4; const f32x4 v = *(const f32x4*)(h + o); const f32x4 gv = *(const f32x4*)(gg + i * 256 + c.lane * 4);
            const f32x4 r = v * rs * gv;
            if (fin) *(f32x4*)(h + o) = r; else { u32x2 w; w.x = cvt_pk_bf16(r[0], r[1]); w.y = cvt_pk_bf16(r[2], r[3]); *(u32x2*)(xn + o) = w; } }
    }
}

typedef float f32x2 __attribute__((ext_vector_type(2)));
template <int CTRL> __device__ __forceinline__ float dpp_mov(float v) { return __builtin_bit_cast(float, __builtin_amdgcn_update_dpp(0, __builtin_bit_cast(int, v), CTRL, 0xf, 0xf, true)); }
__device__ __forceinline__ float row16_sum(float v) { v += dpp_mov<0xB1>(v); v += dpp_mov<0x4E>(v); v += dpp_mov<0x124>(v); v += dpp_mov<0x128>(v); return v; }
__device__ __forceinline__ float wave_sum2(float v) { v = row16_sum(v); const int vi = __builtin_bit_cast(int, v); const float a = __builtin_bit_cast(float, __builtin_amdgcn_readlane(vi, 0)), b = __builtin_bit_cast(float, __builtin_amdgcn_readlane(vi, 16)), c2 = __builtin_bit_cast(float, __builtin_amdgcn_readlane(vi, 32)), d = __builtin_bit_cast(float, __builtin_amdgcn_readlane(vi, 48)); return (a + b) + (c2 + d); }
__device__ __forceinline__ float oct_sum(float v) { v += dpp_mov<0xB1>(v); v += dpp_mov<0x4E>(v); v += dpp_mov<0x141>(v); return v; }
constexpr int RW_NBLK = 128, TWS = 72;

struct RwRows { unsigned zr[5], zk[5], zv[5], zw[5], za[5]; };
__device__ __forceinline__ float rw_get(const unsigned (&a)[5], int i) { return (i & 1) ? hi16(a[i >> 1]) : lo16(a[i >> 1]); }
__device__ __forceinline__ void rw_load_rows(RwRows& R, const bf16_t* zrw, int b, int blk, int w, int lane, int cj) {
#pragma unroll
    for (int p = 0; p < 5; ++p) { unsigned r_[2] = {0, 0}, k_[2] = {0, 0}, v_[2] = {0, 0}, w_[2] = {0, 0}, a_[2] = {0, 0};
#pragma unroll
        for (int h = 0; h < 2; ++h) { const int i = 2 * p + h; if (i < 9) { const int lp = blk * 64 + w * 8 - 1 + i; const bool ok = lp >= 0; const bf16_t* rp = zrw + ((size_t)b * SEQ + (ok ? lp : 0)) * ZRW_LD;
            const unsigned m = ok ? 0xffffu : 0u;
            r_[h] = rp[cj] & m; k_[h] = rp[512 + cj] & m; v_[h] = rp[1024 + cj] & m; w_[h] = rp[1536 + lane] & m; a_[h] = rp[1600 + lane] & m; } }
        R.zr[p] = r_[0] | (r_[1] << 16); R.zk[p] = k_[0] | (k_[1] << 16); R.zv[p] = v_[0] | (v_[1] << 16); R.zw[p] = w_[0] | (w_[1] << 16); R.za[p] = a_[0] | (a_[1] << 16); }
}

constexpr int CH_AT = 0, CH_RT = 2304, CH_KT = 4608, CH_BT = 6912, CH_KH = 9216, CH_NB = 12288, CH_VT = 15360, CH_LRK = 18432, CH_NLRB = 19200, CH_GI = 19968,
              CH_LAB = 20736, CH_LAK = 21760, CH_GC = 22784, CH_BYTES = 23040;
constexpr int RW_YY = 4 * CH_BYTES, RW_TW = RW_YY + 16384, RW_AD = RW_TW + 64 * TWS * 2, RW_AR = RW_TW  , RW_GP = RW_AD + 64 * TWS * 2,
              RW_W2 = RW_GP + 2048, RW_A2 = RW_W2 + 64 * TWS * 2, RW_CT = RW_A2 + 64 * TWS * 2, RW_END = RW_CT + 12 * 64 * 4;
static_assert(RW_END <= LDS_BYTES, "rwkv lds");
__device__ __forceinline__ void lds_barrier() { asm volatile("s_waitcnt lgkmcnt(0)\n\ts_barrier" ::: "memory"); }
typedef short bf16x4 __attribute__((ext_vector_type(4)));
__device__ __forceinline__ bf16x8 cat4(bf16x4 lo, bf16x4 hi) { return __builtin_shufflevector(lo, hi, 0, 1, 2, 3, 4, 5, 6, 7); }
__device__ __forceinline__ bf16x8 cat4z(bf16x4 lo) { const bf16x4 z = {0, 0, 0, 0}; return __builtin_shufflevector(lo, z, 0, 1, 2, 3, 4, 5, 6, 7); }
__device__ __forceinline__ bf16x4 pk4(f32x4 v) { u32x2 w; w.x = cvt_pk_bf16(v[0], v[1]); w.y = cvt_pk_bf16(v[2], v[3]); return __builtin_bit_cast(bf16x4, w); }

__device__ void phase_rwkv(const Ctx& c, int l, int blk_lo, int blk_hi, bool dry = false) {
    if (blockIdx.x >= 32) return;
    const Params& P = *c.P; const int b = blockIdx.x >> 3, hd = blockIdx.x & 7, lane = c.lane, w = c.wave, cj = hd * 64 + lane, fr = lane & 15, fq = lane >> 4;
    LAS unsigned char* LB = c.lds;
    LAS float* YY = (LAS float*)(LB + RW_YY); LAS float* WR = YY; LAS float* AR = (LAS float*)(LB + RW_AR); LAS float* GP = (LAS float*)(LB + RW_GP);
    LAS bf16_t* TWb = (LAS bf16_t*)(LB + RW_TW); LAS bf16_t* ADb = (LAS bf16_t*)(LB + RW_AD);
    const bf16_t* zrw = (const bf16_t*)(c.ws + OFF_ZRW); bf16_t* g3 = (bf16_t*)(c.ws + OFF_G3);
    LAS float* CT = (LAS float*)(LB + RW_CT);
    if (c.tid < 64) { const float* mu = P.in[4] + (size_t)l * 1664; const int j = hd * 64 + c.tid;
        CT[0 * 64 + c.tid] = mu[j]; CT[1 * 64 + c.tid] = mu[512 + j]; CT[2 * 64 + c.tid] = mu[1024 + j]; CT[3 * 64 + c.tid] = mu[1536 + c.tid]; CT[4 * 64 + c.tid] = mu[1600 + c.tid];
        CT[5 * 64 + c.tid] = P.in[5][l * BW + j]; CT[6 * 64 + c.tid] = P.in[7][l * BW + j]; CT[7 * 64 + c.tid] = P.in[9][l * BW + j]; CT[8 * 64 + c.tid] = P.in[10][l * BW + j];
        CT[9 * 64 + c.tid] = P.in[11][l * BW + j]; CT[10 * 64 + c.tid] = P.in[12][l * BW + j]; CT[11 * 64 + c.tid] = P.in[13][l * BW + j]; }
    const int mt_ = w >> 1, nh = w & 1;
    LAS bf16_t* W2I = (LAS bf16_t*)(LB + RW_W2); LAS bf16_t* A2I = (LAS bf16_t*)(LB + RW_A2);
    for (int i = c.tid; i < 4096; i += 512) { const int k = i >> 6, j = i & 63; W2I[j * TWS + k] = f2bf(P.in[6][((size_t)l * 64 + k) * BW + hd * 64 + j]); A2I[j * TWS + k] = f2bf(P.in[8][((size_t)l * 64 + k) * BW + hd * 64 + j]); }
    __syncthreads();
    f32x4 Macc[4];
#pragma unroll
    for (int i = 0; i < 4; ++i) Macc[i] = (f32x4){0.f, 0.f, 0.f, 0.f};
    const int cc = w >> 1, hc = w & 1;
    RwRows cur;
    rw_load_rows(cur, zrw, b, blk_lo, w, lane, cj);
    for (int blk = blk_lo; blk < blk_hi; ++blk) {
        const size_t t0 = (size_t)b * SEQ + blk * 64;
        float rs[8], ks_[8], vs[8];
        const float mu_r = CT[lane], mu_k = CT[64 + lane], mu_v = CT[128 + lane], mu_w = CT[192 + lane], mu_a = CT[256 + lane];
#pragma unroll
        for (int i = 0; i < 8; ++i) { const int tok = w * 8 + i;
            { const float r0 = rw_get(cur.zr, i), r1 = rw_get(cur.zr, i + 1), k0 = rw_get(cur.zk, i), k1 = rw_get(cur.zk, i + 1), v0 = rw_get(cur.zv, i), v1 = rw_get(cur.zv, i + 1);
              rs[i] = r1 + mu_r * (r0 - r1); ks_[i] = k1 + mu_k * (k0 - k1); vs[i] = v1 + mu_v * (v0 - v1); }
            const float w0_ = rw_get(cur.zw, i), w1_ = rw_get(cur.zw, i + 1), a0_ = rw_get(cur.za, i), a1_ = rw_get(cur.za, i + 1);
            const float wds = w1_ + mu_w * (w0_ - w1_), ads = a1_ + mu_a * (a0_ - a1_);
            const float e2 = __expf(2.0f * wds); const float th = 1.0f - 2.0f * __builtin_amdgcn_rcpf(e2 + 1.0f);
            TWb[tok * TWS + lane] = f2bf(th); ADb[tok * TWS + lane] = f2bf(ads); }
        if (blk + 1 < RW_NBLK) rw_load_rows(cur, zrw, b, blk + 1, w, lane, cj);
        unsigned gtp[4];
#pragma unroll
        for (int i = 0; i < 4; ++i) gtp[i] = (unsigned)g3[(t0 + w * 8 + 2 * i) * G3_LD + cj] | ((unsigned)g3[(t0 + w * 8 + 2 * i + 1) * G3_LD + cj] << 16);
        lds_barrier();
        { bf16x8 atw[2], aad[2];
#pragma unroll
          for (int ks = 0; ks < 2; ++ks) { atw[ks] = *(const LAS bf16x8*)(TWb + (16 * mt_ + fr) * TWS + 32 * ks + 8 * fq); aad[ks] = *(const LAS bf16x8*)(ADb + (16 * mt_ + fr) * TWS + 32 * ks + 8 * fq); }
          f32x4 cw[2], ca[2];
#pragma unroll
          for (int n2 = 0; n2 < 2; ++n2) { cw[n2] = (f32x4){0.f, 0.f, 0.f, 0.f}; ca[n2] = cw[n2];
#pragma unroll
              for (int ks = 0; ks < 2; ++ks) { const int bo = (32 * nh + 16 * n2 + fr) * TWS + 32 * ks + 8 * fq;
                  cw[n2] = __builtin_amdgcn_mfma_f32_16x16x32_bf16(atw[ks], *(const LAS bf16x8*)(W2I + bo), cw[n2], 0, 0, 0); ca[n2] = __builtin_amdgcn_mfma_f32_16x16x32_bf16(aad[ks], *(const LAS bf16x8*)(A2I + bo), ca[n2], 0, 0, 0); } }
          lds_barrier();
#pragma unroll
          for (int n2 = 0; n2 < 2; ++n2)
#pragma unroll
              for (int r = 0; r < 4; ++r) { const int o = (16 * mt_ + 4 * fq + r) * 64 + 32 * nh + 16 * n2 + fr; WR[o] = cw[n2][r]; AR[o] = ca[n2][r]; } }
        lds_barrier();
        float kkv[8], kpv[8], bbv[8], gl[8], cbv[8];
        { float g = 1.0f; const float w0j = CT[320 + lane], a0j = CT[384 + lane], kkj = CT[448 + lane], kaj = CT[512 + lane], rkj = CT[576 + lane];
#pragma unroll
          for (int i = 0; i < 8; ++i) { const int o = (w * 8 + i) * 64 + lane;
            const float wraw = w0j + WR[o], araw = a0j + AR[o];
            const float d = __expf(-0.6065306597126334f * sigmoidf_(wraw)), a = sigmoidf_(araw);
            float kk = ks_[i] * kkj; const float n2 = wave_sum2(kk * kk); kk = kk * __builtin_amdgcn_rsqf(fmaxf(n2, 1e-24f));
            const float kp = ks_[i] * (1.0f + (a - 1.0f) * kaj);
            cbv[i] = wave_sum2(rs[i] * kp * rkj);
            g *= d; gl[i] = g; kkv[i] = kk; kpv[i] = kp; bbv[i] = kk * a; }
          GP[w * 64 + lane] = g; }
        lds_barrier();
        { LAS unsigned char* CB_ = LB + cc * CH_BYTES;
          LAS bf16_t *AT = (LAS bf16_t*)(CB_ + CH_AT), *RT = (LAS bf16_t*)(CB_ + CH_RT), *KT = (LAS bf16_t*)(CB_ + CH_KT), *BT = (LAS bf16_t*)(CB_ + CH_BT),
                     *KH = (LAS bf16_t*)(CB_ + CH_KH), *NBH = (LAS bf16_t*)(CB_ + CH_NB), *VT = (LAS bf16_t*)(CB_ + CH_VT);
          const float g0 = GP[(2 * cc) * 64 + lane], g1 = GP[(2 * cc + 1) * 64 + lane], gC = g0 * g1, pre = hc ? g0 : 1.0f;
          if (hc == 0) ((LAS float*)(CB_ + CH_GC))[lane] = gC;
#pragma unroll
          for (int i = 0; i < 8; ++i) { const int tl = 8 * hc + i;
            const float gam = pre * gl[i], gprev = (i == 0) ? pre : pre * gl[i - 1], ig = __builtin_amdgcn_rcpf(gam), gr = gC * ig;
            AT[tl * TWS + lane] = f2bf(kkv[i] * gprev); RT[tl * TWS + lane] = f2bf(rs[i] * gam); KT[tl * TWS + lane] = f2bf(kpv[i] * ig); BT[tl * TWS + lane] = f2bf(bbv[i] * ig);
            KH[lane * 24 + tl] = f2bf(kpv[i] * gr); NBH[lane * 24 + tl] = f2bf(-bbv[i] * gr); VT[lane * 24 + tl] = f2bf(vs[i]); } }
        lds_barrier();
        if (w < 4 && !(RW_OFF & 4)) { LAS unsigned char* CB_ = LB + w * CH_BYTES;
          const LAS bf16_t *AT = (const LAS bf16_t*)(CB_ + CH_AT), *RT = (const LAS bf16_t*)(CB_ + CH_RT), *KT = (const LAS bf16_t*)(CB_ + CH_KT), *BT = (const LAS bf16_t*)(CB_ + CH_BT);
          f32x4 lab = (f32x4){0.f, 0.f, 0.f, 0.f}, lak = lab, lrk = lab, lrb = lab;
#pragma unroll
          for (int ks = 0; ks < 2; ++ks) { const int o = fr * TWS + 32 * ks + 8 * fq;
            const bf16x8 af = *(const LAS bf16x8*)(AT + o), rf = *(const LAS bf16x8*)(RT + o), kf = *(const LAS bf16x8*)(KT + o), bf = *(const LAS bf16x8*)(BT + o);
            lab = __builtin_amdgcn_mfma_f32_16x16x32_bf16(af, bf, lab, 0, 0, 0); lak = __builtin_amdgcn_mfma_f32_16x16x32_bf16(af, kf, lak, 0, 0, 0);
            lrk = __builtin_amdgcn_mfma_f32_16x16x32_bf16(rf, kf, lrk, 0, 0, 0); lrb = __builtin_amdgcn_mfma_f32_16x16x32_bf16(rf, bf, lrb, 0, 0, 0); }
          LAS float *LAB = (LAS float*)(CB_ + CH_LAB), *LAK = (LAS float*)(CB_ + CH_LAK); LAS bf16_t *LRK = (LAS bf16_t*)(CB_ + CH_LRK), *NLRB = (LAS bf16_t*)(CB_ + CH_NLRB);
#pragma unroll
          for (int r = 0; r < 4; ++r) { const int t = 4 * fq + r, s_ = fr; const bool lo_ = t > s_, le_ = t >= s_;
            LAB[t * 16 + s_] = lo_ ? lab[r] : 0.0f; LAK[t * 16 + s_] = lo_ ? lak[r] : 0.0f;
            LRK[t * 24 + s_] = f2bf(le_ ? lrk[r] : 0.0f); NLRB[t * 24 + s_] = f2bf(le_ ? -lrb[r] : 0.0f); } }
        lds_barrier();
        { const int ch6 = w & 3; LAS unsigned char* CB_ = LB + ch6 * CH_BYTES;
          const LAS bf16_t* AT = (const LAS bf16_t*)(CB_ + CH_AT); const LAS float *LAB = (const LAS float*)(CB_ + CH_LAB), *LAK = (const LAS float*)(CB_ + CH_LAK);
          LAS bf16_t *WI = (LAS bf16_t*)(CB_ + CH_KT), *GI = (LAS bf16_t*)(CB_ + CH_GI);
          float xv[16];
          if (w < 4) {
#pragma unroll
            for (int t = 0; t < 16; ++t) xv[t] = bf2f(AT[t * TWS + lane]);
          } else {
#pragma unroll
            for (int t = 0; t < 16; ++t) xv[t] = LAK[t * 16 + fr];
          }
#pragma unroll
          for (int t = 1; t < 16; ++t) { float xa = xv[t];
#pragma unroll
            for (int q = 0; q < 4; ++q) if (4 * q < t) { const f32x4 lr = *(const LAS f32x4*)(LAB + t * 16 + 4 * q);
#pragma unroll
              for (int e = 0; e < 4; ++e) if (4 * q + e < t) xa -= lr[e] * xv[4 * q + e]; }
            xv[t] = xa; asm volatile("" : "+v"(xv[t]) :: "memory"); }
          if (w < 4) {
#pragma unroll
            for (int t = 0; t < 16; ++t) WI[t * TWS + lane] = f2bf(xv[t]);
          } else if (lane < 16) {
#pragma unroll
            for (int t = 0; t < 16; ++t) GI[t * 24 + lane] = f2bf(xv[t]);
          } }
        lds_barrier();
        if (w < 4 && !(RW_OFF & 2)) {
#pragma unroll 1
          for (int ch = 0; ch < 4; ++ch) { LAS unsigned char* CB_ = LB + ch * CH_BYTES;
            const LAS bf16_t *RT = (const LAS bf16_t*)(CB_ + CH_RT), *WI = (const LAS bf16_t*)(CB_ + CH_KT), *KH = (const LAS bf16_t*)(CB_ + CH_KH), *NBH = (const LAS bf16_t*)(CB_ + CH_NB),
                             *VT = (const LAS bf16_t*)(CB_ + CH_VT), *LRK = (const LAS bf16_t*)(CB_ + CH_LRK), *NLRB = (const LAS bf16_t*)(CB_ + CH_NLRB), *GI = (const LAS bf16_t*)(CB_ + CH_GI);
            const LAS float* GC = (const LAS float*)(CB_ + CH_GC);
            bf16x8 Mb[2], Wp[2], Rp[2];
#pragma unroll
            for (int ks = 0; ks < 2; ++ks) { Mb[ks] = cat4(pk4(Macc[2 * ks]), pk4(Macc[2 * ks + 1]));
              Wp[ks] = cat4(*(const LAS bf16x4*)(WI + fr * TWS + 32 * ks + 4 * fq), *(const LAS bf16x4*)(WI + fr * TWS + 32 * ks + 16 + 4 * fq));
              Rp[ks] = cat4(*(const LAS bf16x4*)(RT + fr * TWS + 32 * ks + 4 * fq), *(const LAS bf16x4*)(RT + fr * TWS + 32 * ks + 16 + 4 * fq)); }
            const bf16x8 Vb = cat4z(*(const LAS bf16x4*)(VT + (16 * w + fr) * 24 + 4 * fq));
            const bf16x8 Gp = cat4z(*(const LAS bf16x4*)(GI + fr * 24 + 4 * fq)), Lrkp = cat4z(*(const LAS bf16x4*)(LRK + fr * 24 + 4 * fq)), Nlrbp = cat4z(*(const LAS bf16x4*)(NLRB + fr * 24 + 4 * fq));
            f32x4 U = (f32x4){0.f, 0.f, 0.f, 0.f};
            U = __builtin_amdgcn_mfma_f32_16x16x32_bf16(Wp[0], Mb[0], U, 0, 0, 0); U = __builtin_amdgcn_mfma_f32_16x16x32_bf16(Wp[1], Mb[1], U, 0, 0, 0); U = __builtin_amdgcn_mfma_f32_16x16x32_bf16(Gp, Vb, U, 0, 0, 0);
            const bf16x8 Ub = cat4z(pk4(U));
            f32x4 Y = (f32x4){0.f, 0.f, 0.f, 0.f};
            Y = __builtin_amdgcn_mfma_f32_16x16x32_bf16(Rp[0], Mb[0], Y, 0, 0, 0); Y = __builtin_amdgcn_mfma_f32_16x16x32_bf16(Rp[1], Mb[1], Y, 0, 0, 0);
            Y = __builtin_amdgcn_mfma_f32_16x16x32_bf16(Lrkp, Vb, Y, 0, 0, 0); Y = __builtin_amdgcn_mfma_f32_16x16x32_bf16(Nlrbp, Ub, Y, 0, 0, 0);
#pragma unroll
            for (int r = 0; r < 4; ++r) YY[(16 * ch + 4 * fq + r) * 64 + 16 * w + fr] = Y[r];
#pragma unroll
            for (int mt = 0; mt < 4; ++mt) { const f32x4 gc = *(const LAS f32x4*)(GC + 16 * mt + 4 * fq); f32x4 m = Macc[mt] * gc;
              const bf16x8 khp = cat4z(*(const LAS bf16x4*)(KH + (16 * mt + fr) * 24 + 4 * fq)), nbp = cat4z(*(const LAS bf16x4*)(NBH + (16 * mt + fr) * 24 + 4 * fq));
              m = __builtin_amdgcn_mfma_f32_16x16x32_bf16(khp, Vb, m, 0, 0, 0); m = __builtin_amdgcn_mfma_f32_16x16x32_bf16(nbp, Ub, m, 0, 0, 0); Macc[mt] = m; } } }
        lds_barrier();
        const float lnw = CT[640 + lane], lnb = CT[704 + lane];
#pragma unroll
        for (int i = 0; i < 8; ++i) {
            const int tok = w * 8 + i; const float y = YY[tok * 64 + lane];
            const float mean = wave_sum2(y) * (1.0f / 64.0f), dl = y - mean, var = wave_sum2(dl * dl) * (1.0f / 64.0f);
            const float yn = dl * rsqrtf(var + 64e-5f) * lnw + lnb + cbv[i] * vs[i];
            const float gti = (i & 1) ? hi16(gtp[i >> 1]) : lo16(gtp[i >> 1]);
            if (!dry) g3[(t0 + tok) * G3_LD + cj] = f2bf(yn * siluf_(gti));
        }
        lds_barrier();
    }
}

__device__ __forceinline__ void spin_until_ge(const unsigned* flag, unsigned want) {
    unsigned it = 0;
    while (__hip_atomic_load(flag, __ATOMIC_RELAXED, __HIP_MEMORY_SCOPE_AGENT) < want) { __builtin_amdgcn_s_sleep(2); if (++it > (1u << 17)) break; }
}
__device__ __forceinline__ unsigned pk2bf(float lo, float hi) { return cvt_pk_bf16(lo, hi); }

__device__ void rwkv_producer(const Ctx& c, int l, int bh, int par) {
    const Params& P = *c.P; const int b = bh >> 3, hd = bh & 7, lane = c.lane, w = c.wave, cj = hd * 64 + lane, fr = lane & 15, fq = lane >> 4;
    LAS unsigned char* LB = c.lds;
    LAS float* WR = (LAS float*)LB; LAS float* AR = (LAS float*)(LB + RW_AR);
    LAS bf16_t* TWb = (LAS bf16_t*)(LB + RW_TW); LAS bf16_t* ADb = (LAS bf16_t*)(LB + RW_AD);
    const bf16_t* zrw = (const bf16_t*)(c.ws + OFF_ZRW);
    unsigned* ready = (unsigned*)(c.ws + OFF_BAR + 256) + (bh * 2 + par) * 64; const unsigned* consumed = (const unsigned*)(c.ws + OFF_BAR + 256 + 64 * 256) + bh * 64;
    unsigned char* ring = c.ws + OFF_RING + (size_t)bh * RING_SLOTS * SLOT_BYTES;
    LAS float* CT = (LAS float*)(LB + RW_CT);
    if (c.tid < 64) { const float* mu = P.in[4] + (size_t)l * 1664; const int j = hd * 64 + c.tid;
        CT[0 * 64 + c.tid] = mu[j]; CT[1 * 64 + c.tid] = mu[512 + j]; CT[2 * 64 + c.tid] = mu[1024 + j]; CT[3 * 64 + c.tid] = mu[1536 + c.tid]; CT[4 * 64 + c.tid] = mu[1600 + c.tid];
        CT[5 * 64 + c.tid] = P.in[5][l * BW + j]; CT[6 * 64 + c.tid] = P.in[7][l * BW + j]; CT[7 * 64 + c.tid] = P.in[9][l * BW + j]; CT[8 * 64 + c.tid] = P.in[10][l * BW + j];
        CT[9 * 64 + c.tid] = P.in[11][l * BW + j]; }
    const int mt_ = w >> 1, nh = w & 1;
    LAS bf16_t* W2I = (LAS bf16_t*)(LB + RW_W2); LAS bf16_t* A2I = (LAS bf16_t*)(LB + RW_A2);
    for (int i = c.tid; i < 4096; i += 512) { const int k = i >> 6, j = i & 63; W2I[j * TWS + k] = f2bf(P.in[6][((size_t)l * 64 + k) * BW + hd * 64 + j]); A2I[j * TWS + k] = f2bf(P.in[8][((size_t)l * 64 + k) * BW + hd * 64 + j]); }
    __syncthreads();
    RwRows cur;
    rw_load_rows(cur, zrw, b, par, w, lane, cj);
    for (int blk = par; blk < RW_NBLK; blk += 2) {
        const unsigned gblk = (unsigned)(l * RW_NBLK + blk);
        float rs[8], ks_[8], vs[8];
        const float mu_r = CT[lane], mu_k = CT[64 + lane], mu_v = CT[128 + lane], mu_w = CT[192 + lane], mu_a = CT[256 + lane];
#pragma unroll
        for (int i = 0; i < 8; ++i) { const int tok = w * 8 + i;
            { const float r0 = rw_get(cur.zr, i), r1 = rw_get(cur.zr, i + 1), k0 = rw_get(cur.zk, i), k1 = rw_get(cur.zk, i + 1), v0 = rw_get(cur.zv, i), v1 = rw_get(cur.zv, i + 1);
              rs[i] = r1 + mu_r * (r0 - r1); ks_[i] = k1 + mu_k * (k0 - k1); vs[i] = v1 + mu_v * (v0 - v1); }
            const float w0_ = rw_get(cur.zw, i), w1_ = rw_get(cur.zw, i + 1), a0_ = rw_get(cur.za, i), a1_ = rw_get(cur.za, i + 1);
            const float wds = w1_ + mu_w * (w0_ - w1_), ads = a1_ + mu_a * (a0_ - a1_);
            const float e2 = __expf(2.0f * wds); const float th = 1.0f - 2.0f * __builtin_amdgcn_rcpf(e2 + 1.0f);
            TWb[tok * TWS + lane] = f2bf(th); ADb[tok * TWS + lane] = f2bf(ads); }
        if (blk + 2 < RW_NBLK) rw_load_rows(cur, zrw, b, blk + 2, w, lane, cj);
        lds_barrier();
        { bf16x8 atw[2], aad[2];
#pragma unroll
          for (int ks = 0; ks < 2; ++ks) { atw[ks] = *(const LAS bf16x8*)(TWb + (16 * mt_ + fr) * TWS + 32 * ks + 8 * fq); aad[ks] = *(const LAS bf16x8*)(ADb + (16 * mt_ + fr) * TWS + 32 * ks + 8 * fq); }
          f32x4 cw[2], ca[2];
#pragma unroll
          for (int n2 = 0; n2 < 2; ++n2) { cw[n2] = (f32x4){0.f, 0.f, 0.f, 0.f}; ca[n2] = cw[n2];
#pragma unroll
              for (int ks = 0; ks < 2; ++ks) { const int bo = (32 * nh + 16 * n2 + fr) * TWS + 32 * ks + 8 * fq;
                  cw[n2] = __builtin_amdgcn_mfma_f32_16x16x32_bf16(atw[ks], *(const LAS bf16x8*)(W2I + bo), cw[n2], 0, 0, 0); ca[n2] = __builtin_amdgcn_mfma_f32_16x16x32_bf16(aad[ks], *(const LAS bf16x8*)(A2I + bo), ca[n2], 0, 0, 0); } }
          lds_barrier();
#pragma unroll
          for (int n2 = 0; n2 < 2; ++n2)
#pragma unroll
              for (int r = 0; r < 4; ++r) { const int o = (16 * mt_ + 4 * fq + r) * 64 + 32 * nh + 16 * n2 + fr; WR[o] = cw[n2][r]; AR[o] = ca[n2][r]; } }
        if (c.tid == 0 && gblk >= RING_SLOTS) spin_until_ge(consumed, gblk - RING_SLOTS + 1);
        lds_barrier();
        unsigned char* slot = ring + (size_t)(gblk % RING_SLOTS) * SLOT_BYTES;
        LAS float* GP = (LAS float*)(LB + RW_GP); const int cc = w >> 1, hc = w & 1;
        float kkv[8], kpv[8], bbv[8], gl[8], cbv[8];
        { const float w0j = CT[320 + lane], a0j = CT[384 + lane], kkj = CT[448 + lane], kaj = CT[512 + lane], rkj = CT[576 + lane]; float g = 1.0f;
#pragma unroll
          for (int i = 0; i < 8; ++i) { const int o = (w * 8 + i) * 64 + lane;
            const float wraw = w0j + WR[o], araw = a0j + AR[o];
            const float d = __expf(-0.6065306597126334f * sigmoidf_(wraw)), a = sigmoidf_(araw);
            float kk = ks_[i] * kkj; const float n2 = wave_sum2(kk * kk); kk = kk * __builtin_amdgcn_rsqf(fmaxf(n2, 1e-24f));
            const float kp = ks_[i] * (1.0f + (a - 1.0f) * kaj);
            cbv[i] = wave_sum2(rs[i] * kp * rkj);
            g *= d; gl[i] = g; kkv[i] = kk; kpv[i] = kp; bbv[i] = kk * a; }
          GP[w * 64 + lane] = g; }
        lds_barrier();
        { LAS unsigned char* CB_ = LB + cc * CH_BYTES;
          LAS bf16_t *AT = (LAS bf16_t*)(CB_ + CH_AT), *RT = (LAS bf16_t*)(CB_ + CH_RT), *KT = (LAS bf16_t*)(CB_ + CH_KT), *BT = (LAS bf16_t*)(CB_ + CH_BT),
                     *KH = (LAS bf16_t*)(CB_ + CH_KH), *NBH = (LAS bf16_t*)(CB_ + CH_NB), *VT = (LAS bf16_t*)(CB_ + CH_VT);
          const float g0 = GP[(2 * cc) * 64 + lane], g1 = GP[(2 * cc + 1) * 64 + lane], gC = g0 * g1, pre = hc ? g0 : 1.0f;
          if (hc == 0) ((LAS float*)(CB_ + CH_GC))[lane] = gC;
#pragma unroll
          for (int i = 0; i < 8; ++i) { const int tl = 8 * hc + i;
            const float gam = pre * gl[i], gprev = (i == 0) ? pre : pre * gl[i - 1], ig = __builtin_amdgcn_rcpf(gam), gr = gC * ig;
            AT[tl * TWS + lane] = f2bf(kkv[i] * gprev); RT[tl * TWS + lane] = f2bf(rs[i] * gam); KT[tl * TWS + lane] = f2bf(kpv[i] * ig); BT[tl * TWS + lane] = f2bf(bbv[i] * ig);
            KH[lane * 20 + tl] = f2bf(kpv[i] * gr); NBH[lane * 20 + tl] = f2bf(-bbv[i] * gr); VT[lane * 20 + tl] = f2bf(vs[i]); } }
        lds_barrier();
        { const __amdgpu_buffer_rsrc_t rs_ = __builtin_amdgcn_make_buffer_rsrc((void*)slot, 0, (int)SLOT_BYTES, 0x00020000);
#pragma unroll
          for (int i = 0; i < 9; ++i) { const int L_ = c.tid * 16 + i * 8192, ch = L_ / 18432, off = L_ - ch * 18432;
              __builtin_amdgcn_raw_buffer_store_b128(*(const LAS u32x4*)(LB + ch * CH_BYTES + off), rs_, (unsigned)L_, 0, 16); }
          if (c.tid < 64) __builtin_amdgcn_raw_buffer_store_b128(*(const LAS u32x4*)(LB + (c.tid >> 4) * CH_BYTES + CH_GC + (c.tid & 15) * 16), rs_, (unsigned)(SLOT_IMG + c.tid * 16), 0, 16);
#pragma unroll
          for (int i = 0; i < 8; ++i) if (lane == i) __hip_atomic_store((unsigned*)(slot + SLOT_IMG + 1024) + w * 8 + i, __float_as_uint(cbv[i]), __ATOMIC_RELAXED, __HIP_MEMORY_SCOPE_AGENT); }
        __syncthreads();
        if (c.tid == 0) __hip_atomic_store(ready, (gblk >> 1) + 1, __ATOMIC_RELAXED, __HIP_MEMORY_SCOPE_AGENT);
    }
}

struct RwSlot { u32x4 img[9]; u32x4 gc; float cb; };
__device__ __forceinline__ void rw_load_slot(RwSlot& R, const unsigned char* slot, int tid, int w, int lane) {
#pragma unroll
    for (int i = 0; i < 9; ++i) R.img[i] = *(const u32x4*)(slot + tid * 16 + i * 8192);
    R.gc = *(const u32x4*)(slot + SLOT_IMG + (tid & 63) * 16);
    R.cb = ((const float*)(slot + SLOT_IMG + 1024))[w * 8 + (lane & 7)];
}

__device__ void rwkv_consumer(const Ctx& c, int l, int bh) {
    const Params& P = *c.P; const int b = bh >> 3, hd = bh & 7, lane = c.lane, w = c.wave, cj = hd * 64 + lane, fr = lane & 15, fq = lane >> 4;
    LAS unsigned char* LB = c.lds;
    LAS float* YY = (LAS float*)(LB + RW_YY);
    bf16_t* g3 = (bf16_t*)(c.ws + OFF_G3);
    const unsigned* ready = (const unsigned*)(c.ws + OFF_BAR + 256) + bh * 128; unsigned* consumed = (unsigned*)(c.ws + OFF_BAR + 256 + 64 * 256) + bh * 64;
    bf16_t* zrw = (bf16_t*)(c.ws + OFF_ZRW); float* cbg = (float*)(c.ws + OFF_CBG);
    const unsigned char* ring = c.ws + OFF_RING + (size_t)bh * RING_SLOTS * SLOT_BYTES;
    f32x4 Macc[4];
#pragma unroll
    for (int i = 0; i < 4; ++i) Macc[i] = (f32x4){0.f, 0.f, 0.f, 0.f};
    RwSlot cur;
    { const unsigned g0 = (unsigned)(l * RW_NBLK);
      if (c.tid == 0) { spin_until_ge(ready + 64 * (g0 & 1), (g0 >> 1) + 1); spin_until_ge(ready + 64 * ((g0 + 1) & 1), ((g0 + 1) >> 1) + 1); __builtin_amdgcn_fence(__ATOMIC_ACQUIRE, "agent"); }
      __syncthreads();
      rw_load_slot(cur, ring + (size_t)(g0 % RING_SLOTS) * SLOT_BYTES, c.tid, w, lane); }
    for (int blk = 0; blk < RW_NBLK; ++blk) {
        const unsigned gblk = (unsigned)(l * RW_NBLK + blk); const size_t t0 = (size_t)b * SEQ + blk * 64;
        float cbv[8];
#pragma unroll
        for (int i = 0; i < 9; ++i) { const int L_ = c.tid * 16 + i * 8192, ch = L_ / 18432, off = L_ - ch * 18432; *(LAS u32x4*)(LB + ch * CH_BYTES + off) = cur.img[i]; }
        if (c.tid < 64) *(LAS u32x4*)(LB + (c.tid >> 4) * CH_BYTES + CH_GC + (c.tid & 15) * 16) = cur.gc;
#pragma unroll
        for (int i = 0; i < 8; ++i) cbv[i] = __builtin_bit_cast(float, __builtin_amdgcn_readlane(__builtin_bit_cast(int, cur.cb), i));
        lds_barrier();
        if (c.tid == 0) __hip_atomic_store(consumed, gblk + 1, __ATOMIC_RELAXED, __HIP_MEMORY_SCOPE_AGENT);
        if (blk + 1 < RW_NBLK) rw_load_slot(cur, ring + (size_t)((gblk + 1) % RING_SLOTS) * SLOT_BYTES, c.tid, w, lane);
        if (w < 4 && true) { LAS unsigned char* CB_ = LB + w * CH_BYTES;
          const LAS bf16_t *AT = (const LAS bf16_t*)(CB_ + CH_AT), *RT = (const LAS bf16_t*)(CB_ + CH_RT), *KT = (const LAS bf16_t*)(CB_ + CH_KT), *BT = (const LAS bf16_t*)(CB_ + CH_BT);
          f32x4 lab = (f32x4){0.f, 0.f, 0.f, 0.f}, lak = lab, lrk = lab, lrb = lab;
#pragma unroll
          for (int ks = 0; ks < 2; ++ks) { const int o = fr * TWS + 32 * ks + 8 * fq;
            const bf16x8 af = *(const LAS bf16x8*)(AT + o), rf = *(const LAS bf16x8*)(RT + o), kf = *(const LAS bf16x8*)(KT + o), bf = *(const LAS bf16x8*)(BT + o);
            lab = __builtin_amdgcn_mfma_f32_16x16x32_bf16(af, bf, lab, 0, 0, 0); lak = __builtin_amdgcn_mfma_f32_16x16x32_bf16(af, kf, lak, 0, 0, 0);
            lrk = __builtin_amdgcn_mfma_f32_16x16x32_bf16(rf, kf, lrk, 0, 0, 0); lrb = __builtin_amdgcn_mfma_f32_16x16x32_bf16(rf, bf, lrb, 0, 0, 0); }
          LAS float *LAB = (LAS float*)(CB_ + CH_LAB), *LAK = (LAS float*)(CB_ + CH_LAK); LAS bf16_t *LRK = (LAS bf16_t*)(CB_ + CH_LRK), *NLRB = (LAS bf16_t*)(CB_ + CH_NLRB);
#pragma unroll
          for (int r = 0; r < 4; ++r) { const int t = 4 * fq + r, s_ = fr; const bool lo_ = t > s_, le_ = t >= s_;
            LAB[t * 16 + s_] = lo_ ? lab[r] : 0.0f; LAK[t * 16 + s_] = lo_ ? lak[r] : 0.0f;
            LRK[t * 24 + s_] = f2bf(le_ ? lrk[r] : 0.0f); NLRB[t * 24 + s_] = f2bf(le_ ? -lrb[r] : 0.0f); } }
        lds_barrier();
        { const int ch6 = w & 3; LAS unsigned char* CB_ = LB + ch6 * CH_BYTES;
          const LAS bf16_t* AT = (const LAS bf16_t*)(CB_ + CH_AT); const LAS float *LAB = (const LAS float*)(CB_ + CH_LAB), *LAK = (const LAS float*)(CB_ + CH_LAK);
          LAS bf16_t *WI = (LAS bf16_t*)(CB_ + CH_KT), *GI = (LAS bf16_t*)(CB_ + CH_GI);
          float xv[16];
          if (w < 4) {
#pragma unroll
            for (int t = 0; t < 16; ++t) xv[t] = bf2f(AT[t * TWS + lane]);
          } else {
#pragma unroll
            for (int t = 0; t < 16; ++t) xv[t] = LAK[t * 16 + fr];
          }
          f32x4 nx[4];
#pragma unroll
          for (int q = 0; q < 4; ++q) nx[q] = *(const LAS f32x4*)(LAB + 16 + 4 * q);
#pragma unroll
          for (int t = 1; t < 16; ++t) { float xa = xv[t]; f32x4 lr[4];
#pragma unroll
            for (int q = 0; q < 4; ++q) lr[q] = nx[q];
            if (t < 15) {
#pragma unroll
              for (int q = 0; q < 4; ++q) if (4 * q < t + 1) nx[q] = *(const LAS f32x4*)(LAB + (t + 1) * 16 + 4 * q); }
            float xb = 0.0f;
#pragma unroll
            for (int q = 0; q < 4; ++q) if (4 * q < t) {
#pragma unroll
              for (int e = 0; e < 4; ++e) if (4 * q + e < t) { if (e & 1) xb -= lr[q][e] * xv[4 * q + e]; else xa -= lr[q][e] * xv[4 * q + e]; } }
            xa += xb;
            xv[t] = xa; asm volatile("" : "+v"(xv[t]), "+v"(nx[0]), "+v"(nx[1]), "+v"(nx[2]), "+v"(nx[3]) :: "memory"); }
          if (w < 4) {
#pragma unroll
            for (int t = 0; t < 16; ++t) WI[t * TWS + lane] = f2bf(xv[t]);
          } else if (lane < 16) {
#pragma unroll
            for (int t = 0; t < 16; ++t) GI[t * 24 + lane] = f2bf(xv[t]);
          } }
        lds_barrier();
        if (w == 4 && lane == 0 && blk + 2 < RW_NBLK) { const unsigned gn = gblk + 2; spin_until_ge(ready + 64 * (gn & 1), (gn >> 1) + 1); __builtin_amdgcn_fence(__ATOMIC_ACQUIRE, "agent"); }
        if (w < 4 && true) {
#pragma unroll
          for (int ch = 0; ch < 4; ++ch) { LAS unsigned char* CB_ = LB + ch * CH_BYTES;
            const LAS bf16_t *RT = (const LAS bf16_t*)(CB_ + CH_RT), *WI = (const LAS bf16_t*)(CB_ + CH_KT), *KH = (const LAS bf16_t*)(CB_ + CH_KH), *NBH = (const LAS bf16_t*)(CB_ + CH_NB),
                             *VT = (const LAS bf16_t*)(CB_ + CH_VT), *LRK = (const LAS bf16_t*)(CB_ + CH_LRK), *NLRB = (const LAS bf16_t*)(CB_ + CH_NLRB), *GI = (const LAS bf16_t*)(CB_ + CH_GI);
            const LAS float* GC = (const LAS float*)(CB_ + CH_GC);
            bf16x8 Mb[2], Wp[2], Rp[2];
#pragma unroll
            for (int ks = 0; ks < 2; ++ks) { Mb[ks] = cat4(pk4(Macc[2 * ks]), pk4(Macc[2 * ks + 1]));
              Wp[ks] = cat4(*(const LAS bf16x4*)(WI + fr * TWS + 32 * ks + 4 * fq), *(const LAS bf16x4*)(WI + fr * TWS + 32 * ks + 16 + 4 * fq));
              Rp[ks] = cat4(*(const LAS bf16x4*)(RT + fr * TWS + 32 * ks + 4 * fq), *(const LAS bf16x4*)(RT + fr * TWS + 32 * ks + 16 + 4 * fq)); }
            const bf16x8 Vb = cat4z(*(const LAS bf16x4*)(VT + (16 * w + fr) * 20 + 4 * fq));
            const bf16x8 Gp = cat4z(*(const LAS bf16x4*)(GI + fr * 24 + 4 * fq)), Lrkp = cat4z(*(const LAS bf16x4*)(LRK + fr * 24 + 4 * fq)), Nlrbp = cat4z(*(const LAS bf16x4*)(NLRB + fr * 24 + 4 * fq));
            f32x4 U = (f32x4){0.f, 0.f, 0.f, 0.f};
            U = __builtin_amdgcn_mfma_f32_16x16x32_bf16(Wp[0], Mb[0], U, 0, 0, 0); U = __builtin_amdgcn_mfma_f32_16x16x32_bf16(Wp[1], Mb[1], U, 0, 0, 0); U = __builtin_amdgcn_mfma_f32_16x16x32_bf16(Gp, Vb, U, 0, 0, 0);
            const bf16x8 Ub = cat4z(pk4(U));
            f32x4 Y = (f32x4){0.f, 0.f, 0.f, 0.f};
            Y = __builtin_amdgcn_mfma_f32_16x16x32_bf16(Rp[0], Mb[0], Y, 0, 0, 0); Y = __builtin_amdgcn_mfma_f32_16x16x32_bf16(Rp[1], Mb[1], Y, 0, 0, 0);
            Y = __builtin_amdgcn_mfma_f32_16x16x32_bf16(Lrkp, Vb, Y, 0, 0, 0); Y = __builtin_amdgcn_mfma_f32_16x16x32_bf16(Nlrbp, Ub, Y, 0, 0, 0);
#pragma unroll
            for (int r = 0; r < 4; ++r) YY[(16 * ch + 4 * fq + r) * 64 + 16 * w + fr] = Y[r];
#pragma unroll
            for (int mt = 0; mt < 4; ++mt) { const f32x4 gc = *(const LAS f32x4*)(GC + 16 * mt + 4 * fq); f32x4 m = Macc[mt] * gc;
              const bf16x8 khp = cat4z(*(const LAS bf16x4*)(KH + (16 * mt + fr) * 20 + 4 * fq)), nbp = cat4z(*(const LAS bf16x4*)(NBH + (16 * mt + fr) * 20 + 4 * fq));
              m = __builtin_amdgcn_mfma_f32_16x16x32_bf16(khp, Vb, m, 0, 0, 0); m = __builtin_amdgcn_mfma_f32_16x16x32_bf16(nbp, Ub, m, 0, 0, 0); Macc[mt] = m; } } }
        lds_barrier();
#pragma unroll
        for (int i = 0; i < 8; ++i) { const int tok = w * 8 + i;
            zrw[(t0 + tok) * ZRW_LD + cj] = f2bf(YY[tok * 64 + lane]);
            if (lane == i) cbg[(t0 + tok) * 8 + hd] = cbv[i]; }
    }
}

__device__ void phase_rwkv_fin(const Ctx& c, int l) {
    const Params& P = *c.P; const bf16_t* zrw = (const bf16_t*)(c.ws + OFF_ZRW); bf16_t* g3 = (bf16_t*)(c.ws + OFF_G3); const float* cbg = (const float*)(c.ws + OFF_CBG);
    const int gw = blockIdx.x * 8 + c.wave, nw = gridDim.x * 8, lane = c.lane;
    for (int item = gw; item < (T / 128) * 8; item += nw) {
        const int hd = item & 7, tg = item >> 3, cj = hd * 64 + lane; const size_t tb = (size_t)tg * 128;
        const float mu_v = P.in[4][(size_t)l * 1664 + 1024 + cj], lnw = P.in[12][l * BW + cj], lnb = P.in[13][l * BW + cj];
        float vprev = ((tb & (SEQ - 1)) == 0) ? 0.0f : bf2f(zrw[(tb - 1) * ZRW_LD + 1024 + cj]);
        for (int t4 = 0; t4 < 128; t4 += 4) {
            float y[4], vv[4], gt[4], cb[4];
#pragma unroll
            for (int i = 0; i < 4; ++i) { const size_t t = tb + t4 + i; y[i] = bf2f(zrw[t * ZRW_LD + cj]); vv[i] = bf2f(zrw[t * ZRW_LD + 1024 + cj]); gt[i] = bf2f(g3[t * G3_LD + cj]); cb[i] = cbg[t * 8 + hd]; }
#pragma unroll
            for (int i = 0; i < 4; ++i) { const size_t t = tb + t4 + i;
                const float vs = vv[i] + mu_v * (vprev - vv[i]); vprev = vv[i];
                const float mean = wave_sum2(y[i]) * (1.0f / 64.0f), ey2 = wave_sum2(y[i] * y[i]) * (1.0f / 64.0f), var = fmaxf(ey2 - mean * mean, 0.0f);
                const float yn = (y[i] - mean) * rsqrtf(var + 64e-5f) * lnw + lnb + cb[i] * vs;
                g3[t * G3_LD + cj] = f2bf(yn * siluf_(gt[i])); }
        }
    }
}

constexpr int RW_WGS = 96;
template <int l, int sp>
__device__ __forceinline__ void run_sub(const Ctx& c, const Params& P, float* ssbase, int G, int cb, unsigned* bar2, unsigned& bar2_target) {
    unsigned char* ws = c.ws;
    if constexpr (sp == 0) {
        if (l == 0) phase_s5_consts(c);
        pg8::Gemm g{(const bf16_t*)(ws + OFF_XN), (const bf16_t*)(ws + OFF_WIN) + (size_t)l * DINP * D, D, D, D}; pg8::Sched S; S.init(T, DINP, G, cb);
        EpiZ E{(bf16_t*)(ws + OFF_ZRW), (bf16_t*)(ws + OFF_G3), (bf16_t*)(ws + OFF_XL), (bf16_t*)(ws + OFF_AS)};
        pg8::gemm_phase(c.lds, g, S, E);
    } else if constexpr (sp == 1) {
        if (cb < 32) rwkv_consumer(c, l, cb); else if (cb < RW_WGS) rwkv_producer(c, l, (cb - 32) & 31, (cb - 32) >> 5);
        else {
            Ctx c2 = c; c2.vb = cb - RW_WGS; c2.vG = G - RW_WGS; const int G2 = G - RW_WGS, cb2 = cb - RW_WGS;
            phase_lru_conv(c2, l);
            { pg8::Gemm g{(const bf16_t*)(ws + OFF_AS), (const bf16_t*)(ws + OFF_S5E) + (size_t)l * 32 * 256 * 256, AS_LD, 256, 256}; pg8::Sched S; S.init(AS_ROWS, 256, G2, cb2, 8);
              EpiE E{(float*)(ws + OFF_E)};
              pg8::gemm_phase(c.lds, g, S, E); }
            grid_bar(bar2, bar2_target, (unsigned)G2);
            phase_s5_carry(c2, l);
            { pg8::Gemm g{(const bf16_t*)(ws + OFF_XC), (const bf16_t*)(ws + OFF_WLRU) + (size_t)l * 1024 * BW, BW, BW, BW}; pg8::Sched S; S.init(T, 1024, G2, cb2);
              EpiLru E{(const bf16_t*)(ws + OFF_XC), P.in[27] + l * BW, P.in[29] + l * BW, P.in[30] + l * BW, (bf16_t*)(ws + OFF_LRUAB)};
              pg8::gemm_phase(c.lds, g, S, E); }
            grid_bar(bar2, bar2_target, (unsigned)G2);
            { pg8::Gemm g{(const bf16_t*)(ws + OFF_AS), (const bf16_t*)(ws + OFF_S5Y) + (size_t)l * 32 * 256 * AS_LD, AS_LD, AS_LD, AS_LD}; pg8::Sched S; S.init(AS_ROWS, 256, G2, cb2, 8);
              EpiY E{(const bf16_t*)(ws + OFF_AS), P.in[21] + l * BW, (bf16_t*)(ws + OFF_ZGS)};
              pg8::gemm_phase(c.lds, g, S, E); }
            phase_lru_scan(c2, 0);
            grid_bar(bar2, bar2_target, (unsigned)G2);
            { pg8::Gemm g{(const bf16_t*)(ws + OFF_ZGS), (const bf16_t*)(ws + OFF_WGLU) + (size_t)l * BW * BW, BW, BW, BW}; pg8::Sched S; S.init(T, BW, G2, cb2);
              EpiGlu E{(const bf16_t*)(ws + OFF_ZGS), P.in[23] + l * BW, (bf16_t*)(ws + OFF_G3)};
              pg8::gemm_phase(c.lds, g, S, E); }
            phase_lru_scan(c2, 1);
            { pg8::Gemm g{(const bf16_t*)(ws + OFF_PB) + (size_t)l * T * DPLE, (const bf16_t*)(ws + OFF_WPLE) + (size_t)l * D * DPLE, DPLE, DPLE, DPLE}; pg8::Sched S; S.init(T, D, G2, cb2);
              EpiPle E{(bf16_t*)(ws + OFF_PW), ssbase + (size_t)l * T};
              pg8::gemm_phase(c.lds, g, S, E); }
        }
    } else if constexpr (sp == 2) {
        phase_rwkv_fin(c, l);
    } else if constexpr (sp == 5) {
        { pg8::Gemm g{(const bf16_t*)(ws + OFF_G3), (const bf16_t*)(ws + OFF_WOUT) + (size_t)l * D * DMIX, DMIX, DMIX, DMIX}; pg8::Sched S; S.init(T, D, G, cb);
          EpiOut E{l == 0 ? P.in[0] : (const float*)P.out, P.out, (bf16_t*)(ws + OFF_H1B)};
          pg8::gemm_phase(c.lds, g, S, E); }
    } else if constexpr (sp == 6) {
        pg8::Gemm g{(const bf16_t*)(ws + OFF_H1B), (const bf16_t*)(ws + OFF_WG) + (size_t)l * D * D, D, D, D}; pg8::Sched S; S.init(T, D, G, cb);
        EpiGate E{P.out, (const bf16_t*)(ws + OFF_PW), ssbase + (size_t)l * T, P.in[33] + l * D, ssbase + (size_t)(2 + l) * T};
        pg8::gemm_phase(c.lds, g, S, E);
    } else {
        phase_norm(c, ssbase + (size_t)(2 + l) * T, l == 0 ? P.in[2] + D : P.in[35], l == 1);
    }
}

constexpr int NPHASE = 1 + 6 * 2;
__global__ void __launch_bounds__(512) hymba_fwd(Params P) {
    extern __shared__ __attribute__((aligned(16))) unsigned char lds_raw[];
    Ctx c; c.P = &P; c.ws = P.ws; c.lds = (LAS unsigned char*)lds_raw; c.ldsg = lds_raw; c.tid = threadIdx.x; c.lane = c.tid & 63; c.wave = __builtin_amdgcn_readfirstlane(c.tid >> 6);
    c.gtid = (size_t)blockIdx.x * 512 + c.tid; c.gsz = (size_t)gridDim.x * 512; c.vb = blockIdx.x; c.vG = gridDim.x;
    unsigned char* ws = P.ws; const int G = gridDim.x, cb = blockIdx.x;
    float* ssbase = (float*)(ws + OFF_SS);
    const int lo = P.ph_lo, hi = P.ph_hi;
    unsigned* barw = (unsigned*)(ws + OFF_BAR); unsigned bar_target = 0; unsigned* bar2 = barw + 32; unsigned bar2_target = 0;
#define PHASE(k, ...) if (((MK_PH_MASK >> (k)) & 1) && lo <= (k) && (k) < hi) { __VA_ARGS__; if ((k) + 1 < hi) { if ((k) == 0) { __threadfence(); cg::this_grid().sync(); } else grid_bar(barw, bar_target, (unsigned)G); } }
    PHASE(0, phase_prep(c))
#define RS(L_, SP_) run_sub<L_, SP_>(c, P, ssbase, G, cb, bar2, bar2_target)
    PHASE(1, RS(0, 0)) PHASE(2, RS(0, 1)) PHASE(3, RS(0, 2)) PHASE(4, RS(0, 5)) PHASE(5, RS(0, 6)) PHASE(6, RS(0, 7))
    PHASE(7, RS(1, 0)) PHASE(8, RS(1, 1)) PHASE(9, RS(1, 2)) PHASE(10, RS(1, 5)) PHASE(11, RS(1, 6)) PHASE(12, RS(1, 7))
#undef RS
#undef PHASE
}

extern "C" void kernel_launch(void* const* d_in, const int* in_sizes, int n_in, void* d_out, int out_size, void* d_ws, size_t ws_size, hipStream_t stream) {
    static int grid = 0;
    if (grid == 0) {
        if (n_in != 36 || out_size != T * D || ws_size < WS_END2) { fprintf(stderr, "kernel_launch: unexpected shapes (n_in %d out %d ws %zu need %zu)\n", n_in, out_size, ws_size, (size_t)WS_END); grid = -1; return; }
        int dev = 0, cus = 0, per_cu = 0;
        hipGetDevice(&dev); hipDeviceGetAttribute(&cus, hipDeviceAttributeMultiprocessorCount, dev);
        hipFuncSetAttribute((const void*)hymba_fwd, hipFuncAttributeMaxDynamicSharedMemorySize, LDS_BYTES);
        hipOccupancyMaxActiveBlocksPerMultiprocessor(&per_cu, (const void*)hymba_fwd, 512, LDS_BYTES);
        if (per_cu < 1) per_cu = 1;
        grid = cus * per_cu; if (grid > 256) grid = 256;
        (void)hipGetLastError();
    }
    if (grid < 0) return;
    (void)hipMemsetAsync((char*)d_ws + OFF_BAR, 0, CTL_BYTES, stream);
    Params p{};
    for (int i = 0; i < 36; ++i) p.in[i] = (const float*)d_in[i];
    p.out = (float*)d_out; p.ws = (unsigned char*)d_ws;
#if MK_PER_PHASE
    for (int ph = 0; ph < NPHASE; ++ph) { p.ph_lo = ph; p.ph_hi = ph + 1; hipLaunchKernelGGL(hymba_fwd, dim3(grid), dim3(512), LDS_BYTES, stream, p); }
#else
    p.ph_lo = 0; p.ph_hi = NPHASE;
    void* args[] = {&p};
    hipError_t e = hipLaunchCooperativeKernel((const void*)hymba_fwd, dim3(grid), dim3(512), args, LDS_BYTES, stream);
    if (e != hipSuccess) fprintf(stderr, "cooperative launch failed: %s (grid %d)\n", hipGetErrorString(e), grid);
#endif
}
```

```cpp
#include <hip/hip_runtime.h>
#include <hip/hip_cooperative_groups.h>
#include <cstdio>
namespace cg = cooperative_groups;

#ifndef MK_PER_PHASE
#define MK_PER_PHASE 0
#endif

#ifndef MK_PH_MASK
#define MK_PH_MASK 0x1fff
#endif
#ifndef MK_DUP
#define MK_DUP 0
#endif
#ifndef RW_OFF
#define RW_OFF 0
#endif
#ifndef MK_OFF
#define MK_OFF 0
#endif
#define LAS __attribute__((address_space(3)))
typedef unsigned short bf16_t;
typedef short bf16x8 __attribute__((ext_vector_type(8)));
typedef float f32x4 __attribute__((ext_vector_type(4)));
typedef unsigned u32x4 __attribute__((ext_vector_type(4)));
typedef unsigned u32x2 __attribute__((ext_vector_type(2)));

constexpr int T = 32768, D = 1024, SEQ = 8192, NB = 4, BW = 512;
constexpr int DIN = 4224, DINP = 4352, DMIX = 1536, DPLE = 256;
constexpr int ZRW_LD = 1792, G3_LD = 1536, AS_LD = 384, AS_ROWS = 65536;
constexpr int LDS_BYTES = 155648;

constexpr size_t al256(size_t x) { return (x + 255) & ~(size_t)255; }
constexpr size_t SZ_WIN = (size_t)2 * DINP * D * 2, SZ_WOUT = (size_t)2 * D * DMIX * 2, SZ_WG = (size_t)2 * D * D * 2, SZ_WPLE = (size_t)2 * D * DPLE * 2,
                 SZ_WGLU = (size_t)2 * BW * BW * 2, SZ_WLRU = (size_t)2 * 1024 * BW * 2, SZ_S5Y = (size_t)2 * 32 * 256 * AS_LD * 2, SZ_S5E = (size_t)2 * 32 * 256 * 256 * 2,
                 SZ_TBL = (size_t)2 * 32 * 64 * 18 * 8, SZ_PB = (size_t)2 * T * DPLE * 2, SZ_XN = (size_t)T * D * 2, SZ_ZRW = (size_t)T * ZRW_LD * 2, SZ_G3 = (size_t)T * G3_LD * 2,
                 SZ_XL = (size_t)T * BW * 2, SZ_AS = (size_t)AS_ROWS * AS_LD * 2, SZ_LRUAB = (size_t)T * 1024 * 2, SZ_AGG = (size_t)NB * 128 * 1024 * 4, SZ_SS = (size_t)4 * T * 4;
constexpr size_t OFF_WIN = 0, OFF_WOUT = OFF_WIN + SZ_WIN, OFF_WG = OFF_WOUT + SZ_WOUT, OFF_WPLE = OFF_WG + SZ_WG, OFF_WGLU = OFF_WPLE + SZ_WPLE, OFF_WLRU = OFF_WGLU + SZ_WGLU,
                 OFF_S5Y = OFF_WLRU + SZ_WLRU, OFF_S5E = OFF_S5Y + SZ_S5Y, OFF_TBL = OFF_S5E + SZ_S5E, OFF_PB = al256(OFF_TBL + SZ_TBL), OFF_XN = OFF_PB + SZ_PB,
                 OFF_ZRW = OFF_XN + SZ_XN, OFF_G3 = OFF_ZRW + SZ_ZRW, OFF_XL = OFF_G3 + SZ_G3, OFF_AS = OFF_XL + SZ_XL, OFF_LRUAB = OFF_AS + SZ_AS, OFF_AGG = OFF_LRUAB + SZ_LRUAB,
                 OFF_SS = OFF_AGG + SZ_AGG, WS_END = OFF_SS + SZ_SS;
constexpr size_t OFF_BAR = WS_END, CTL_BYTES = 256 + 96 * 256;
constexpr size_t RING_SLOTS = 3, SLOT_IMG = 4 * 18432, SLOT_BYTES = SLOT_IMG + 4 * 256 + 256;
constexpr size_t OFF_RING = OFF_BAR + CTL_BYTES, OFF_CBG = OFF_RING + 32 * RING_SLOTS * SLOT_BYTES, WS_END2 = OFF_CBG + (size_t)T * 8 * 4;
constexpr size_t OFF_E = OFF_XN, OFF_XC = OFF_XN + (size_t)AS_ROWS * 128 * 4, OFF_H1B = OFF_ZRW, OFF_PW = OFF_XN, OFF_ZGS = OFF_XL;
static_assert(OFF_XC + (size_t)T * BW * 2 <= OFF_ZRW, "alias overflow");

struct Params {
    const float* in[36];
    float* out;
    unsigned char* ws;
    int ph_lo, ph_hi;
};

__device__ __forceinline__ float bf2f(bf16_t v) { return __uint_as_float(((unsigned)v) << 16); }
__device__ __forceinline__ bf16_t f2bf_sw(float f) { unsigned u = __float_as_uint(f); u += 0x7FFFu + ((u >> 16) & 1u); return (bf16_t)(u >> 16); }
typedef float f32x2_ __attribute__((ext_vector_type(2)));
typedef __bf16 b16x2_ __attribute__((ext_vector_type(2)));
__device__ __forceinline__ unsigned cvt_pk_bf16(float lo, float hi) { const f32x2_ v = {lo, hi}; return __builtin_bit_cast(unsigned, __builtin_convertvector(v, b16x2_)); }
__device__ __forceinline__ bf16_t f2bf(float f) { return (bf16_t)cvt_pk_bf16(f, f); }
__device__ __forceinline__ float lo16(unsigned u) { return __uint_as_float(u << 16); }
__device__ __forceinline__ float hi16(unsigned u) { return __uint_as_float(u & 0xffff0000u); }
__device__ __forceinline__ float sigmoidf_(float x) { return __builtin_amdgcn_rcpf(1.0f + __expf(-x)); }
__device__ __forceinline__ float siluf_(float x) { return x * sigmoidf_(x); }
__device__ __forceinline__ float softplusf_(float x) { return fmaxf(x, 0.0f) + log1pf(__expf(-fabsf(x))); }
__device__ __forceinline__ float gelu_tanh(float x) { const float u2 = 1.5957691216057308f * (x + 0.044715f * x * x * x); return x * sigmoidf_(u2); }
__device__ __forceinline__ float wave_sum(float v) {
#pragma unroll
    for (int o = 32; o > 0; o >>= 1) v += __shfl_xor(v, o);
    return v;
}
__device__ __forceinline__ void unpack8(const u32x4 w, float (&f)[8]) {
    f[0] = lo16(w.x); f[1] = hi16(w.x); f[2] = lo16(w.y); f[3] = hi16(w.y); f[4] = lo16(w.z); f[5] = hi16(w.z); f[6] = lo16(w.w); f[7] = hi16(w.w);
}
__device__ __forceinline__ u32x4 pack8(const float (&f)[8]) {
    u32x4 w; w.x = cvt_pk_bf16(f[0], f[1]); w.y = cvt_pk_bf16(f[2], f[3]); w.z = cvt_pk_bf16(f[4], f[5]); w.w = cvt_pk_bf16(f[6], f[7]); return w;
}


__device__ __forceinline__ void grid_bar(unsigned* ctr, unsigned& target, unsigned nblk) {
    __syncthreads();
    if (threadIdx.x == 0) {
        target += nblk;
        __builtin_amdgcn_fence(__ATOMIC_RELEASE, "agent");
        __hip_atomic_fetch_add(ctr, 1u, __ATOMIC_RELAXED, __HIP_MEMORY_SCOPE_AGENT);
        while (__hip_atomic_load(ctr, __ATOMIC_RELAXED, __HIP_MEMORY_SCOPE_AGENT) < target) __builtin_amdgcn_s_sleep(1);
        __builtin_amdgcn_fence(__ATOMIC_ACQUIRE, "agent");
    }
    __syncthreads();
}

namespace pg8 {
constexpr int BM = 256, BK = 64, HALF = 128, HTB = HALF * BK * 2, STAGE_BYTES = 8 * HTB, NXCD = 8, WGM = 8;
__host__ __device__ __forceinline__ int lds_byte(int r, int c) { const int st = (r >> 4) * 2 + (c >> 5), rr = r & 15, cc = c & 31, ob = rr * 64 + cc * 2; return st * 1024 + (ob ^ (((ob >> 9) & 1) << 5)); }
__host__ __device__ __forceinline__ void stage_rc(int b, int& R, int& C) { const int st = b / 1024, sb = b % 1024, swz = sb ^ (((sb >> 9) & 1) << 5); R = (st >> 1) * 16 + swz / 64; C = (st & 1) * 32 + (swz % 64) / 2; }
__host__ __device__ __forceinline__ int perm32(int rho) { const int n = rho >> 4, i = rho & 15; return 8 * (i >> 2) + 4 * n + (i & 3); }

struct Unit { int pm, pn, pb; };
struct Gemm { const bf16_t* A; const bf16_t* Bt; int lda, ldb, K; };

struct Sched {
    int nM, nN, nwg, G, c, grp;
    __device__ void init(int M, int N, int G_, int c_, int grp_ = 0) { nM = M / BM; nN = N / BM; nwg = nM * nN; G = G_; c = c_; grp = grp_; }
    __device__ bool next(int i, Unit& u) const {
        const long L = (long)i * G + c; if (L >= nwg) return false;
        int wgid = (int)L; { const int q = nwg / NXCD, r = nwg % NXCD, xcd = wgid % NXCD, off = wgid / NXCD; wgid = (xcd < r ? xcd * (q + 1) : r * (q + 1) + (xcd - r) * q) + off; }
        const int nig = WGM * nN, gid = wgid / nig, fm = gid * WGM, gsz = (nM - fm) < WGM ? (nM - fm) : WGM;
        u.pm = fm + ((wgid % nig) % gsz); u.pn = (wgid % nig) / gsz; u.pb = grp ? (u.pm / grp) * nN + u.pn : u.pn; return true;
    }
};

template <class Epi>
__device__ __forceinline__ void gemm_phase(LAS unsigned char* lds, const Gemm g, const Sched& S, const Epi& E) {
    const int tid = threadIdx.x, wid = __builtin_amdgcn_readfirstlane(tid >> 6), lane = tid & 63, wr = wid >> 2, wc = wid & 3, fr = lane & 15, fq = lane >> 4;
    const int K = g.K, nt = K / BK;
    unsigned voffA[2], voffB[2];
#pragma unroll
    for (int i = 0; i < 2; ++i) { int R, C; stage_rc(tid * 16 + i * 8192, R, C); const int Rb = Epi::PERM ? ((R & ~31) + perm32(R & 31)) : R;
        voffA[i] = (unsigned)(R * g.lda + C) * 2u; voffB[i] = (unsigned)(Rb * g.ldb + C) * 2u; }
    const size_t kstep = (size_t)(BK * 2);
    const size_t hstepA = (size_t)HALF * g.lda * 2, hstepB = (size_t)HALF * g.ldb * 2;
    const size_t tstepA = 2 * hstepA, tstepB = 2 * hstepB;
    const unsigned ldsw = (unsigned)wid * 1024u;
    const int aoff = lds_byte(wr * 64 + fr, fq * 8), boff = lds_byte(wc * 32 + fr, fq * 8);
#define PG8_SA(b, h) (((b) * 2 + (h)) * HTB)
#define PG8_SB(b, h) ((4 + (b) * 2 + (h)) * HTB)
#define PG8_STAGE(bufoff, gbase, voff) do { _Pragma("unroll") for (int _i = 0; _i < 2; ++_i) \
        __builtin_amdgcn_global_load_lds((const unsigned*)((const char*)(gbase) + (voff)[_i]), (LAS unsigned*)(lds + (bufoff) + ldsw + _i * 8192), 16, 0, 0); } while (0)
#define PG8_LDA(dst, b, h) do { _Pragma("unroll") for (int m = 0; m < 4; ++m) _Pragma("unroll") for (int k = 0; k < 2; ++k) dst[m][k] = *(const LAS bf16x8*)(lds + PG8_SA(b, h) + aoff + m * 2048 + k * 1024); } while (0)
#define PG8_LDB(dst, b, h) do { _Pragma("unroll") for (int n = 0; n < 2; ++n) _Pragma("unroll") for (int k = 0; k < 2; ++k) dst[n][k] = *(const LAS bf16x8*)(lds + PG8_SB(b, h) + boff + n * 2048 + k * 1024); } while (0)
#define PG8_MMA(ai, bj, At, Bt) do { __builtin_amdgcn_s_setprio(1); _Pragma("unroll") for (int m = 0; m < 4; ++m) _Pragma("unroll") for (int n = 0; n < 2; ++n) _Pragma("unroll") for (int k = 0; k < 2; ++k) \
        acc[ai][bj][m][n] = __builtin_amdgcn_mfma_f32_16x16x32_bf16(Bt[n][k], At[m][k], acc[ai][bj][m][n], 0, 0, 0); __builtin_amdgcn_s_setprio(0); } while (0)
#define PG8_WAIT_V(n) asm volatile("s_waitcnt vmcnt(" #n ")" ::: "memory")
#define PG8_WAIT_L(n) asm volatile("s_waitcnt lgkmcnt(" #n ")" ::: "memory")
#define PG8_BAR __builtin_amdgcn_s_barrier()
#define PG8_SCHED __builtin_amdgcn_sched_barrier(0)
    Unit cur, nxt; int ui = 0;
    if (!S.next(0, cur)) return;
    f32x4 acc[2][2][4][2];
#pragma unroll
    for (int a = 0; a < 2; ++a)
#pragma unroll
        for (int b = 0; b < 2; ++b)
#pragma unroll
            for (int m = 0; m < 4; ++m)
#pragma unroll
                for (int n = 0; n < 2; ++n) acc[a][b][m][n] = (f32x4){0.f, 0.f, 0.f, 0.f};
    bf16x8 At[4][2], B0[2][2], B1[2][2];
    const char* cA = (const char*)g.A + (size_t)cur.pm * tstepA; const char* cB = (const char*)g.Bt + (size_t)cur.pb * tstepB;
    PG8_STAGE(PG8_SB(0, 0), cB, voffB); PG8_STAGE(PG8_SA(0, 0), cA, voffA); PG8_STAGE(PG8_SB(0, 1), cB + hstepB, voffB); PG8_STAGE(PG8_SA(0, 1), cA + hstepA, voffA);
    if (wr == 1) PG8_BAR;
    PG8_WAIT_V(4); PG8_BAR;
    PG8_STAGE(PG8_SB(1, 0), cB + kstep, voffB); PG8_STAGE(PG8_SA(1, 0), cA + kstep, voffA); PG8_STAGE(PG8_SB(1, 1), cB + hstepB + kstep, voffB);
    PG8_WAIT_V(6); PG8_BAR;
    for (;;) {
        const bool has_next = S.next(ui + 1, nxt);
        const char* nA = has_next ? (const char*)g.A + (size_t)nxt.pm * tstepA : cA; const char* nB = has_next ? (const char*)g.Bt + (size_t)nxt.pb * tstepB : cB;
#pragma unroll 1
        for (int t = 0; t < nt; t += 2) {
            const bool last = (t == nt - 2);
            const char* a1 = cA + (size_t)(t + 1) * kstep;
            const char* a2 = last ? nA : cA + (size_t)(t + 2) * kstep; const char* b2 = last ? nB : cB + (size_t)(t + 2) * kstep;
            const char* a3 = a2 + kstep; const char* b3 = b2 + kstep;
            PG8_LDB(B0, 0, 0); PG8_SCHED; PG8_LDA(At, 0, 0); PG8_STAGE(PG8_SA(1, 1), a1 + hstepA, voffA);
            PG8_WAIT_L(8); PG8_BAR; PG8_WAIT_L(0); PG8_MMA(0, 0, At, B0); PG8_BAR; PG8_SCHED;
            PG8_LDB(B1, 0, 1); PG8_STAGE(PG8_SB(0, 0), b2, voffB);
            PG8_BAR; PG8_WAIT_L(0); PG8_MMA(0, 1, At, B1); PG8_BAR;
            PG8_LDA(At, 0, 1); PG8_STAGE(PG8_SA(0, 0), a2, voffA);
            PG8_BAR; PG8_WAIT_L(0); PG8_MMA(1, 0, At, B0); PG8_BAR; PG8_SCHED;
            PG8_STAGE(PG8_SB(0, 1), b2 + hstepB, voffB);
            PG8_WAIT_V(6); PG8_BAR; PG8_MMA(1, 1, At, B1); PG8_BAR;
            PG8_LDB(B0, 1, 0); PG8_SCHED; PG8_LDA(At, 1, 0); PG8_STAGE(PG8_SA(0, 1), a2 + hstepA, voffA);
            PG8_WAIT_L(8); PG8_BAR; PG8_WAIT_L(0); PG8_MMA(0, 0, At, B0); PG8_BAR; PG8_SCHED;
            PG8_LDB(B1, 1, 1); PG8_STAGE(PG8_SB(1, 0), b3, voffB);
            PG8_BAR; PG8_WAIT_L(0); PG8_MMA(0, 1, At, B1); PG8_BAR;
            PG8_LDA(At, 1, 1); PG8_STAGE(PG8_SA(1, 0), a3, voffA);
            PG8_BAR; PG8_WAIT_L(0); PG8_MMA(1, 0, At, B0); PG8_BAR; PG8_SCHED;
            PG8_STAGE(PG8_SB(1, 1), b3 + hstepB, voffB);
            PG8_WAIT_V(6); PG8_BAR; PG8_MMA(1, 1, At, B1); PG8_BAR;
        }
        { int fr_ = fr, fq_ = fq; asm volatile("" : "+v"(fr_), "+v"(fq_)); E(acc, cur, wr, wc, fr_, fq_); }
        if (!has_next) break;
#pragma unroll
        for (int a = 0; a < 2; ++a)
#pragma unroll
            for (int b = 0; b < 2; ++b)
#pragma unroll
                for (int m = 0; m < 4; ++m)
#pragma unroll
                    for (int n = 0; n < 2; ++n) acc[a][b][m][n] = (f32x4){0.f, 0.f, 0.f, 0.f};
        cur = nxt; cA = nA; cB = nB; ++ui;
    }
    PG8_WAIT_V(0);
    if (wr == 0) PG8_BAR;
    PG8_BAR;
#undef PG8_SA
#undef PG8_SB
#undef PG8_STAGE
#undef PG8_LDA
#undef PG8_LDB
#undef PG8_MMA
#undef PG8_WAIT_V
#undef PG8_WAIT_L
#undef PG8_BAR
#undef PG8_SCHED
}
}
using pg8::Unit; using pg8::HALF;
typedef const f32x4 (&AccRef)[2][2][4][2];

struct EpiZ {
    static constexpr bool PERM = true;
    bf16_t *zrw, *g3, *xl, *as;
    __device__ __forceinline__ void operator()(AccRef acc, const Unit& u, int wr, int wc, int fr, int fq) const {
        const int row0 = u.pm * 256 + wr * 64 + fr, colt = wc * 32 + 8 * fq, pn = u.pn;
        if (pn == 9 || pn == 10) {
#pragma unroll
            for (int ai = 0; ai < 2; ++ai)
#pragma unroll
                for (int m = 0; m < 4; ++m) { const int row = row0 + ai * HALF + m * 16; const int b = row >> 13, l = row & 8191;
#pragma unroll
                    for (int bj = 0; bj < 2; ++bj) { const int c = (pn - 9) * 256 + bj * HALF + colt; const int g = c >> 4, h0 = c & 15;
                        const size_t asrow = (size_t)g * 2048 + b * 512 + (l >> 4);
                        const f32x4 v0 = acc[ai][bj][m][0], v1 = acc[ai][bj][m][1];
                        u32x4 w; w.x = cvt_pk_bf16(v0[0], v0[1]); w.y = cvt_pk_bf16(v0[2], v0[3]); w.z = cvt_pk_bf16(v1[0], v1[1]); w.w = cvt_pk_bf16(v1[2], v1[3]);
                        *(u32x4*)(as + asrow * AS_LD + (l & 15) * 16 + h0) = w; } }
            return;
        }
        bf16_t* base; int ld, c0;
        if (pn < 7) { base = zrw; ld = ZRW_LD; c0 = pn * 256; }
        else if (pn < 9) { base = g3; ld = G3_LD; c0 = (pn - 7) * 256; }
        else if (pn < 13) { base = g3; ld = G3_LD; c0 = 512 + (pn - 11) * 256; }
        else if (pn < 15) { base = xl; ld = BW; c0 = (pn - 13) * 256; }
        else { base = g3; ld = G3_LD; c0 = 1024 + (pn - 15) * 256; }
#pragma unroll
        for (int ai = 0; ai < 2; ++ai)
#pragma unroll
            for (int m = 0; m < 4; ++m) { bf16_t* rowp = base + (size_t)(row0 + ai * HALF + m * 16) * ld + c0 + colt;
#pragma unroll
                for (int bj = 0; bj < 2; ++bj) { const f32x4 v0 = acc[ai][bj][m][0], v1 = acc[ai][bj][m][1];
                    u32x4 w; w.x = cvt_pk_bf16(v0[0], v0[1]); w.y = cvt_pk_bf16(v0[2], v0[3]); w.z = cvt_pk_bf16(v1[0], v1[1]); w.w = cvt_pk_bf16(v1[2], v1[3]);
                    *(u32x4*)(rowp + bj * HALF) = w; } }
    }
};
struct EpiPle {
    static constexpr bool PERM = true;
    bf16_t* pw; float* ss;
    __device__ __forceinline__ void operator()(AccRef acc, const Unit& u, int wr, int wc, int fr, int fq) const {
        const int row0 = u.pm * 256 + wr * 64 + fr, col0 = u.pn * 256 + wc * 32 + 8 * fq;
#pragma unroll
        for (int ai = 0; ai < 2; ++ai)
#pragma unroll
            for (int m = 0; m < 4; ++m) { const int row = row0 + ai * HALF + m * 16; bf16_t* rowp = pw + (size_t)row * D + col0; float s = 0.f;
#pragma unroll
                for (int bj = 0; bj < 2; ++bj) { const f32x4 v0 = acc[ai][bj][m][0], v1 = acc[ai][bj][m][1];
                    s += v0[0] * v0[0] + v0[1] * v0[1] + v0[2] * v0[2] + v0[3] * v0[3] + v1[0] * v1[0] + v1[1] * v1[1] + v1[2] * v1[2] + v1[3] * v1[3];
                    u32x4 w; w.x = cvt_pk_bf16(v0[0], v0[1]); w.y = cvt_pk_bf16(v0[2], v0[3]); w.z = cvt_pk_bf16(v1[0], v1[1]); w.w = cvt_pk_bf16(v1[2], v1[3]);
                    *(u32x4*)(rowp + bj * HALF) = w; }
                s += __shfl_xor(s, 16); s += __shfl_xor(s, 32);
                if (fq == 0) unsafeAtomicAdd(ss + row, s);
                asm volatile("" ::: "memory"); }
    }
};
struct EpiE {
    static constexpr bool PERM = false;
    float* e;
    __device__ __forceinline__ void operator()(AccRef acc, const Unit& u, int wr, int wc, int fr, int fq) const {
        const int row0 = u.pm * 256 + wr * 64 + fr, col0 = wc * 32 + 4 * fq;
#pragma unroll
        for (int ai = 0; ai < 2; ++ai)
#pragma unroll
            for (int m = 0; m < 4; ++m) { float* rowp = e + (size_t)(row0 + ai * HALF + m * 16) * 128 + col0;
#pragma unroll
                for (int n = 0; n < 2; ++n) *(f32x4*)(rowp + n * 16) = acc[ai][0][m][n]; }
    }
};
struct EpiY {
    static constexpr bool PERM = true;
    const bf16_t* as; const float* dvec; bf16_t* zgs;
    __device__ __forceinline__ void operator()(AccRef acc, const Unit& u, int wr, int wc, int fr, int fq) const {
        const int row0 = u.pm * 256 + wr * 64 + fr, colt = wc * 32 + 8 * fq, g = u.pm >> 3, h0 = (8 * fq) & 15;
        const f32x4 d0 = *(const f32x4*)(dvec + g * 16 + h0), d1 = *(const f32x4*)(dvec + g * 16 + h0 + 4);
#pragma unroll
        for (int ai = 0; ai < 2; ++ai)
#pragma unroll
            for (int m = 0; m < 4; ++m) { const int row = row0 + ai * HALF + m * 16; const int b = (row >> 9) & 3, ch = row & 511;
#pragma unroll
                for (int bj = 0; bj < 2; ++bj) { const int c = bj * HALF + colt, tt = c >> 4;
                    float uu[8]; unpack8(*(const u32x4*)(as + (size_t)row * AS_LD + c), uu);
                    const f32x4 v0 = acc[ai][bj][m][0], v1 = acc[ai][bj][m][1];
                    float o[8];
#pragma unroll
                    for (int j = 0; j < 4; ++j) { o[j] = gelu_tanh(v0[j] + d0[j] * uu[j]); o[4 + j] = gelu_tanh(v1[j] + d1[j] * uu[4 + j]); }
                    const size_t tok = (size_t)b * SEQ + ch * 16 + tt;
                    *(u32x4*)(zgs + tok * BW + g * 16 + h0) = pack8(o); }
                asm volatile("" ::: "memory"); }
    }
};
struct EpiGlu {
    static constexpr bool PERM = true;
    const bf16_t* zgs; const float* bias; bf16_t* g3;
    __device__ __forceinline__ void operator()(AccRef acc, const Unit& u, int wr, int wc, int fr, int fq) const {
        const int row0 = u.pm * 256 + wr * 64 + fr, col0 = u.pn * 256 + wc * 32 + 8 * fq;
#pragma unroll
        for (int ai = 0; ai < 2; ++ai)
#pragma unroll
            for (int m = 0; m < 4; ++m) { const size_t row = (size_t)(row0 + ai * HALF + m * 16);
#pragma unroll
                for (int bj = 0; bj < 2; ++bj) { const int c = col0 + bj * HALF;
                    float z[8], gt[8]; unpack8(*(const u32x4*)(zgs + row * BW + c), z); bf16_t* gp = g3 + row * G3_LD + 512 + c; unpack8(*(const u32x4*)gp, gt);
                    const f32x4 b0 = *(const f32x4*)(bias + c), b1 = *(const f32x4*)(bias + c + 4);
                    const f32x4 v0 = acc[ai][bj][m][0], v1 = acc[ai][bj][m][1];
                    float o[8];
#pragma unroll
                    for (int j = 0; j < 4; ++j) { o[j] = z[j] * sigmoidf_(v0[j] + b0[j]) * siluf_(gt[j]); o[4 + j] = z[4 + j] * sigmoidf_(v1[j] + b1[j]) * siluf_(gt[4 + j]); }
                    *(u32x4*)gp = pack8(o); } }
    }
};
struct EpiLru {
    static constexpr bool PERM = true;
    const bf16_t* xc; const float *ba, *bx, *lam; bf16_t* ab;
    __device__ __forceinline__ void operator()(AccRef acc, const Unit& u, int wr, int wc, int fr, int fq) const {
        const int row0 = u.pm * 256 + wr * 64 + fr, ch = u.pn * 128 + wc * 32 + 8 * fq;
        float bav[8], bxv[8], spl[8];
#pragma unroll
        for (int j = 0; j < 8; ++j) { bav[j] = ba[ch + j]; bxv[j] = bx[ch + j]; spl[j] = -8.0f * softplusf_(-lam[ch + j]); }
#pragma unroll
        for (int ai = 0; ai < 2; ++ai)
#pragma unroll
            for (int m = 0; m < 4; ++m) { const size_t row = (size_t)(row0 + ai * HALF + m * 16);
                float x[8]; unpack8(*(const u32x4*)(xc + row * BW + ch), x);
                float la[8], bb[8];
#pragma unroll
                for (int j = 0; j < 8; ++j) { const float za = acc[ai][0][m][j >> 2][j & 3], zx = acc[ai][1][m][j >> 2][j & 3];
                    const float r = sigmoidf_(za + bav[j]), ig = sigmoidf_(zx + bxv[j]);
                    const float l_a = spl[j] * r; la[j] = l_a;
                    bb[j] = sqrtf(fmaxf(-expm1f(2.0f * l_a), 0.0f)) * (ig * x[j]); }
                *(u32x4*)(ab + row * 1024 + ch) = pack8(la); *(u32x4*)(ab + row * 1024 + 512 + ch) = pack8(bb); }
    }
};
struct EpiOut {
    static constexpr bool PERM = false;
    const float* hin; float* h; bf16_t* h1b;
    __device__ __forceinline__ void operator()(AccRef acc, const Unit& u, int wr, int wc, int fr, int fq) const {
        const int row0 = u.pm * 256 + wr * 64 + fr, col0 = u.pn * 256 + wc * 32 + 4 * fq;
#pragma unroll
        for (int ai = 0; ai < 2; ++ai)
#pragma unroll
            for (int m = 0; m < 4; ++m) { const size_t off = (size_t)(row0 + ai * HALF + m * 16) * D + col0;
#pragma unroll
                for (int bj = 0; bj < 2; ++bj)
#pragma unroll
                    for (int n = 0; n < 2; ++n) { const size_t o = off + bj * HALF + n * 16; const f32x4 v = *(const f32x4*)(hin + o) + acc[ai][bj][m][n];
                        *(f32x4*)(h + o) = v; u32x2 w; w.x = cvt_pk_bf16(v[0], v[1]); w.y = cvt_pk_bf16(v[2], v[3]); *(u32x2*)(h1b + o) = w; }
                asm volatile("" ::: "memory"); }
    }
};
struct EpiGate {
    static constexpr bool PERM = false;
    float* h; const bf16_t* pw; const float* ssp; const float* gple; float* ssh;
    __device__ __forceinline__ void operator()(AccRef acc, const Unit& u, int wr, int wc, int fr, int fq) const {
        const int row0 = u.pm * 256 + wr * 64 + fr, col0 = u.pn * 256 + wc * 32 + 4 * fq;
        f32x4 gv[2][2];
#pragma unroll
        for (int bj = 0; bj < 2; ++bj)
#pragma unroll
            for (int n = 0; n < 2; ++n) gv[bj][n] = *(const f32x4*)(gple + col0 + bj * HALF + n * 16);
#pragma unroll
        for (int ai = 0; ai < 2; ++ai)
#pragma unroll
            for (int m = 0; m < 4; ++m) { const int row = row0 + ai * HALF + m * 16; const size_t off = (size_t)row * D + col0;
                const float rs = rsqrtf(ssp[row] * (1.0f / 1024.0f) + 1e-6f); float s = 0.f;
#pragma unroll
                for (int bj = 0; bj < 2; ++bj)
#pragma unroll
                    for (int n = 0; n < 2; ++n) { const size_t o = off + bj * HALF + n * 16; const u32x2 pwv = *(const u32x2*)(pw + o); const f32x4 a = acc[ai][bj][m][n]; f32x4 v = *(const f32x4*)(h + o);
                        v[0] += lo16(pwv.x) * rs * gv[bj][n][0] * sigmoidf_(a[0]); v[1] += hi16(pwv.x) * rs * gv[bj][n][1] * sigmoidf_(a[1]);
                        v[2] += lo16(pwv.y) * rs * gv[bj][n][2] * sigmoidf_(a[2]); v[3] += hi16(pwv.y) * rs * gv[bj][n][3] * sigmoidf_(a[3]);
                        s += v[0] * v[0] + v[1] * v[1] + v[2] * v[2] + v[3] * v[3];
                        *(f32x4*)(h + o) = v; }
                s += __shfl_xor(s, 16); s += __shfl_xor(s, 32);
                if (fq == 0) unsafeAtomicAdd(ssh + row, s); }
    }
};

struct Ctx { const Params* P; unsigned char* ws; LAS unsigned char* lds; unsigned char* ldsg; int tid, lane, wave; size_t gtid, gsz; int vb, vG; };

template <class Map>
__device__ void transpose_w(const Ctx& c, const float* src, bf16_t* dst, int K, int Nsrc, int Npad, Map map) {
    const int K8 = K / 8; const size_t total = (size_t)2 * Npad * K8;
    for (size_t idx = c.gtid; idx < total; idx += c.gsz) {
        const int n = (int)(idx % Npad); const int k8 = (int)((idx / Npad) % K8); const int l = (int)(idx / ((size_t)Npad * K8));
        const int s = map(n); float f[8];
#pragma unroll
        for (int i = 0; i < 8; ++i) f[i] = (s >= 0) ? src[((size_t)l * K + k8 * 8 + i) * Nsrc + s] : 0.0f;
        *(u32x4*)(dst + ((size_t)l * Npad + n) * K + k8 * 8) = pack8(f);
    }
}

__device__ __forceinline__ void s5_lam_pow(const Params& P, int l, int g, int p, int n, float& re, float& im) {
    const float are = P.in[14][(l * 32 + g) * 64 + p], aim = P.in[15][(l * 32 + g) * 64 + p], dt = __expf(P.in[16][l * 32 + g]);
    const float mag = __expf(are * dt * (float)n);
    double rev = (double)aim * (double)dt * (double)n * 0.15915494309189535; rev -= rint(rev);
    const float ang = (float)(rev * 6.283185307179586);
    re = mag * cosf(ang); im = mag * sinf(ang);
}

__device__ void phase_prep(const Ctx& c) {
    const Params& P = *c.P; unsigned char* ws = c.ws;
    transpose_w(c, P.in[3], (bf16_t*)(ws + OFF_WIN), D, DIN, DINP, [](int n) { return n < 1664 ? n : (n < 1792 ? -1 : n - 128); });
    transpose_w(c, P.in[31], (bf16_t*)(ws + OFF_WOUT), DMIX, D, D, [](int n) { return n; });
    transpose_w(c, P.in[34], (bf16_t*)(ws + OFF_WG), D, D, D, [](int n) { return n; });
    transpose_w(c, P.in[32], (bf16_t*)(ws + OFF_WPLE), DPLE, D, D, [](int n) { return n; });
    transpose_w(c, P.in[22], (bf16_t*)(ws + OFF_WGLU), BW, BW, BW, [](int n) { return n; });
    { bf16_t* dst = (bf16_t*)(ws + OFF_WLRU);
      for (size_t idx = c.gtid; idx < (size_t)2 * 1024 * 64; idx += c.gsz) {
          const int n = (int)(idx & 1023), k8 = (int)((idx >> 10) & 63), l = (int)(idx >> 16);
          const int pn = n >> 8, rr = n & 255, ch = 128 * pn + (rr & 127), which = rr >> 7, hb = ch >> 6, j = ch & 63, k0 = k8 * 8;
          const float* W = which ? P.in[28] : P.in[26]; float f[8];
#pragma unroll
          for (int i = 0; i < 8; ++i) f[i] = ((k0 >> 6) == hb) ? W[(((size_t)l * 8 + hb) * 64 + (k0 & 63) + i) * 64 + j] : 0.0f;
          *(u32x4*)(dst + ((size_t)l * 1024 + n) * BW + k0) = pack8(f); } }
    { float* tbl = (float*)(ws + OFF_TBL);
      for (size_t idx = c.gtid; idx < (size_t)2 * 32 * 64 * 18; idx += c.gsz) {
          const int n = (int)(idx % 18), lgp = (int)(idx / 18), p = lgp & 63, g = (lgp >> 6) & 31, l = lgp >> 11; float re, im;
          if (n < 17) s5_lam_pow(P, l, g, p, n, re, im);
          else { float lr, li; s5_lam_pow(P, l, g, p, 1, lr, li); const float ar = P.in[14][(l * 32 + g) * 64 + p], ai = P.in[15][(l * 32 + g) * 64 + p];
                 const float cr = lr - 1.0f, ci = li, den = 1.0f / (ar * ar + ai * ai); re = (cr * ar + ci * ai) * den; im = (ci * ar - cr * ai) * den; }
          tbl[idx * 2] = re; tbl[idx * 2 + 1] = im; } }
    { const float* x = P.in[0]; const float* gg = P.in[2]; bf16_t* xn = (bf16_t*)(ws + OFF_XN);
      for (int row = blockIdx.x * 8 + c.wave; row < T; row += gridDim.x * 8) {
          f32x4 v[4]; float s = 0.f;
#pragma unroll
          for (int i = 0; i < 4; ++i) { v[i] = *(const f32x4*)(x + (size_t)row * D + i * 256 + c.lane * 4); s += v[i][0] * v[i][0] + v[i][1] * v[i][1] + v[i][2] * v[i][2] + v[i][3] * v[i][3]; }
          s = wave_sum(s); const float rs = rsqrtf(s * (1.0f / 1024.0f) + 1e-6f);
#pragma unroll
          for (int i = 0; i < 4; ++i) { const f32x4 gv = *(const f32x4*)(gg + i * 256 + c.lane * 4); u32x2 w; w.x = cvt_pk_bf16(v[i][0] * rs * gv[0], v[i][1] * rs * gv[1]); w.y = cvt_pk_bf16(v[i][2] * rs * gv[2], v[i][3] * rs * gv[3]);
              *(u32x2*)(xn + (size_t)row * D + i * 256 + c.lane * 4) = w; } } }
    { float* ss = (float*)(ws + OFF_SS); for (size_t i = c.gtid; i < (size_t)4 * T; i += c.gsz) ss[i] = 0.0f; }
    { const float* p = P.in[1]; bf16_t* pb = (bf16_t*)(ws + OFF_PB);
      for (size_t i = c.gtid; i < (size_t)2 * T * DPLE / 8; i += c.gsz) { const f32x4 a = *(const f32x4*)(p + i * 8), b = *(const f32x4*)(p + i * 8 + 4);
          u32x4 w; w.x = cvt_pk_bf16(a[0], a[1]); w.y = cvt_pk_bf16(a[2], a[3]); w.z = cvt_pk_bf16(b[0], b[1]); w.w = cvt_pk_bf16(b[2], b[3]); *(u32x4*)(pb + i * 8) = w; } }
}

__device__ void phase_s5_consts(const Ctx& c) {
    const Params& P = *c.P; unsigned char* ws = c.ws;
    const float* tbl = (const float*)(ws + OFF_TBL); bf16_t* by = (bf16_t*)(ws + OFF_S5Y); bf16_t* be = (bf16_t*)(ws + OFF_S5E);
    const float *bre = P.in[17], *bim = P.in[18], *cre = P.in[19], *cim = P.in[20];
    for (size_t idx = c.gtid; idx < (size_t)2 * 32 * 16 * 256; idx += c.gsz) {
        const int hp = (int)(idx & 15), h = (int)((idx >> 4) & 15), tau = (int)((idx >> 8) & 15), g = (int)((idx >> 12) & 31), l = (int)(idx >> 17);
        const int lg = l * 32 + g; float s = 0.f;
        for (int p = 0; p < 64; ++p) { const float* tp = tbl + ((size_t)(lg * 64 + p) * 18) * 2;
            const float pr = tp[tau * 2], pi = tp[tau * 2 + 1], qr = tp[34], qi = tp[35];
            const float br = bre[((size_t)lg * 64 + p) * 16 + hp], bi = bim[((size_t)lg * 64 + p) * 16 + hp];
            const float bbr = qr * br - qi * bi, bbi = qr * bi + qi * br;
            const float zr = pr * bbr - pi * bbi, zi = pr * bbi + pi * bbr;
            const float cr = cre[((size_t)lg * 16 + h) * 64 + p], ci = cim[((size_t)lg * 16 + h) * 64 + p];
            s += cr * zr - ci * zi; }
        const bf16_t kv = f2bf(s); bf16_t* base = by + (size_t)lg * 256 * AS_LD;
        for (int s0 = 0; s0 + tau < 16; ++s0) { const int t = s0 + tau;
            base[(size_t)(t * 16 + h) * AS_LD + s0 * 16 + hp] = kv;
            if (tau > 0) base[(size_t)(s0 * 16 + h) * AS_LD + t * 16 + hp] = 0; }
    }
    for (size_t idx = c.gtid; idx < (size_t)2 * 32 * 256 * 64; idx += c.gsz) {
        const int p = (int)(idx & 63), th = (int)((idx >> 6) & 255), lg = (int)(idx >> 14); const int t = th >> 4, h = th & 15;
        const float* tp = tbl + ((size_t)(lg * 64 + p) * 18) * 2; const float pr = tp[(t + 1) * 2], pi = tp[(t + 1) * 2 + 1];
        const float cr = cre[((size_t)lg * 16 + h) * 64 + p], ci = cim[((size_t)lg * 16 + h) * 64 + p];
        bf16_t* rowp = by + ((size_t)lg * 256 + th) * AS_LD; rowp[256 + p] = f2bf(cr * pr - ci * pi); rowp[320 + p] = f2bf(-(cr * pi + ci * pr));
    }
    for (size_t idx = c.gtid; idx < (size_t)2 * 32 * 256 * 256; idx += c.gsz) {
        const int col = (int)(idx & 255), n = (int)((idx >> 8) & 255), lg = (int)(idx >> 16); float v = 0.f;
        if (n < 128) { const int p = n & 63, s0 = col >> 4, hp = col & 15; const float* tp = tbl + ((size_t)(lg * 64 + p) * 18) * 2;
            const float pr = tp[(15 - s0) * 2], pi = tp[(15 - s0) * 2 + 1], qr = tp[34], qi = tp[35];
            const float br = bre[((size_t)lg * 64 + p) * 16 + hp], bi = bim[((size_t)lg * 64 + p) * 16 + hp];
            const float bbr = qr * br - qi * bi, bbi = qr * bi + qi * br;
            v = (n < 64) ? (pr * bbr - pi * bbi) : (pr * bbi + pi * bbr); }
        be[idx] = f2bf(v);
    }
}

__device__ void phase_lru_conv(const Ctx& c, int l) {
    const Params& P = *c.P; const bf16_t* xl = (const bf16_t*)(c.ws + OFF_XL); bf16_t* xc = (bf16_t*)(c.ws + OFF_XC);
    const float* cw = P.in[24] + (size_t)l * 4 * BW; const float* cb = P.in[25] + (size_t)l * BW;
    for (size_t idx = (size_t)c.vb * 512 + c.tid; idx < (size_t)T * 64; idx += (size_t)c.vG * 512) {
        const int c8 = (int)(idx & 63) * 8; const int row = (int)(idx >> 6), lpos = row & (SEQ - 1);
        float o[8];
#pragma unroll
        for (int i = 0; i < 8; ++i) o[i] = cb[c8 + i];
#pragma unroll
        for (int j = 0; j < 4; ++j) { if (lpos - 3 + j >= 0) { float x[8]; unpack8(*(const u32x4*)(xl + (size_t)(row - 3 + j) * BW + c8), x);
#pragma unroll
                for (int i = 0; i < 8; ++i) o[i] += x[i] * cw[j * BW + c8 + i]; } }
        *(u32x4*)(xc + (size_t)row * BW + c8) = pack8(o);
    }
}

__device__ void phase_s5_carry(const Ctx& c, int l) {
    if (c.wave != 0 || c.vb >= 128) return;
    const int g = c.vb >> 2, b = c.vb & 3, p = c.lane;
    float lr, li; s5_lam_pow(*c.P, l, g, p, 16, lr, li);
    const float* e = (const float*)(c.ws + OFF_E); bf16_t* as = (bf16_t*)(c.ws + OFF_AS);
    const size_t base = (size_t)g * 2048 + b * 512; float xr = 0.f, xi = 0.f;
    for (int c0 = 0; c0 < 512; c0 += 32) {
        float er[32], ei[32];
#pragma unroll
        for (int i = 0; i < 32; ++i) { er[i] = e[(base + c0 + i) * 128 + p]; ei[i] = e[(base + c0 + i) * 128 + 64 + p]; }
#pragma unroll
        for (int i = 0; i < 32; ++i) { bf16_t* rowp = as + (base + c0 + i) * AS_LD; rowp[256 + p] = f2bf(xr); rowp[320 + p] = f2bf(xi);
            const float nr = lr * xr - li * xi + er[i], ni = lr * xi + li * xr + ei[i]; xr = nr; xi = ni; }
    }
}

__device__ void phase_lru_scan(const Ctx& c, int pass) {
    const bf16_t* ab = (const bf16_t*)(c.ws + OFF_LRUAB); float* agg = (float*)(c.ws + OFF_AGG); bf16_t* g3 = (bf16_t*)(c.ws + OFF_G3);
    const int ch = c.tid;
    for (int unit = c.vb; unit < NB * 128; unit += c.vG) {
        const int b = unit >> 7, ck = unit & 127; const size_t t0 = (size_t)b * SEQ + ck * 64;
        float h = 0.f, sl = 0.f;
        if (pass == 1) {
            for (int i0 = 0; i0 < ck; i0 += 16) { float sl_[16], he_[16];
#pragma unroll
                for (int j = 0; j < 16; ++j) { const int ii = (i0 + j < ck) ? i0 + j : ck - 1; const float* a = agg + ((size_t)(b * 128 + ii)) * 1024; sl_[j] = a[ch]; he_[j] = a[512 + ch]; }
#pragma unroll
                for (int j = 0; j < 16; ++j) if (i0 + j < ck) h = __expf(sl_[j]) * h + he_[j]; }
        }
        for (int t8 = 0; t8 < 64; t8 += 16) {
            float la[16], bb[16], gt[16];
#pragma unroll
            for (int i = 0; i < 16; ++i) { la[i] = bf2f(ab[(t0 + t8 + i) * 1024 + ch]); bb[i] = bf2f(ab[(t0 + t8 + i) * 1024 + 512 + ch]); if (pass == 1) gt[i] = bf2f(g3[(t0 + t8 + i) * G3_LD + 1024 + ch]); }
#pragma unroll
            for (int i = 0; i < 16; ++i) { h = __expf(la[i]) * h + bb[i]; sl += la[i];
                if (pass == 1) g3[(t0 + t8 + i) * G3_LD + 1024 + ch] = f2bf(h * siluf_(gt[i])); }
        }
        if (pass == 0) { float* a = agg + ((size_t)(b * 128 + ck)) * 1024; a[ch] = sl; a[512 + ch] = h; }
    }
}

__device__ void phase_norm(const Ctx& c, const float* ss, const float* gg, int fin) {
    float* h = c.P->out; bf16_t* xn = (bf16_t*)(c.ws + OFF_XN);
    for (int row = blockIdx.x * 8 + c.wave; row < T; row += gridDim.x * 8) {
        const float rs = rsqrtf(ss[row] * (1.0f / 1024.0f) + 1e-6f);
#pragma unroll
        for (int i = 0; i < 4; ++i) { const size_t o = (size_t)row * D + i * 256 + c.lane * 4; const f32x4 v = *(const f32x4*)(h + o); const f32x4 gv = *(const f32x4*)(gg + i * 256 + c.lane * 4);
            const f32x4 r = v * rs * gv;
            if (fin) *(f32x4*)(h + o) = r; else { u32x2 w; w.x = cvt_pk_bf16(r[0], r[1]); w.y = cvt_pk_bf16(r[2], r[3]); *(u32x2*)(xn + o) = w; } }
    }
}

typedef float f32x2 __attribute__((ext_vector_type(2)));
template <int CTRL> __device__ __forceinline__ float dpp_mov(float v) { return __builtin_bit_cast(float, __builtin_amdgcn_update_dpp(0, __builtin_bit_cast(int, v), CTRL, 0xf, 0xf, true)); }
__device__ __forceinline__ float row16_sum(float v) { v += dpp_mov<0xB1>(v); v += dpp_mov<0x4E>(v); v += dpp_mov<0x124>(v); v += dpp_mov<0x128>(v); return v; }
__device__ __forceinline__ float wave_sum2(float v) { v = row16_sum(v); const int vi = __builtin_bit_cast(int, v); const float a = __builtin_bit_cast(float, __builtin_amdgcn_readlane(vi, 0)), b = __builtin_bit_cast(float, __builtin_amdgcn_readlane(vi, 16)), c2 = __builtin_bit_cast(float, __builtin_amdgcn_readlane(vi, 32)), d = __builtin_bit_cast(float, __builtin_amdgcn_readlane(vi, 48)); return (a + b) + (c2 + d); }
__device__ __forceinline__ float oct_sum(float v) { v += dpp_mov<0xB1>(v); v += dpp_mov<0x4E>(v); v += dpp_mov<0x141>(v); return v; }
constexpr int RW_NBLK = 128, TWS = 72;

struct RwRows { unsigned zr[5], zk[5], zv[5], zw[5], za[5]; };
__device__ __forceinline__ float rw_get(const unsigned (&a)[5], int i) { return (i & 1) ? hi16(a[i >> 1]) : lo16(a[i >> 1]); }
__device__ __forceinline__ void rw_load_rows(RwRows& R, const bf16_t* zrw, int b, int blk, int w, int lane, int cj) {
#pragma unroll
    for (int p = 0; p < 5; ++p) { unsigned r_[2] = {0, 0}, k_[2] = {0, 0}, v_[2] = {0, 0}, w_[2] = {0, 0}, a_[2] = {0, 0};
#pragma unroll
        for (int h = 0; h < 2; ++h) { const int i = 2 * p + h; if (i < 9) { const int lp = blk * 64 + w * 8 - 1 + i; const bool ok = lp >= 0; const bf16_t* rp = zrw + ((size_t)b * SEQ + (ok ? lp : 0)) * ZRW_LD;
            const unsigned m = ok ? 0xffffu : 0u;
            r_[h] = rp[cj] & m; k_[h] = rp[512 + cj] & m; v_[h] = rp[1024 + cj] & m; w_[h] = rp[1536 + lane] & m; a_[h] = rp[1600 + lane] & m; } }
        R.zr[p] = r_[0] | (r_[1] << 16); R.zk[p] = k_[0] | (k_[1] << 16); R.zv[p] = v_[0] | (v_[1] << 16); R.zw[p] = w_[0] | (w_[1] << 16); R.za[p] = a_[0] | (a_[1] << 16); }
}

constexpr int CH_AT = 0, CH_RT = 2304, CH_KT = 4608, CH_BT = 6912, CH_KH = 9216, CH_NB = 12288, CH_VT = 15360, CH_LRK = 18432, CH_NLRB = 19200, CH_GI = 19968,
              CH_LAB = 20736, CH_LAK = 21760, CH_GC = 22784, CH_BYTES = 23040;
constexpr int RW_YY = 4 * CH_BYTES, RW_TW = RW_YY + 16384, RW_AD = RW_TW + 64 * TWS * 2, RW_AR = RW_TW  , RW_GP = RW_AD + 64 * TWS * 2,
              RW_W2 = RW_GP + 2048, RW_A2 = RW_W2 + 64 * TWS * 2, RW_CT = RW_A2 + 64 * TWS * 2, RW_END = RW_CT + 12 * 64 * 4;
static_assert(RW_END <= LDS_BYTES, "rwkv lds");
__device__ __forceinline__ void lds_barrier() { asm volatile("s_waitcnt lgkmcnt(0)\n\ts_barrier" ::: "memory"); }
typedef short bf16x4 __attribute__((ext_vector_type(4)));
__device__ __forceinline__ bf16x8 cat4(bf16x4 lo, bf16x4 hi) { return __builtin_shufflevector(lo, hi, 0, 1, 2, 3, 4, 5, 6, 7); }
__device__ __forceinline__ bf16x8 cat4z(bf16x4 lo) { const bf16x4 z = {0, 0, 0, 0}; return __builtin_shufflevector(lo, z, 0, 1, 2, 3, 4, 5, 6, 7); }
__device__ __forceinline__ bf16x4 pk4(f32x4 v) { u32x2 w; w.x = cvt_pk_bf16(v[0], v[1]); w.y = cvt_pk_bf16(v[2], v[3]); return __builtin_bit_cast(bf16x4, w); }

__device__ void phase_rwkv(const Ctx& c, int l, int blk_lo, int blk_hi, bool dry = false) {
    if (blockIdx.x >= 32) return;
    const Params& P = *c.P; const int b = blockIdx.x >> 3, hd = blockIdx.x & 7, lane = c.lane, w = c.wave, cj = hd * 64 + lane, fr = lane & 15, fq = lane >> 4;
    LAS unsigned char* LB = c.lds;
    LAS float* YY = (LAS float*)(LB + RW_YY); LAS float* WR = YY; LAS float* AR = (LAS float*)(LB + RW_AR); LAS float* GP = (LAS float*)(LB + RW_GP);
    LAS bf16_t* TWb = (LAS bf16_t*)(LB + RW_TW); LAS bf16_t* ADb = (LAS bf16_t*)(LB + RW_AD);
    const bf16_t* zrw = (const bf16_t*)(c.ws + OFF_ZRW); bf16_t* g3 = (bf16_t*)(c.ws + OFF_G3);
    LAS float* CT = (LAS float*)(LB + RW_CT);
    if (c.tid < 64) { const float* mu = P.in[4] + (size_t)l * 1664; const int j = hd * 64 + c.tid;
        CT[0 * 64 + c.tid] = mu[j]; CT[1 * 64 + c.tid] = mu[512 + j]; CT[2 * 64 + c.tid] = mu[1024 + j]; CT[3 * 64 + c.tid] = mu[1536 + c.tid]; CT[4 * 64 + c.tid] = mu[1600 + c.tid];
        CT[5 * 64 + c.tid] = P.in[5][l * BW + j]; CT[6 * 64 + c.tid] = P.in[7][l * BW + j]; CT[7 * 64 + c.tid] = P.in[9][l * BW + j]; CT[8 * 64 + c.tid] = P.in[10][l * BW + j];
        CT[9 * 64 + c.tid] = P.in[11][l * BW + j]; CT[10 * 64 + c.tid] = P.in[12][l * BW + j]; CT[11 * 64 + c.tid] = P.in[13][l * BW + j]; }
    const int mt_ = w >> 1, nh = w & 1;
    LAS bf16_t* W2I = (LAS bf16_t*)(LB + RW_W2); LAS bf16_t* A2I = (LAS bf16_t*)(LB + RW_A2);
    for (int i = c.tid; i < 4096; i += 512) { const int k = i >> 6, j = i & 63; W2I[j * TWS + k] = f2bf(P.in[6][((size_t)l * 64 + k) * BW + hd * 64 + j]); A2I[j * TWS + k] = f2bf(P.in[8][((size_t)l * 64 + k) * BW + hd * 64 + j]); }
    __syncthreads();
    f32x4 Macc[4];
#pragma unroll
    for (int i = 0; i < 4; ++i) Macc[i] = (f32x4){0.f, 0.f, 0.f, 0.f};
    const int cc = w >> 1, hc = w & 1;
    RwRows cur;
    rw_load_rows(cur, zrw, b, blk_lo, w, lane, cj);
    for (int blk = blk_lo; blk < blk_hi; ++blk) {
        const size_t t0 = (size_t)b * SEQ + blk * 64;
        float rs[8], ks_[8], vs[8];
        const float mu_r = CT[lane], mu_k = CT[64 + lane], mu_v = CT[128 + lane], mu_w = CT[192 + lane], mu_a = CT[256 + lane];
#pragma unroll
        for (int i = 0; i < 8; ++i) { const int tok = w * 8 + i;
            { const float r0 = rw_get(cur.zr, i), r1 = rw_get(cur.zr, i + 1), k0 = rw_get(cur.zk, i), k1 = rw_get(cur.zk, i + 1), v0 = rw_get(cur.zv, i), v1 = rw_get(cur.zv, i + 1);
              rs[i] = r1 + mu_r * (r0 - r1); ks_[i] = k1 + mu_k * (k0 - k1); vs[i] = v1 + mu_v * (v0 - v1); }
            const float w0_ = rw_get(cur.zw, i), w1_ = rw_get(cur.zw, i + 1), a0_ = rw_get(cur.za, i), a1_ = rw_get(cur.za, i + 1);
            const float wds = w1_ + mu_w * (w0_ - w1_), ads = a1_ + mu_a * (a0_ - a1_);
            const float e2 = __expf(2.0f * wds); const float th = 1.0f - 2.0f * __builtin_amdgcn_rcpf(e2 + 1.0f);
            TWb[tok * TWS + lane] = f2bf(th); ADb[tok * TWS + lane] = f2bf(ads); }
        if (blk + 1 < RW_NBLK) rw_load_rows(cur, zrw, b, blk + 1, w, lane, cj);
        unsigned gtp[4];
#pragma unroll
        for (int i = 0; i < 4; ++i) gtp[i] = (unsigned)g3[(t0 + w * 8 + 2 * i) * G3_LD + cj] | ((unsigned)g3[(t0 + w * 8 + 2 * i + 1) * G3_LD + cj] << 16);
        lds_barrier();
        { bf16x8 atw[2], aad[2];
#pragma unroll
          for (int ks = 0; ks < 2; ++ks) { atw[ks] = *(const LAS bf16x8*)(TWb + (16 * mt_ + fr) * TWS + 32 * ks + 8 * fq); aad[ks] = *(const LAS bf16x8*)(ADb + (16 * mt_ + fr) * TWS + 32 * ks + 8 * fq); }
          f32x4 cw[2], ca[2];
#pragma unroll
          for (int n2 = 0; n2 < 2; ++n2) { cw[n2] = (f32x4){0.f, 0.f, 0.f, 0.f}; ca[n2] = cw[n2];
#pragma unroll
              for (int ks = 0; ks < 2; ++ks) { const int bo = (32 * nh + 16 * n2 + fr) * TWS + 32 * ks + 8 * fq;
                  cw[n2] = __builtin_amdgcn_mfma_f32_16x16x32_bf16(atw[ks], *(const LAS bf16x8*)(W2I + bo), cw[n2], 0, 0, 0); ca[n2] = __builtin_amdgcn_mfma_f32_16x16x32_bf16(aad[ks], *(const LAS bf16x8*)(A2I + bo), ca[n2], 0, 0, 0); } }
          lds_barrier();
#pragma unroll
          for (int n2 = 0; n2 < 2; ++n2)
#pragma unroll
              for (int r = 0; r < 4; ++r) { const int o = (16 * mt_ + 4 * fq + r) * 64 + 32 * nh + 16 * n2 + fr; WR[o] = cw[n2][r]; AR[o] = ca[n2][r]; } }
        lds_barrier();
        float kkv[8], kpv[8], bbv[8], gl[8], cbv[8];
        { float g = 1.0f; const float w0j = CT[320 + lane], a0j = CT[384 + lane], kkj = CT[448 + lane], kaj = CT[512 + lane], rkj = CT[576 + lane];
#pragma unroll
          for (int i = 0; i < 8; ++i) { const int o = (w * 8 + i) * 64 + lane;
            const float wraw = w0j + WR[o], araw = a0j + AR[o];
            const float d = __expf(-0.6065306597126334f * sigmoidf_(wraw)), a = sigmoidf_(araw);
            float kk = ks_[i] * kkj; const float n2 = wave_sum2(kk * kk); kk = kk * __builtin_amdgcn_rsqf(fmaxf(n2, 1e-24f));
            const float kp = ks_[i] * (1.0f + (a - 1.0f) * kaj);
            cbv[i] = wave_sum2(rs[i] * kp * rkj);
            g *= d; gl[i] = g; kkv[i] = kk; kpv[i] = kp; bbv[i] = kk * a; }
          GP[w * 64 + lane] = g; }
        lds_barrier();
        { LAS unsigned char* CB_ = LB + cc * CH_BYTES;
          LAS bf16_t *AT = (LAS bf16_t*)(CB_ + CH_AT), *RT = (LAS bf16_t*)(CB_ + CH_RT), *KT = (LAS bf16_t*)(CB_ + CH_KT), *BT = (LAS bf16_t*)(CB_ + CH_BT),
                     *KH = (LAS bf16_t*)(CB_ + CH_KH), *NBH = (LAS bf16_t*)(CB_ + CH_NB), *VT = (LAS bf16_t*)(CB_ + CH_VT);
          const float g0 = GP[(2 * cc) * 64 + lane], g1 = GP[(2 * cc + 1) * 64 + lane], gC = g0 * g1, pre = hc ? g0 : 1.0f;
          if (hc == 0) ((LAS float*)(CB_ + CH_GC))[lane] = gC;
#pragma unroll
          for (int i = 0; i < 8; ++i) { const int tl = 8 * hc + i;
            const float gam = pre * gl[i], gprev = (i == 0) ? pre : pre * gl[i - 1], ig = __builtin_amdgcn_rcpf(gam), gr = gC * ig;
            AT[tl * TWS + lane] = f2bf(kkv[i] * gprev); RT[tl * TWS + lane] = f2bf(rs[i] * gam); KT[tl * TWS + lane] = f2bf(kpv[i] * ig); BT[tl * TWS + lane] = f2bf(bbv[i] * ig);
            KH[lane * 24 + tl] = f2bf(kpv[i] * gr); NBH[lane * 24 + tl] = f2bf(-bbv[i] * gr); VT[lane * 24 + tl] = f2bf(vs[i]); } }
        lds_barrier();
        if (w < 4 && !(RW_OFF & 4)) { LAS unsigned char* CB_ = LB + w * CH_BYTES;
          const LAS bf16_t *AT = (const LAS bf16_t*)(CB_ + CH_AT), *RT = (const LAS bf16_t*)(CB_ + CH_RT), *KT = (const LAS bf16_t*)(CB_ + CH_KT), *BT = (const LAS bf16_t*)(CB_ + CH_BT);
          f32x4 lab = (f32x4){0.f, 0.f, 0.f, 0.f}, lak = lab, lrk = lab, lrb = lab;
#pragma unroll
          for (int ks = 0; ks < 2; ++ks) { const int o = fr * TWS + 32 * ks + 8 * fq;
            const bf16x8 af = *(const LAS bf16x8*)(AT + o), rf = *(const LAS bf16x8*)(RT + o), kf = *(const LAS bf16x8*)(KT + o), bf = *(const LAS bf16x8*)(BT + o);
            lab = __builtin_amdgcn_mfma_f32_16x16x32_bf16(af, bf, lab, 0, 0, 0); lak = __builtin_amdgcn_mfma_f32_16x16x32_bf16(af, kf, lak, 0, 0, 0);
            lrk = __builtin_amdgcn_mfma_f32_16x16x32_bf16(rf, kf, lrk, 0, 0, 0); lrb = __builtin_amdgcn_mfma_f32_16x16x32_bf16(rf, bf, lrb, 0, 0, 0); }
          LAS float *LAB = (LAS float*)(CB_ + CH_LAB), *LAK = (LAS float*)(CB_ + CH_LAK); LAS bf16_t *LRK = (LAS bf16_t*)(CB_ + CH_LRK), *NLRB = (LAS bf16_t*)(CB_ + CH_NLRB);
#pragma unroll
          for (int r = 0; r < 4; ++r) { const int t = 4 * fq + r, s_ = fr; const bool lo_ = t > s_, le_ = t >= s_;
            LAB[t * 16 + s_] = lo_ ? lab[r] : 0.0f; LAK[t * 16 + s_] = lo_ ? lak[r] : 0.0f;
            LRK[t * 24 + s_] = f2bf(le_ ? lrk[r] : 0.0f); NLRB[t * 24 + s_] = f2bf(le_ ? -lrb[r] : 0.0f); } }
        lds_barrier();
        { const int ch6 = w & 3; LAS unsigned char* CB_ = LB + ch6 * CH_BYTES;
          const LAS bf16_t* AT = (const LAS bf16_t*)(CB_ + CH_AT); const LAS float *LAB = (const LAS float*)(CB_ + CH_LAB), *LAK = (const LAS float*)(CB_ + CH_LAK);
          LAS bf16_t *WI = (LAS bf16_t*)(CB_ + CH_KT), *GI = (LAS bf16_t*)(CB_ + CH_GI);
          float xv[16];
          if (w < 4) {
#pragma unroll
            for (int t = 0; t < 16; ++t) xv[t] = bf2f(AT[t * TWS + lane]);
          } else {
#pragma unroll
            for (int t = 0; t < 16; ++t) xv[t] = LAK[t * 16 + fr];
          }
#pragma unroll
          for (int t = 1; t < 16; ++t) { float xa = xv[t];
#pragma unroll
            for (int q = 0; q < 4; ++q) if (4 * q < t) { const f32x4 lr = *(const LAS f32x4*)(LAB + t * 16 + 4 * q);
#pragma unroll
              for (int e = 0; e < 4; ++e) if (4 * q + e < t) xa -= lr[e] * xv[4 * q + e]; }
            xv[t] = xa; asm volatile("" : "+v"(xv[t]) :: "memory"); }
          if (w < 4) {
#pragma unroll
            for (int t = 0; t < 16; ++t) WI[t * TWS + lane] = f2bf(xv[t]);
          } else if (lane < 16) {
#pragma unroll
            for (int t = 0; t < 16; ++t) GI[t * 24 + lane] = f2bf(xv[t]);
          } }
        lds_barrier();
        if (w < 4 && !(RW_OFF & 2)) {
#pragma unroll 1
          for (int ch = 0; ch < 4; ++ch) { LAS unsigned char* CB_ = LB + ch * CH_BYTES;
            const LAS bf16_t *RT = (const LAS bf16_t*)(CB_ + CH_RT), *WI = (const LAS bf16_t*)(CB_ + CH_KT), *KH = (const LAS bf16_t*)(CB_ + CH_KH), *NBH = (const LAS bf16_t*)(CB_ + CH_NB),
                             *VT = (const LAS bf16_t*)(CB_ + CH_VT), *LRK = (const LAS bf16_t*)(CB_ + CH_LRK), *NLRB = (const LAS bf16_t*)(CB_ + CH_NLRB), *GI = (const LAS bf16_t*)(CB_ + CH_GI);
            const LAS float* GC = (const LAS float*)(CB_ + CH_GC);
            bf16x8 Mb[2], Wp[2], Rp[2];
#pragma unroll
            for (int ks = 0; ks < 2; ++ks) { Mb[ks] = cat4(pk4(Macc[2 * ks]), pk4(Macc[2 * ks + 1]));
              Wp[ks] = cat4(*(const LAS bf16x4*)(WI + fr * TWS + 32 * ks + 4 * fq), *(const LAS bf16x4*)(WI + fr * TWS + 32 * ks + 16 + 4 * fq));
              Rp[ks] = cat4(*(const LAS bf16x4*)(RT + fr * TWS + 32 * ks + 4 * fq), *(const LAS bf16x4*)(RT + fr * TWS + 32 * ks + 16 + 4 * fq)); }
            const bf16x8 Vb = cat4z(*(const LAS bf16x4*)(VT + (16 * w + fr) * 24 + 4 * fq));
            const bf16x8 Gp = cat4z(*(const LAS bf16x4*)(GI + fr * 24 + 4 * fq)), Lrkp = cat4z(*(const LAS bf16x4*)(LRK + fr * 24 + 4 * fq)), Nlrbp = cat4z(*(const LAS bf16x4*)(NLRB + fr * 24 + 4 * fq));
            f32x4 U = (f32x4){0.f, 0.f, 0.f, 0.f};
            U = __builtin_amdgcn_mfma_f32_16x16x32_bf16(Wp[0], Mb[0], U, 0, 0, 0); U = __builtin_amdgcn_mfma_f32_16x16x32_bf16(Wp[1], Mb[1], U, 0, 0, 0); U = __builtin_amdgcn_mfma_f32_16x16x32_bf16(Gp, Vb, U, 0, 0, 0);
            const bf16x8 Ub = cat4z(pk4(U));
            f32x4 Y = (f32x4){0.f, 0.f, 0.f, 0.f};
            Y = __builtin_amdgcn_mfma_f32_16x16x32_bf16(Rp[0], Mb[0], Y, 0, 0, 0); Y = __builtin_amdgcn_mfma_f32_16x16x32_bf16(Rp[1], Mb[1], Y, 0, 0, 0);
            Y = __builtin_amdgcn_mfma_f32_16x16x32_bf16(Lrkp, Vb, Y, 0, 0, 0); Y = __builtin_amdgcn_mfma_f32_16x16x32_bf16(Nlrbp, Ub, Y, 0, 0, 0);
#pragma unroll
            for (int r = 0; r < 4; ++r) YY[(16 * ch + 4 * fq + r) * 64 + 16 * w + fr] = Y[r];
#pragma unroll
            for (int mt = 0; mt < 4; ++mt) { const f32x4 gc = *(const LAS f32x4*)(GC + 16 * mt + 4 * fq); f32x4 m = Macc[mt] * gc;
              const bf16x8 khp = cat4z(*(const LAS bf16x4*)(KH + (16 * mt + fr) * 24 + 4 * fq)), nbp = cat4z(*(const LAS bf16x4*)(NBH + (16 * mt + fr) * 24 + 4 * fq));
              m = __builtin_amdgcn_mfma_f32_16x16x32_bf16(khp, Vb, m, 0, 0, 0); m = __builtin_amdgcn_mfma_f32_16x16x32_bf16(nbp, Ub, m, 0, 0, 0); Macc[mt] = m; } } }
        lds_barrier();
        const float lnw = CT[640 + lane], lnb = CT[704 + lane];
#pragma unroll
        for (int i = 0; i < 8; ++i) {
            const int tok = w * 8 + i; const float y = YY[tok * 64 + lane];
            const float mean = wave_sum2(y) * (1.0f / 64.0f), dl = y - mean, var = wave_sum2(dl * dl) * (1.0f / 64.0f);
            const float yn = dl * rsqrtf(var + 64e-5f) * lnw + lnb + cbv[i] * vs[i];
            const float gti = (i & 1) ? hi16(gtp[i >> 1]) : lo16(gtp[i >> 1]);
            if (!dry) g3[(t0 + tok) * G3_LD + cj] = f2bf(yn * siluf_(gti));
        }
        lds_barrier();
    }
}

__device__ __forceinline__ void spin_until_ge(const unsigned* flag, unsigned want) {
    unsigned it = 0;
    while (__hip_atomic_load(flag, __ATOMIC_RELAXED, __HIP_MEMORY_SCOPE_AGENT) < want) { __builtin_amdgcn_s_sleep(2); if (++it > (1u << 17)) break; }
}
__device__ __forceinline__ unsigned pk2bf(float lo, float hi) { return cvt_pk_bf16(lo, hi); }

__device__ void rwkv_producer(const Ctx& c, int l, int bh, int par) {
    const Params& P = *c.P; const int b = bh >> 3, hd = bh & 7, lane = c.lane, w = c.wave, cj = hd * 64 + lane, fr = lane & 15, fq = lane >> 4;
    LAS unsigned char* LB = c.lds;
    LAS float* WR = (LAS float*)LB; LAS float* AR = (LAS float*)(LB + RW_AR);
    LAS bf16_t* TWb = (LAS bf16_t*)(LB + RW_TW); LAS bf16_t* ADb = (LAS bf16_t*)(LB + RW_AD);
    const bf16_t* zrw = (const bf16_t*)(c.ws + OFF_ZRW);
    unsigned* ready = (unsigned*)(c.ws + OFF_BAR + 256) + (bh * 2 + par) * 64; const unsigned* consumed = (const unsigned*)(c.ws + OFF_BAR + 256 + 64 * 256) + bh * 64;
    unsigned char* ring = c.ws + OFF_RING + (size_t)bh * RING_SLOTS * SLOT_BYTES;
    LAS float* CT = (LAS float*)(LB + RW_CT);
    if (c.tid < 64) { const float* mu = P.in[4] + (size_t)l * 1664; const int j = hd * 64 + c.tid;
        CT[0 * 64 + c.tid] = mu[j]; CT[1 * 64 + c.tid] = mu[512 + j]; CT[2 * 64 + c.tid] = mu[1024 + j]; CT[3 * 64 + c.tid] = mu[1536 + c.tid]; CT[4 * 64 + c.tid] = mu[1600 + c.tid];
        CT[5 * 64 + c.tid] = P.in[5][l * BW + j]; CT[6 * 64 + c.tid] = P.in[7][l * BW + j]; CT[7 * 64 + c.tid] = P.in[9][l * BW + j]; CT[8 * 64 + c.tid] = P.in[10][l * BW + j];
        CT[9 * 64 + c.tid] = P.in[11][l * BW + j]; }
    const int mt_ = w >> 1, nh = w & 1;
    LAS bf16_t* W2I = (LAS bf16_t*)(LB + RW_W2); LAS bf16_t* A2I = (LAS bf16_t*)(LB + RW_A2);
    for (int i = c.tid; i < 4096; i += 512) { const int k = i >> 6, j = i & 63; W2I[j * TWS + k] = f2bf(P.in[6][((size_t)l * 64 + k) * BW + hd * 64 + j]); A2I[j * TWS + k] = f2bf(P.in[8][((size_t)l * 64 + k) * BW + hd * 64 + j]); }
    __syncthreads();
    RwRows cur;
    rw_load_rows(cur, zrw, b, par, w, lane, cj);
    for (int blk = par; blk < RW_NBLK; blk += 2) {
        const unsigned gblk = (unsigned)(l * RW_NBLK + blk);
        float rs[8], ks_[8], vs[8];
        const float mu_r = CT[lane], mu_k = CT[64 + lane], mu_v = CT[128 + lane], mu_w = CT[192 + lane], mu_a = CT[256 + lane];
#pragma unroll
        for (int i = 0; i < 8; ++i) { const int tok = w * 8 + i;
            { const float r0 = rw_get(cur.zr, i), r1 = rw_get(cur.zr, i + 1), k0 = rw_get(cur.zk, i), k1 = rw_get(cur.zk, i + 1), v0 = rw_get(cur.zv, i), v1 = rw_get(cur.zv, i + 1);
              rs[i] = r1 + mu_r * (r0 - r1); ks_[i] = k1 + mu_k * (k0 - k1); vs[i] = v1 + mu_v * (v0 - v1); }
            const float w0_ = rw_get(cur.zw, i), w1_ = rw_get(cur.zw, i + 1), a0_ = rw_get(cur.za, i), a1_ = rw_get(cur.za, i + 1);
            const float wds = w1_ + mu_w * (w0_ - w1_), ads = a1_ + mu_a * (a0_ - a1_);
            const float e2 = __expf(2.0f * wds); const float th = 1.0f - 2.0f * __builtin_amdgcn_rcpf(e2 + 1.0f);
            TWb[tok * TWS + lane] = f2bf(th); ADb[tok * TWS + lane] = f2bf(ads); }
        if (blk + 2 < RW_NBLK) rw_load_rows(cur, zrw, b, blk + 2, w, lane, cj);
        lds_barrier();
        { bf16x8 atw[2], aad[2];
#pragma unroll
          for (int ks = 0; ks < 2; ++ks) { atw[ks] = *(const LAS bf16x8*)(TWb + (16 * mt_ + fr) * TWS + 32 * ks + 8 * fq); aad[ks] = *(const LAS bf16x8*)(ADb + (16 * mt_ + fr) * TWS + 32 * ks + 8 * fq); }
          f32x4 cw[2], ca[2];
#pragma unroll
          for (int n2 = 0; n2 < 2; ++n2) { cw[n2] = (f32x4){0.f, 0.f, 0.f, 0.f}; ca[n2] = cw[n2];
#pragma unroll
              for (int ks = 0; ks < 2; ++ks) { const int bo = (32 * nh + 16 * n2 + fr) * TWS + 32 * ks + 8 * fq;
                  cw[n2] = __builtin_amdgcn_mfma_f32_16x16x32_bf16(atw[ks], *(const LAS bf16x8*)(W2I + bo), cw[n2], 0, 0, 0); ca[n2] = __builtin_amdgcn_mfma_f32_16x16x32_bf16(aad[ks], *(const LAS bf16x8*)(A2I + bo), ca[n2], 0, 0, 0); } }
          lds_barrier();
#pragma unroll
          for (int n2 = 0; n2 < 2; ++n2)
#pragma unroll
              for (int r = 0; r < 4; ++r) { const int o = (16 * mt_ + 4 * fq + r) * 64 + 32 * nh + 16 * n2 + fr; WR[o] = cw[n2][r]; AR[o] = ca[n2][r]; } }
        if (c.tid == 0 && gblk >= RING_SLOTS) spin_until_ge(consumed, gblk - RING_SLOTS + 1);
        lds_barrier();
        unsigned char* slot = ring + (size_t)(gblk % RING_SLOTS) * SLOT_BYTES;
        LAS float* GP = (LAS float*)(LB + RW_GP); const int cc = w >> 1, hc = w & 1;
        float kkv[8], kpv[8], bbv[8], gl[8], cbv[8];
        { const float w0j = CT[320 + lane], a0j = CT[384 + lane], kkj = CT[448 + lane], kaj = CT[512 + lane], rkj = CT[576 + lane]; float g = 1.0f;
#pragma unroll
          for (int i = 0; i < 8; ++i) { const int o = (w * 8 + i) * 64 + lane;
            const float wraw = w0j + WR[o], araw = a0j + AR[o];
            const float d = __expf(-0.6065306597126334f * sigmoidf_(wraw)), a = sigmoidf_(araw);
            float kk = ks_[i] * kkj; const float n2 = wave_sum2(kk * kk); kk = kk * __builtin_amdgcn_rsqf(fmaxf(n2, 1e-24f));
            const float kp = ks_[i] * (1.0f + (a - 1.0f) * kaj);
            cbv[i] = wave_sum2(rs[i] * kp * rkj);
            g *= d; gl[i] = g; kkv[i] = kk; kpv[i] = kp; bbv[i] = kk * a; }
          GP[w * 64 + lane] = g; }
        lds_barrier();
        { LAS unsigned char* CB_ = LB + cc * CH_BYTES;
          LAS bf16_t *AT = (LAS bf16_t*)(CB_ + CH_AT), *RT = (LAS bf16_t*)(CB_ + CH_RT), *KT = (LAS bf16_t*)(CB_ + CH_KT), *BT = (LAS bf16_t*)(CB_ + CH_BT),
                     *KH = (LAS bf16_t*)(CB_ + CH_KH), *NBH = (LAS bf16_t*)(CB_ + CH_NB), *VT = (LAS bf16_t*)(CB_ + CH_VT);
          const float g0 = GP[(2 * cc) * 64 + lane], g1 = GP[(2 * cc + 1) * 64 + lane], gC = g0 * g1, pre = hc ? g0 : 1.0f;
          if (hc == 0) ((LAS float*)(CB_ + CH_GC))[lane] = gC;
#pragma unroll
          for (int i = 0; i < 8; ++i) { const int tl = 8 * hc + i;
            const float gam = pre * gl[i], gprev = (i == 0) ? pre : pre * gl[i - 1], ig = __builtin_amdgcn_rcpf(gam), gr = gC * ig;
            AT[tl * TWS + lane] = f2bf(kkv[i] * gprev); RT[tl * TWS + lane] = f2bf(rs[i] * gam); KT[tl * TWS + lane] = f2bf(kpv[i] * ig); BT[tl * TWS + lane] = f2bf(bbv[i] * ig);
            KH[lane * 20 + tl] = f2bf(kpv[i] * gr); NBH[lane * 20 + tl] = f2bf(-bbv[i] * gr); VT[lane * 20 + tl] = f2bf(vs[i]); } }
        lds_barrier();
        { const __amdgpu_buffer_rsrc_t rs_ = __builtin_amdgcn_make_buffer_rsrc((void*)slot, 0, (int)SLOT_BYTES, 0x00020000);
#pragma unroll
          for (int i = 0; i < 9; ++i) { const int L_ = c.tid * 16 + i * 8192, ch = L_ / 18432, off = L_ - ch * 18432;
              __builtin_amdgcn_raw_buffer_store_b128(*(const LAS u32x4*)(LB + ch * CH_BYTES + off), rs_, (unsigned)L_, 0, 16); }
          if (c.tid < 64) __builtin_amdgcn_raw_buffer_store_b128(*(const LAS u32x4*)(LB + (c.tid >> 4) * CH_BYTES + CH_GC + (c.tid & 15) * 16), rs_, (unsigned)(SLOT_IMG + c.tid * 16), 0, 16);
#pragma unroll
          for (int i = 0; i < 8; ++i) if (lane == i) __hip_atomic_store((unsigned*)(slot + SLOT_IMG + 1024) + w * 8 + i, __float_as_uint(cbv[i]), __ATOMIC_RELAXED, __HIP_MEMORY_SCOPE_AGENT); }
        __syncthreads();
        if (c.tid == 0) __hip_atomic_store(ready, (gblk >> 1) + 1, __ATOMIC_RELAXED, __HIP_MEMORY_SCOPE_AGENT);
    }
}

struct RwSlot { u32x4 img[9]; u32x4 gc; float cb; };
__device__ __forceinline__ void rw_load_slot(RwSlot& R, const unsigned char* slot, int tid, int w, int lane) {
#pragma unroll
    for (int i = 0; i < 9; ++i) R.img[i] = *(const u32x4*)(slot + tid * 16 + i * 8192);
    R.gc = *(const u32x4*)(slot + SLOT_IMG + (tid & 63) * 16);
    R.cb = ((const float*)(slot + SLOT_IMG + 1024))[w * 8 + (lane & 7)];
}

__device__ void rwkv_consumer(const Ctx& c, int l, int bh) {
    const Params& P = *c.P; const int b = bh >> 3, hd = bh & 7, lane = c.lane, w = c.wave, cj = hd * 64 + lane, fr = lane & 15, fq = lane >> 4;
    LAS unsigned char* LB = c.lds;
    LAS float* YY = (LAS float*)(LB + RW_YY);
    bf16_t* g3 = (bf16_t*)(c.ws + OFF_G3);
    const unsigned* ready = (const unsigned*)(c.ws + OFF_BAR + 256) + bh * 128; unsigned* consumed = (unsigned*)(c.ws + OFF_BAR + 256 + 64 * 256) + bh * 64;
    bf16_t* zrw = (bf16_t*)(c.ws + OFF_ZRW); float* cbg = (float*)(c.ws + OFF_CBG);
    const unsigned char* ring = c.ws + OFF_RING + (size_t)bh * RING_SLOTS * SLOT_BYTES;
    f32x4 Macc[4];
#pragma unroll
    for (int i = 0; i < 4; ++i) Macc[i] = (f32x4){0.f, 0.f, 0.f, 0.f};
    RwSlot cur;
    { const unsigned g0 = (unsigned)(l * RW_NBLK);
      if (c.tid == 0) { spin_until_ge(ready + 64 * (g0 & 1), (g0 >> 1) + 1); spin_until_ge(ready + 64 * ((g0 + 1) & 1), ((g0 + 1) >> 1) + 1); __builtin_amdgcn_fence(__ATOMIC_ACQUIRE, "agent"); }
      __syncthreads();
      rw_load_slot(cur, ring + (size_t)(g0 % RING_SLOTS) * SLOT_BYTES, c.tid, w, lane); }
    for (int blk = 0; blk < RW_NBLK; ++blk) {
        const unsigned gblk = (unsigned)(l * RW_NBLK + blk); const size_t t0 = (size_t)b * SEQ + blk * 64;
        float cbv[8];
#pragma unroll
        for (int i = 0; i < 9; ++i) { const int L_ = c.tid * 16 + i * 8192, ch = L_ / 18432, off = L_ - ch * 18432; *(LAS u32x4*)(LB + ch * CH_BYTES + off) = cur.img[i]; }
        if (c.tid < 64) *(LAS u32x4*)(LB + (c.tid >> 4) * CH_BYTES + CH_GC + (c.tid & 15) * 16) = cur.gc;
#pragma unroll
        for (int i = 0; i < 8; ++i) cbv[i] = __builtin_bit_cast(float, __builtin_amdgcn_readlane(__builtin_bit_cast(int, cur.cb), i));
        lds_barrier();
        if (c.tid == 0) __hip_atomic_store(consumed, gblk + 1, __ATOMIC_RELAXED, __HIP_MEMORY_SCOPE_AGENT);
        if (blk + 1 < RW_NBLK) rw_load_slot(cur, ring + (size_t)((gblk + 1) % RING_SLOTS) * SLOT_BYTES, c.tid, w, lane);
        if (w < 4 && true) { LAS unsigned char* CB_ = LB + w * CH_BYTES;
          const LAS bf16_t *AT = (const LAS bf16_t*)(CB_ + CH_AT), *RT = (const LAS bf16_t*)(CB_ + CH_RT), *KT = (const LAS bf16_t*)(CB_ + CH_KT), *BT = (const LAS bf16_t*)(CB_ + CH_BT);
          f32x4 lab = (f32x4){0.f, 0.f, 0.f, 0.f}, lak = lab, lrk = lab, lrb = lab;
#pragma unroll
          for (int ks = 0; ks < 2; ++ks) { const int o = fr * TWS + 32 * ks + 8 * fq;
            const bf16x8 af = *(const LAS bf16x8*)(AT + o), rf = *(const LAS bf16x8*)(RT + o), kf = *(const LAS bf16x8*)(KT + o), bf = *(const LAS bf16x8*)(BT + o);
            lab = __builtin_amdgcn_mfma_f32_16x16x32_bf16(af, bf, lab, 0, 0, 0); lak = __builtin_amdgcn_mfma_f32_16x16x32_bf16(af, kf, lak, 0, 0, 0);
            lrk = __builtin_amdgcn_mfma_f32_16x16x32_bf16(rf, kf, lrk, 0, 0, 0); lrb = __builtin_amdgcn_mfma_f32_16x16x32_bf16(rf, bf, lrb, 0, 0, 0); }
          LAS float *LAB = (LAS float*)(CB_ + CH_LAB), *LAK = (LAS float*)(CB_ + CH_LAK); LAS bf16_t *LRK = (LAS bf16_t*)(CB_ + CH_LRK), *NLRB = (LAS bf16_t*)(CB_ + CH_NLRB);
#pragma unroll
          for (int r = 0; r < 4; ++r) { const int t = 4 * fq + r, s_ = fr; const bool lo_ = t > s_, le_ = t >= s_;
            LAB[t * 16 + s_] = lo_ ? lab[r] : 0.0f; LAK[t * 16 + s_] = lo_ ? lak[r] : 0.0f;
            LRK[t * 24 + s_] = f2bf(le_ ? lrk[r] : 0.0f); NLRB[t * 24 + s_] = f2bf(le_ ? -lrb[r] : 0.0f); } }
        lds_barrier();
        { const int ch6 = w & 3; LAS unsigned char* CB_ = LB + ch6 * CH_BYTES;
          const LAS bf16_t* AT = (const LAS bf16_t*)(CB_ + CH_AT); const LAS float *LAB = (const LAS float*)(CB_ + CH_LAB), *LAK = (const LAS float*)(CB_ + CH_LAK);
          LAS bf16_t *WI = (LAS bf16_t*)(CB_ + CH_KT), *GI = (LAS bf16_t*)(CB_ + CH_GI);
          float xv[16];
          if (w < 4) {
#pragma unroll
            for (int t = 0; t < 16; ++t) xv[t] = bf2f(AT[t * TWS + lane]);
          } else {
#pragma unroll
            for (int t = 0; t < 16; ++t) xv[t] = LAK[t * 16 + fr];
          }
          f32x4 nx[4];
#pragma unroll
          for (int q = 0; q < 4; ++q) nx[q] = *(const LAS f32x4*)(LAB + 16 + 4 * q);
#pragma unroll
          for (int t = 1; t < 16; ++t) { float xa = xv[t]; f32x4 lr[4];
#pragma unroll
            for (int q = 0; q < 4; ++q) lr[q] = nx[q];
            if (t < 15) {
#pragma unroll
              for (int q = 0; q < 4; ++q) if (4 * q < t + 1) nx[q] = *(const LAS f32x4*)(LAB + (t + 1) * 16 + 4 * q); }
            float xb = 0.0f;
#pragma unroll
            for (int q = 0; q < 4; ++q) if (4 * q < t) {
#pragma unroll
              for (int e = 0; e < 4; ++e) if (4 * q + e < t) { if (e & 1) xb -= lr[q][e] * xv[4 * q + e]; else xa -= lr[q][e] * xv[4 * q + e]; } }
            xa += xb;
            xv[t] = xa; asm volatile("" : "+v"(xv[t]), "+v"(nx[0]), "+v"(nx[1]), "+v"(nx[2]), "+v"(nx[3]) :: "memory"); }
          if (w < 4) {
#pragma unroll
            for (int t = 0; t < 16; ++t) WI[t * TWS + lane] = f2bf(xv[t]);
          } else if (lane < 16) {
#pragma unroll
            for (int t = 0; t < 16; ++t) GI[t * 24 + lane] = f2bf(xv[t]);
          } }
        lds_barrier();
        if (w == 4 && lane == 0 && blk + 2 < RW_NBLK) { const unsigned gn = gblk + 2; spin_until_ge(ready + 64 * (gn & 1), (gn >> 1) + 1); __builtin_amdgcn_fence(__ATOMIC_ACQUIRE, "agent"); }
        if (w < 4 && true) {
#pragma unroll
          for (int ch = 0; ch < 4; ++ch) { LAS unsigned char* CB_ = LB + ch * CH_BYTES;
            const LAS bf16_t *RT = (const LAS bf16_t*)(CB_ + CH_RT), *WI = (const LAS bf16_t*)(CB_ + CH_KT), *KH = (const LAS bf16_t*)(CB_ + CH_KH), *NBH = (const LAS bf16_t*)(CB_ + CH_NB),
                             *VT = (const LAS bf16_t*)(CB_ + CH_VT), *LRK = (const LAS bf16_t*)(CB_ + CH_LRK), *NLRB = (const LAS bf16_t*)(CB_ + CH_NLRB), *GI = (const LAS bf16_t*)(CB_ + CH_GI);
            const LAS float* GC = (const LAS float*)(CB_ + CH_GC);
            bf16x8 Mb[2], Wp[2], Rp[2];
#pragma unroll
            for (int ks = 0; ks < 2; ++ks) { Mb[ks] = cat4(pk4(Macc[2 * ks]), pk4(Macc[2 * ks + 1]));
              Wp[ks] = cat4(*(const LAS bf16x4*)(WI + fr * TWS + 32 * ks + 4 * fq), *(const LAS bf16x4*)(WI + fr * TWS + 32 * ks + 16 + 4 * fq));
              Rp[ks] = cat4(*(const LAS bf16x4*)(RT + fr * TWS + 32 * ks + 4 * fq), *(const LAS bf16x4*)(RT + fr * TWS + 32 * ks + 16 + 4 * fq)); }
            const bf16x8 Vb = cat4z(*(const LAS bf16x4*)(VT + (16 * w + fr) * 20 + 4 * fq));
            const bf16x8 Gp = cat4z(*(const LAS bf16x4*)(GI + fr * 24 + 4 * fq)), Lrkp = cat4z(*(const LAS bf16x4*)(LRK + fr * 24 + 4 * fq)), Nlrbp = cat4z(*(const LAS bf16x4*)(NLRB + fr * 24 + 4 * fq));
            f32x4 U = (f32x4){0.f, 0.f, 0.f, 0.f};
            U = __builtin_amdgcn_mfma_f32_16x16x32_bf16(Wp[0], Mb[0], U, 0, 0, 0); U = __builtin_amdgcn_mfma_f32_16x16x32_bf16(Wp[1], Mb[1], U, 0, 0, 0); U = __builtin_amdgcn_mfma_f32_16x16x32_bf16(Gp, Vb, U, 0, 0, 0);
            const bf16x8 Ub = cat4z(pk4(U));
            f32x4 Y = (f32x4){0.f, 0.f, 0.f, 0.f};
            Y = __builtin_amdgcn_mfma_f32_16x16x32_bf16(Rp[0], Mb[0], Y, 0, 0, 0); Y = __builtin_amdgcn_mfma_f32_16x16x32_bf16(Rp[1], Mb[1], Y, 0, 0, 0);
            Y = __builtin_amdgcn_mfma_f32_16x16x32_bf16(Lrkp, Vb, Y, 0, 0, 0); Y = __builtin_amdgcn_mfma_f32_16x16x32_bf16(Nlrbp, Ub, Y, 0, 0, 0);
#pragma unroll
            for (int r = 0; r < 4; ++r) YY[(16 * ch + 4 * fq + r) * 64 + 16 * w + fr] = Y[r];
#pragma unroll
            for (int mt = 0; mt < 4; ++mt) { const f32x4 gc = *(const LAS f32x4*)(GC + 16 * mt + 4 * fq); f32x4 m = Macc[mt] * gc;
              const bf16x8 khp = cat4z(*(const LAS bf16x4*)(KH + (16 * mt + fr) * 20 + 4 * fq)), nbp = cat4z(*(const LAS bf16x4*)(NBH + (16 * mt + fr) * 20 + 4 * fq));
              m = __builtin_amdgcn_mfma_f32_16x16x32_bf16(khp, Vb, m, 0, 0, 0); m = __builtin_amdgcn_mfma_f32_16x16x32_bf16(nbp, Ub, m, 0, 0, 0); Macc[mt] = m; } } }
        lds_barrier();
#pragma unroll
        for (int i = 0; i < 8; ++i) { const int tok = w * 8 + i;
            zrw[(t0 + tok) * ZRW_LD + cj] = f2bf(YY[tok * 64 + lane]);
            if (lane == i) cbg[(t0 + tok) * 8 + hd] = cbv[i]; }
    }
}

__device__ void phase_rwkv_fin(const Ctx& c, int l) {
    const Params& P = *c.P; const bf16_t* zrw = (const bf16_t*)(c.ws + OFF_ZRW); bf16_t* g3 = (bf16_t*)(c.ws + OFF_G3); const float* cbg = (const float*)(c.ws + OFF_CBG);
    const int gw = blockIdx.x * 8 + c.wave, nw = gridDim.x * 8, lane = c.lane;
    for (int item = gw; item < (T / 128) * 8; item += nw) {
        const int hd = item & 7, tg = item >> 3, cj = hd * 64 + lane; const size_t tb = (size_t)tg * 128;
        const float mu_v = P.in[4][(size_t)l * 1664 + 1024 + cj], lnw = P.in[12][l * BW + cj], lnb = P.in[13][l * BW + cj];
        float vprev = ((tb & (SEQ - 1)) == 0) ? 0.0f : bf2f(zrw[(tb - 1) * ZRW_LD + 1024 + cj]);
        for (int t4 = 0; t4 < 128; t4 += 4) {
            float y[4], vv[4], gt[4], cb[4];
#pragma unroll
            for (int i = 0; i < 4; ++i) { const size_t t = tb + t4 + i; y[i] = bf2f(zrw[t * ZRW_LD + cj]); vv[i] = bf2f(zrw[t * ZRW_LD + 1024 + cj]); gt[i] = bf2f(g3[t * G3_LD + cj]); cb[i] = cbg[t * 8 + hd]; }
#pragma unroll
            for (int i = 0; i < 4; ++i) { const size_t t = tb + t4 + i;
                const float vs = vv[i] + mu_v * (vprev - vv[i]); vprev = vv[i];
                const float mean = wave_sum2(y[i]) * (1.0f / 64.0f), ey2 = wave_sum2(y[i] * y[i]) * (1.0f / 64.0f), var = fmaxf(ey2 - mean * mean, 0.0f);
                const float yn = (y[i] - mean) * rsqrtf(var + 64e-5f) * lnw + lnb + cb[i] * vs;
                g3[t * G3_LD + cj] = f2bf(yn * siluf_(gt[i])); }
        }
    }
}

constexpr int RW_WGS = 96;
template <int l, int sp>
__device__ __forceinline__ void run_sub(const Ctx& c, const Params& P, float* ssbase, int G, int cb, unsigned* bar2, unsigned& bar2_target) {
    unsigned char* ws = c.ws;
    if constexpr (sp == 0) {
        if (l == 0) phase_s5_consts(c);
        pg8::Gemm g{(const bf16_t*)(ws + OFF_XN), (const bf16_t*)(ws + OFF_WIN) + (size_t)l * DINP * D, D, D, D}; pg8::Sched S; S.init(T, DINP, G, cb);
        EpiZ E{(bf16_t*)(ws + OFF_ZRW), (bf16_t*)(ws + OFF_G3), (bf16_t*)(ws + OFF_XL), (bf16_t*)(ws + OFF_AS)};
        pg8::gemm_phase(c.lds, g, S, E);
    } else if constexpr (sp == 1) {
        if (cb < 32) rwkv_consumer(c, l, cb); else if (cb < RW_WGS) rwkv_producer(c, l, (cb - 32) & 31, (cb - 32) >> 5);
        else {
            Ctx c2 = c; c2.vb = cb - RW_WGS; c2.vG = G - RW_WGS; const int G2 = G - RW_WGS, cb2 = cb - RW_WGS;
            phase_lru_conv(c2, l);
            { pg8::Gemm g{(const bf16_t*)(ws + OFF_AS), (const bf16_t*)(ws + OFF_S5E) + (size_t)l * 32 * 256 * 256, AS_LD, 256, 256}; pg8::Sched S; S.init(AS_ROWS, 256, G2, cb2, 8);
              EpiE E{(float*)(ws + OFF_E)};
              pg8::gemm_phase(c.lds, g, S, E); }
            grid_bar(bar2, bar2_target, (unsigned)G2);
            phase_s5_carry(c2, l);
            { pg8::Gemm g{(const bf16_t*)(ws + OFF_XC), (const bf16_t*)(ws + OFF_WLRU) + (size_t)l * 1024 * BW, BW, BW, BW}; pg8::Sched S; S.init(T, 1024, G2, cb2);
              EpiLru E{(const bf16_t*)(ws + OFF_XC), P.in[27] + l * BW, P.in[29] + l * BW, P.in[30] + l * BW, (bf16_t*)(ws + OFF_LRUAB)};
              pg8::gemm_phase(c.lds, g, S, E); }
            grid_bar(bar2, bar2_target, (unsigned)G2);
            { pg8::Gemm g{(const bf16_t*)(ws + OFF_AS), (const bf16_t*)(ws + OFF_S5Y) + (size_t)l * 32 * 256 * AS_LD, AS_LD, AS_LD, AS_LD}; pg8::Sched S; S.init(AS_ROWS, 256, G2, cb2, 8);
              EpiY E{(const bf16_t*)(ws + OFF_AS), P.in[21] + l * BW, (bf16_t*)(ws + OFF_ZGS)};
              pg8::gemm_phase(c.lds, g, S, E); }
            phase_lru_scan(c2, 0);
            grid_bar(bar2, bar2_target, (unsigned)G2);
            { pg8::Gemm g{(const bf16_t*)(ws + OFF_ZGS), (const bf16_t*)(ws + OFF_WGLU) + (size_t)l * BW * BW, BW, BW, BW}; pg8::Sched S; S.init(T, BW, G2, cb2);
              EpiGlu E{(const bf16_t*)(ws + OFF_ZGS), P.in[23] + l * BW, (bf16_t*)(ws + OFF_G3)};
              pg8::gemm_phase(c.lds, g, S, E); }
            phase_lru_scan(c2, 1);
            { pg8::Gemm g{(const bf16_t*)(ws + OFF_PB) + (size_t)l * T * DPLE, (const bf16_t*)(ws + OFF_WPLE) + (size_t)l * D * DPLE, DPLE, DPLE, DPLE}; pg8::Sched S; S.init(T, D, G2, cb2);
              EpiPle E{(bf16_t*)(ws + OFF_PW), ssbase + (size_t)l * T};
              pg8::gemm_phase(c.lds, g, S, E); }
        }
    } else if constexpr (sp == 2) {
        phase_rwkv_fin(c, l);
    } else if constexpr (sp == 5) {
        { pg8::Gemm g{(const bf16_t*)(ws + OFF_G3), (const bf16_t*)(ws + OFF_WOUT) + (size_t)l * D * DMIX, DMIX, DMIX, DMIX}; pg8::Sched S; S.init(T, D, G, cb);
          EpiOut E{l == 0 ? P.in[0] : (const float*)P.out, P.out, (bf16_t*)(ws + OFF_H1B)};
          pg8::gemm_phase(c.lds, g, S, E); }
    } else if constexpr (sp == 6) {
        pg8::Gemm g{(const bf16_t*)(ws + OFF_H1B), (const bf16_t*)(ws + OFF_WG) + (size_t)l * D * D, D, D, D}; pg8::Sched S; S.init(T, D, G, cb);
        EpiGate E{P.out, (const bf16_t*)(ws + OFF_PW), ssbase + (size_t)l * T, P.in[33] + l * D, ssbase + (size_t)(2 + l) * T};
        pg8::gemm_phase(c.lds, g, S, E);
    } else {
        phase_norm(c, ssbase + (size_t)(2 + l) * T, l == 0 ? P.in[2] + D : P.in[35], l == 1);
    }
}

constexpr int NPHASE = 1 + 6 * 2;
__global__ void __launch_bounds__(512) hymba_fwd(Params P) {
    extern __shared__ __attribute__((aligned(16))) unsigned char lds_raw[];
    Ctx c; c.P = &P; c.ws = P.ws; c.lds = (LAS unsigned char*)lds_raw; c.ldsg = lds_raw; c.tid = threadIdx.x; c.lane = c.tid & 63; c.wave = __builtin_amdgcn_readfirstlane(c.tid >> 6);
    c.gtid = (size_t)blockIdx.x * 512 + c.tid; c.gsz = (size_t)gridDim.x * 512; c.vb = blockIdx.x; c.vG = gridDim.x;
    unsigned char* ws = P.ws; const int G = gridDim.x, cb = blockIdx.x;
    float* ssbase = (float*)(ws + OFF_SS);
    const int lo = P.ph_lo, hi = P.ph_hi;
    unsigned* barw = (unsigned*)(ws + OFF_BAR); unsigned bar_target = 0; unsigned* bar2 = barw + 32; unsigned bar2_target = 0;
#define PHASE(k, ...) if (((MK_PH_MASK >> (k)) & 1) && lo <= (k) && (k) < hi) { __VA_ARGS__; if ((k) + 1 < hi) { if ((k) == 0) { __threadfence(); cg::this_grid().sync(); } else grid_bar(barw, bar_target, (unsigned)G); } }
    PHASE(0, phase_prep(c))
#define RS(L_, SP_) run_sub<L_, SP_>(c, P, ssbase, G, cb, bar2, bar2_target)
    PHASE(1, RS(0, 0)) PHASE(2, RS(0, 1)) PHASE(3, RS(0, 2)) PHASE(4, RS(0, 5)) PHASE(5, RS(0, 6)) PHASE(6, RS(0, 7))
    PHASE(7, RS(1, 0)) PHASE(8, RS(1, 1)) PHASE(9, RS(1, 2)) PHASE(10, RS(1, 5)) PHASE(11, RS(1, 6)) PHASE(12, RS(1, 7))
#undef RS
#undef PHASE
}

extern "C" void kernel_launch(void* const* d_in, const int* in_sizes, int n_in, void* d_out, int out_size, void* d_ws, size_t ws_size, hipStream_t stream) {
    static int grid = 0;
    if (grid == 0) {
        if (n_in != 36 || out_size != T * D || ws_size < WS_END2) { fprintf(stderr, "kernel_launch: unexpected shapes (n_in %d out %d ws %zu need %zu)\n", n_in, out_size, ws_size, (size_t)WS_END); grid = -1; return; }
        int dev = 0, cus = 0, per_cu = 0;
        hipGetDevice(&dev); hipDeviceGetAttribute(&cus, hipDeviceAttributeMultiprocessorCount, dev);
        hipFuncSetAttribute((const void*)hymba_fwd, hipFuncAttributeMaxDynamicSharedMemorySize, LDS_BYTES);
        hipOccupancyMaxActiveBlocksPerMultiprocessor(&per_cu, (const void*)hymba_fwd, 512, LDS_BYTES);
        if (per_cu < 1) per_cu = 1;
        grid = cus * per_cu; if (grid > 256) grid = 256;
        (void)hipGetLastError();
    }
    if (grid < 0) return;
    (void)hipMemsetAsync((char*)d_ws + OFF_BAR, 0, CTL_BYTES, stream);
    Params p{};
    for (int i = 0; i < 36; ++i) p.in[i] = (const float*)d_in[i];
    p.out = (float*)d_out; p.ws = (unsigned char*)d_ws;
#if MK_PER_PHASE
    for (int ph = 0; ph < NPHASE; ++ph) { p.ph_lo = ph; p.ph_hi = ph + 1; hipLaunchKernelGGL(hymba_fwd, dim3(grid), dim3(512), LDS_BYTES, stream, p); }
#else
    p.ph_lo = 0; p.ph_hi = NPHASE;
    void* args[] = {&p};
    hipError_t e = hipLaunchCooperativeKernel((const void*)hymba_fwd, dim3(grid), dim3(512), args, LDS_BYTES, stream);
    if (e != hipSuccess) fprintf(stderr, "cooperative launch failed: %s (grid %d)\n", hipGetErrorString(e), grid);
#endif
}
```

```cpp
#include <hip/hip_runtime.h>
#include <hip/hip_cooperative_groups.h>
#include <cstdio>
namespace cg = cooperative_groups;

#ifndef MK_PER_PHASE
#define MK_PER_PHASE 0
#endif

#ifndef MK_PH_MASK
#define MK_PH_MASK 0x1fff
#endif
#ifndef MK_DUP
#define MK_DUP 0
#endif
#ifndef RW_OFF
#define RW_OFF 0
#endif
#ifndef MK_OFF
#define MK_OFF 0
#endif
#define LAS __attribute__((address_space(3)))
typedef unsigned short bf16_t;
typedef short bf16x8 __attribute__((ext_vector_type(8)));
typedef float f32x4 __attribute__((ext_vector_type(4)));
typedef unsigned u32x4 __attribute__((ext_vector_type(4)));
typedef unsigned u32x2 __attribute__((ext_vector_type(2)));

constexpr int T = 32768, D = 1024, SEQ = 8192, NB = 4, BW = 512;
constexpr int DIN = 4224, DINP = 4352, DMIX = 1536, DPLE = 256;
constexpr int ZRW_LD = 1792, G3_LD = 1536, AS_LD = 384, AS_ROWS = 65536;
constexpr int LDS_BYTES = 155648;

constexpr size_t al256(size_t x) { return (x + 255) & ~(size_t)255; }
constexpr size_t SZ_WIN = (size_t)2 * DINP * D * 2, SZ_WOUT = (size_t)2 * D * DMIX * 2, SZ_WG = (size_t)2 * D * D * 2, SZ_WPLE = (size_t)2 * D * DPLE * 2,
                 SZ_WGLU = (size_t)2 * BW * BW * 2, SZ_WLRU = (size_t)2 * 1024 * BW * 2, SZ_S5Y = (size_t)2 * 32 * 256 * AS_LD * 2, SZ_S5E = (size_t)2 * 32 * 256 * 256 * 2,
                 SZ_TBL = (size_t)2 * 32 * 64 * 18 * 8, SZ_PB = (size_t)2 * T * DPLE * 2, SZ_XN = (size_t)T * D * 2, SZ_ZRW = (size_t)T * ZRW_LD * 2, SZ_G3 = (size_t)T * G3_LD * 2,
                 SZ_XL = (size_t)T * BW * 2, SZ_AS = (size_t)AS_ROWS * AS_LD * 2, SZ_LRUAB = (size_t)T * 1024 * 2, SZ_AGG = (size_t)NB * 128 * 1024 * 4, SZ_SS = (size_t)4 * T * 4;
constexpr size_t OFF_WIN = 0, OFF_WOUT = OFF_WIN + SZ_WIN, OFF_WG = OFF_WOUT + SZ_WOUT, OFF_WPLE = OFF_WG + SZ_WG, OFF_WGLU = OFF_WPLE + SZ_WPLE, OFF_WLRU = OFF_WGLU + SZ_WGLU,
                 OFF_S5Y = OFF_WLRU + SZ_WLRU, OFF_S5E = OFF_S5Y + SZ_S5Y, OFF_TBL = OFF_S5E + SZ_S5E, OFF_PB = al256(OFF_TBL + SZ_TBL), OFF_XN = OFF_PB + SZ_PB,
                 OFF_ZRW = OFF_XN + SZ_XN, OFF_G3 = OFF_ZRW + SZ_ZRW, OFF_XL = OFF_G3 + SZ_G3, OFF_AS = OFF_XL + SZ_XL, OFF_LRUAB = OFF_AS + SZ_AS, OFF_AGG = OFF_LRUAB + SZ_LRUAB,
                 OFF_SS = OFF_AGG + SZ_AGG, WS_END = OFF_SS + SZ_SS;
constexpr size_t OFF_BAR = WS_END, CTL_BYTES = 256 + 96 * 256;
constexpr size_t RING_SLOTS = 3, SLOT_IMG = 4 * 18432, SLOT_BYTES = SLOT_IMG + 4 * 256 + 256;
constexpr size_t OFF_RING = OFF_BAR + CTL_BYTES, OFF_CBG = OFF_RING + 32 * RING_SLOTS * SLOT_BYTES, WS_END2 = OFF_CBG + (size_t)T * 8 * 4;
constexpr size_t OFF_E = OFF_XN, OFF_XC = OFF_XN + (size_t)AS_ROWS * 128 * 4, OFF_H1B = OFF_ZRW, OFF_PW = OFF_XN, OFF_ZGS = OFF_XL;
static_assert(OFF_XC + (size_t)T * BW * 2 <= OFF_ZRW, "alias overflow");

struct Params {
    const float* in[36];
    float* out;
    unsigned char* ws;
    int ph_lo, ph_hi;
};

__device__ __forceinline__ float bf2f(bf16_t v) { return __uint_as_float(((unsigned)v) << 16); }
__device__ __forceinline__ bf16_t f2bf_sw(float f) { unsigned u = __float_as_uint(f); u += 0x7FFFu + ((u >> 16) & 1u); return (bf16_t)(u >> 16); }
typedef float f32x2_ __attribute__((ext_vector_type(2)));
typedef __bf16 b16x2_ __attribute__((ext_vector_type(2)));
__device__ __forceinline__ unsigned cvt_pk_bf16(float lo, float hi) { const f32x2_ v = {lo, hi}; return __builtin_bit_cast(unsigned, __builtin_convertvector(v, b16x2_)); }
__device__ __forceinline__ bf16_t f2bf(float f) { return (bf16_t)cvt_pk_bf16(f, f); }
__device__ __forceinline__ float lo16(unsigned u) { return __uint_as_float(u << 16); }
__device__ __forceinline__ float hi16(unsigned u) { return __uint_as_float(u & 0xffff0000u); }
__device__ __forceinline__ float sigmoidf_(float x) { return __builtin_amdgcn_rcpf(1.0f + __expf(-x)); }
__device__ __forceinline__ float siluf_(float x) { return x * sigmoidf_(x); }
__device__ __forceinline__ float softplusf_(float x) { return fmaxf(x, 0.0f) + log1pf(__expf(-fabsf(x))); }
__device__ __forceinline__ float gelu_tanh(float x) { const float u2 = 1.5957691216057308f * (x + 0.044715f * x * x * x); return x * sigmoidf_(u2); }
__device__ __forceinline__ float wave_sum(float v) {
#pragma unroll
    for (int o = 32; o > 0; o >>= 1) v += __shfl_xor(v, o);
    return v;
}
__device__ __forceinline__ void unpack8(const u32x4 w, float (&f)[8]) {
    f[0] = lo16(w.x); f[1] = hi16(w.x); f[2] = lo16(w.y); f[3] = hi16(w.y); f[4] = lo16(w.z); f[5] = hi16(w.z); f[6] = lo16(w.w); f[7] = hi16(w.w);
}
__device__ __forceinline__ u32x4 pack8(const float (&f)[8]) {
    u32x4 w; w.x = cvt_pk_bf16(f[0], f[1]); w.y = cvt_pk_bf16(f[2], f[3]); w.z = cvt_pk_bf16(f[4], f[5]); w.w = cvt_pk_bf16(f[6], f[7]); return w;
}


__device__ __forceinline__ void grid_bar(unsigned* ctr, unsigned& target, unsigned nblk) {
    __syncthreads();
    if (threadIdx.x == 0) {
        target += nblk;
        __builtin_amdgcn_fence(__ATOMIC_RELEASE, "agent");
        __hip_atomic_fetch_add(ctr, 1u, __ATOMIC_RELAXED, __HIP_MEMORY_SCOPE_AGENT);
        while (__hip_atomic_load(ctr, __ATOMIC_RELAXED, __HIP_MEMORY_SCOPE_AGENT) < target) __builtin_amdgcn_s_sleep(1);
        __builtin_amdgcn_fence(__ATOMIC_ACQUIRE, "agent");
    }
    __syncthreads();
}

namespace pg8 {
constexpr int BM = 256, BK = 64, HALF = 128, HTB = HALF * BK * 2, STAGE_BYTES = 8 * HTB, NXCD = 8, WGM = 8;
__host__ __device__ __forceinline__ int lds_byte(int r, int c) { const int st = (r >> 4) * 2 + (c >> 5), rr = r & 15, cc = c & 31, ob = rr * 64 + cc * 2; return st * 1024 + (ob ^ (((ob >> 9) & 1) << 5)); }
__host__ __device__ __forceinline__ void stage_rc(int b, int& R, int& C) { const int st = b / 1024, sb = b % 1024, swz = sb ^ (((sb >> 9) & 1) << 5); R = (st >> 1) * 16 + swz / 64; C = (st & 1) * 32 + (swz % 64) / 2; }
__host__ __device__ __forceinline__ int perm32(int rho) { const int n = rho >> 4, i = rho & 15; return 8 * (i >> 2) + 4 * n + (i & 3); }

struct Unit { int pm, pn, pb; };
struct Gemm { const bf16_t* A; const bf16_t* Bt; int lda, ldb, K; };

struct Sched {
    int nM, nN, nwg, G, c, grp;
    __device__ void init(int M, int N, int G_, int c_, int grp_ = 0) { nM = M / BM; nN = N / BM; nwg = nM * nN; G = G_; c = c_; grp = grp_; }
    __device__ bool next(int i, Unit& u) const {
        const long L = (long)i * G + c; if (L >= nwg) return false;
        int wgid = (int)L; { const int q = nwg / NXCD, r = nwg % NXCD, xcd = wgid % NXCD, off = wgid / NXCD; wgid = (xcd < r ? xcd * (q + 1) : r * (q + 1) + (xcd - r) * q) + off; }
        const int nig = WGM * nN, gid = wgid / nig, fm = gid * WGM, gsz = (nM - fm) < WGM ? (nM - fm) : WGM;
        u.pm = fm + ((wgid % nig) % gsz); u.pn = (wgid % nig) / gsz; u.pb = grp ? (u.pm / grp) * nN + u.pn : u.pn; return true;
    }
};

template <class Epi>
__device__ __forceinline__ void gemm_phase(LAS unsigned char* lds, const Gemm g, const Sched& S, const Epi& E) {
    const int tid = threadIdx.x, wid = __builtin_amdgcn_readfirstlane(tid >> 6), lane = tid & 63, wr = wid >> 2, wc = wid & 3, fr = lane & 15, fq = lane >> 4;
    const int K = g.K, nt = K / BK;
    unsigned voffA[2], voffB[2];
#pragma unroll
    for (int i = 0; i < 2; ++i) { int R, C; stage_rc(tid * 16 + i * 8192, R, C); const int Rb = Epi::PERM ? ((R & ~31) + perm32(R & 31)) : R;
        voffA[i] = (unsigned)(R * g.lda + C) * 2u; voffB[i] = (unsigned)(Rb * g.ldb + C) * 2u; }
    const size_t kstep = (size_t)(BK * 2);
    const size_t hstepA = (size_t)HALF * g.lda * 2, hstepB = (size_t)HALF * g.ldb * 2;
    const size_t tstepA = 2 * hstepA, tstepB = 2 * hstepB;
    const unsigned ldsw = (unsigned)wid * 1024u;
    const int aoff = lds_byte(wr * 64 + fr, fq * 8), boff = lds_byte(wc * 32 + fr, fq * 8);
#define PG8_SA(b, h) (((b) * 2 + (h)) * HTB)
#define PG8_SB(b, h) ((4 + (b) * 2 + (h)) * HTB)
#define PG8_STAGE(bufoff, gbase, voff) do { _Pragma("unroll") for (int _i = 0; _i < 2; ++_i) \
        __builtin_amdgcn_global_load_lds((const unsigned*)((const char*)(gbase) + (voff)[_i]), (LAS unsigned*)(lds + (bufoff) + ldsw + _i * 8192), 16, 0, 0); } while (0)
#define PG8_LDA(dst, b, h) do { _Pragma("unroll") for (int m = 0; m < 4; ++m) _Pragma("unroll") for (int k = 0; k < 2; ++k) dst[m][k] = *(const LAS bf16x8*)(lds + PG8_SA(b, h) + aoff + m * 2048 + k * 1024); } while (0)
#define PG8_LDB(dst, b, h) do { _Pragma("unroll") for (int n = 0; n < 2; ++n) _Pragma("unroll") for (int k = 0; k < 2; ++k) dst[n][k] = *(const LAS bf16x8*)(lds + PG8_SB(b, h) + boff + n * 2048 + k * 1024); } while (0)
#define PG8_MMA(ai, bj, At, Bt) do { __builtin_amdgcn_s_setprio(1); _Pragma("unroll") for (int m = 0; m < 4; ++m) _Pragma("unroll") for (int n = 0; n < 2; ++n) _Pragma("unroll") for (int k = 0; k < 2; ++k) \
        acc[ai][bj][m][n] = __builtin_amdgcn_mfma_f32_16x16x32_bf16(Bt[n][k], At[m][k], acc[ai][bj][m][n], 0, 0, 0); __builtin_amdgcn_s_setprio(0); } while (0)
#define PG8_WAIT_V(n) asm volatile("s_waitcnt vmcnt(" #n ")" ::: "memory")
#define PG8_WAIT_L(n) asm volatile("s_waitcnt lgkmcnt(" #n ")" ::: "memory")
#define PG8_BAR __builtin_amdgcn_s_barrier()
#define PG8_SCHED __builtin_amdgcn_sched_barrier(0)
    Unit cur, nxt; int ui = 0;
    if (!S.next(0, cur)) return;
    f32x4 acc[2][2][4][2];
#pragma unroll
    for (int a = 0; a < 2; ++a)
#pragma unroll
        for (int b = 0; b < 2; ++b)
#pragma unroll
            for (int m = 0; m < 4; ++m)
#pragma unroll
                for (int n = 0; n < 2; ++n) acc[a][b][m][n] = (f32x4){0.f, 0.f, 0.f, 0.f};
    bf16x8 At[4][2], B0[2][2], B1[2][2];
    const char* cA = (const char*)g.A + (size_t)cur.pm * tstepA; const char* cB = (const char*)g.Bt + (size_t)cur.pb * tstepB;
    PG8_STAGE(PG8_SB(0, 0), cB, voffB); PG8_STAGE(PG8_SA(0, 0), cA, voffA); PG8_STAGE(PG8_SB(0, 1), cB + hstepB, voffB); PG8_STAGE(PG8_SA(0, 1), cA + hstepA, voffA);
    if (wr == 1) PG8_BAR;
    PG8_WAIT_V(4); PG8_BAR;
    PG8_STAGE(PG8_SB(1, 0), cB + kstep, voffB); PG8_STAGE(PG8_SA(1, 0), cA + kstep, voffA); PG8_STAGE(PG8_SB(1, 1), cB + hstepB + kstep, voffB);
    PG8_WAIT_V(6); PG8_BAR;
    for (;;) {
        const bool has_next = S.next(ui + 1, nxt);
        const char* nA = has_next ? (const char*)g.A + (size_t)nxt.pm * tstepA : cA; const char* nB = has_next ? (const char*)g.Bt + (size_t)nxt.pb * tstepB : cB;
#pragma unroll 1
        for (int t = 0; t < nt; t += 2) {
            const bool last = (t == nt - 2);
            const char* a1 = cA + (size_t)(t + 1) * kstep;
            const char* a2 = last ? nA : cA + (size_t)(t + 2) * kstep; const char* b2 = last ? nB : cB + (size_t)(t + 2) * kstep;
            const char* a3 = a2 + kstep; const char* b3 = b2 + kstep;
            PG8_LDB(B0, 0, 0); PG8_SCHED; PG8_LDA(At, 0, 0); PG8_STAGE(PG8_SA(1, 1), a1 + hstepA, voffA);
            PG8_WAIT_L(8); PG8_BAR; PG8_WAIT_L(0); PG8_MMA(0, 0, At, B0); PG8_BAR; PG8_SCHED;
            PG8_LDB(B1, 0, 1); PG8_STAGE(PG8_SB(0, 0), b2, voffB);
            PG8_BAR; PG8_WAIT_L(0); PG8_MMA(0, 1, At, B1); PG8_BAR;
            PG8_LDA(At, 0, 1); PG8_STAGE(PG8_SA(0, 0), a2, voffA);
            PG8_BAR; PG8_WAIT_L(0); PG8_MMA(1, 0, At, B0); PG8_BAR; PG8_SCHED;
            PG8_STAGE(PG8_SB(0, 1), b2 + hstepB, voffB);
            PG8_WAIT_V(6); PG8_BAR; PG8_MMA(1, 1, At, B1); PG8_BAR;
            PG8_LDB(B0, 1, 0); PG8_SCHED; PG8_LDA(At, 1, 0); PG8_STAGE(PG8_SA(0, 1), a2 + hstepA, voffA);
            PG8_WAIT_L(8); PG8_BAR; PG8_WAIT_L(0); PG8_MMA(0, 0, At, B0); PG8_BAR; PG8_SCHED;
            PG8_LDB(B1, 1, 1); PG8_STAGE(PG8_SB(1, 0), b3, voffB);
            PG8_BAR; PG8_WAIT_L(0); PG8_MMA(0, 1, At, B1); PG8_BAR;
            PG8_LDA(At, 1, 1); PG8_STAGE(PG8_SA(1, 0), a3, voffA);
            PG8_BAR; PG8_WAIT_L(0); PG8_MMA(1, 0, At, B0); PG8_BAR; PG8_SCHED;
            PG8_STAGE(PG8_SB(1, 1), b3 + hstepB, voffB);
            PG8_WAIT_V(6); PG8_BAR; PG8_MMA(1, 1, At, B1); PG8_BAR;
        }
        { int fr_ = fr, fq_ = fq; asm volatile("" : "+v"(fr_), "+v"(fq_)); E(acc, cur, wr, wc, fr_, fq_); }
        if (!has_next) break;
#pragma unroll
        for (int a = 0; a < 2; ++a)
#pragma unroll
            for (int b = 0; b < 2; ++b)
#pragma unroll
                for (int m = 0; m < 4; ++m)
#pragma unroll
                    for (int n = 0; n < 2; ++n) acc[a][b][m][n] = (f32x4){0.f, 0.f, 0.f, 0.f};
        cur = nxt; cA = nA; cB = nB; ++ui;
    }
    PG8_WAIT_V(0);
    if (wr == 0) PG8_BAR;
    PG8_BAR;
#undef PG8_SA
#undef PG8_SB
#undef PG8_STAGE
#undef PG8_LDA
#undef PG8_LDB
#undef PG8_MMA
#undef PG8_WAIT_V
#undef PG8_WAIT_L
#undef PG8_BAR
#undef PG8_SCHED
}
}
using pg8::Unit; using pg8::HALF;
typedef const f32x4 (&AccRef)[2][2][4][2];

struct EpiZ {
    static constexpr bool PERM = true;
    bf16_t *zrw, *g3, *xl, *as;
    __device__ __forceinline__ void operator()(AccRef acc, const Unit& u, int wr, int wc, int fr, int fq) const {
        const int row0 = u.pm * 256 + wr * 64 + fr, colt = wc * 32 + 8 * fq, pn = u.pn;
        if (pn == 9 || pn == 10) {
#pragma unroll
            for (int ai = 0; ai < 2; ++ai)
#pragma unroll
                for (int m = 0; m < 4; ++m) { const int row = row0 + ai * HALF + m * 16; const int b = row >> 13, l = row & 8191;
#pragma unroll
                    for (int bj = 0; bj < 2; ++bj) { const int c = (pn - 9) * 256 + bj * HALF + colt; const int g = c >> 4, h0 = c & 15;
                        const size_t asrow = (size_t)g * 2048 + b * 512 + (l >> 4);
                        const f32x4 v0 = acc[ai][bj][m][0], v1 = acc[ai][bj][m][1];
                        u32x4 w; w.x = cvt_pk_bf16(v0[0], v0[1]); w.y = cvt_pk_bf16(v0[2], v0[3]); w.z = cvt_pk_bf16(v1[0], v1[1]); w.w = cvt_pk_bf16(v1[2], v1[3]);
                        *(u32x4*)(as + asrow * AS_LD + (l & 15) * 16 + h0) = w; } }
            return;
        }
        bf16_t* base; int ld, c0;
        if (pn < 7) { base = zrw; ld = ZRW_LD; c0 = pn * 256; }
        else if (pn < 9) { base = g3; ld = G3_LD; c0 = (pn - 7) * 256; }
        else if (pn < 13) { base = g3; ld = G3_LD; c0 = 512 + (pn - 11) * 256; }
        else if (pn < 15) { base = xl; ld = BW; c0 = (pn - 13) * 256; }
        else { base = g3; ld = G3_LD; c0 = 1024 + (pn - 15) * 256; }
#pragma unroll
        for (int ai = 0; ai < 2; ++ai)
#pragma unroll
            for (int m = 0; m < 4; ++m) { bf16_t* rowp = base + (size_t)(row0 + ai * HALF + m * 16) * ld + c0 + colt;
#pragma unroll
                for (int bj = 0; bj < 2; ++bj) { const f32x4 v0 = acc[ai][bj][m][0], v1 = acc[ai][bj][m][1];
                    u32x4 w; w.x = cvt_pk_bf16(v0[0], v0[1]); w.y = cvt_pk_bf16(v0[2], v0[3]); w.z = cvt_pk_bf16(v1[0], v1[1]); w.w = cvt_pk_bf16(v1[2], v1[3]);
                    *(u32x4*)(rowp + bj * HALF) = w; } }
    }
};
struct EpiPle {
    static constexpr bool PERM = true;
    bf16_t* pw; float* ss;
    __device__ __forceinline__ void operator()(AccRef acc, const Unit& u, int wr, int wc, int fr, int fq) const {
        const int row0 = u.pm * 256 + wr * 64 + fr, col0 = u.pn * 256 + wc * 32 + 8 * fq;
#pragma unroll
        for (int ai = 0; ai < 2; ++ai)
#pragma unroll
            for (int m = 0; m < 4; ++m) { const int row = row0 + ai * HALF + m * 16; bf16_t* rowp = pw + (size_t)row * D + col0; float s = 0.f;
#pragma unroll
                for (int bj = 0; bj < 2; ++bj) { const f32x4 v0 = acc[ai][bj][m][0], v1 = acc[ai][bj][m][1];
                    s += v0[0] * v0[0] + v0[1] * v0[1] + v0[2] * v0[2] + v0[3] * v0[3] + v1[0] * v1[0] + v1[1] * v1[1] + v1[2] * v1[2] + v1[3] * v1[3];
                    u32x4 w; w.x = cvt_pk_bf16(v0[0], v0[1]); w.y = cvt_pk_bf16(v0[2], v0[3]); w.z = cvt_pk_bf16(v1[0], v1[1]); w.w = cvt_pk_bf16(v1[2], v1[3]);
                    *(u32x4*)(rowp + bj * HALF) = w; }
                s += __shfl_xor(s, 16); s += __shfl_xor(s, 32);
                if (fq == 0) unsafeAtomicAdd(ss + row, s);
                asm volatile("" ::: "memory"); }
    }
};
struct EpiE {
    static constexpr bool PERM = false;
    float* e;
    __device__ __forceinline__ void operator()(AccRef acc, const Unit& u, int wr, int wc, int fr, int fq) const {
        const int row0 = u.pm * 256 + wr * 64 + fr, col0 = wc * 32 + 4 * fq;
#pragma unroll
        for (int ai = 0; ai < 2; ++ai)
#pragma unroll
            for (int m = 0; m < 4; ++m) { float* rowp = e + (size_t)(row0 + ai * HALF + m * 16) * 128 + col0;
#pragma unroll
                for (int n = 0; n < 2; ++n) *(f32x4*)(rowp + n * 16) = acc[ai][0][m][n]; }
    }
};
struct EpiY {
    static constexpr bool PERM = true;
    const bf16_t* as; const float* dvec; bf16_t* zgs;
    __device__ __forceinline__ void operator()(AccRef acc, const Unit& u, int wr, int wc, int fr, int fq) const {
        const int row0 = u.pm * 256 + wr * 64 + fr, colt = wc * 32 + 8 * fq, g = u.pm >> 3, h0 = (8 * fq) & 15;
        const f32x4 d0 = *(const f32x4*)(dvec + g * 16 + h0), d1 = *(const f32x4*)(dvec + g * 16 + h0 + 4);
#pragma unroll
        for (int ai = 0; ai < 2; ++ai)
#pragma unroll
            for (int m = 0; m < 4; ++m) { const int row = row0 + ai * HALF + m * 16; const int b = (row >> 9) & 3, ch = row & 511;
#pragma unroll
                for (int bj = 0; bj < 2; ++bj) { const int c = bj * HALF + colt, tt = c >> 4;
                    float uu[8]; unpack8(*(const u32x4*)(as + (size_t)row * AS_LD + c), uu);
                    const f32x4 v0 = acc[ai][bj][m][0], v1 = acc[ai][bj][m][1];
                    float o[8];
#pragma unroll
                    for (int j = 0; j < 4; ++j) { o[j] = gelu_tanh(v0[j] + d0[j] * uu[j]); o[4 + j] = gelu_tanh(v1[j] + d1[j] * uu[4 + j]); }
                    const size_t tok = (size_t)b * SEQ + ch * 16 + tt;
                    *(u32x4*)(zgs + tok * BW + g * 16 + h0) = pack8(o); }
                asm volatile("" ::: "memory"); }
    }
};
struct EpiGlu {
    static constexpr bool PERM = true;
    const bf16_t* zgs; const float* bias; bf16_t* g3;
    __device__ __forceinline__ void operator()(AccRef acc, const Unit& u, int wr, int wc, int fr, int fq) const {
        const int row0 = u.pm * 256 + wr * 64 + fr, col0 = u.pn * 256 + wc * 32 + 8 * fq;
#pragma unroll
        for (int ai = 0; ai < 2; ++ai)
#pragma unroll
            for (int m = 0; m < 4; ++m) { const size_t row = (size_t)(row0 + ai * HALF + m * 16);
#pragma unroll
                for (int bj = 0; bj < 2; ++bj) { const int c = col0 + bj * HALF;
                    float z[8], gt[8]; unpack8(*(const u32x4*)(zgs + row * BW + c), z); bf16_t* gp = g3 + row * G3_LD + 512 + c; unpack8(*(const u32x4*)gp, gt);
                    const f32x4 b0 = *(const f32x4*)(bias + c), b1 = *(const f32x4*)(bias + c + 4);
                    const f32x4 v0 = acc[ai][bj][m][0], v1 = acc[ai][bj][m][1];
                    float o[8];
#pragma unroll
                    for (int j = 0; j < 4; ++j) { o[j] = z[j] * sigmoidf_(v0[j] + b0[j]) * siluf_(gt[j]); o[4 + j] = z[4 + j] * sigmoidf_(v1[j] + b1[j]) * siluf_(gt[4 + j]); }
                    *(u32x4*)gp = pack8(o); } }
    }
};
struct EpiLru {
    static constexpr bool PERM = true;
    const bf16_t* xc; const float *ba, *bx, *lam; bf16_t* ab;
    __device__ __forceinline__ void operator()(AccRef acc, const Unit& u, int wr, int wc, int fr, int fq) const {
        const int row0 = u.pm * 256 + wr * 64 + fr, ch = u.pn * 128 + wc * 32 + 8 * fq;
        float bav[8], bxv[8], spl[8];
#pragma unroll
        for (int j = 0; j < 8; ++j) { bav[j] = ba[ch + j]; bxv[j] = bx[ch + j]; spl[j] = -8.0f * softplusf_(-lam[ch + j]); }
#pragma unroll
        for (int ai = 0; ai < 2; ++ai)
#pragma unroll
            for (int m = 0; m < 4; ++m) { const size_t row = (size_t)(row0 + ai * HALF + m * 16);
                float x[8]; unpack8(*(const u32x4*)(xc + row * BW + ch), x);
                float la[8], bb[8];
#pragma unroll
                for (int j = 0; j < 8; ++j) { const float za = acc[ai][0][m][j >> 2][j & 3], zx = acc[ai][1][m][j >> 2][j & 3];
                    const float r = sigmoidf_(za + bav[j]), ig = sigmoidf_(zx + bxv[j]);
                    const float l_a = spl[j] * r; la[j] = l_a;
                    bb[j] = sqrtf(fmaxf(-expm1f(2.0f * l_a), 0.0f)) * (ig * x[j]); }
                *(u32x4*)(ab + row * 1024 + ch) = pack8(la); *(u32x4*)(ab + row * 1024 + 512 + ch) = pack8(bb); }
    }
};
struct EpiOut {
    static constexpr bool PERM = false;
    const float* hin; float* h; bf16_t* h1b;
    __device__ __forceinline__ void operator()(AccRef acc, const Unit& u, int wr, int wc, int fr, int fq) const {
        const int row0 = u.pm * 256 + wr * 64 + fr, col0 = u.pn * 256 + wc * 32 + 4 * fq;
#pragma unroll
        for (int ai = 0; ai < 2; ++ai)
#pragma unroll
            for (int m = 0; m < 4; ++m) { const size_t off = (size_t)(row0 + ai * HALF + m * 16) * D + col0;
#pragma unroll
                for (int bj = 0; bj < 2; ++bj)
#pragma unroll
                    for (int n = 0; n < 2; ++n) { const size_t o = off + bj * HALF + n * 16; const f32x4 v = *(const f32x4*)(hin + o) + acc[ai][bj][m][n];
                        *(f32x4*)(h + o) = v; u32x2 w; w.x = cvt_pk_bf16(v[0], v[1]); w.y = cvt_pk_bf16(v[2], v[3]); *(u32x2*)(h1b + o) = w; }
                asm volatile("" ::: "memory"); }
    }
};
struct EpiGate {
    static constexpr bool PERM = false;
    float* h; const bf16_t* pw; const float* ssp; const float* gple; float* ssh;
    __device__ __forceinline__ void operator()(AccRef acc, const Unit& u, int wr, int wc, int fr, int fq) const {
        const int row0 = u.pm * 256 + wr * 64 + fr, col0 = u.pn * 256 + wc * 32 + 4 * fq;
        f32x4 gv[2][2];
#pragma unroll
        for (int bj = 0; bj < 2; ++bj)
#pragma unroll
            for (int n = 0; n < 2; ++n) gv[bj][n] = *(const f32x4*)(gple + col0 + bj * HALF + n * 16);
#pragma unroll
        for (int ai = 0; ai < 2; ++ai)
#pragma unroll
            for (int m = 0; m < 4; ++m) { const int row = row0 + ai * HALF + m * 16; const size_t off = (size_t)row * D + col0;
                const float rs = rsqrtf(ssp[row] * (1.0f / 1024.0f) + 1e-6f); float s = 0.f;
#pragma unroll
                for (int bj = 0; bj < 2; ++bj)
#pragma unroll
                    for (int n = 0; n < 2; ++n) { const size_t o = off + bj * HALF + n * 16; const u32x2 pwv = *(const u32x2*)(pw + o); const f32x4 a = acc[ai][bj][m][n]; f32x4 v = *(const f32x4*)(h + o);
                        v[0] += lo16(pwv.x) * rs * gv[bj][n][0] * sigmoidf_(a[0]); v[1] += hi16(pwv.x) * rs * gv[bj][n][1] * sigmoidf_(a[1]);
                        v[2] += lo16(pwv.y) * rs * gv[bj][n][2] * sigmoidf_(a[2]); v[3] += hi16(pwv.y) * rs * gv[bj][n][3] * sigmoidf_(a[3]);
                        s += v[0] * v[0] + v[1] * v[1] + v[2] * v[2] + v[3] * v[3];
                        *(f32x4*)(h + o) = v; }
                s += __shfl_xor(s, 16); s += __shfl_xor(s, 32);
                if (fq == 0) unsafeAtomicAdd(ssh + row, s); }
    }
};

struct Ctx { const Params* P; unsigned char* ws; LAS unsigned char* lds; unsigned char* ldsg; int tid, lane, wave; size_t gtid, gsz; int vb, vG; };

template <class Map>
__device__ void transpose_w(const Ctx& c, const float* src, bf16_t* dst, int K, int Nsrc, int Npad, Map map) {
    const int K8 = K / 8; const size_t total = (size_t)2 * Npad * K8;
    for (size_t idx = c.gtid; idx < total; idx += c.gsz) {
        const int n = (int)(idx % Npad); const int k8 = (int)((idx / Npad) % K8); const int l = (int)(idx / ((size_t)Npad * K8));
        const int s = map(n); float f[8];
#pragma unroll
        for (int i = 0; i < 8; ++i) f[i] = (s >= 0) ? src[((size_t)l * K + k8 * 8 + i) * Nsrc + s] : 0.0f;
        *(u32x4*)(dst + ((size_t)l * Npad + n) * K + k8 * 8) = pack8(f);
    }
}

__device__ __forceinline__ void s5_lam_pow(const Params& P, int l, int g, int p, int n, float& re, float& im) {
    const float are = P.in[14][(l * 32 + g) * 64 + p], aim = P.in[15][(l * 32 + g) * 64 + p], dt = __expf(P.in[16][l * 32 + g]);
    const float mag = __expf(are * dt * (float)n);
    double rev = (double)aim * (double)dt * (double)n * 0.15915494309189535; rev -= rint(rev);
    const float ang = (float)(rev * 6.283185307179586);
    re = mag * cosf(ang); im = mag * sinf(ang);
}

__device__ void phase_prep(const Ctx& c) {
    const Params& P = *c.P; unsigned char* ws = c.ws;
    transpose_w(c, P.in[3], (bf16_t*)(ws + OFF_WIN), D, DIN, DINP, [](int n) { return n < 1664 ? n : (n < 1792 ? -1 : n - 128); });
    transpose_w(c, P.in[31], (bf16_t*)(ws + OFF_WOUT), DMIX, D, D, [](int n) { return n; });
    transpose_w(c, P.in[34], (bf16_t*)(ws + OFF_WG), D, D, D, [](int n) { return n; });
    transpose_w(c, P.in[32], (bf16_t*)(ws + OFF_WPLE), DPLE, D, D, [](int n) { return n; });
    transpose_w(c, P.in[22], (bf16_t*)(ws + OFF_WGLU), BW, BW, BW, [](int n) { return n; });
    { bf16_t* dst = (bf16_t*)(ws + OFF_WLRU);
      for (size_t idx = c.gtid; idx < (size_t)2 * 1024 * 64; idx += c.gsz) {
          const int n = (int)(idx & 1023), k8 = (int)((idx >> 10) & 63), l = (int)(idx >> 16);
          const int pn = n >> 8, rr = n & 255, ch = 128 * pn + (rr & 127), which = rr >> 7, hb = ch >> 6, j = ch & 63, k0 = k8 * 8;
          const float* W = which ? P.in[28] : P.in[26]; float f[8];
#pragma unroll
          for (int i = 0; i < 8; ++i) f[i] = ((k0 >> 6) == hb) ? W[(((size_t)l * 8 + hb) * 64 + (k0 & 63) + i) * 64 + j] : 0.0f;
          *(u32x4*)(dst + ((size_t)l * 1024 + n) * BW + k0) = pack8(f); } }
    { float* tbl = (float*)(ws + OFF_TBL);
      for (size_t idx = c.gtid; idx < (size_t)2 * 32 * 64 * 18; idx += c.gsz) {
          const int n = (int)(idx % 18), lgp = (int)(idx / 18), p = lgp & 63, g = (lgp >> 6) & 31, l = lgp >> 11; float re, im;
          if (n < 17) s5_lam_pow(P, l, g, p, n, re, im);
          else { float lr, li; s5_lam_pow(P, l, g, p, 1, lr, li); const float ar = P.in[14][(l * 32 + g) * 64 + p], ai = P.in[15][(l * 32 + g) * 64 + p];
                 const float cr = lr - 1.0f, ci = li, den = 1.0f / (ar * ar + ai * ai); re = (cr * ar + ci * ai) * den; im = (ci * ar - cr * ai) * den; }
          tbl[idx * 2] = re; tbl[idx * 2 + 1] = im; } }
    { const float* x = P.in[0]; const float* gg = P.in[2]; bf16_t* xn = (bf16_t*)(ws + OFF_XN);
      const int stride = gridDim.x * 8;
      for (int row0 = blockIdx.x * 8 + c.wave; row0 < T; row0 += 2 * stride) {
          f32x4 v[2][4]; float sq[2]; bool ok[2];
#pragma unroll
          for (int r = 0; r < 2; ++r) { const int row = row0 + r * stride; ok[r] = row < T; const int rr = ok[r] ? row : row0; sq[r] = 0.f;
#pragma unroll
              for (int i = 0; i < 4; ++i) { v[r][i] = *(const f32x4*)(x + (size_t)rr * D + i * 256 + c.lane * 4); sq[r] += v[r][i][0] * v[r][i][0] + v[r][i][1] * v[r][i][1] + v[r][i][2] * v[r][i][2] + v[r][i][3] * v[r][i][3]; } }
#pragma unroll
          for (int r = 0; r < 2; ++r) { if (!ok[r]) continue; const int row = row0 + r * stride; const float rs = rsqrtf(wave_sum(sq[r]) * (1.0f / 1024.0f) + 1e-6f);
#pragma unroll
              for (int i = 0; i < 4; ++i) { const f32x4 gv = *(const f32x4*)(gg + i * 256 + c.lane * 4); u32x2 w; w.x = cvt_pk_bf16(v[r][i][0] * rs * gv[0], v[r][i][1] * rs * gv[1]); w.y = cvt_pk_bf16(v[r][i][2] * rs * gv[2], v[r][i][3] * rs * gv[3]);
                  *(u32x2*)(xn + (size_t)row * D + i * 256 + c.lane * 4) = w; } } } }
    { float* ss = (float*)(ws + OFF_SS); for (size_t i = c.gtid; i < (size_t)4 * T; i += c.gsz) ss[i] = 0.0f; }
    { const float* p = P.in[1]; bf16_t* pb = (bf16_t*)(ws + OFF_PB);
      for (size_t i = c.gtid; i < (size_t)2 * T * DPLE / 8; i += c.gsz) { const f32x4 a = *(const f32x4*)(p + i * 8), b = *(const f32x4*)(p + i * 8 + 4);
          u32x4 w; w.x = cvt_pk_bf16(a[0], a[1]); w.y = cvt_pk_bf16(a[2], a[3]); w.z = cvt_pk_bf16(b[0], b[1]); w.w = cvt_pk_bf16(b[2], b[3]); *(u32x4*)(pb + i * 8) = w; } }
}

__device__ void phase_s5_consts(const Ctx& c) {
    const Params& P = *c.P; unsigned char* ws = c.ws;
    const float* tbl = (const float*)(ws + OFF_TBL); bf16_t* by = (bf16_t*)(ws + OFF_S5Y); bf16_t* be = (bf16_t*)(ws + OFF_S5E);
    const float *bre = P.in[17], *bim = P.in[18], *cre = P.in[19], *cim = P.in[20];
    for (size_t idx = c.gtid; idx < (size_t)2 * 32 * 16 * 256; idx += c.gsz) {
        const int hp = (int)(idx & 15), h = (int)((idx >> 4) & 15), tau = (int)((idx >> 8) & 15), g = (int)((idx >> 12) & 31), l = (int)(idx >> 17);
        const int lg = l * 32 + g; float s = 0.f;
        for (int p = 0; p < 64; ++p) { const float* tp = tbl + ((size_t)(lg * 64 + p) * 18) * 2;
            const float pr = tp[tau * 2], pi = tp[tau * 2 + 1], qr = tp[34], qi = tp[35];
            const float br = bre[((size_t)lg * 64 + p) * 16 + hp], bi = bim[((size_t)lg * 64 + p) * 16 + hp];
            const float bbr = qr * br - qi * bi, bbi = qr * bi + qi * br;
            const float zr = pr * bbr - pi * bbi, zi = pr * bbi + pi * bbr;
            const float cr = cre[((size_t)lg * 16 + h) * 64 + p], ci = cim[((size_t)lg * 16 + h) * 64 + p];
            s += cr * zr - ci * zi; }
        const bf16_t kv = f2bf(s); bf16_t* base = by + (size_t)lg * 256 * AS_LD;
        for (int s0 = 0; s0 + tau < 16; ++s0) { const int t = s0 + tau;
            base[(size_t)(t * 16 + h) * AS_LD + s0 * 16 + hp] = kv;
            if (tau > 0) base[(size_t)(s0 * 16 + h) * AS_LD + t * 16 + hp] = 0; }
    }
    for (size_t idx = c.gtid; idx < (size_t)2 * 32 * 256 * 64; idx += c.gsz) {
        const int p = (int)(idx & 63), th = (int)((idx >> 6) & 255), lg = (int)(idx >> 14); const int t = th >> 4, h = th & 15;
        const float* tp = tbl + ((size_t)(lg * 64 + p) * 18) * 2; const float pr = tp[(t + 1) * 2], pi = tp[(t + 1) * 2 + 1];
        const float cr = cre[((size_t)lg * 16 + h) * 64 + p], ci = cim[((size_t)lg * 16 + h) * 64 + p];
        bf16_t* rowp = by + ((size_t)lg * 256 + th) * AS_LD; rowp[256 + p] = f2bf(cr * pr - ci * pi); rowp[320 + p] = f2bf(-(cr * pi + ci * pr));
    }
    for (size_t idx = c.gtid; idx < (size_t)2 * 32 * 256 * 256; idx += c.gsz) {
        const int col = (int)(idx & 255), n = (int)((idx >> 8) & 255), lg = (int)(idx >> 16); float v = 0.f;
        if (n < 128) { const int p = n & 63, s0 = col >> 4, hp = col & 15; const float* tp = tbl + ((size_t)(lg * 64 + p) * 18) * 2;
            const float pr = tp[(15 - s0) * 2], pi = tp[(15 - s0) * 2 + 1], qr = tp[34], qi = tp[35];
            const float br = bre[((size_t)lg * 64 + p) * 16 + hp], bi = bim[((size_t)lg * 64 + p) * 16 + hp];
            const float bbr = qr * br - qi * bi, bbi = qr * bi + qi * br;
            v = (n < 64) ? (pr * bbr - pi * bbi) : (pr * bbi + pi * bbr); }
        be[idx] = f2bf(v);
    }
}

__device__ void phase_lru_conv(const Ctx& c, int l) {
    const Params& P = *c.P; const bf16_t* xl = (const bf16_t*)(c.ws + OFF_XL); bf16_t* xc = (bf16_t*)(c.ws + OFF_XC);
    const float* cw = P.in[24] + (size_t)l * 4 * BW; const float* cb = P.in[25] + (size_t)l * BW;
    for (size_t idx = (size_t)c.vb * 512 + c.tid; idx < (size_t)T * 64; idx += (size_t)c.vG * 512) {
        const int c8 = (int)(idx & 63) * 8; const int row = (int)(idx >> 6), lpos = row & (SEQ - 1);
        float o[8];
#pragma unroll
        for (int i = 0; i < 8; ++i) o[i] = cb[c8 + i];
#pragma unroll
        for (int j = 0; j < 4; ++j) { if (lpos - 3 + j >= 0) { float x[8]; unpack8(*(const u32x4*)(xl + (size_t)(row - 3 + j) * BW + c8), x);
#pragma unroll
                for (int i = 0; i < 8; ++i) o[i] += x[i] * cw[j * BW + c8 + i]; } }
        *(u32x4*)(xc + (size_t)row * BW + c8) = pack8(o);
    }
}

__device__ void phase_s5_carry(const Ctx& c, int l) {
    if (c.wave != 0 || c.vb >= 128) return;
    const int g = c.vb >> 2, b = c.vb & 3, p = c.lane;
    float lr, li; s5_lam_pow(*c.P, l, g, p, 16, lr, li);
    const float* e = (const float*)(c.ws + OFF_E); bf16_t* as = (bf16_t*)(c.ws + OFF_AS);
    const size_t base = (size_t)g * 2048 + b * 512; float xr = 0.f, xi = 0.f;
    for (int c0 = 0; c0 < 512; c0 += 32) {
        float er[32], ei[32];
#pragma unroll
        for (int i = 0; i < 32; ++i) { er[i] = e[(base + c0 + i) * 128 + p]; ei[i] = e[(base + c0 + i) * 128 + 64 + p]; }
#pragma unroll
        for (int i = 0; i < 32; ++i) { bf16_t* rowp = as + (base + c0 + i) * AS_LD; rowp[256 + p] = f2bf(xr); rowp[320 + p] = f2bf(xi);
            const float nr = lr * xr - li * xi + er[i], ni = lr * xi + li * xr + ei[i]; xr = nr; xi = ni; }
    }
}

__device__ void phase_lru_scan(const Ctx& c, int pass) {
    const bf16_t* ab = (const bf16_t*)(c.ws + OFF_LRUAB); float* agg = (float*)(c.ws + OFF_AGG); bf16_t* g3 = (bf16_t*)(c.ws + OFF_G3);
    const int ch = c.tid;
    for (int unit = c.vb; unit < NB * 128; unit += c.vG) {
        const int b = unit >> 7, ck = unit & 127; const size_t t0 = (size_t)b * SEQ + ck * 64;
        float h = 0.f, sl = 0.f;
        if (pass == 1) {
            for (int i0 = 0; i0 < ck; i0 += 16) { float sl_[16], he_[16];
#pragma unroll
                for (int j = 0; j < 16; ++j) { const int ii = (i0 + j < ck) ? i0 + j : ck - 1; const float* a = agg + ((size_t)(b * 128 + ii)) * 1024; sl_[j] = a[ch]; he_[j] = a[512 + ch]; }
#pragma unroll
                for (int j = 0; j < 16; ++j) if (i0 + j < ck) h = __expf(sl_[j]) * h + he_[j]; }
        }
        for (int t8 = 0; t8 < 64; t8 += 16) {
            float la[16], bb[16], gt[16];
#pragma unroll
            for (int i = 0; i < 16; ++i) { la[i] = bf2f(ab[(t0 + t8 + i) * 1024 + ch]); bb[i] = bf2f(ab[(t0 + t8 + i) * 1024 + 512 + ch]); if (pass == 1) gt[i] = bf2f(g3[(t0 + t8 + i) * G3_LD + 1024 + ch]); }
#pragma unroll
            for (int i = 0; i < 16; ++i) { h = __expf(la[i]) * h + bb[i]; sl += la[i];
                if (pass == 1) g3[(t0 + t8 + i) * G3_LD + 1024 + ch] = f2bf(h * siluf_(gt[i])); }
        }
        if (pass == 0) { float* a = agg + ((size_t)(b * 128 + ck)) * 1024; a[ch] = sl; a[512 + ch] = h; }
    }
}

__device__ void phase_norm(const Ctx& c, const float* ss, const float* gg, int fin) {
    float* h = c.P->out; bf16_t* xn = (bf16_t*)(c.ws + OFF_XN);
    const int stride = gridDim.x * 8;
    f32x4 gv[4];
#pragma unroll
    for (int i = 0; i < 4; ++i) gv[i] = *(const f32x4*)(gg + i * 256 + c.lane * 4);
    for (int row0 = blockIdx.x * 8 + c.wave; row0 < T; row0 += 4 * stride) {
        f32x4 v[4][4]; float rs[4]; bool ok[4];
#pragma unroll
        for (int r = 0; r < 4; ++r) { const int row = row0 + r * stride; ok[r] = row < T; const int rr = ok[r] ? row : row0; rs[r] = ss[rr];
#pragma unroll
            for (int i = 0; i < 4; ++i) v[r][i] = *(const f32x4*)(h + (size_t)rr * D + i * 256 + c.lane * 4); }
#pragma unroll
        for (int r = 0; r < 4; ++r) { if (!ok[r]) continue; const int row = row0 + r * stride; const float sc = rsqrtf(rs[r] * (1.0f / 1024.0f) + 1e-6f);
#pragma unroll
            for (int i = 0; i < 4; ++i) { const size_t o = (size_t)row * D + i * 256 + c.lane * 4; const f32x4 q = v[r][i] * sc * gv[i];
                if (fin) *(f32x4*)(h + o) = q; else { u32x2 w; w.x = cvt_pk_bf16(q[0], q[1]); w.y = cvt_pk_bf16(q[2], q[3]); *(u32x2*)(xn + o) = w; } } }
    }
}

typedef float f32x2 __attribute__((ext_vector_type(2)));
template <int CTRL> __device__ __forceinline__ float dpp_mov(float v) { return __builtin_bit_cast(float, __builtin_amdgcn_update_dpp(0, __builtin_bit_cast(int, v), CTRL, 0xf, 0xf, true)); }
__device__ __forceinline__ float row16_sum(float v) { v += dpp_mov<0xB1>(v); v += dpp_mov<0x4E>(v); v += dpp_mov<0x124>(v); v += dpp_mov<0x128>(v); return v; }
__device__ __forceinline__ float wave_sum2(float v) { v = row16_sum(v); const int vi = __builtin_bit_cast(int, v); const float a = __builtin_bit_cast(float, __builtin_amdgcn_readlane(vi, 0)), b = __builtin_bit_cast(float, __builtin_amdgcn_readlane(vi, 16)), c2 = __builtin_bit_cast(float, __builtin_amdgcn_readlane(vi, 32)), d = __builtin_bit_cast(float, __builtin_amdgcn_readlane(vi, 48)); return (a + b) + (c2 + d); }
__device__ __forceinline__ float oct_sum(float v) { v += dpp_mov<0xB1>(v); v += dpp_mov<0x4E>(v); v += dpp_mov<0x141>(v); return v; }
constexpr int RW_NBLK = 128, TWS = 72;

struct RwRows { unsigned zr[5], zk[5], zv[5], zw[5], za[5]; };
__device__ __forceinline__ float rw_get(const unsigned (&a)[5], int i) { return (i & 1) ? hi16(a[i >> 1]) : lo16(a[i >> 1]); }
__device__ __forceinline__ void rw_load_rows(RwRows& R, const bf16_t* zrw, int b, int blk, int w, int lane, int cj) {
#pragma unroll
    for (int p = 0; p < 5; ++p) { unsigned r_[2] = {0, 0}, k_[2] = {0, 0}, v_[2] = {0, 0}, w_[2] = {0, 0}, a_[2] = {0, 0};
#pragma unroll
        for (int h = 0; h < 2; ++h) { const int i = 2 * p + h; if (i < 9) { const int lp = blk * 64 + w * 8 - 1 + i; const bool ok = lp >= 0; const bf16_t* rp = zrw + ((size_t)b * SEQ + (ok ? lp : 0)) * ZRW_LD;
            const unsigned m = ok ? 0xffffu : 0u;
            r_[h] = rp[cj] & m; k_[h] = rp[512 + cj] & m; v_[h] = rp[1024 + cj] & m; w_[h] = rp[1536 + lane] & m; a_[h] = rp[1600 + lane] & m; } }
        R.zr[p] = r_[0] | (r_[1] << 16); R.zk[p] = k_[0] | (k_[1] << 16); R.zv[p] = v_[0] | (v_[1] << 16); R.zw[p] = w_[0] | (w_[1] << 16); R.za[p] = a_[0] | (a_[1] << 16); }
}

constexpr int CH_AT = 0, CH_RT = 2304, CH_KT = 4608, CH_BT = 6912, CH_KH = 9216, CH_NB = 12288, CH_VT = 15360, CH_LRK = 18432, CH_NLRB = 19200, CH_GI = 19968,
              CH_LAB = 20736, CH_LAK = 21760, CH_GC = 22784, CH_BYTES = 23040;
constexpr int RW_YY = 4 * CH_BYTES, RW_TW = RW_YY + 16384, RW_AD = RW_TW + 64 * TWS * 2, RW_AR = RW_TW  , RW_GP = RW_AD + 64 * TWS * 2,
              RW_W2 = RW_GP + 2048, RW_A2 = RW_W2 + 64 * TWS * 2, RW_CT = RW_A2 + 64 * TWS * 2, RW_END = RW_CT + 12 * 64 * 4;
static_assert(RW_END <= LDS_BYTES, "rwkv lds");
__device__ __forceinline__ void lds_barrier() { asm volatile("s_waitcnt lgkmcnt(0)\n\ts_barrier" ::: "memory"); }
typedef short bf16x4 __attribute__((ext_vector_type(4)));
__device__ __forceinline__ bf16x8 cat4(bf16x4 lo, bf16x4 hi) { return __builtin_shufflevector(lo, hi, 0, 1, 2, 3, 4, 5, 6, 7); }
__device__ __forceinline__ bf16x8 cat4z(bf16x4 lo) { const bf16x4 z = {0, 0, 0, 0}; return __builtin_shufflevector(lo, z, 0, 1, 2, 3, 4, 5, 6, 7); }
__device__ __forceinline__ bf16x4 pk4(f32x4 v) { u32x2 w; w.x = cvt_pk_bf16(v[0], v[1]); w.y = cvt_pk_bf16(v[2], v[3]); return __builtin_bit_cast(bf16x4, w); }

__device__ void phase_rwkv(const Ctx& c, int l, int blk_lo, int blk_hi, bool dry = false) {
    if (blockIdx.x >= 32) return;
    const Params& P = *c.P; const int b = blockIdx.x >> 3, hd = blockIdx.x & 7, lane = c.lane, w = c.wave, cj = hd * 64 + lane, fr = lane & 15, fq = lane >> 4;
    LAS unsigned char* LB = c.lds;
    LAS float* YY = (LAS float*)(LB + RW_YY); LAS float* WR = YY; LAS float* AR = (LAS float*)(LB + RW_AR); LAS float* GP = (LAS float*)(LB + RW_GP);
    LAS bf16_t* TWb = (LAS bf16_t*)(LB + RW_TW); LAS bf16_t* ADb = (LAS bf16_t*)(LB + RW_AD);
    const bf16_t* zrw = (const bf16_t*)(c.ws + OFF_ZRW); bf16_t* g3 = (bf16_t*)(c.ws + OFF_G3);
    LAS float* CT = (LAS float*)(LB + RW_CT);
    if (c.tid < 64) { const float* mu = P.in[4] + (size_t)l * 1664; const int j = hd * 64 + c.tid;
        CT[0 * 64 + c.tid] = mu[j]; CT[1 * 64 + c.tid] = mu[512 + j]; CT[2 * 64 + c.tid] = mu[1024 + j]; CT[3 * 64 + c.tid] = mu[1536 + c.tid]; CT[4 * 64 + c.tid] = mu[1600 + c.tid];
        CT[5 * 64 + c.tid] = P.in[5][l * BW + j]; CT[6 * 64 + c.tid] = P.in[7][l * BW + j]; CT[7 * 64 + c.tid] = P.in[9][l * BW + j]; CT[8 * 64 + c.tid] = P.in[10][l * BW + j];
        CT[9 * 64 + c.tid] = P.in[11][l * BW + j]; CT[10 * 64 + c.tid] = P.in[12][l * BW + j]; CT[11 * 64 + c.tid] = P.in[13][l * BW + j]; }
    const int mt_ = w >> 1, nh = w & 1;
    LAS bf16_t* W2I = (LAS bf16_t*)(LB + RW_W2); LAS bf16_t* A2I = (LAS bf16_t*)(LB + RW_A2);
    for (int i = c.tid; i < 4096; i += 512) { const int k = i >> 6, j = i & 63; W2I[j * TWS + k] = f2bf(P.in[6][((size_t)l * 64 + k) * BW + hd * 64 + j]); A2I[j * TWS + k] = f2bf(P.in[8][((size_t)l * 64 + k) * BW + hd * 64 + j]); }
    __syncthreads();
    f32x4 Macc[4];
#pragma unroll
    for (int i = 0; i < 4; ++i) Macc[i] = (f32x4){0.f, 0.f, 0.f, 0.f};
    const int cc = w >> 1, hc = w & 1;
    RwRows cur;
    rw_load_rows(cur, zrw, b, blk_lo, w, lane, cj);
    for (int blk = blk_lo; blk < blk_hi; ++blk) {
        const size_t t0 = (size_t)b * SEQ + blk * 64;
        float rs[8], ks_[8], vs[8];
        const float mu_r = CT[lane], mu_k = CT[64 + lane], mu_v = CT[128 + lane], mu_w = CT[192 + lane], mu_a = CT[256 + lane];
#pragma unroll
        for (int i = 0; i < 8; ++i) { const int tok = w * 8 + i;
            { const float r0 = rw_get(cur.zr, i), r1 = rw_get(cur.zr, i + 1), k0 = rw_get(cur.zk, i), k1 = rw_get(cur.zk, i + 1), v0 = rw_get(cur.zv, i), v1 = rw_get(cur.zv, i + 1);
              rs[i] = r1 + mu_r * (r0 - r1); ks_[i] = k1 + mu_k * (k0 - k1); vs[i] = v1 + mu_v * (v0 - v1); }
            const float w0_ = rw_get(cur.zw, i), w1_ = rw_get(cur.zw, i + 1), a0_ = rw_get(cur.za, i), a1_ = rw_get(cur.za, i + 1);
            const float wds = w1_ + mu_w * (w0_ - w1_), ads = a1_ + mu_a * (a0_ - a1_);
            const float e2 = __expf(2.0f * wds); const float th = 1.0f - 2.0f * __builtin_amdgcn_rcpf(e2 + 1.0f);
            TWb[tok * TWS + lane] = f2bf(th); ADb[tok * TWS + lane] = f2bf(ads); }
        if (blk + 1 < RW_NBLK) rw_load_rows(cur, zrw, b, blk + 1, w, lane, cj);
        unsigned gtp[4];
#pragma unroll
        for (int i = 0; i < 4; ++i) gtp[i] = (unsigned)g3[(t0 + w * 8 + 2 * i) * G3_LD + cj] | ((unsigned)g3[(t0 + w * 8 + 2 * i + 1) * G3_LD + cj] << 16);
        lds_barrier();
        { bf16x8 atw[2], aad[2];
#pragma unroll
          for (int ks = 0; ks < 2; ++ks) { atw[ks] = *(const LAS bf16x8*)(TWb + (16 * mt_ + fr) * TWS + 32 * ks + 8 * fq); aad[ks] = *(const LAS bf16x8*)(ADb + (16 * mt_ + fr) * TWS + 32 * ks + 8 * fq); }
          f32x4 cw[2], ca[2];
#pragma unroll
          for (int n2 = 0; n2 < 2; ++n2) { cw[n2] = (f32x4){0.f, 0.f, 0.f, 0.f}; ca[n2] = cw[n2];
#pragma unroll
              for (int ks = 0; ks < 2; ++ks) { const int bo = (32 * nh + 16 * n2 + fr) * TWS + 32 * ks + 8 * fq;
                  cw[n2] = __builtin_amdgcn_mfma_f32_16x16x32_bf16(atw[ks], *(const LAS bf16x8*)(W2I + bo), cw[n2], 0, 0, 0); ca[n2] = __builtin_amdgcn_mfma_f32_16x16x32_bf16(aad[ks], *(const LAS bf16x8*)(A2I + bo), ca[n2], 0, 0, 0); } }
          lds_barrier();
#pragma unroll
          for (int n2 = 0; n2 < 2; ++n2)
#pragma unroll
              for (int r = 0; r < 4; ++r) { const int o = (16 * mt_ + 4 * fq + r) * 64 + 32 * nh + 16 * n2 + fr; WR[o] = cw[n2][r]; AR[o] = ca[n2][r]; } }
        lds_barrier();
        float kkv[8], kpv[8], bbv[8], gl[8], cbv[8];
        { float g = 1.0f; const float w0j = CT[320 + lane], a0j = CT[384 + lane], kkj = CT[448 + lane], kaj = CT[512 + lane], rkj = CT[576 + lane];
#pragma unroll
          for (int i = 0; i < 8; ++i) { const int o = (w * 8 + i) * 64 + lane;
            const float wraw = w0j + WR[o], araw = a0j + AR[o];
            const float d = __expf(-0.6065306597126334f * sigmoidf_(wraw)), a = sigmoidf_(araw);
            float kk = ks_[i] * kkj; const float n2 = wave_sum2(kk * kk); kk = kk * __builtin_amdgcn_rsqf(fmaxf(n2, 1e-24f));
            const float kp = ks_[i] * (1.0f + (a - 1.0f) * kaj);
            cbv[i] = wave_sum2(rs[i] * kp * rkj);
            g *= d; gl[i] = g; kkv[i] = kk; kpv[i] = kp; bbv[i] = kk * a; }
          GP[w * 64 + lane] = g; }
        lds_barrier();
        { LAS unsigned char* CB_ = LB + cc * CH_BYTES;
          LAS bf16_t *AT = (LAS bf16_t*)(CB_ + CH_AT), *RT = (LAS bf16_t*)(CB_ + CH_RT), *KT = (LAS bf16_t*)(CB_ + CH_KT), *BT = (LAS bf16_t*)(CB_ + CH_BT),
                     *KH = (LAS bf16_t*)(CB_ + CH_KH), *NBH = (LAS bf16_t*)(CB_ + CH_NB), *VT = (LAS bf16_t*)(CB_ + CH_VT);
          const float g0 = GP[(2 * cc) * 64 + lane], g1 = GP[(2 * cc + 1) * 64 + lane], gC = g0 * g1, pre = hc ? g0 : 1.0f;
          if (hc == 0) ((LAS float*)(CB_ + CH_GC))[lane] = gC;
#pragma unroll
          for (int i = 0; i < 8; ++i) { const int tl = 8 * hc + i;
            const float gam = pre * gl[i], gprev = (i == 0) ? pre : pre * gl[i - 1], ig = __builtin_amdgcn_rcpf(gam), gr = gC * ig;
            AT[tl * TWS + lane] = f2bf(kkv[i] * gprev); RT[tl * TWS + lane] = f2bf(rs[i] * gam); KT[tl * TWS + lane] = f2bf(kpv[i] * ig); BT[tl * TWS + lane] = f2bf(bbv[i] * ig);
            KH[lane * 24 + tl] = f2bf(kpv[i] * gr); NBH[lane * 24 + tl] = f2bf(-bbv[i] * gr); VT[lane * 24 + tl] = f2bf(vs[i]); } }
        lds_barrier();
        if (w < 4 && !(RW_OFF & 4)) { LAS unsigned char* CB_ = LB + w * CH_BYTES;
          const LAS bf16_t *AT = (const LAS bf16_t*)(CB_ + CH_AT), *RT = (const LAS bf16_t*)(CB_ + CH_RT), *KT = (const LAS bf16_t*)(CB_ + CH_KT), *BT = (const LAS bf16_t*)(CB_ + CH_BT);
          f32x4 lab = (f32x4){0.f, 0.f, 0.f, 0.f}, lak = lab, lrk = lab, lrb = lab;
#pragma unroll
          for (int ks = 0; ks < 2; ++ks) { const int o = fr * TWS + 32 * ks + 8 * fq;
            const bf16x8 af = *(const LAS bf16x8*)(AT + o), rf = *(const LAS bf16x8*)(RT + o), kf = *(const LAS bf16x8*)(KT + o), bf = *(const LAS bf16x8*)(BT + o);
            lab = __builtin_amdgcn_mfma_f32_16x16x32_bf16(af, bf, lab, 0, 0, 0); lak = __builtin_amdgcn_mfma_f32_16x16x32_bf16(af, kf, lak, 0, 0, 0);
            lrk = __builtin_amdgcn_mfma_f32_16x16x32_bf16(rf, kf, lrk, 0, 0, 0); lrb = __builtin_amdgcn_mfma_f32_16x16x32_bf16(rf, bf, lrb, 0, 0, 0); }
          LAS float *LAB = (LAS float*)(CB_ + CH_LAB), *LAK = (LAS float*)(CB_ + CH_LAK); LAS bf16_t *LRK = (LAS bf16_t*)(CB_ + CH_LRK), *NLRB = (LAS bf16_t*)(CB_ + CH_NLRB);
#pragma unroll
          for (int r = 0; r < 4; ++r) { const int t = 4 * fq + r, s_ = fr; const bool lo_ = t > s_, le_ = t >= s_;
            LAB[t * 16 + s_] = lo_ ? lab[r] : 0.0f; LAK[t * 16 + s_] = lo_ ? lak[r] : 0.0f;
            LRK[t * 24 + s_] = f2bf(le_ ? lrk[r] : 0.0f); NLRB[t * 24 + s_] = f2bf(le_ ? -lrb[r] : 0.0f); } }
        lds_barrier();
        { const int ch6 = w & 3; LAS unsigned char* CB_ = LB + ch6 * CH_BYTES;
          const LAS bf16_t* AT = (const LAS bf16_t*)(CB_ + CH_AT); const LAS float *LAB = (const LAS float*)(CB_ + CH_LAB), *LAK = (const LAS float*)(CB_ + CH_LAK);
          LAS bf16_t *WI = (LAS bf16_t*)(CB_ + CH_KT), *GI = (LAS bf16_t*)(CB_ + CH_GI);
          float xv[16];
          if (w < 4) {
#pragma unroll
            for (int t = 0; t < 16; ++t) xv[t] = bf2f(AT[t * TWS + lane]);
          } else {
#pragma unroll
            for (int t = 0; t < 16; ++t) xv[t] = LAK[t * 16 + fr];
          }
#pragma unroll
          for (int t = 1; t < 16; ++t) { float xa = xv[t];
#pragma unroll
            for (int q = 0; q < 4; ++q) if (4 * q < t) { const f32x4 lr = *(const LAS f32x4*)(LAB + t * 16 + 4 * q);
#pragma unroll
              for (int e = 0; e < 4; ++e) if (4 * q + e < t) xa -= lr[e] * xv[4 * q + e]; }
            xv[t] = xa; asm volatile("" : "+v"(xv[t]) :: "memory"); }
          if (w < 4) {
#pragma unroll
            for (int t = 0; t < 16; ++t) WI[t * TWS + lane] = f2bf(xv[t]);
          } else if (lane < 16) {
#pragma unroll
            for (int t = 0; t < 16; ++t) GI[t * 24 + lane] = f2bf(xv[t]);
          } }
        lds_barrier();
        if (w < 4 && !(RW_OFF & 2)) {
#pragma unroll 1
          for (int ch = 0; ch < 4; ++ch) { LAS unsigned char* CB_ = LB + ch * CH_BYTES;
            const LAS bf16_t *RT = (const LAS bf16_t*)(CB_ + CH_RT), *WI = (const LAS bf16_t*)(CB_ + CH_KT), *KH = (const LAS bf16_t*)(CB_ + CH_KH), *NBH = (const LAS bf16_t*)(CB_ + CH_NB),
                             *VT = (const LAS bf16_t*)(CB_ + CH_VT), *LRK = (const LAS bf16_t*)(CB_ + CH_LRK), *NLRB = (const LAS bf16_t*)(CB_ + CH_NLRB), *GI = (const LAS bf16_t*)(CB_ + CH_GI);
            const LAS float* GC = (const LAS float*)(CB_ + CH_GC);
            bf16x8 Mb[2], Wp[2], Rp[2];
#pragma unroll
            for (int ks = 0; ks < 2; ++ks) { Mb[ks] = cat4(pk4(Macc[2 * ks]), pk4(Macc[2 * ks + 1]));
              Wp[ks] = cat4(*(const LAS bf16x4*)(WI + fr * TWS + 32 * ks + 4 * fq), *(const LAS bf16x4*)(WI + fr * TWS + 32 * ks + 16 + 4 * fq));
              Rp[ks] = cat4(*(const LAS bf16x4*)(RT + fr * TWS + 32 * ks + 4 * fq), *(const LAS bf16x4*)(RT + fr * TWS + 32 * ks + 16 + 4 * fq)); }
            const bf16x8 Vb = cat4z(*(const LAS bf16x4*)(VT + (16 * w + fr) * 24 + 4 * fq));
            const bf16x8 Gp = cat4z(*(const LAS bf16x4*)(GI + fr * 24 + 4 * fq)), Lrkp = cat4z(*(const LAS bf16x4*)(LRK + fr * 24 + 4 * fq)), Nlrbp = cat4z(*(const LAS bf16x4*)(NLRB + fr * 24 + 4 * fq));
            f32x4 U = (f32x4){0.f, 0.f, 0.f, 0.f};
            U = __builtin_amdgcn_mfma_f32_16x16x32_bf16(Wp[0], Mb[0], U, 0, 0, 0); U = __builtin_amdgcn_mfma_f32_16x16x32_bf16(Wp[1], Mb[1], U, 0, 0, 0); U = __builtin_amdgcn_mfma_f32_16x16x32_bf16(Gp, Vb, U, 0, 0, 0);
            const bf16x8 Ub = cat4z(pk4(U));
            f32x4 Y = (f32x4){0.f, 0.f, 0.f, 0.f};
            Y = __builtin_amdgcn_mfma_f32_16x16x32_bf16(Rp[0], Mb[0], Y, 0, 0, 0); Y = __builtin_amdgcn_mfma_f32_16x16x32_bf16(Rp[1], Mb[1], Y, 0, 0, 0);
            Y = __builtin_amdgcn_mfma_f32_16x16x32_bf16(Lrkp, Vb, Y, 0, 0, 0); Y = __builtin_amdgcn_mfma_f32_16x16x32_bf16(Nlrbp, Ub, Y, 0, 0, 0);
#pragma unroll
            for (int r = 0; r < 4; ++r) YY[(16 * ch + 4 * fq + r) * 64 + 16 * w + fr] = Y[r];
#pragma unroll
            for (int mt = 0; mt < 4; ++mt) { const f32x4 gc = *(const LAS f32x4*)(GC + 16 * mt + 4 * fq); f32x4 m = Macc[mt] * gc;
              const bf16x8 khp = cat4z(*(const LAS bf16x4*)(KH + (16 * mt + fr) * 24 + 4 * fq)), nbp = cat4z(*(const LAS bf16x4*)(NBH + (16 * mt + fr) * 24 + 4 * fq));
              m = __builtin_amdgcn_mfma_f32_16x16x32_bf16(khp, Vb, m, 0, 0, 0); m = __builtin_amdgcn_mfma_f32_16x16x32_bf16(nbp, Ub, m, 0, 0, 0); Macc[mt] = m; } } }
        lds_barrier();
        const float lnw = CT[640 + lane], lnb = CT[704 + lane];
#pragma unroll
        for (int i = 0; i < 8; ++i) {
            const int tok = w * 8 + i; const float y = YY[tok * 64 + lane];
            const float mean = wave_sum2(y) * (1.0f / 64.0f), dl = y - mean, var = wave_sum2(dl * dl) * (1.0f / 64.0f);
            const float yn = dl * rsqrtf(var + 64e-5f) * lnw + lnb + cbv[i] * vs[i];
            const float gti = (i & 1) ? hi16(gtp[i >> 1]) : lo16(gtp[i >> 1]);
            if (!dry) g3[(t0 + tok) * G3_LD + cj] = f2bf(yn * siluf_(gti));
        }
        lds_barrier();
    }
}

__device__ __forceinline__ void spin_until_ge(const unsigned* flag, unsigned want) {
    unsigned it = 0;
    while (__hip_atomic_load(flag, __ATOMIC_RELAXED, __HIP_MEMORY_SCOPE_AGENT) < want) { __builtin_amdgcn_s_sleep(2); if (++it > (1u << 17)) break; }
}
__device__ __forceinline__ unsigned pk2bf(float lo, float hi) { return cvt_pk_bf16(lo, hi); }

__device__ void rwkv_producer(const Ctx& c, int l, int bh, int par) {
    const Params& P = *c.P; const int b = bh >> 3, hd = bh & 7, lane = c.lane, w = c.wave, cj = hd * 64 + lane, fr = lane & 15, fq = lane >> 4;
    LAS unsigned char* LB = c.lds;
    LAS float* WR = (LAS float*)LB; LAS float* AR = (LAS float*)(LB + RW_AR);
    LAS bf16_t* TWb = (LAS bf16_t*)(LB + RW_TW); LAS bf16_t* ADb = (LAS bf16_t*)(LB + RW_AD);
    const bf16_t* zrw = (const bf16_t*)(c.ws + OFF_ZRW);
    unsigned* ready = (unsigned*)(c.ws + OFF_BAR + 256) + (bh * 2 + par) * 64; const unsigned* consumed = (const unsigned*)(c.ws + OFF_BAR + 256 + 64 * 256) + bh * 64;
    unsigned char* ring = c.ws + OFF_RING + (size_t)bh * RING_SLOTS * SLOT_BYTES;
    LAS float* CT = (LAS float*)(LB + RW_CT);
    if (c.tid < 64) { const float* mu = P.in[4] + (size_t)l * 1664; const int j = hd * 64 + c.tid;
        CT[0 * 64 + c.tid] = mu[j]; CT[1 * 64 + c.tid] = mu[512 + j]; CT[2 * 64 + c.tid] = mu[1024 + j]; CT[3 * 64 + c.tid] = mu[1536 + c.tid]; CT[4 * 64 + c.tid] = mu[1600 + c.tid];
        CT[5 * 64 + c.tid] = P.in[5][l * BW + j]; CT[6 * 64 + c.tid] = P.in[7][l * BW + j]; CT[7 * 64 + c.tid] = P.in[9][l * BW + j]; CT[8 * 64 + c.tid] = P.in[10][l * BW + j];
        CT[9 * 64 + c.tid] = P.in[11][l * BW + j]; }
    const int mt_ = w >> 1, nh = w & 1;
    LAS bf16_t* W2I = (LAS bf16_t*)(LB + RW_W2); LAS bf16_t* A2I = (LAS bf16_t*)(LB + RW_A2);
    for (int i = c.tid; i < 4096; i += 512) { const int k = i >> 6, j = i & 63; W2I[j * TWS + k] = f2bf(P.in[6][((size_t)l * 64 + k) * BW + hd * 64 + j]); A2I[j * TWS + k] = f2bf(P.in[8][((size_t)l * 64 + k) * BW + hd * 64 + j]); }
    __syncthreads();
    RwRows cur;
    rw_load_rows(cur, zrw, b, par, w, lane, cj);
    for (int blk = par; blk < RW_NBLK; blk += 2) {
        const unsigned gblk = (unsigned)(l * RW_NBLK + blk);
        float rs[8], ks_[8], vs[8];
        const float mu_r = CT[lane], mu_k = CT[64 + lane], mu_v = CT[128 + lane], mu_w = CT[192 + lane], mu_a = CT[256 + lane];
#pragma unroll
        for (int i = 0; i < 8; ++i) { const int tok = w * 8 + i;
            { const float r0 = rw_get(cur.zr, i), r1 = rw_get(cur.zr, i + 1), k0 = rw_get(cur.zk, i), k1 = rw_get(cur.zk, i + 1), v0 = rw_get(cur.zv, i), v1 = rw_get(cur.zv, i + 1);
              rs[i] = r1 + mu_r * (r0 - r1); ks_[i] = k1 + mu_k * (k0 - k1); vs[i] = v1 + mu_v * (v0 - v1); }
            const float w0_ = rw_get(cur.zw, i), w1_ = rw_get(cur.zw, i + 1), a0_ = rw_get(cur.za, i), a1_ = rw_get(cur.za, i + 1);
            const float wds = w1_ + mu_w * (w0_ - w1_), ads = a1_ + mu_a * (a0_ - a1_);
            const float e2 = __expf(2.0f * wds); const float th = 1.0f - 2.0f * __builtin_amdgcn_rcpf(e2 + 1.0f);
            TWb[tok * TWS + lane] = f2bf(th); ADb[tok * TWS + lane] = f2bf(ads); }
        if (blk + 2 < RW_NBLK) rw_load_rows(cur, zrw, b, blk + 2, w, lane, cj);
        lds_barrier();
        { bf16x8 atw[2], aad[2];
#pragma unroll
          for (int ks = 0; ks < 2; ++ks) { atw[ks] = *(const LAS bf16x8*)(TWb + (16 * mt_ + fr) * TWS + 32 * ks + 8 * fq); aad[ks] = *(const LAS bf16x8*)(ADb + (16 * mt_ + fr) * TWS + 32 * ks + 8 * fq); }
          f32x4 cw[2], ca[2];
#pragma unroll
          for (int n2 = 0; n2 < 2; ++n2) { cw[n2] = (f32x4){0.f, 0.f, 0.f, 0.f}; ca[n2] = cw[n2];
#pragma unroll
              for (int ks = 0; ks < 2; ++ks) { const int bo = (32 * nh + 16 * n2 + fr) * TWS + 32 * ks + 8 * fq;
                  cw[n2] = __builtin_amdgcn_mfma_f32_16x16x32_bf16(atw[ks], *(const LAS bf16x8*)(W2I + bo), cw[n2], 0, 0, 0); ca[n2] = __builtin_amdgcn_mfma_f32_16x16x32_bf16(aad[ks], *(const LAS bf16x8*)(A2I + bo), ca[n2], 0, 0, 0); } }
          lds_barrier();
#pragma unroll
          for (int n2 = 0; n2 < 2; ++n2)
#pragma unroll
              for (int r = 0; r < 4; ++r) { const int o = (16 * mt_ + 4 * fq + r) * 64 + 32 * nh + 16 * n2 + fr; WR[o] = cw[n2][r]; AR[o] = ca[n2][r]; } }
        if (c.tid == 0 && gblk >= RING_SLOTS) spin_until_ge(consumed, gblk - RING_SLOTS + 1);
        lds_barrier();
        unsigned char* slot = ring + (size_t)(gblk % RING_SLOTS) * SLOT_BYTES;
        LAS float* GP = (LAS float*)(LB + RW_GP); const int cc = w >> 1, hc = w & 1;
        float kkv[8], kpv[8], bbv[8], gl[8], cbv[8];
        { const float w0j = CT[320 + lane], a0j = CT[384 + lane], kkj = CT[448 + lane], kaj = CT[512 + lane], rkj = CT[576 + lane]; float g = 1.0f;
#pragma unroll
          for (int i = 0; i < 8; ++i) { const int o = (w * 8 + i) * 64 + lane;
            const float wraw = w0j + WR[o], araw = a0j + AR[o];
            const float d = __expf(-0.6065306597126334f * sigmoidf_(wraw)), a = sigmoidf_(araw);
            float kk = ks_[i] * kkj; const float n2 = wave_sum2(kk * kk); kk = kk * __builtin_amdgcn_rsqf(fmaxf(n2, 1e-24f));
            const float kp = ks_[i] * (1.0f + (a - 1.0f) * kaj);
            cbv[i] = wave_sum2(rs[i] * kp * rkj);
            g *= d; gl[i] = g; kkv[i] = kk; kpv[i] = kp; bbv[i] = kk * a; }
          GP[w * 64 + lane] = g; }
        lds_barrier();
        { LAS unsigned char* CB_ = LB + cc * CH_BYTES;
          LAS bf16_t *AT = (LAS bf16_t*)(CB_ + CH_AT), *RT = (LAS bf16_t*)(CB_ + CH_RT), *KT = (LAS bf16_t*)(CB_ + CH_KT), *BT = (LAS bf16_t*)(CB_ + CH_BT),
                     *KH = (LAS bf16_t*)(CB_ + CH_KH), *NBH = (LAS bf16_t*)(CB_ + CH_NB), *VT = (LAS bf16_t*)(CB_ + CH_VT);
          const float g0 = GP[(2 * cc) * 64 + lane], g1 = GP[(2 * cc + 1) * 64 + lane], gC = g0 * g1, pre = hc ? g0 : 1.0f;
          if (hc == 0) ((LAS float*)(CB_ + CH_GC))[lane] = gC;
#pragma unroll
          for (int i = 0; i < 8; ++i) { const int tl = 8 * hc + i;
            const float gam = pre * gl[i], gprev = (i == 0) ? pre : pre * gl[i - 1], ig = __builtin_amdgcn_rcpf(gam), gr = gC * ig;
            AT[tl * TWS + lane] = f2bf(kkv[i] * gprev); RT[tl * TWS + lane] = f2bf(rs[i] * gam); KT[tl * TWS + lane] = f2bf(kpv[i] * ig); BT[tl * TWS + lane] = f2bf(bbv[i] * ig);
            KH[lane * 20 + tl] = f2bf(kpv[i] * gr); NBH[lane * 20 + tl] = f2bf(-bbv[i] * gr); VT[lane * 20 + tl] = f2bf(vs[i]); } }
        lds_barrier();
        { const __amdgpu_buffer_rsrc_t rs_ = __builtin_amdgcn_make_buffer_rsrc((void*)slot, 0, (int)SLOT_BYTES, 0x00020000);
#pragma unroll
          for (int i = 0; i < 9; ++i) { const int L_ = c.tid * 16 + i * 8192, ch = L_ / 18432, off = L_ - ch * 18432;
              __builtin_amdgcn_raw_buffer_store_b128(*(const LAS u32x4*)(LB + ch * CH_BYTES + off), rs_, (unsigned)L_, 0, 16); }
          if (c.tid < 64) __builtin_amdgcn_raw_buffer_store_b128(*(const LAS u32x4*)(LB + (c.tid >> 4) * CH_BYTES + CH_GC + (c.tid & 15) * 16), rs_, (unsigned)(SLOT_IMG + c.tid * 16), 0, 16);
#pragma unroll
          for (int i = 0; i < 8; ++i) if (lane == i) __hip_atomic_store((unsigned*)(slot + SLOT_IMG + 1024) + w * 8 + i, __float_as_uint(cbv[i]), __ATOMIC_RELAXED, __HIP_MEMORY_SCOPE_AGENT); }
        __syncthreads();
        if (c.tid == 0) __hip_atomic_store(ready, (gblk >> 1) + 1, __ATOMIC_RELAXED, __HIP_MEMORY_SCOPE_AGENT);
    }
}

struct RwSlot { u32x4 img[9]; u32x4 gc; float cb; };
__device__ __forceinline__ void rw_load_slot(RwSlot& R, const unsigned char* slot, int tid, int w, int lane) {
#pragma unroll
    for (int i = 0; i < 9; ++i) R.img[i] = *(const u32x4*)(slot + tid * 16 + i * 8192);
    R.gc = *(const u32x4*)(slot + SLOT_IMG + (tid & 63) * 16);
    R.cb = ((const float*)(slot + SLOT_IMG + 1024))[w * 8 + (lane & 7)];
}

__device__ void rwkv_consumer(const Ctx& c, int l, int bh) {
    const Params& P = *c.P; const int b = bh >> 3, hd = bh & 7, lane = c.lane, w = c.wave, cj = hd * 64 + lane, fr = lane & 15, fq = lane >> 4;
    LAS unsigned char* LB = c.lds;
    LAS float* YY = (LAS float*)(LB + RW_YY);
    bf16_t* g3 = (bf16_t*)(c.ws + OFF_G3);
    const unsigned* ready = (const unsigned*)(c.ws + OFF_BAR + 256) + bh * 128; unsigned* consumed = (unsigned*)(c.ws + OFF_BAR + 256 + 64 * 256) + bh * 64;
    bf16_t* zrw = (bf16_t*)(c.ws + OFF_ZRW); float* cbg = (float*)(c.ws + OFF_CBG);
    const unsigned char* ring = c.ws + OFF_RING + (size_t)bh * RING_SLOTS * SLOT_BYTES;
    f32x4 Macc[4];
#pragma unroll
    for (int i = 0; i < 4; ++i) Macc[i] = (f32x4){0.f, 0.f, 0.f, 0.f};
    RwSlot cur;
    { const unsigned g0 = (unsigned)(l * RW_NBLK);
      if (c.tid == 0) { spin_until_ge(ready + 64 * (g0 & 1), (g0 >> 1) + 1); spin_until_ge(ready + 64 * ((g0 + 1) & 1), ((g0 + 1) >> 1) + 1); __builtin_amdgcn_fence(__ATOMIC_ACQUIRE, "agent"); }
      __syncthreads();
      rw_load_slot(cur, ring + (size_t)(g0 % RING_SLOTS) * SLOT_BYTES, c.tid, w, lane); }
    for (int blk = 0; blk < RW_NBLK; ++blk) {
        const unsigned gblk = (unsigned)(l * RW_NBLK + blk); const size_t t0 = (size_t)b * SEQ + blk * 64;
        float cbv[8];
#pragma unroll
        for (int i = 0; i < 9; ++i) { const int L_ = c.tid * 16 + i * 8192, ch = L_ / 18432, off = L_ - ch * 18432; *(LAS u32x4*)(LB + ch * CH_BYTES + off) = cur.img[i]; }
        if (c.tid < 64) *(LAS u32x4*)(LB + (c.tid >> 4) * CH_BYTES + CH_GC + (c.tid & 15) * 16) = cur.gc;
#pragma unroll
        for (int i = 0; i < 8; ++i) cbv[i] = __builtin_bit_cast(float, __builtin_amdgcn_readlane(__builtin_bit_cast(int, cur.cb), i));
        lds_barrier();
        if (c.tid == 0) __hip_atomic_store(consumed, gblk + 1, __ATOMIC_RELAXED, __HIP_MEMORY_SCOPE_AGENT);
        if (blk + 1 < RW_NBLK) rw_load_slot(cur, ring + (size_t)((gblk + 1) % RING_SLOTS) * SLOT_BYTES, c.tid, w, lane);
        if (w < 4 && true) { LAS unsigned char* CB_ = LB + w * CH_BYTES;
          const LAS bf16_t *AT = (const LAS bf16_t*)(CB_ + CH_AT), *RT = (const LAS bf16_t*)(CB_ + CH_RT), *KT = (const LAS bf16_t*)(CB_ + CH_KT), *BT = (const LAS bf16_t*)(CB_ + CH_BT);
          f32x4 lab = (f32x4){0.f, 0.f, 0.f, 0.f}, lak = lab, lrk = lab, lrb = lab;
#pragma unroll
          for (int ks = 0; ks < 2; ++ks) { const int o = fr * TWS + 32 * ks + 8 * fq;
            const bf16x8 af = *(const LAS bf16x8*)(AT + o), rf = *(const LAS bf16x8*)(RT + o), kf = *(const LAS bf16x8*)(KT + o), bf = *(const LAS bf16x8*)(BT + o);
            lab = __builtin_amdgcn_mfma_f32_16x16x32_bf16(af, bf, lab, 0, 0, 0); lak = __builtin_amdgcn_mfma_f32_16x16x32_bf16(af, kf, lak, 0, 0, 0);
            lrk = __builtin_amdgcn_mfma_f32_16x16x32_bf16(rf, kf, lrk, 0, 0, 0); lrb = __builtin_amdgcn_mfma_f32_16x16x32_bf16(rf, bf, lrb, 0, 0, 0); }
          LAS float *LAB = (LAS float*)(CB_ + CH_LAB), *LAK = (LAS float*)(CB_ + CH_LAK); LAS bf16_t *LRK = (LAS bf16_t*)(CB_ + CH_LRK), *NLRB = (LAS bf16_t*)(CB_ + CH_NLRB);
#pragma unroll
          for (int r = 0; r < 4; ++r) { const int t = 4 * fq + r, s_ = fr; const bool lo_ = t > s_, le_ = t >= s_;
            LAB[t * 16 + s_] = lo_ ? lab[r] : 0.0f; LAK[t * 16 + s_] = lo_ ? lak[r] : 0.0f;
            LRK[t * 24 + s_] = f2bf(le_ ? lrk[r] : 0.0f); NLRB[t * 24 + s_] = f2bf(le_ ? -lrb[r] : 0.0f); } }
        lds_barrier();
        { const int ch6 = w & 3; LAS unsigned char* CB_ = LB + ch6 * CH_BYTES;
          const LAS bf16_t* AT = (const LAS bf16_t*)(CB_ + CH_AT); const LAS float *LAB = (const LAS float*)(CB_ + CH_LAB), *LAK = (const LAS float*)(CB_ + CH_LAK);
          LAS bf16_t *WI = (LAS bf16_t*)(CB_ + CH_KT), *GI = (LAS bf16_t*)(CB_ + CH_GI);
          float xv[16];
          if (w < 4) {
#pragma unroll
            for (int t = 0; t < 16; ++t) xv[t] = bf2f(AT[t * TWS + lane]);
          } else {
#pragma unroll
            for (int t = 0; t < 16; ++t) xv[t] = LAK[t * 16 + fr];
          }
          f32x4 nx[4];
#pragma unroll
          for (int q = 0; q < 4; ++q) nx[q] = *(const LAS f32x4*)(LAB + 16 + 4 * q);
#pragma unroll
          for (int t = 1; t < 16; ++t) { float xa = xv[t]; f32x4 lr[4];
#pragma unroll
            for (int q = 0; q < 4; ++q) lr[q] = nx[q];
            if (t < 15) {
#pragma unroll
              for (int q = 0; q < 4; ++q) if (4 * q < t + 1) nx[q] = *(const LAS f32x4*)(LAB + (t + 1) * 16 + 4 * q); }
            float xb = 0.0f;
#pragma unroll
            for (int q = 0; q < 4; ++q) if (4 * q < t) {
#pragma unroll
              for (int e = 0; e < 4; ++e) if (4 * q + e < t) { if (e & 1) xb -= lr[q][e] * xv[4 * q + e]; else xa -= lr[q][e] * xv[4 * q + e]; } }
            xa += xb;
            xv[t] = xa; asm volatile("" : "+v"(xv[t]), "+v"(nx[0]), "+v"(nx[1]), "+v"(nx[2]), "+v"(nx[3]) :: "memory"); }
          if (w < 4) {
#pragma unroll
            for (int t = 0; t < 16; ++t) WI[t * TWS + lane] = f2bf(xv[t]);
          } else if (lane < 16) {
#pragma unroll
            for (int t = 0; t < 16; ++t) GI[t * 24 + lane] = f2bf(xv[t]);
          } }
        lds_barrier();
        if (w == 4 && lane == 0 && blk + 2 < RW_NBLK) { const unsigned gn = gblk + 2; spin_until_ge(ready + 64 * (gn & 1), (gn >> 1) + 1); __builtin_amdgcn_fence(__ATOMIC_ACQUIRE, "agent"); }
        if (w < 4 && true) {
#pragma unroll
          for (int ch = 0; ch < 4; ++ch) { LAS unsigned char* CB_ = LB + ch * CH_BYTES;
            const LAS bf16_t *RT = (const LAS bf16_t*)(CB_ + CH_RT), *WI = (const LAS bf16_t*)(CB_ + CH_KT), *KH = (const LAS bf16_t*)(CB_ + CH_KH), *NBH = (const LAS bf16_t*)(CB_ + CH_NB),
                             *VT = (const LAS bf16_t*)(CB_ + CH_VT), *LRK = (const LAS bf16_t*)(CB_ + CH_LRK), *NLRB = (const LAS bf16_t*)(CB_ + CH_NLRB), *GI = (const LAS bf16_t*)(CB_ + CH_GI);
            const LAS float* GC = (const LAS float*)(CB_ + CH_GC);
            bf16x8 Mb[2], Wp[2], Rp[2];
#pragma unroll
            for (int ks = 0; ks < 2; ++ks) { Mb[ks] = cat4(pk4(Macc[2 * ks]), pk4(Macc[2 * ks + 1]));
              Wp[ks] = cat4(*(const LAS bf16x4*)(WI + fr * TWS + 32 * ks + 4 * fq), *(const LAS bf16x4*)(WI + fr * TWS + 32 * ks + 16 + 4 * fq));
              Rp[ks] = cat4(*(const LAS bf16x4*)(RT + fr * TWS + 32 * ks + 4 * fq), *(const LAS bf16x4*)(RT + fr * TWS + 32 * ks + 16 + 4 * fq)); }
            const bf16x8 Vb = cat4z(*(const LAS bf16x4*)(VT + (16 * w + fr) * 20 + 4 * fq));
            const bf16x8 Gp = cat4z(*(const LAS bf16x4*)(GI + fr * 24 + 4 * fq)), Lrkp = cat4z(*(const LAS bf16x4*)(LRK + fr * 24 + 4 * fq)), Nlrbp = cat4z(*(const LAS bf16x4*)(NLRB + fr * 24 + 4 * fq));
            f32x4 U = (f32x4){0.f, 0.f, 0.f, 0.f};
            U = __builtin_amdgcn_mfma_f32_16x16x32_bf16(Wp[0], Mb[0], U, 0, 0, 0); U = __builtin_amdgcn_mfma_f32_16x16x32_bf16(Wp[1], Mb[1], U, 0, 0, 0); U = __builtin_amdgcn_mfma_f32_16x16x32_bf16(Gp, Vb, U, 0, 0, 0);
            const bf16x8 Ub = cat4z(pk4(U));
            f32x4 Y = (f32x4){0.f, 0.f, 0.f, 0.f};
            Y = __builtin_amdgcn_mfma_f32_16x16x32_bf16(Rp[0], Mb[0], Y, 0, 0, 0); Y = __builtin_amdgcn_mfma_f32_16x16x32_bf16(Rp[1], Mb[1], Y, 0, 0, 0);
            Y = __builtin_amdgcn_mfma_f32_16x16x32_bf16(Lrkp, Vb, Y, 0, 0, 0); Y = __builtin_amdgcn_mfma_f32_16x16x32_bf16(Nlrbp, Ub, Y, 0, 0, 0);
#pragma unroll
            for (int r = 0; r < 4; ++r) YY[(16 * ch + 4 * fq + r) * 64 + 16 * w + fr] = Y[r];
#pragma unroll
            for (int mt = 0; mt < 4; ++mt) { const f32x4 gc = *(const LAS f32x4*)(GC + 16 * mt + 4 * fq); f32x4 m = Macc[mt] * gc;
              const bf16x8 khp = cat4z(*(const LAS bf16x4*)(KH + (16 * mt + fr) * 20 + 4 * fq)), nbp = cat4z(*(const LAS bf16x4*)(NBH + (16 * mt + fr) * 20 + 4 * fq));
              m = __builtin_amdgcn_mfma_f32_16x16x32_bf16(khp, Vb, m, 0, 0, 0); m = __builtin_amdgcn_mfma_f32_16x16x32_bf16(nbp, Ub, m, 0, 0, 0); Macc[mt] = m; } } }
        lds_barrier();
#pragma unroll
        for (int i = 0; i < 8; ++i) { const int tok = w * 8 + i;
            zrw[(t0 + tok) * ZRW_LD + cj] = f2bf(YY[tok * 64 + lane]);
            if (lane == i) cbg[(t0 + tok) * 8 + hd] = cbv[i]; }
    }
}

__device__ void phase_rwkv_fin(const Ctx& c, int l) {
    const Params& P = *c.P; const bf16_t* zrw = (const bf16_t*)(c.ws + OFF_ZRW); bf16_t* g3 = (bf16_t*)(c.ws + OFF_G3); const float* cbg = (const float*)(c.ws + OFF_CBG);
    const int gw = blockIdx.x * 8 + c.wave, nw = gridDim.x * 8, lane = c.lane;
    for (int item = gw; item < (T / 128) * 8; item += nw) {
        const int hd = item & 7, tg = item >> 3, cj = hd * 64 + lane; const size_t tb = (size_t)tg * 128;
        const float mu_v = P.in[4][(size_t)l * 1664 + 1024 + cj], lnw = P.in[12][l * BW + cj], lnb = P.in[13][l * BW + cj];
        float vprev = ((tb & (SEQ - 1)) == 0) ? 0.0f : bf2f(zrw[(tb - 1) * ZRW_LD + 1024 + cj]);
        for (int t4 = 0; t4 < 128; t4 += 8) {
            float y[8], vv[8], gt[8], cb[8];
#pragma unroll
            for (int i = 0; i < 8; ++i) { const size_t t = tb + t4 + i; y[i] = bf2f(zrw[t * ZRW_LD + cj]); vv[i] = bf2f(zrw[t * ZRW_LD + 1024 + cj]); gt[i] = bf2f(g3[t * G3_LD + cj]); cb[i] = cbg[t * 8 + hd]; }
#pragma unroll
            for (int i = 0; i < 8; ++i) { const size_t t = tb + t4 + i;
                const float vs = vv[i] + mu_v * (vprev - vv[i]); vprev = vv[i];
                const float mean = wave_sum2(y[i]) * (1.0f / 64.0f), ey2 = wave_sum2(y[i] * y[i]) * (1.0f / 64.0f), var = fmaxf(ey2 - mean * mean, 0.0f);
                const float yn = (y[i] - mean) * rsqrtf(var + 64e-5f) * lnw + lnb + cb[i] * vs;
                g3[t * G3_LD + cj] = f2bf(yn * siluf_(gt[i])); }
        }
    }
}

constexpr int RW_WGS = 96;
template <int l, int sp>
__device__ __forceinline__ void run_sub(const Ctx& c, const Params& P, float* ssbase, int G, int cb, unsigned* bar2, unsigned& bar2_target) {
    unsigned char* ws = c.ws;
    if constexpr (sp == 0) {
        if (l == 0) phase_s5_consts(c);
        pg8::Gemm g{(const bf16_t*)(ws + OFF_XN), (const bf16_t*)(ws + OFF_WIN) + (size_t)l * DINP * D, D, D, D}; pg8::Sched S; S.init(T, DINP, G, cb);
        EpiZ E{(bf16_t*)(ws + OFF_ZRW), (bf16_t*)(ws + OFF_G3), (bf16_t*)(ws + OFF_XL), (bf16_t*)(ws + OFF_AS)};
        pg8::gemm_phase(c.lds, g, S, E);
    } else if constexpr (sp == 1) {
        if (cb < 32) rwkv_consumer(c, l, cb); else if (cb < RW_WGS) rwkv_producer(c, l, (cb - 32) & 31, (cb - 32) >> 5);
        else {
            Ctx c2 = c; c2.vb = cb - RW_WGS; c2.vG = G - RW_WGS; const int G2 = G - RW_WGS, cb2 = cb - RW_WGS;
            phase_lru_conv(c2, l);
            { pg8::Gemm g{(const bf16_t*)(ws + OFF_AS), (const bf16_t*)(ws + OFF_S5E) + (size_t)l * 32 * 256 * 256, AS_LD, 256, 256}; pg8::Sched S; S.init(AS_ROWS, 256, G2, cb2, 8);
              EpiE E{(float*)(ws + OFF_E)};
              pg8::gemm_phase(c.lds, g, S, E); }
            grid_bar(bar2, bar2_target, (unsigned)G2);
            phase_s5_carry(c2, l);
            { pg8::Gemm g{(const bf16_t*)(ws + OFF_XC), (const bf16_t*)(ws + OFF_WLRU) + (size_t)l * 1024 * BW, BW, BW, BW}; pg8::Sched S; S.init(T, 1024, G2, cb2);
              EpiLru E{(const bf16_t*)(ws + OFF_XC), P.in[27] + l * BW, P.in[29] + l * BW, P.in[30] + l * BW, (bf16_t*)(ws + OFF_LRUAB)};
              pg8::gemm_phase(c.lds, g, S, E); }
            grid_bar(bar2, bar2_target, (unsigned)G2);
            { pg8::Gemm g{(const bf16_t*)(ws + OFF_AS), (const bf16_t*)(ws + OFF_S5Y) + (size_t)l * 32 * 256 * AS_LD, AS_LD, AS_LD, AS_LD}; pg8::Sched S; S.init(AS_ROWS, 256, G2, cb2, 8);
              EpiY E{(const bf16_t*)(ws + OFF_AS), P.in[21] + l * BW, (bf16_t*)(ws + OFF_ZGS)};
              pg8::gemm_phase(c.lds, g, S, E); }
            phase_lru_scan(c2, 0);
            grid_bar(bar2, bar2_target, (unsigned)G2);
            { pg8::Gemm g{(const bf16_t*)(ws + OFF_ZGS), (const bf16_t*)(ws + OFF_WGLU) + (size_t)l * BW * BW, BW, BW, BW}; pg8::Sched S; S.init(T, BW, G2, cb2);
              EpiGlu E{(const bf16_t*)(ws + OFF_ZGS), P.in[23] + l * BW, (bf16_t*)(ws + OFF_G3)};
              pg8::gemm_phase(c.lds, g, S, E); }
            phase_lru_scan(c2, 1);
            { pg8::Gemm g{(const bf16_t*)(ws + OFF_PB) + (size_t)l * T * DPLE, (const bf16_t*)(ws + OFF_WPLE) + (size_t)l * D * DPLE, DPLE, DPLE, DPLE}; pg8::Sched S; S.init(T, D, G2, cb2);
              EpiPle E{(bf16_t*)(ws + OFF_PW), ssbase + (size_t)l * T};
              pg8::gemm_phase(c.lds, g, S, E); }
        }
    } else if constexpr (sp == 2) {
        phase_rwkv_fin(c, l);
    } else if constexpr (sp == 5) {
        { pg8::Gemm g{(const bf16_t*)(ws + OFF_G3), (const bf16_t*)(ws + OFF_WOUT) + (size_t)l * D * DMIX, DMIX, DMIX, DMIX}; pg8::Sched S; S.init(T, D, G, cb);
          EpiOut E{l == 0 ? P.in[0] : (const float*)P.out, P.out, (bf16_t*)(ws + OFF_H1B)};
          pg8::gemm_phase(c.lds, g, S, E); }
    } else if constexpr (sp == 6) {
        pg8::Gemm g{(const bf16_t*)(ws + OFF_H1B), (const bf16_t*)(ws + OFF_WG) + (size_t)l * D * D, D, D, D}; pg8::Sched S; S.init(T, D, G, cb);
        EpiGate E{P.out, (const bf16_t*)(ws + OFF_PW), ssbase + (size_t)l * T, P.in[33] + l * D, ssbase + (size_t)(2 + l) * T};
        pg8::gemm_phase(c.lds, g, S, E);
    } else {
        phase_norm(c, ssbase + (size_t)(2 + l) * T, l == 0 ? P.in[2] + D : P.in[35], l == 1);
    }
}

constexpr int NPHASE = 1 + 6 * 2;
__global__ void __launch_bounds__(512) hymba_fwd(Params P) {
    extern __shared__ __attribute__((aligned(16))) unsigned char lds_raw[];
    Ctx c; c.P = &P; c.ws = P.ws; c.lds = (LAS unsigned char*)lds_raw; c.ldsg = lds_raw; c.tid = threadIdx.x; c.lane = c.tid & 63; c.wave = __builtin_amdgcn_readfirstlane(c.tid >> 6);
    c.gtid = (size_t)blockIdx.x * 512 + c.tid; c.gsz = (size_t)gridDim.x * 512; c.vb = blockIdx.x; c.vG = gridDim.x;
    unsigned char* ws = P.ws; const int G = gridDim.x, cb = blockIdx.x;
    float* ssbase = (float*)(ws + OFF_SS);
    const int lo = P.ph_lo, hi = P.ph_hi;
    unsigned* barw = (unsigned*)(ws + OFF_BAR); unsigned bar_target = 0; unsigned* bar2 = barw + 32; unsigned bar2_target = 0;
#define PHASE(k, ...) if (((MK_PH_MASK >> (k)) & 1) && lo <= (k) && (k) < hi) { __VA_ARGS__; if ((k) + 1 < hi) { if ((k) == 0) { __threadfence(); cg::this_grid().sync(); } else grid_bar(barw, bar_target, (unsigned)G); } }
    PHASE(0, phase_prep(c))
#define RS(L_, SP_) run_sub<L_, SP_>(c, P, ssbase, G, cb, bar2, bar2_target)
    PHASE(1, RS(0, 0)) PHASE(2, RS(0, 1)) PHASE(3, RS(0, 2)) PHASE(4, RS(0, 5)) PHASE(5, RS(0, 6)) PHASE(6, RS(0, 7))
    PHASE(7, RS(1, 0)) PHASE(8, RS(1, 1)) PHASE(9, RS(1, 2)) PHASE(10, RS(1, 5)) PHASE(11, RS(1, 6)) PHASE(12, RS(1, 7))
#undef RS
#undef PHASE
}

extern "C" void kernel_launch(void* const* d_in, const int* in_sizes, int n_in, void* d_out, int out_size, void* d_ws, size_t ws_size, hipStream_t stream) {
    static int grid = 0;
    if (grid == 0) {
        if (n_in != 36 || out_size != T * D || ws_size < WS_END2) { fprintf(stderr, "kernel_launch: unexpected shapes (n_in %d out %d ws %zu need %zu)\n", n_in, out_size, ws_size, (size_t)WS_END); grid = -1; return; }
        int dev = 0, cus = 0, per_cu = 0;
        hipGetDevice(&dev); hipDeviceGetAttribute(&cus, hipDeviceAttributeMultiprocessorCount, dev);
        hipFuncSetAttribute((const void*)hymba_fwd, hipFuncAttributeMaxDynamicSharedMemorySize, LDS_BYTES);
        hipOccupancyMaxActiveBlocksPerMultiprocessor(&per_cu, (const void*)hymba_fwd, 512, LDS_BYTES);
        if (per_cu < 1) per_cu = 1;
        grid = cus * per_cu; if (grid > 256) grid = 256;
        (void)hipGetLastError();
    }
    if (grid < 0) return;
    (void)hipMemsetAsync((char*)d_ws + OFF_BAR, 0, CTL_BYTES, stream);
    Params p{};
    for (int i = 0; i < 36; ++i) p.in[i] = (const float*)d_in[i];
    p.out = (float*)d_out; p.ws = (unsigned char*)d_ws;
#if MK_PER_PHASE
    for (int ph = 0; ph < NPHASE; ++ph) { p.ph_lo = ph; p.ph_hi = ph + 1; hipLaunchKernelGGL(hymba_fwd, dim3(grid), dim3(512), LDS_BYTES, stream, p); }
#else
    p.ph_lo = 0; p.ph_hi = NPHASE;
    void* args[] = {&p};
    hipError_t e = hipLaunchCooperativeKernel((const void*)hymba_fwd, dim3(grid), dim3(512), args, LDS_BYTES, stream);
    if (e != hipSuccess) fprintf(stderr, "cooperative launch failed: %s (grid %d)\n", hipGetErrorString(e), grid);
#endif
}
```

```cpp
#include <hip/hip_runtime.h>
#include <hip/hip_cooperative_groups.h>
#include <cstdio>
namespace cg = cooperative_groups;

#ifndef MK_PER_PHASE
#define MK_PER_PHASE 0
#endif

#ifndef MK_PH_MASK
#define MK_PH_MASK 0x1fff
#endif
#ifndef MK_DUP
#define MK_DUP 0
#endif
#ifndef RW_OFF
#define RW_OFF 0
#endif
#ifndef MK_OFF
#define MK_OFF 0
#endif
#define LAS __attribute__((address_space(3)))
typedef unsigned short bf16_t;
typedef short bf16x8 __attribute__((ext_vector_type(8)));
typedef float f32x4 __attribute__((ext_vector_type(4)));
typedef unsigned u32x4 __attribute__((ext_vector_type(4)));
typedef unsigned u32x2 __attribute__((ext_vector_type(2)));

constexpr int T = 32768, D = 1024, SEQ = 8192, NB = 4, BW = 512;
constexpr int DIN = 4224, DINP = 4352, DMIX = 1536, DPLE = 256;
constexpr int ZRW_LD = 1792, G3_LD = 1536, AS_LD = 384, AS_ROWS = 65536;
constexpr int LDS_BYTES = 155648;

constexpr size_t al256(size_t x) { return (x + 255) & ~(size_t)255; }
constexpr size_t SZ_WIN = (size_t)2 * DINP * D * 2, SZ_WOUT = (size_t)2 * D * DMIX * 2, SZ_WG = (size_t)2 * D * D * 2, SZ_WPLE = (size_t)2 * D * DPLE * 2,
                 SZ_WGLU = (size_t)2 * BW * BW * 2, SZ_WLRU = (size_t)2 * 1024 * BW * 2, SZ_S5Y = (size_t)2 * 32 * 256 * AS_LD * 2, SZ_S5E = (size_t)2 * 32 * 256 * 256 * 2,
                 SZ_TBL = (size_t)2 * 32 * 64 * 18 * 8, SZ_PB = (size_t)2 * T * DPLE * 2, SZ_XN = (size_t)T * D * 2, SZ_ZRW = (size_t)T * ZRW_LD * 2, SZ_G3 = (size_t)T * G3_LD * 2,
                 SZ_XL = (size_t)T * BW * 2, SZ_AS = (size_t)AS_ROWS * AS_LD * 2, SZ_LRUAB = (size_t)T * 1024 * 2, SZ_AGG = (size_t)NB * 128 * 1024 * 4, SZ_SS = (size_t)4 * T * 4;
constexpr size_t OFF_WIN = 0, OFF_WOUT = OFF_WIN + SZ_WIN, OFF_WG = OFF_WOUT + SZ_WOUT, OFF_WPLE = OFF_WG + SZ_WG, OFF_WGLU = OFF_WPLE + SZ_WPLE, OFF_WLRU = OFF_WGLU + SZ_WGLU,
                 OFF_S5Y = OFF_WLRU + SZ_WLRU, OFF_S5E = OFF_S5Y + SZ_S5Y, OFF_TBL = OFF_S5E + SZ_S5E, OFF_PB = al256(OFF_TBL + SZ_TBL), OFF_XN = OFF_PB + SZ_PB,
                 OFF_ZRW = OFF_XN + SZ_XN, OFF_G3 = OFF_ZRW + SZ_ZRW, OFF_XL = OFF_G3 + SZ_G3, OFF_AS = OFF_XL + SZ_XL, OFF_LRUAB = OFF_AS + SZ_AS, OFF_AGG = OFF_LRUAB + SZ_LRUAB,
                 OFF_SS = OFF_AGG + SZ_AGG, WS_END = OFF_SS + SZ_SS;
constexpr size_t OFF_BAR = WS_END, CTL_BYTES = 256 + 96 * 256;
constexpr size_t RING_SLOTS = 3, SLOT_IMG = 4 * 18432, SLOT_BYTES = SLOT_IMG + 4 * 256 + 256;
constexpr size_t OFF_RING = OFF_BAR + CTL_BYTES, OFF_CBG = OFF_RING + 32 * RING_SLOTS * SLOT_BYTES, WS_END2 = OFF_CBG + (size_t)T * 8 * 4;
constexpr size_t OFF_E = OFF_XN, OFF_XC = OFF_XN + (size_t)AS_ROWS * 128 * 4, OFF_H1B = OFF_ZRW, OFF_PW = OFF_XN, OFF_ZGS = OFF_XL;
static_assert(OFF_XC + (size_t)T * BW * 2 <= OFF_ZRW, "alias overflow");

struct Params {
    const float* in[36];
    float* out;
    unsigned char* ws;
    int ph_lo, ph_hi;
};

__device__ __forceinline__ float bf2f(bf16_t v) { return __uint_as_float(((unsigned)v) << 16); }
__device__ __forceinline__ bf16_t f2bf_sw(float f) { unsigned u = __float_as_uint(f); u += 0x7FFFu + ((u >> 16) & 1u); return (bf16_t)(u >> 16); }
typedef float f32x2_ __attribute__((ext_vector_type(2)));
typedef __bf16 b16x2_ __attribute__((ext_vector_type(2)));
__device__ __forceinline__ unsigned cvt_pk_bf16(float lo, float hi) { const f32x2_ v = {lo, hi}; return __builtin_bit_cast(unsigned, __builtin_convertvector(v, b16x2_)); }
__device__ __forceinline__ bf16_t f2bf(float f) { return (bf16_t)cvt_pk_bf16(f, f); }
__device__ __forceinline__ float lo16(unsigned u) { return __uint_as_float(u << 16); }
__device__ __forceinline__ float hi16(unsigned u) { return __uint_as_float(u & 0xffff0000u); }
__device__ __forceinline__ float sigmoidf_(float x) { return __builtin_amdgcn_rcpf(1.0f + __expf(-x)); }
__device__ __forceinline__ float siluf_(float x) { return x * sigmoidf_(x); }
__device__ __forceinline__ float softplusf_(float x) { return fmaxf(x, 0.0f) + log1pf(__expf(-fabsf(x))); }
__device__ __forceinline__ float gelu_tanh(float x) { const float u2 = 1.5957691216057308f * (x + 0.044715f * x * x * x); return x * sigmoidf_(u2); }
__device__ __forceinline__ float wave_sum(float v) {
#pragma unroll
    for (int o = 32; o > 0; o >>= 1) v += __shfl_xor(v, o);
    return v;
}
__device__ __forceinline__ void unpack8(const u32x4 w, float (&f)[8]) {
    f[0] = lo16(w.x); f[1] = hi16(w.x); f[2] = lo16(w.y); f[3] = hi16(w.y); f[4] = lo16(w.z); f[5] = hi16(w.z); f[6] = lo16(w.w); f[7] = hi16(w.w);
}
__device__ __forceinline__ u32x4 pack8(const float (&f)[8]) {
    u32x4 w; w.x = cvt_pk_bf16(f[0], f[1]); w.y = cvt_pk_bf16(f[2], f[3]); w.z = cvt_pk_bf16(f[4], f[5]); w.w = cvt_pk_bf16(f[6], f[7]); return w;
}


__device__ __forceinline__ void grid_bar(unsigned* ctr, unsigned& target, unsigned nblk) {
    __syncthreads();
    if (threadIdx.x == 0) {
        target += nblk;
        __builtin_amdgcn_fence(__ATOMIC_RELEASE, "agent");
        __hip_atomic_fetch_add(ctr, 1u, __ATOMIC_RELAXED, __HIP_MEMORY_SCOPE_AGENT);
        while (__hip_atomic_load(ctr, __ATOMIC_RELAXED, __HIP_MEMORY_SCOPE_AGENT) < target) __builtin_amdgcn_s_sleep(1);
        __builtin_amdgcn_fence(__ATOMIC_ACQUIRE, "agent");
    }
    __syncthreads();
}

namespace pg8 {
constexpr int BM = 256, BK = 64, HALF = 128, HTB = HALF * BK * 2, STAGE_BYTES = 8 * HTB, NXCD = 8, WGM = 8;
__host__ __device__ __forceinline__ int lds_byte(int r, int c) { const int st = (r >> 4) * 2 + (c >> 5), rr = r & 15, cc = c & 31, ob = rr * 64 + cc * 2; return st * 1024 + (ob ^ (((ob >> 9) & 1) << 5)); }
__host__ __device__ __forceinline__ void stage_rc(int b, int& R, int& C) { const int st = b / 1024, sb = b % 1024, swz = sb ^ (((sb >> 9) & 1) << 5); R = (st >> 1) * 16 + swz / 64; C = (st & 1) * 32 + (swz % 64) / 2; }
__host__ __device__ __forceinline__ int perm32(int rho) { const int n = rho >> 4, i = rho & 15; return 8 * (i >> 2) + 4 * n + (i & 3); }

struct Unit { int pm, pn, pb; };
struct Gemm { const bf16_t* A; const bf16_t* Bt; int lda, ldb, K; };

struct Sched {
    int nM, nN, nwg, G, c, grp;
    __device__ void init(int M, int N, int G_, int c_, int grp_ = 0) { nM = M / BM; nN = N / BM; nwg = nM * nN; G = G_; c = c_; grp = grp_; }
    __device__ bool next(int i, Unit& u) const {
        const long L = (long)i * G + c; if (L >= nwg) return false;
        int wgid = (int)L; { const int q = nwg / NXCD, r = nwg % NXCD, xcd = wgid % NXCD, off = wgid / NXCD; wgid = (xcd < r ? xcd * (q + 1) : r * (q + 1) + (xcd - r) * q) + off; }
        const int nig = WGM * nN, gid = wgid / nig, fm = gid * WGM, gsz = (nM - fm) < WGM ? (nM - fm) : WGM;
        u.pm = fm + ((wgid % nig) % gsz); u.pn = (wgid % nig) / gsz; u.pb = grp ? (u.pm / grp) * nN + u.pn : u.pn; return true;
    }
};

template <class Epi>
__device__ __forceinline__ void gemm_phase(LAS unsigned char* lds, const Gemm g, const Sched& S, const Epi& E) {
    const int tid = threadIdx.x, wid = __builtin_amdgcn_readfirstlane(tid >> 6), lane = tid & 63, wr = wid >> 2, wc = wid & 3, fr = lane & 15, fq = lane >> 4;
    const int K = g.K, nt = K / BK;
    unsigned voffA[2], voffB[2];
#pragma unroll
    for (int i = 0; i < 2; ++i) { int R, C; stage_rc(tid * 16 + i * 8192, R, C); const int Rb = Epi::PERM ? ((R & ~31) + perm32(R & 31)) : R;
        voffA[i] = (unsigned)(R * g.lda + C) * 2u; voffB[i] = (unsigned)(Rb * g.ldb + C) * 2u; }
    const size_t kstep = (size_t)(BK * 2);
    const size_t hstepA = (size_t)HALF * g.lda * 2, hstepB = (size_t)HALF * g.ldb * 2;
    const size_t tstepA = 2 * hstepA, tstepB = 2 * hstepB;
    const unsigned ldsw = (unsigned)wid * 1024u;
    const int aoff = lds_byte(wr * 64 + fr, fq * 8), boff = lds_byte(wc * 32 + fr, fq * 8);
#define PG8_SA(b, h) (((b) * 2 + (h)) * HTB)
#define PG8_SB(b, h) ((4 + (b) * 2 + (h)) * HTB)
#define PG8_STAGE(bufoff, gbase, voff) do { _Pragma("unroll") for (int _i = 0; _i < 2; ++_i) \
        __builtin_amdgcn_global_load_lds((const unsigned*)((const char*)(gbase) + (voff)[_i]), (LAS unsigned*)(lds + (bufoff) + ldsw + _i * 8192), 16, 0, 0); } while (0)
#define PG8_LDA(dst, b, h) do { _Pragma("unroll") for (int m = 0; m < 4; ++m) _Pragma("unroll") for (int k = 0; k < 2; ++k) dst[m][k] = *(const LAS bf16x8*)(lds + PG8_SA(b, h) + aoff + m * 2048 + k * 1024); } while (0)
#define PG8_LDB(dst, b, h) do { _Pragma("unroll") for (int n = 0; n < 2; ++n) _Pragma("unroll") for (int k = 0; k < 2; ++k) dst[n][k] = *(const LAS bf16x8*)(lds + PG8_SB(b, h) + boff + n * 2048 + k * 1024); } while (0)
#define PG8_MMA(ai, bj, At, Bt) do { __builtin_amdgcn_s_setprio(1); _Pragma("unroll") for (int m = 0; m < 4; ++m) _Pragma("unroll") for (int n = 0; n < 2; ++n) _Pragma("unroll") for (int k = 0; k < 2; ++k) \
        acc[ai][bj][m][n] = __builtin_amdgcn_mfma_f32_16x16x32_bf16(Bt[n][k], At[m][k], acc[ai][bj][m][n], 0, 0, 0); __builtin_amdgcn_s_setprio(0); } while (0)
#define PG8_WAIT_V(n) asm volatile("s_waitcnt vmcnt(" #n ")" ::: "memory")
#define PG8_WAIT_L(n) asm volatile("s_waitcnt lgkmcnt(" #n ")" ::: "memory")
#define PG8_BAR __builtin_amdgcn_s_barrier()
#define PG8_SCHED __builtin_amdgcn_sched_barrier(0)
    Unit cur, nxt; int ui = 0;
    if (!S.next(0, cur)) return;
    f32x4 acc[2][2][4][2];
#pragma unroll
    for (int a = 0; a < 2; ++a)
#pragma unroll
        for (int b = 0; b < 2; ++b)
#pragma unroll
            for (int m = 0; m < 4; ++m)
#pragma unroll
                for (int n = 0; n < 2; ++n) acc[a][b][m][n] = (f32x4){0.f, 0.f, 0.f, 0.f};
    bf16x8 At[4][2], B0[2][2], B1[2][2];
    const char* cA = (const char*)g.A + (size_t)cur.pm * tstepA; const char* cB = (const char*)g.Bt + (size_t)cur.pb * tstepB;
    PG8_STAGE(PG8_SB(0, 0), cB, voffB); PG8_STAGE(PG8_SA(0, 0), cA, voffA); PG8_STAGE(PG8_SB(0, 1), cB + hstepB, voffB); PG8_STAGE(PG8_SA(0, 1), cA + hstepA, voffA);
    if (wr == 1) PG8_BAR;
    PG8_WAIT_V(4); PG8_BAR;
    PG8_STAGE(PG8_SB(1, 0), cB + kstep, voffB); PG8_STAGE(PG8_SA(1, 0), cA + kstep, voffA); PG8_STAGE(PG8_SB(1, 1), cB + hstepB + kstep, voffB);
    PG8_WAIT_V(6); PG8_BAR;
    for (;;) {
        const bool has_next = S.next(ui + 1, nxt);
        const char* nA = has_next ? (const char*)g.A + (size_t)nxt.pm * tstepA : cA; const char* nB = has_next ? (const char*)g.Bt + (size_t)nxt.pb * tstepB : cB;
#pragma unroll 1
        for (int t = 0; t < nt; t += 2) {
            const bool last = (t == nt - 2);
            const char* a1 = cA + (size_t)(t + 1) * kstep;
            const char* a2 = last ? nA : cA + (size_t)(t + 2) * kstep; const char* b2 = last ? nB : cB + (size_t)(t + 2) * kstep;
            const char* a3 = a2 + kstep; const char* b3 = b2 + kstep;
            PG8_LDB(B0, 0, 0); PG8_SCHED; PG8_LDA(At, 0, 0); PG8_STAGE(PG8_SA(1, 1), a1 + hstepA, voffA);
            PG8_WAIT_L(8); PG8_BAR; PG8_WAIT_L(0); PG8_MMA(0, 0, At, B0); PG8_BAR; PG8_SCHED;
            PG8_LDB(B1, 0, 1); PG8_STAGE(PG8_SB(0, 0), b2, voffB);
            PG8_BAR; PG8_WAIT_L(0); PG8_MMA(0, 1, At, B1); PG8_BAR;
            PG8_LDA(At, 0, 1); PG8_STAGE(PG8_SA(0, 0), a2, voffA);
            PG8_BAR; PG8_WAIT_L(0); PG8_MMA(1, 0, At, B0); PG8_BAR; PG8_SCHED;
            PG8_STAGE(PG8_SB(0, 1), b2 + hstepB, voffB);
            PG8_WAIT_V(6); PG8_BAR; PG8_MMA(1, 1, At, B1); PG8_BAR;
            PG8_LDB(B0, 1, 0); PG8_SCHED; PG8_LDA(At, 1, 0); PG8_STAGE(PG8_SA(0, 1), a2 + hstepA, voffA);
            PG8_WAIT_L(8); PG8_BAR; PG8_WAIT_L(0); PG8_MMA(0, 0, At, B0); PG8_BAR; PG8_SCHED;
            PG8_LDB(B1, 1, 1); PG8_STAGE(PG8_SB(1, 0), b3, voffB);
            PG8_BAR; PG8_WAIT_L(0); PG8_MMA(0, 1, At, B1); PG8_BAR;
            PG8_LDA(At, 1, 1); PG8_STAGE(PG8_SA(1, 0), a3, voffA);
            PG8_BAR; PG8_WAIT_L(0); PG8_MMA(1, 0, At, B0); PG8_BAR; PG8_SCHED;
            PG8_STAGE(PG8_SB(1, 1), b3 + hstepB, voffB);
            PG8_WAIT_V(6); PG8_BAR; PG8_MMA(1, 1, At, B1); PG8_BAR;
        }
        { int fr_ = fr, fq_ = fq; asm volatile("" : "+v"(fr_), "+v"(fq_)); E(acc, cur, wr, wc, fr_, fq_); }
        if (!has_next) break;
#pragma unroll
        for (int a = 0; a < 2; ++a)
#pragma unroll
            for (int b = 0; b < 2; ++b)
#pragma unroll
                for (int m = 0; m < 4; ++m)
#pragma unroll
                    for (int n = 0; n < 2; ++n) acc[a][b][m][n] = (f32x4){0.f, 0.f, 0.f, 0.f};
        cur = nxt; cA = nA; cB = nB; ++ui;
    }
    PG8_WAIT_V(0);
    if (wr == 0) PG8_BAR;
    PG8_BAR;
#undef PG8_SA
#undef PG8_SB
#undef PG8_STAGE
#undef PG8_LDA
#undef PG8_LDB
#undef PG8_MMA
#undef PG8_WAIT_V
#undef PG8_WAIT_L
#undef PG8_BAR
#undef PG8_SCHED
}
}
using pg8::Unit; using pg8::HALF;
typedef const f32x4 (&AccRef)[2][2][4][2];

struct EpiZ {
    static constexpr bool PERM = true;
    bf16_t *zrw, *g3, *xl, *as;
    __device__ __forceinline__ void operator()(AccRef acc, const Unit& u, int wr, int wc, int fr, int fq) const {
        const int row0 = u.pm * 256 + wr * 64 + fr, colt = wc * 32 + 8 * fq, pn = u.pn;
        if (pn == 9 || pn == 10) {
#pragma unroll
            for (int ai = 0; ai < 2; ++ai)
#pragma unroll
                for (int m = 0; m < 4; ++m) { const int row = row0 + ai * HALF + m * 16; const int b = row >> 13, l = row & 8191;
#pragma unroll
                    for (int bj = 0; bj < 2; ++bj) { const int c = (pn - 9) * 256 + bj * HALF + colt; const int g = c >> 4, h0 = c & 15;
                        const size_t asrow = (size_t)g * 2048 + b * 512 + (l >> 4);
                        const f32x4 v0 = acc[ai][bj][m][0], v1 = acc[ai][bj][m][1];
                        u32x4 w; w.x = cvt_pk_bf16(v0[0], v0[1]); w.y = cvt_pk_bf16(v0[2], v0[3]); w.z = cvt_pk_bf16(v1[0], v1[1]); w.w = cvt_pk_bf16(v1[2], v1[3]);
                        *(u32x4*)(as + asrow * AS_LD + (l & 15) * 16 + h0) = w; } }
            return;
        }
        bf16_t* base; int ld, c0;
        if (pn < 7) { base = zrw; ld = ZRW_LD; c0 = pn * 256; }
        else if (pn < 9) { base = g3; ld = G3_LD; c0 = (pn - 7) * 256; }
        else if (pn < 13) { base = g3; ld = G3_LD; c0 = 512 + (pn - 11) * 256; }
        else if (pn < 15) { base = xl; ld = BW; c0 = (pn - 13) * 256; }
        else { base = g3; ld = G3_LD; c0 = 1024 + (pn - 15) * 256; }
#pragma unroll
        for (int ai = 0; ai < 2; ++ai)
#pragma unroll
            for (int m = 0; m < 4; ++m) { bf16_t* rowp = base + (size_t)(row0 + ai * HALF + m * 16) * ld + c0 + colt;
#pragma unroll
                for (int bj = 0; bj < 2; ++bj) { const f32x4 v0 = acc[ai][bj][m][0], v1 = acc[ai][bj][m][1];
                    u32x4 w; w.x = cvt_pk_bf16(v0[0], v0[1]); w.y = cvt_pk_bf16(v0[2], v0[3]); w.z = cvt_pk_bf16(v1[0], v1[1]); w.w = cvt_pk_bf16(v1[2], v1[3]);
                    *(u32x4*)(rowp + bj * HALF) = w; } }
    }
};
struct EpiPle {
    static constexpr bool PERM = true;
    bf16_t* pw; float* ss;
    __device__ __forceinline__ void operator()(AccRef acc, const Unit& u, int wr, int wc, int fr, int fq) const {
        const int row0 = u.pm * 256 + wr * 64 + fr, col0 = u.pn * 256 + wc * 32 + 8 * fq;
#pragma unroll
        for (int ai = 0; ai < 2; ++ai)
#pragma unroll
            for (int m = 0; m < 4; ++m) { const int row = row0 + ai * HALF + m * 16; bf16_t* rowp = pw + (size_t)row * D + col0; float s = 0.f;
#pragma unroll
                for (int bj = 0; bj < 2; ++bj) { const f32x4 v0 = acc[ai][bj][m][0], v1 = acc[ai][bj][m][1];
                    s += v0[0] * v0[0] + v0[1] * v0[1] + v0[2] * v0[2] + v0[3] * v0[3] + v1[0] * v1[0] + v1[1] * v1[1] + v1[2] * v1[2] + v1[3] * v1[3];
                    u32x4 w; w.x = cvt_pk_bf16(v0[0], v0[1]); w.y = cvt_pk_bf16(v0[2], v0[3]); w.z = cvt_pk_bf16(v1[0], v1[1]); w.w = cvt_pk_bf16(v1[2], v1[3]);
                    *(u32x4*)(rowp + bj * HALF) = w; }
                s += __shfl_xor(s, 16); s += __shfl_xor(s, 32);
                if (fq == 0) unsafeAtomicAdd(ss + row, s);
                asm volatile("" ::: "memory"); }
    }
};
struct EpiE {
    static constexpr bool PERM = false;
    float* e;
    __device__ __forceinline__ void operator()(AccRef acc, const Unit& u, int wr, int wc, int fr, int fq) const {
        const int row0 = u.pm * 256 + wr * 64 + fr, col0 = wc * 32 + 4 * fq;
#pragma unroll
        for (int ai = 0; ai < 2; ++ai)
#pragma unroll
            for (int m = 0; m < 4; ++m) { float* rowp = e + (size_t)(row0 + ai * HALF + m * 16) * 128 + col0;
#pragma unroll
                for (int n = 0; n < 2; ++n) *(f32x4*)(rowp + n * 16) = acc[ai][0][m][n]; }
    }
};
struct EpiY {
    static constexpr bool PERM = true;
    const bf16_t* as; const float* dvec; bf16_t* zgs;
    __device__ __forceinline__ void operator()(AccRef acc, const Unit& u, int wr, int wc, int fr, int fq) const {
        const int row0 = u.pm * 256 + wr * 64 + fr, colt = wc * 32 + 8 * fq, g = u.pm >> 3, h0 = (8 * fq) & 15;
        const f32x4 d0 = *(const f32x4*)(dvec + g * 16 + h0), d1 = *(const f32x4*)(dvec + g * 16 + h0 + 4);
#pragma unroll
        for (int ai = 0; ai < 2; ++ai)
#pragma unroll
            for (int m = 0; m < 4; ++m) { const int row = row0 + ai * HALF + m * 16; const int b = (row >> 9) & 3, ch = row & 511;
#pragma unroll
                for (int bj = 0; bj < 2; ++bj) { const int c = bj * HALF + colt, tt = c >> 4;
                    float uu[8]; unpack8(*(const u32x4*)(as + (size_t)row * AS_LD + c), uu);
                    const f32x4 v0 = acc[ai][bj][m][0], v1 = acc[ai][bj][m][1];
                    float o[8];
#pragma unroll
                    for (int j = 0; j < 4; ++j) { o[j] = gelu_tanh(v0[j] + d0[j] * uu[j]); o[4 + j] = gelu_tanh(v1[j] + d1[j] * uu[4 + j]); }
                    const size_t tok = (size_t)b * SEQ + ch * 16 + tt;
                    *(u32x4*)(zgs + tok * BW + g * 16 + h0) = pack8(o); }
                asm volatile("" ::: "memory"); }
    }
};
struct EpiGlu {
    static constexpr bool PERM = true;
    const bf16_t* zgs; const float* bias; bf16_t* g3;
    __device__ __forceinline__ void operator()(AccRef acc, const Unit& u, int wr, int wc, int fr, int fq) const {
        const int row0 = u.pm * 256 + wr * 64 + fr, col0 = u.pn * 256 + wc * 32 + 8 * fq;
#pragma unroll
        for (int ai = 0; ai < 2; ++ai)
#pragma unroll
            for (int m = 0; m < 4; ++m) { const size_t row = (size_t)(row0 + ai * HALF + m * 16);
#pragma unroll
                for (int bj = 0; bj < 2; ++bj) { const int c = col0 + bj * HALF;
                    float z[8], gt[8]; unpack8(*(const u32x4*)(zgs + row * BW + c), z); bf16_t* gp = g3 + row * G3_LD + 512 + c; unpack8(*(const u32x4*)gp, gt);
                    const f32x4 b0 = *(const f32x4*)(bias + c), b1 = *(const f32x4*)(bias + c + 4);
                    const f32x4 v0 = acc[ai][bj][m][0], v1 = acc[ai][bj][m][1];
                    float o[8];
#pragma unroll
                    for (int j = 0; j < 4; ++j) { o[j] = z[j] * sigmoidf_(v0[j] + b0[j]) * siluf_(gt[j]); o[4 + j] = z[4 + j] * sigmoidf_(v1[j] + b1[j]) * siluf_(gt[4 + j]); }
                    *(u32x4*)gp = pack8(o); } }
    }
};
struct EpiLru {
    static constexpr bool PERM = true;
    const bf16_t* xc; const float *ba, *bx, *lam; bf16_t* ab;
    __device__ __forceinline__ void operator()(AccRef acc, const Unit& u, int wr, int wc, int fr, int fq) const {
        const int row0 = u.pm * 256 + wr * 64 + fr, ch = u.pn * 128 + wc * 32 + 8 * fq;
        float bav[8], bxv[8], spl[8];
#pragma unroll
        for (int j = 0; j < 8; ++j) { bav[j] = ba[ch + j]; bxv[j] = bx[ch + j]; spl[j] = -8.0f * softplusf_(-lam[ch + j]); }
#pragma unroll
        for (int ai = 0; ai < 2; ++ai)
#pragma unroll
            for (int m = 0; m < 4; ++m) { const size_t row = (size_t)(row0 + ai * HALF + m * 16);
                float x[8]; unpack8(*(const u32x4*)(xc + row * BW + ch), x);
                float la[8], bb[8];
#pragma unroll
                for (int j = 0; j < 8; ++j) { const float za = acc[ai][0][m][j >> 2][j & 3], zx = acc[ai][1][m][j >> 2][j & 3];
                    const float r = sigmoidf_(za + bav[j]), ig = sigmoidf_(zx + bxv[j]);
                    const float l_a = spl[j] * r; la[j] = l_a;
                    bb[j] = sqrtf(fmaxf(-expm1f(2.0f * l_a), 0.0f)) * (ig * x[j]); }
                *(u32x4*)(ab + row * 1024 + ch) = pack8(la); *(u32x4*)(ab + row * 1024 + 512 + ch) = pack8(bb); }
    }
};
struct EpiOut {
    static constexpr bool PERM = true;
    const float* hin; float* h; bf16_t* h1b;
    __device__ __forceinline__ void operator()(AccRef acc, const Unit& u, int wr, int wc, int fr, int fq) const {
        const int row0 = u.pm * 256 + wr * 64 + fr, col0 = u.pn * 256 + wc * 32 + 8 * fq;
#pragma unroll
        for (int ai = 0; ai < 2; ++ai)
#pragma unroll
            for (int m = 0; m < 4; ++m) { const size_t off = (size_t)(row0 + ai * HALF + m * 16) * D + col0;
#pragma unroll
                for (int bj = 0; bj < 2; ++bj) { const size_t o = off + bj * HALF;
                    const f32x4 v0 = *(const f32x4*)(hin + o) + acc[ai][bj][m][0], v1 = *(const f32x4*)(hin + o + 4) + acc[ai][bj][m][1];
                    *(f32x4*)(h + o) = v0; *(f32x4*)(h + o + 4) = v1;
                    u32x4 w; w.x = cvt_pk_bf16(v0[0], v0[1]); w.y = cvt_pk_bf16(v0[2], v0[3]); w.z = cvt_pk_bf16(v1[0], v1[1]); w.w = cvt_pk_bf16(v1[2], v1[3]); *(u32x4*)(h1b + o) = w; }
                asm volatile("" ::: "memory"); }
    }
};
struct EpiGate {
    static constexpr bool PERM = true;
    float* h; const bf16_t* pw; const float* ssp; const float* gple; float* ssh;
    __device__ __forceinline__ void operator()(AccRef acc, const Unit& u, int wr, int wc, int fr, int fq) const {
        const int row0 = u.pm * 256 + wr * 64 + fr, col0 = u.pn * 256 + wc * 32 + 8 * fq;
        f32x4 gv[2][2];
#pragma unroll
        for (int bj = 0; bj < 2; ++bj)
#pragma unroll
            for (int n = 0; n < 2; ++n) gv[bj][n] = *(const f32x4*)(gple + col0 + bj * HALF + 4 * n);
#pragma unroll
        for (int ai = 0; ai < 2; ++ai)
#pragma unroll
            for (int m = 0; m < 4; ++m) { const int row = row0 + ai * HALF + m * 16; const size_t off = (size_t)row * D + col0;
                const float rs = rsqrtf(ssp[row] * (1.0f / 1024.0f) + 1e-6f); float s = 0.f;
#pragma unroll
                for (int bj = 0; bj < 2; ++bj) { const size_t o = off + bj * HALF; float pv[8]; unpack8(*(const u32x4*)(pw + o), pv);
#pragma unroll
                    for (int n = 0; n < 2; ++n) { const f32x4 a = acc[ai][bj][m][n]; f32x4 v = *(const f32x4*)(h + o + 4 * n);
#pragma unroll
                        for (int j = 0; j < 4; ++j) { v[j] += pv[4 * n + j] * rs * gv[bj][n][j] * sigmoidf_(a[j]); s += v[j] * v[j]; }
                        *(f32x4*)(h + o + 4 * n) = v; } }
                s += __shfl_xor(s, 16); s += __shfl_xor(s, 32);
                if (fq == 0) unsafeAtomicAdd(ssh + row, s); }
    }
};

struct Ctx { const Params* P; unsigned char* ws; LAS unsigned char* lds; unsigned char* ldsg; int tid, lane, wave; size_t gtid, gsz; int vb, vG; };

template <class Map>
__device__ void transpose_w(const Ctx& c, const float* src, bf16_t* dst, int K, int Nsrc, int Npad, Map map) {
    const int K8 = K / 8; const size_t total = (size_t)2 * Npad * K8;
    for (size_t idx = c.gtid; idx < total; idx += c.gsz) {
        const int n = (int)(idx % Npad); const int k8 = (int)((idx / Npad) % K8); const int l = (int)(idx / ((size_t)Npad * K8));
        const int s = map(n); float f[8];
#pragma unroll
        for (int i = 0; i < 8; ++i) f[i] = (s >= 0) ? src[((size_t)l * K + k8 * 8 + i) * Nsrc + s] : 0.0f;
        *(u32x4*)(dst + ((size_t)l * Npad + n) * K + k8 * 8) = pack8(f);
    }
}

__device__ __forceinline__ void s5_lam_pow(const Params& P, int l, int g, int p, int n, float& re, float& im) {
    const float are = P.in[14][(l * 32 + g) * 64 + p], aim = P.in[15][(l * 32 + g) * 64 + p], dt = __expf(P.in[16][l * 32 + g]);
    const float mag = __expf(are * dt * (float)n);
    double rev = (double)aim * (double)dt * (double)n * 0.15915494309189535; rev -= rint(rev);
    const float ang = (float)(rev * 6.283185307179586);
    re = mag * cosf(ang); im = mag * sinf(ang);
}

__device__ void phase_prep(const Ctx& c) {
    const Params& P = *c.P; unsigned char* ws = c.ws;
    transpose_w(c, P.in[3], (bf16_t*)(ws + OFF_WIN), D, DIN, DINP, [](int n) { return n < 1664 ? n : (n < 1792 ? -1 : n - 128); });
    transpose_w(c, P.in[31], (bf16_t*)(ws + OFF_WOUT), DMIX, D, D, [](int n) { return n; });
    transpose_w(c, P.in[34], (bf16_t*)(ws + OFF_WG), D, D, D, [](int n) { return n; });
    transpose_w(c, P.in[32], (bf16_t*)(ws + OFF_WPLE), DPLE, D, D, [](int n) { return n; });
    transpose_w(c, P.in[22], (bf16_t*)(ws + OFF_WGLU), BW, BW, BW, [](int n) { return n; });
    { bf16_t* dst = (bf16_t*)(ws + OFF_WLRU);
      for (size_t idx = c.gtid; idx < (size_t)2 * 1024 * 64; idx += c.gsz) {
          const int n = (int)(idx & 1023), k8 = (int)((idx >> 10) & 63), l = (int)(idx >> 16);
          const int pn = n >> 8, rr = n & 255, ch = 128 * pn + (rr & 127), which = rr >> 7, hb = ch >> 6, j = ch & 63, k0 = k8 * 8;
          const float* W = which ? P.in[28] : P.in[26]; float f[8];
#pragma unroll
          for (int i = 0; i < 8; ++i) f[i] = ((k0 >> 6) == hb) ? W[(((size_t)l * 8 + hb) * 64 + (k0 & 63) + i) * 64 + j] : 0.0f;
          *(u32x4*)(dst + ((size_t)l * 1024 + n) * BW + k0) = pack8(f); } }
    { float* tbl = (float*)(ws + OFF_TBL);
      for (size_t idx = c.gtid; idx < (size_t)2 * 32 * 64 * 18; idx += c.gsz) {
          const int n = (int)(idx % 18), lgp = (int)(idx / 18), p = lgp & 63, g = (lgp >> 6) & 31, l = lgp >> 11; float re, im;
          if (n < 17) s5_lam_pow(P, l, g, p, n, re, im);
          else { float lr, li; s5_lam_pow(P, l, g, p, 1, lr, li); const float ar = P.in[14][(l * 32 + g) * 64 + p], ai = P.in[15][(l * 32 + g) * 64 + p];
                 const float cr = lr - 1.0f, ci = li, den = 1.0f / (ar * ar + ai * ai); re = (cr * ar + ci * ai) * den; im = (ci * ar - cr * ai) * den; }
          tbl[idx * 2] = re; tbl[idx * 2 + 1] = im; } }
    { const float* x = P.in[0]; const float* gg = P.in[2]; bf16_t* xn = (bf16_t*)(ws + OFF_XN);
      const int stride = gridDim.x * 8;
      for (int row0 = blockIdx.x * 8 + c.wave; row0 < T; row0 += 2 * stride) {
          f32x4 v[2][4]; float sq[2]; bool ok[2];
#pragma unroll
          for (int r = 0; r < 2; ++r) { const int row = row0 + r * stride; ok[r] = row < T; const int rr = ok[r] ? row : row0; sq[r] = 0.f;
#pragma unroll
              for (int i = 0; i < 4; ++i) { v[r][i] = *(const f32x4*)(x + (size_t)rr * D + i * 256 + c.lane * 4); sq[r] += v[r][i][0] * v[r][i][0] + v[r][i][1] * v[r][i][1] + v[r][i][2] * v[r][i][2] + v[r][i][3] * v[r][i][3]; } }
#pragma unroll
          for (int r = 0; r < 2; ++r) { if (!ok[r]) continue; const int row = row0 + r * stride; const float rs = rsqrtf(wave_sum(sq[r]) * (1.0f / 1024.0f) + 1e-6f);
#pragma unroll
              for (int i = 0; i < 4; ++i) { const f32x4 gv = *(const f32x4*)(gg + i * 256 + c.lane * 4); u32x2 w; w.x = cvt_pk_bf16(v[r][i][0] * rs * gv[0], v[r][i][1] * rs * gv[1]); w.y = cvt_pk_bf16(v[r][i][2] * rs * gv[2], v[r][i][3] * rs * gv[3]);
                  *(u32x2*)(xn + (size_t)row * D + i * 256 + c.lane * 4) = w; } } } }
    { float* ss = (float*)(ws + OFF_SS); for (size_t i = c.gtid; i < (size_t)4 * T; i += c.gsz) ss[i] = 0.0f; }
    { const float* p = P.in[1]; bf16_t* pb = (bf16_t*)(ws + OFF_PB);
      for (size_t i = c.gtid; i < (size_t)2 * T * DPLE / 8; i += c.gsz) { const f32x4 a = *(const f32x4*)(p + i * 8), b = *(const f32x4*)(p + i * 8 + 4);
          u32x4 w; w.x = cvt_pk_bf16(a[0], a[1]); w.y = cvt_pk_bf16(a[2], a[3]); w.z = cvt_pk_bf16(b[0], b[1]); w.w = cvt_pk_bf16(b[2], b[3]); *(u32x4*)(pb + i * 8) = w; } }
}

__device__ void phase_s5_consts(const Ctx& c) {
    const Params& P = *c.P; unsigned char* ws = c.ws;
    const float* tbl = (const float*)(ws + OFF_TBL); bf16_t* by = (bf16_t*)(ws + OFF_S5Y); bf16_t* be = (bf16_t*)(ws + OFF_S5E);
    const float *bre = P.in[17], *bim = P.in[18], *cre = P.in[19], *cim = P.in[20];
    for (size_t idx = c.gtid; idx < (size_t)2 * 32 * 16 * 256; idx += c.gsz) {
        const int hp = (int)(idx & 15), h = (int)((idx >> 4) & 15), tau = (int)((idx >> 8) & 15), g = (int)((idx >> 12) & 31), l = (int)(idx >> 17);
        const int lg = l * 32 + g; float s = 0.f;
        for (int p = 0; p < 64; ++p) { const float* tp = tbl + ((size_t)(lg * 64 + p) * 18) * 2;
            const float pr = tp[tau * 2], pi = tp[tau * 2 + 1], qr = tp[34], qi = tp[35];
            const float br = bre[((size_t)lg * 64 + p) * 16 + hp], bi = bim[((size_t)lg * 64 + p) * 16 + hp];
            const float bbr = qr * br - qi * bi, bbi = qr * bi + qi * br;
            const float zr = pr * bbr - pi * bbi, zi = pr * bbi + pi * bbr;
            const float cr = cre[((size_t)lg * 16 + h) * 64 + p], ci = cim[((size_t)lg * 16 + h) * 64 + p];
            s += cr * zr - ci * zi; }
        const bf16_t kv = f2bf(s); bf16_t* base = by + (size_t)lg * 256 * AS_LD;
        for (int s0 = 0; s0 + tau < 16; ++s0) { const int t = s0 + tau;
            base[(size_t)(t * 16 + h) * AS_LD + s0 * 16 + hp] = kv;
            if (tau > 0) base[(size_t)(s0 * 16 + h) * AS_LD + t * 16 + hp] = 0; }
    }
    for (size_t idx = c.gtid; idx < (size_t)2 * 32 * 256 * 64; idx += c.gsz) {
        const int p = (int)(idx & 63), th = (int)((idx >> 6) & 255), lg = (int)(idx >> 14); const int t = th >> 4, h = th & 15;
        const float* tp = tbl + ((size_t)(lg * 64 + p) * 18) * 2; const float pr = tp[(t + 1) * 2], pi = tp[(t + 1) * 2 + 1];
        const float cr = cre[((size_t)lg * 16 + h) * 64 + p], ci = cim[((size_t)lg * 16 + h) * 64 + p];
        bf16_t* rowp = by + ((size_t)lg * 256 + th) * AS_LD; rowp[256 + p] = f2bf(cr * pr - ci * pi); rowp[320 + p] = f2bf(-(cr * pi + ci * pr));
    }
    for (size_t idx = c.gtid; idx < (size_t)2 * 32 * 256 * 256; idx += c.gsz) {
        const int col = (int)(idx & 255), n = (int)((idx >> 8) & 255), lg = (int)(idx >> 16); float v = 0.f;
        if (n < 128) { const int p = n & 63, s0 = col >> 4, hp = col & 15; const float* tp = tbl + ((size_t)(lg * 64 + p) * 18) * 2;
            const float pr = tp[(15 - s0) * 2], pi = tp[(15 - s0) * 2 + 1], qr = tp[34], qi = tp[35];
            const float br = bre[((size_t)lg * 64 + p) * 16 + hp], bi = bim[((size_t)lg * 64 + p) * 16 + hp];
            const float bbr = qr * br - qi * bi, bbi = qr * bi + qi * br;
            v = (n < 64) ? (pr * bbr - pi * bbi) : (pr * bbi + pi * bbr); }
        be[idx] = f2bf(v);
    }
}

__device__ void phase_lru_conv(const Ctx& c, int l) {
    const Params& P = *c.P; const bf16_t* xl = (const bf16_t*)(c.ws + OFF_XL); bf16_t* xc = (bf16_t*)(c.ws + OFF_XC);
    const float* cw = P.in[24] + (size_t)l * 4 * BW; const float* cb = P.in[25] + (size_t)l * BW;
    for (size_t idx = (size_t)c.vb * 512 + c.tid; idx < (size_t)T * 64; idx += (size_t)c.vG * 512) {
        const int c8 = (int)(idx & 63) * 8; const int row = (int)(idx >> 6), lpos = row & (SEQ - 1);
        float o[8];
#pragma unroll
        for (int i = 0; i < 8; ++i) o[i] = cb[c8 + i];
#pragma unroll
        for (int j = 0; j < 4; ++j) { if (lpos - 3 + j >= 0) { float x[8]; unpack8(*(const u32x4*)(xl + (size_t)(row - 3 + j) * BW + c8), x);
#pragma unroll
                for (int i = 0; i < 8; ++i) o[i] += x[i] * cw[j * BW + c8 + i]; } }
        *(u32x4*)(xc + (size_t)row * BW + c8) = pack8(o);
    }
}

__device__ void phase_s5_carry(const Ctx& c, int l) {
    if (c.wave != 0 || c.vb >= 128) return;
    const int g = c.vb >> 2, b = c.vb & 3, p = c.lane;
    float lr, li; s5_lam_pow(*c.P, l, g, p, 16, lr, li);
    const float* e = (const float*)(c.ws + OFF_E); bf16_t* as = (bf16_t*)(c.ws + OFF_AS);
    const size_t base = (size_t)g * 2048 + b * 512; float xr = 0.f, xi = 0.f;
    for (int c0 = 0; c0 < 512; c0 += 32) {
        float er[32], ei[32];
#pragma unroll
        for (int i = 0; i < 32; ++i) { er[i] = e[(base + c0 + i) * 128 + p]; ei[i] = e[(base + c0 + i) * 128 + 64 + p]; }
#pragma unroll
        for (int i = 0; i < 32; ++i) { bf16_t* rowp = as + (base + c0 + i) * AS_LD; rowp[256 + p] = f2bf(xr); rowp[320 + p] = f2bf(xi);
            const float nr = lr * xr - li * xi + er[i], ni = lr * xi + li * xr + ei[i]; xr = nr; xi = ni; }
    }
}

__device__ void phase_lru_scan(const Ctx& c, int pass) {
    const bf16_t* ab = (const bf16_t*)(c.ws + OFF_LRUAB); float* agg = (float*)(c.ws + OFF_AGG); bf16_t* g3 = (bf16_t*)(c.ws + OFF_G3);
    const int ch = c.tid;
    for (int unit = c.vb; unit < NB * 128; unit += c.vG) {
        const int b = unit >> 7, ck = unit & 127; const size_t t0 = (size_t)b * SEQ + ck * 64;
        float h = 0.f, sl = 0.f;
        if (pass == 1) {
            for (int i0 = 0; i0 < ck; i0 += 16) { float sl_[16], he_[16];
#pragma unroll
                for (int j = 0; j < 16; ++j) { const int ii = (i0 + j < ck) ? i0 + j : ck - 1; const float* a = agg + ((size_t)(b * 128 + ii)) * 1024; sl_[j] = a[ch]; he_[j] = a[512 + ch]; }
#pragma unroll
                for (int j = 0; j < 16; ++j) if (i0 + j < ck) h = __expf(sl_[j]) * h + he_[j]; }
        }
        for (int t8 = 0; t8 < 64; t8 += 16) {
            float la[16], bb[16], gt[16];
#pragma unroll
            for (int i = 0; i < 16; ++i) { la[i] = bf2f(ab[(t0 + t8 + i) * 1024 + ch]); bb[i] = bf2f(ab[(t0 + t8 + i) * 1024 + 512 + ch]); if (pass == 1) gt[i] = bf2f(g3[(t0 + t8 + i) * G3_LD + 1024 + ch]); }
#pragma unroll
            for (int i = 0; i < 16; ++i) { h = __expf(la[i]) * h + bb[i]; sl += la[i];
                if (pass == 1) g3[(t0 + t8 + i) * G3_LD + 1024 + ch] = f2bf(h * siluf_(gt[i])); }
        }
        if (pass == 0) { float* a = agg + ((size_t)(b * 128 + ck)) * 1024; a[ch] = sl; a[512 + ch] = h; }
    }
}

__device__ void phase_norm(const Ctx& c, const float* ss, const float* gg, int fin) {
    float* h = c.P->out; bf16_t* xn = (bf16_t*)(c.ws + OFF_XN);
    const int stride = gridDim.x * 8;
    f32x4 gv[4];
#pragma unroll
    for (int i = 0; i < 4; ++i) gv[i] = *(const f32x4*)(gg + i * 256 + c.lane * 4);
    for (int row0 = blockIdx.x * 8 + c.wave; row0 < T; row0 += 4 * stride) {
        f32x4 v[4][4]; float rs[4]; bool ok[4];
#pragma unroll
        for (int r = 0; r < 4; ++r) { const int row = row0 + r * stride; ok[r] = row < T; const int rr = ok[r] ? row : row0; rs[r] = ss[rr];
#pragma unroll
            for (int i = 0; i < 4; ++i) v[r][i] = *(const f32x4*)(h + (size_t)rr * D + i * 256 + c.lane * 4); }
#pragma unroll
        for (int r = 0; r < 4; ++r) { if (!ok[r]) continue; const int row = row0 + r * stride; const float sc = rsqrtf(rs[r] * (1.0f / 1024.0f) + 1e-6f);
#pragma unroll
            for (int i = 0; i < 4; ++i) { const size_t o = (size_t)row * D + i * 256 + c.lane * 4; const f32x4 q = v[r][i] * sc * gv[i];
                if (fin) *(f32x4*)(h + o) = q; else { u32x2 w; w.x = cvt_pk_bf16(q[0], q[1]); w.y = cvt_pk_bf16(q[2], q[3]); *(u32x2*)(xn + o) = w; } } }
    }
}

typedef float f32x2 __attribute__((ext_vector_type(2)));
template <int CTRL> __device__ __forceinline__ float dpp_mov(float v) { return __builtin_bit_cast(float, __builtin_amdgcn_update_dpp(0, __builtin_bit_cast(int, v), CTRL, 0xf, 0xf, true)); }
__device__ __forceinline__ float row16_sum(float v) { v += dpp_mov<0xB1>(v); v += dpp_mov<0x4E>(v); v += dpp_mov<0x124>(v); v += dpp_mov<0x128>(v); return v; }
__device__ __forceinline__ float wave_sum2(float v) { v = row16_sum(v); const int vi = __builtin_bit_cast(int, v); const float a = __builtin_bit_cast(float, __builtin_amdgcn_readlane(vi, 0)), b = __builtin_bit_cast(float, __builtin_amdgcn_readlane(vi, 16)), c2 = __builtin_bit_cast(float, __builtin_amdgcn_readlane(vi, 32)), d = __builtin_bit_cast(float, __builtin_amdgcn_readlane(vi, 48)); return (a + b) + (c2 + d); }
__device__ __forceinline__ float oct_sum(float v) { v += dpp_mov<0xB1>(v); v += dpp_mov<0x4E>(v); v += dpp_mov<0x141>(v); return v; }
constexpr int RW_NBLK = 128, TWS = 72;

struct RwRows { unsigned zr[5], zk[5], zv[5], zw[5], za[5]; };
__device__ __forceinline__ float rw_get(const unsigned (&a)[5], int i) { return (i & 1) ? hi16(a[i >> 1]) : lo16(a[i >> 1]); }
__device__ __forceinline__ void rw_load_rows(RwRows& R, const bf16_t* zrw, int b, int blk, int w, int lane, int cj) {
#pragma unroll
    for (int p = 0; p < 5; ++p) { unsigned r_[2] = {0, 0}, k_[2] = {0, 0}, v_[2] = {0, 0}, w_[2] = {0, 0}, a_[2] = {0, 0};
#pragma unroll
        for (int h = 0; h < 2; ++h) { const int i = 2 * p + h; if (i < 9) { const int lp = blk * 64 + w * 8 - 1 + i; const bool ok = lp >= 0; const bf16_t* rp = zrw + ((size_t)b * SEQ + (ok ? lp : 0)) * ZRW_LD;
            const unsigned m = ok ? 0xffffu : 0u;
            r_[h] = rp[cj] & m; k_[h] = rp[512 + cj] & m; v_[h] = rp[1024 + cj] & m; w_[h] = rp[1536 + lane] & m; a_[h] = rp[1600 + lane] & m; } }
        R.zr[p] = r_[0] | (r_[1] << 16); R.zk[p] = k_[0] | (k_[1] << 16); R.zv[p] = v_[0] | (v_[1] << 16); R.zw[p] = w_[0] | (w_[1] << 16); R.za[p] = a_[0] | (a_[1] << 16); }
}

constexpr int CH_AT = 0, CH_RT = 2304, CH_KT = 4608, CH_BT = 6912, CH_KH = 9216, CH_NB = 12288, CH_VT = 15360, CH_LRK = 18432, CH_NLRB = 19200, CH_GI = 19968,
              CH_LAB = 20736, CH_LAK = 21760, CH_GC = 22784, CH_BYTES = 23040;
constexpr int RW_YY = 4 * CH_BYTES, RW_TW = RW_YY + 16384, RW_AD = RW_TW + 64 * TWS * 2, RW_AR = RW_TW  , RW_GP = RW_AD + 64 * TWS * 2,
              RW_W2 = RW_GP + 2048, RW_A2 = RW_W2 + 64 * TWS * 2, RW_CT = RW_A2 + 64 * TWS * 2, RW_END = RW_CT + 12 * 64 * 4;
static_assert(RW_END <= LDS_BYTES, "rwkv lds");
__device__ __forceinline__ void lds_barrier() { asm volatile("s_waitcnt lgkmcnt(0)\n\ts_barrier" ::: "memory"); }
typedef short bf16x4 __attribute__((ext_vector_type(4)));
__device__ __forceinline__ bf16x8 cat4(bf16x4 lo, bf16x4 hi) { return __builtin_shufflevector(lo, hi, 0, 1, 2, 3, 4, 5, 6, 7); }
__device__ __forceinline__ bf16x8 cat4z(bf16x4 lo) { const bf16x4 z = {0, 0, 0, 0}; return __builtin_shufflevector(lo, z, 0, 1, 2, 3, 4, 5, 6, 7); }
__device__ __forceinline__ bf16x4 pk4(f32x4 v) { u32x2 w; w.x = cvt_pk_bf16(v[0], v[1]); w.y = cvt_pk_bf16(v[2], v[3]); return __builtin_bit_cast(bf16x4, w); }

__device__ void phase_rwkv(const Ctx& c, int l, int blk_lo, int blk_hi, bool dry = false) {
    if (blockIdx.x >= 32) return;
    const Params& P = *c.P; const int b = blockIdx.x >> 3, hd = blockIdx.x & 7, lane = c.lane, w = c.wave, cj = hd * 64 + lane, fr = lane & 15, fq = lane >> 4;
    LAS unsigned char* LB = c.lds;
    LAS float* YY = (LAS float*)(LB + RW_YY); LAS float* WR = YY; LAS float* AR = (LAS float*)(LB + RW_AR); LAS float* GP = (LAS float*)(LB + RW_GP);
    LAS bf16_t* TWb = (LAS bf16_t*)(LB + RW_TW); LAS bf16_t* ADb = (LAS bf16_t*)(LB + RW_AD);
    const bf16_t* zrw = (const bf16_t*)(c.ws + OFF_ZRW); bf16_t* g3 = (bf16_t*)(c.ws + OFF_G3);
    LAS float* CT = (LAS float*)(LB + RW_CT);
    if (c.tid < 64) { const float* mu = P.in[4] + (size_t)l * 1664; const int j = hd * 64 + c.tid;
        CT[0 * 64 + c.tid] = mu[j]; CT[1 * 64 + c.tid] = mu[512 + j]; CT[2 * 64 + c.tid] = mu[1024 + j]; CT[3 * 64 + c.tid] = mu[1536 + c.tid]; CT[4 * 64 + c.tid] = mu[1600 + c.tid];
        CT[5 * 64 + c.tid] = P.in[5][l * BW + j]; CT[6 * 64 + c.tid] = P.in[7][l * BW + j]; CT[7 * 64 + c.tid] = P.in[9][l * BW + j]; CT[8 * 64 + c.tid] = P.in[10][l * BW + j];
        CT[9 * 64 + c.tid] = P.in[11][l * BW + j]; CT[10 * 64 + c.tid] = P.in[12][l * BW + j]; CT[11 * 64 + c.tid] = P.in[13][l * BW + j]; }
    const int mt_ = w >> 1, nh = w & 1;
    LAS bf16_t* W2I = (LAS bf16_t*)(LB + RW_W2); LAS bf16_t* A2I = (LAS bf16_t*)(LB + RW_A2);
    for (int i = c.tid; i < 4096; i += 512) { const int k = i >> 6, j = i & 63; W2I[j * TWS + k] = f2bf(P.in[6][((size_t)l * 64 + k) * BW + hd * 64 + j]); A2I[j * TWS + k] = f2bf(P.in[8][((size_t)l * 64 + k) * BW + hd * 64 + j]); }
    __syncthreads();
    f32x4 Macc[4];
#pragma unroll
    for (int i = 0; i < 4; ++i) Macc[i] = (f32x4){0.f, 0.f, 0.f, 0.f};
    const int cc = w >> 1, hc = w & 1;
    RwRows cur;
    rw_load_rows(cur, zrw, b, blk_lo, w, lane, cj);
    for (int blk = blk_lo; blk < blk_hi; ++blk) {
        const size_t t0 = (size_t)b * SEQ + blk * 64;
        float rs[8], ks_[8], vs[8];
        const float mu_r = CT[lane], mu_k = CT[64 + lane], mu_v = CT[128 + lane], mu_w = CT[192 + lane], mu_a = CT[256 + lane];
#pragma unroll
        for (int i = 0; i < 8; ++i) { const int tok = w * 8 + i;
            { const float r0 = rw_get(cur.zr, i), r1 = rw_get(cur.zr, i + 1), k0 = rw_get(cur.zk, i), k1 = rw_get(cur.zk, i + 1), v0 = rw_get(cur.zv, i), v1 = rw_get(cur.zv, i + 1);
              rs[i] = r1 + mu_r * (r0 - r1); ks_[i] = k1 + mu_k * (k0 - k1); vs[i] = v1 + mu_v * (v0 - v1); }
            const float w0_ = rw_get(cur.zw, i), w1_ = rw_get(cur.zw, i + 1), a0_ = rw_get(cur.za, i), a1_ = rw_get(cur.za, i + 1);
            const float wds = w1_ + mu_w * (w0_ - w1_), ads = a1_ + mu_a * (a0_ - a1_);
            const float e2 = __expf(2.0f * wds); const float th = 1.0f - 2.0f * __builtin_amdgcn_rcpf(e2 + 1.0f);
            TWb[tok * TWS + lane] = f2bf(th); ADb[tok * TWS + lane] = f2bf(ads); }
        if (blk + 1 < RW_NBLK) rw_load_rows(cur, zrw, b, blk + 1, w, lane, cj);
        unsigned gtp[4];
#pragma unroll
        for (int i = 0; i < 4; ++i) gtp[i] = (unsigned)g3[(t0 + w * 8 + 2 * i) * G3_LD + cj] | ((unsigned)g3[(t0 + w * 8 + 2 * i + 1) * G3_LD + cj] << 16);
        lds_barrier();
        { bf16x8 atw[2], aad[2];
#pragma unroll
          for (int ks = 0; ks < 2; ++ks) { atw[ks] = *(const LAS bf16x8*)(TWb + (16 * mt_ + fr) * TWS + 32 * ks + 8 * fq); aad[ks] = *(const LAS bf16x8*)(ADb + (16 * mt_ + fr) * TWS + 32 * ks + 8 * fq); }
          f32x4 cw[2], ca[2];
#pragma unroll
          for (int n2 = 0; n2 < 2; ++n2) { cw[n2] = (f32x4){0.f, 0.f, 0.f, 0.f}; ca[n2] = cw[n2];
#pragma unroll
              for (int ks = 0; ks < 2; ++ks) { const int bo = (32 * nh + 16 * n2 + fr) * TWS + 32 * ks + 8 * fq;
                  cw[n2] = __builtin_amdgcn_mfma_f32_16x16x32_bf16(atw[ks], *(const LAS bf16x8*)(W2I + bo), cw[n2], 0, 0, 0); ca[n2] = __builtin_amdgcn_mfma_f32_16x16x32_bf16(aad[ks], *(const LAS bf16x8*)(A2I + bo), ca[n2], 0, 0, 0); } }
          lds_barrier();
#pragma unroll
          for (int n2 = 0; n2 < 2; ++n2)
#pragma unroll
              for (int r = 0; r < 4; ++r) { const int o = (16 * mt_ + 4 * fq + r) * 64 + 32 * nh + 16 * n2 + fr; WR[o] = cw[n2][r]; AR[o] = ca[n2][r]; } }
        lds_barrier();
        float kkv[8], kpv[8], bbv[8], gl[8], cbv[8];
        { float g = 1.0f; const float w0j = CT[320 + lane], a0j = CT[384 + lane], kkj = CT[448 + lane], kaj = CT[512 + lane], rkj = CT[576 + lane];
#pragma unroll
          for (int i = 0; i < 8; ++i) { const int o = (w * 8 + i) * 64 + lane;
            const float wraw = w0j + WR[o], araw = a0j + AR[o];
            const float d = __expf(-0.6065306597126334f * sigmoidf_(wraw)), a = sigmoidf_(araw);
            float kk = ks_[i] * kkj; const float n2 = wave_sum2(kk * kk); kk = kk * __builtin_amdgcn_rsqf(fmaxf(n2, 1e-24f));
            const float kp = ks_[i] * (1.0f + (a - 1.0f) * kaj);
            cbv[i] = wave_sum2(rs[i] * kp * rkj);
            g *= d; gl[i] = g; kkv[i] = kk; kpv[i] = kp; bbv[i] = kk * a; }
          GP[w * 64 + lane] = g; }
        lds_barrier();
        { LAS unsigned char* CB_ = LB + cc * CH_BYTES;
          LAS bf16_t *AT = (LAS bf16_t*)(CB_ + CH_AT), *RT = (LAS bf16_t*)(CB_ + CH_RT), *KT = (LAS bf16_t*)(CB_ + CH_KT), *BT = (LAS bf16_t*)(CB_ + CH_BT),
                     *KH = (LAS bf16_t*)(CB_ + CH_KH), *NBH = (LAS bf16_t*)(CB_ + CH_NB), *VT = (LAS bf16_t*)(CB_ + CH_VT);
          const float g0 = GP[(2 * cc) * 64 + lane], g1 = GP[(2 * cc + 1) * 64 + lane], gC = g0 * g1, pre = hc ? g0 : 1.0f;
          if (hc == 0) ((LAS float*)(CB_ + CH_GC))[lane] = gC;
#pragma unroll
          for (int i = 0; i < 8; ++i) { const int tl = 8 * hc + i;
            const float gam = pre * gl[i], gprev = (i == 0) ? pre : pre * gl[i - 1], ig = __builtin_amdgcn_rcpf(gam), gr = gC * ig;
            AT[tl * TWS + lane] = f2bf(kkv[i] * gprev); RT[tl * TWS + lane] = f2bf(rs[i] * gam); KT[tl * TWS + lane] = f2bf(kpv[i] * ig); BT[tl * TWS + lane] = f2bf(bbv[i] * ig);
            KH[lane * 24 + tl] = f2bf(kpv[i] * gr); NBH[lane * 24 + tl] = f2bf(-bbv[i] * gr); VT[lane * 24 + tl] = f2bf(vs[i]); } }
        lds_barrier();
        if (w < 4 && !(RW_OFF & 4)) { LAS unsigned char* CB_ = LB + w * CH_BYTES;
          const LAS bf16_t *AT = (const LAS bf16_t*)(CB_ + CH_AT), *RT = (const LAS bf16_t*)(CB_ + CH_RT), *KT = (const LAS bf16_t*)(CB_ + CH_KT), *BT = (const LAS bf16_t*)(CB_ + CH_BT);
          f32x4 lab = (f32x4){0.f, 0.f, 0.f, 0.f}, lak = lab, lrk = lab, lrb = lab;
#pragma unroll
          for (int ks = 0; ks < 2; ++ks) { const int o = fr * TWS + 32 * ks + 8 * fq;
            const bf16x8 af = *(const LAS bf16x8*)(AT + o), rf = *(const LAS bf16x8*)(RT + o), kf = *(const LAS bf16x8*)(KT + o), bf = *(const LAS bf16x8*)(BT + o);
            lab = __builtin_amdgcn_mfma_f32_16x16x32_bf16(af, bf, lab, 0, 0, 0); lak = __builtin_amdgcn_mfma_f32_16x16x32_bf16(af, kf, lak, 0, 0, 0);
            lrk = __builtin_amdgcn_mfma_f32_16x16x32_bf16(rf, kf, lrk, 0, 0, 0); lrb = __builtin_amdgcn_mfma_f32_16x16x32_bf16(rf, bf, lrb, 0, 0, 0); }
          LAS float *LAB = (LAS float*)(CB_ + CH_LAB), *LAK = (LAS float*)(CB_ + CH_LAK); LAS bf16_t *LRK = (LAS bf16_t*)(CB_ + CH_LRK), *NLRB = (LAS bf16_t*)(CB_ + CH_NLRB);
#pragma unroll
          for (int r = 0; r < 4; ++r) { const int t = 4 * fq + r, s_ = fr; const bool lo_ = t > s_, le_ = t >= s_;
            LAB[t * 16 + s_] = lo_ ? lab[r] : 0.0f; LAK[t * 16 + s_] = lo_ ? lak[r] : 0.0f;
            LRK[t * 24 + s_] = f2bf(le_ ? lrk[r] : 0.0f); NLRB[t * 24 + s_] = f2bf(le_ ? -lrb[r] : 0.0f); } }
        lds_barrier();
        { const int ch6 = w & 3; LAS unsigned char* CB_ = LB + ch6 * CH_BYTES;
          const LAS bf16_t* AT = (const LAS bf16_t*)(CB_ + CH_AT); const LAS float *LAB = (const LAS float*)(CB_ + CH_LAB), *LAK = (const LAS float*)(CB_ + CH_LAK);
          LAS bf16_t *WI = (LAS bf16_t*)(CB_ + CH_KT), *GI = (LAS bf16_t*)(CB_ + CH_GI);
          float xv[16];
          if (w < 4) {
#pragma unroll
            for (int t = 0; t < 16; ++t) xv[t] = bf2f(AT[t * TWS + lane]);
          } else {
#pragma unroll
            for (int t = 0; t < 16; ++t) xv[t] = LAK[t * 16 + fr];
          }
#pragma unroll
          for (int t = 1; t < 16; ++t) { float xa = xv[t];
#pragma unroll
            for (int q = 0; q < 4; ++q) if (4 * q < t) { const f32x4 lr = *(const LAS f32x4*)(LAB + t * 16 + 4 * q);
#pragma unroll
              for (int e = 0; e < 4; ++e) if (4 * q + e < t) xa -= lr[e] * xv[4 * q + e]; }
            xv[t] = xa; asm volatile("" : "+v"(xv[t]) :: "memory"); }
          if (w < 4) {
#pragma unroll
            for (int t = 0; t < 16; ++t) WI[t * TWS + lane] = f2bf(xv[t]);
          } else if (lane < 16) {
#pragma unroll
            for (int t = 0; t < 16; ++t) GI[t * 24 + lane] = f2bf(xv[t]);
          } }
        lds_barrier();
        if (w < 4 && !(RW_OFF & 2)) {
#pragma unroll 1
          for (int ch = 0; ch < 4; ++ch) { LAS unsigned char* CB_ = LB + ch * CH_BYTES;
            const LAS bf16_t *RT = (const LAS bf16_t*)(CB_ + CH_RT), *WI = (const LAS bf16_t*)(CB_ + CH_KT), *KH = (const LAS bf16_t*)(CB_ + CH_KH), *NBH = (const LAS bf16_t*)(CB_ + CH_NB),
                             *VT = (const LAS bf16_t*)(CB_ + CH_VT), *LRK = (const LAS bf16_t*)(CB_ + CH_LRK), *NLRB = (const LAS bf16_t*)(CB_ + CH_NLRB), *GI = (const LAS bf16_t*)(CB_ + CH_GI);
            const LAS float* GC = (const LAS float*)(CB_ + CH_GC);
            bf16x8 Mb[2], Wp[2], Rp[2];
#pragma unroll
            for (int ks = 0; ks < 2; ++ks) { Mb[ks] = cat4(pk4(Macc[2 * ks]), pk4(Macc[2 * ks + 1]));
              Wp[ks] = cat4(*(const LAS bf16x4*)(WI + fr * TWS + 32 * ks + 4 * fq), *(const LAS bf16x4*)(WI + fr * TWS + 32 * ks + 16 + 4 * fq));
              Rp[ks] = cat4(*(const LAS bf16x4*)(RT + fr * TWS + 32 * ks + 4 * fq), *(const LAS bf16x4*)(RT + fr * TWS + 32 * ks + 16 + 4 * fq)); }
            const bf16x8 Vb = cat4z(*(const LAS bf16x4*)(VT + (16 * w + fr) * 24 + 4 * fq));
            const bf16x8 Gp = cat4z(*(const LAS bf16x4*)(GI + fr * 24 + 4 * fq)), Lrkp = cat4z(*(const LAS bf16x4*)(LRK + fr * 24 + 4 * fq)), Nlrbp = cat4z(*(const LAS bf16x4*)(NLRB + fr * 24 + 4 * fq));
            f32x4 U = (f32x4){0.f, 0.f, 0.f, 0.f};
            U = __builtin_amdgcn_mfma_f32_16x16x32_bf16(Wp[0], Mb[0], U, 0, 0, 0); U = __builtin_amdgcn_mfma_f32_16x16x32_bf16(Wp[1], Mb[1], U, 0, 0, 0); U = __builtin_amdgcn_mfma_f32_16x16x32_bf16(Gp, Vb, U, 0, 0, 0);
            const bf16x8 Ub = cat4z(pk4(U));
            f32x4 Y = (f32x4){0.f, 0.f, 0.f, 0.f};
            Y = __builtin_amdgcn_mfma_f32_16x16x32_bf16(Rp[0], Mb[0], Y, 0, 0, 0); Y = __builtin_amdgcn_mfma_f32_16x16x32_bf16(Rp[1], Mb[1], Y, 0, 0, 0);
            Y = __builtin_amdgcn_mfma_f32_16x16x32_bf16(Lrkp, Vb, Y, 0, 0, 0); Y = __builtin_amdgcn_mfma_f32_16x16x32_bf16(Nlrbp, Ub, Y, 0, 0, 0);
#pragma unroll
            for (int r = 0; r < 4; ++r) YY[(16 * ch + 4 * fq + r) * 64 + 16 * w + fr] = Y[r];
#pragma unroll
            for (int mt = 0; mt < 4; ++mt) { const f32x4 gc = *(const LAS f32x4*)(GC + 16 * mt + 4 * fq); f32x4 m = Macc[mt] * gc;
              const bf16x8 khp = cat4z(*(const LAS bf16x4*)(KH + (16 * mt + fr) * 24 + 4 * fq)), nbp = cat4z(*(const LAS bf16x4*)(NBH + (16 * mt + fr) * 24 + 4 * fq));
              m = __builtin_amdgcn_mfma_f32_16x16x32_bf16(khp, Vb, m, 0, 0, 0); m = __builtin_amdgcn_mfma_f32_16x16x32_bf16(nbp, Ub, m, 0, 0, 0); Macc[mt] = m; } } }
        lds_barrier();
        const float lnw = CT[640 + lane], lnb = CT[704 + lane];
#pragma unroll
        for (int i = 0; i < 8; ++i) {
            const int tok = w * 8 + i; const float y = YY[tok * 64 + lane];
            const float mean = wave_sum2(y) * (1.0f / 64.0f), dl = y - mean, var = wave_sum2(dl * dl) * (1.0f / 64.0f);
            const float yn = dl * rsqrtf(var + 64e-5f) * lnw + lnb + cbv[i] * vs[i];
            const float gti = (i & 1) ? hi16(gtp[i >> 1]) : lo16(gtp[i >> 1]);
            if (!dry) g3[(t0 + tok) * G3_LD + cj] = f2bf(yn * siluf_(gti));
        }
        lds_barrier();
    }
}

__device__ __forceinline__ void spin_until_ge(const unsigned* flag, unsigned want) {
    unsigned it = 0;
    while (__hip_atomic_load(flag, __ATOMIC_RELAXED, __HIP_MEMORY_SCOPE_AGENT) < want) { __builtin_amdgcn_s_sleep(2); if (++it > (1u << 17)) break; }
}
__device__ __forceinline__ unsigned pk2bf(float lo, float hi) { return cvt_pk_bf16(lo, hi); }

__device__ void rwkv_producer(const Ctx& c, int l, int bh, int par) {
    const Params& P = *c.P; const int b = bh >> 3, hd = bh & 7, lane = c.lane, w = c.wave, cj = hd * 64 + lane, fr = lane & 15, fq = lane >> 4;
    LAS unsigned char* LB = c.lds;
    LAS float* WR = (LAS float*)LB; LAS float* AR = (LAS float*)(LB + RW_AR);
    LAS bf16_t* TWb = (LAS bf16_t*)(LB + RW_TW); LAS bf16_t* ADb = (LAS bf16_t*)(LB + RW_AD);
    const bf16_t* zrw = (const bf16_t*)(c.ws + OFF_ZRW);
    unsigned* ready = (unsigned*)(c.ws + OFF_BAR + 256) + (bh * 2 + par) * 64; const unsigned* consumed = (const unsigned*)(c.ws + OFF_BAR + 256 + 64 * 256) + bh * 64;
    unsigned char* ring = c.ws + OFF_RING + (size_t)bh * RING_SLOTS * SLOT_BYTES;
    LAS float* CT = (LAS float*)(LB + RW_CT);
    if (c.tid < 64) { const float* mu = P.in[4] + (size_t)l * 1664; const int j = hd * 64 + c.tid;
        CT[0 * 64 + c.tid] = mu[j]; CT[1 * 64 + c.tid] = mu[512 + j]; CT[2 * 64 + c.tid] = mu[1024 + j]; CT[3 * 64 + c.tid] = mu[1536 + c.tid]; CT[4 * 64 + c.tid] = mu[1600 + c.tid];
        CT[5 * 64 + c.tid] = P.in[5][l * BW + j]; CT[6 * 64 + c.tid] = P.in[7][l * BW + j]; CT[7 * 64 + c.tid] = P.in[9][l * BW + j]; CT[8 * 64 + c.tid] = P.in[10][l * BW + j];
        CT[9 * 64 + c.tid] = P.in[11][l * BW + j]; }
    const int mt_ = w >> 1, nh = w & 1;
    LAS bf16_t* W2I = (LAS bf16_t*)(LB + RW_W2); LAS bf16_t* A2I = (LAS bf16_t*)(LB + RW_A2);
    for (int i = c.tid; i < 4096; i += 512) { const int k = i >> 6, j = i & 63; W2I[j * TWS + k] = f2bf(P.in[6][((size_t)l * 64 + k) * BW + hd * 64 + j]); A2I[j * TWS + k] = f2bf(P.in[8][((size_t)l * 64 + k) * BW + hd * 64 + j]); }
    __syncthreads();
    RwRows cur;
    rw_load_rows(cur, zrw, b, par, w, lane, cj);
    for (int blk = par; blk < RW_NBLK; blk += 2) {
        const unsigned gblk = (unsigned)(l * RW_NBLK + blk);
        float rs[8], ks_[8], vs[8];
        const float mu_r = CT[lane], mu_k = CT[64 + lane], mu_v = CT[128 + lane], mu_w = CT[192 + lane], mu_a = CT[256 + lane];
#pragma unroll
        for (int i = 0; i < 8; ++i) { const int tok = w * 8 + i;
            { const float r0 = rw_get(cur.zr, i), r1 = rw_get(cur.zr, i + 1), k0 = rw_get(cur.zk, i), k1 = rw_get(cur.zk, i + 1), v0 = rw_get(cur.zv, i), v1 = rw_get(cur.zv, i + 1);
              rs[i] = r1 + mu_r * (r0 - r1); ks_[i] = k1 + mu_k * (k0 - k1); vs[i] = v1 + mu_v * (v0 - v1); }
            const float w0_ = rw_get(cur.zw, i), w1_ = rw_get(cur.zw, i + 1), a0_ = rw_get(cur.za, i), a1_ = rw_get(cur.za, i + 1);
            const float wds = w1_ + mu_w * (w0_ - w1_), ads = a1_ + mu_a * (a0_ - a1_);
            const float e2 = __expf(2.0f * wds); const float th = 1.0f - 2.0f * __builtin_amdgcn_rcpf(e2 + 1.0f);
            TWb[tok * TWS + lane] = f2bf(th); ADb[tok * TWS + lane] = f2bf(ads); }
        if (blk + 2 < RW_NBLK) rw_load_rows(cur, zrw, b, blk + 2, w, lane, cj);
        lds_barrier();
        { bf16x8 atw[2], aad[2];
#pragma unroll
          for (int ks = 0; ks < 2; ++ks) { atw[ks] = *(const LAS bf16x8*)(TWb + (16 * mt_ + fr) * TWS + 32 * ks + 8 * fq); aad[ks] = *(const LAS bf16x8*)(ADb + (16 * mt_ + fr) * TWS + 32 * ks + 8 * fq); }
          f32x4 cw[2], ca[2];
#pragma unroll
          for (int n2 = 0; n2 < 2; ++n2) { cw[n2] = (f32x4){0.f, 0.f, 0.f, 0.f}; ca[n2] = cw[n2];
#pragma unroll
              for (int ks = 0; ks < 2; ++ks) { const int bo = (32 * nh + 16 * n2 + fr) * TWS + 32 * ks + 8 * fq;
                  cw[n2] = __builtin_amdgcn_mfma_f32_16x16x32_bf16(atw[ks], *(const LAS bf16x8*)(W2I + bo), cw[n2], 0, 0, 0); ca[n2] = __builtin_amdgcn_mfma_f32_16x16x32_bf16(aad[ks], *(const LAS bf16x8*)(A2I + bo), ca[n2], 0, 0, 0); } }
          lds_barrier();
#pragma unroll
          for (int n2 = 0; n2 < 2; ++n2)
#pragma unroll
              for (int r = 0; r < 4; ++r) { const int o = (16 * mt_ + 4 * fq + r) * 64 + 32 * nh + 16 * n2 + fr; WR[o] = cw[n2][r]; AR[o] = ca[n2][r]; } }
        if (c.tid == 0 && gblk >= RING_SLOTS) spin_until_ge(consumed, gblk - RING_SLOTS + 1);
        lds_barrier();
        unsigned char* slot = ring + (size_t)(gblk % RING_SLOTS) * SLOT_BYTES;
        LAS float* GP = (LAS float*)(LB + RW_GP); const int cc = w >> 1, hc = w & 1;
        float kkv[8], kpv[8], bbv[8], gl[8], cbv[8];
        { const float w0j = CT[320 + lane], a0j = CT[384 + lane], kkj = CT[448 + lane], kaj = CT[512 + lane], rkj = CT[576 + lane]; float g = 1.0f;
#pragma unroll
          for (int i = 0; i < 8; ++i) { const int o = (w * 8 + i) * 64 + lane;
            const float wraw = w0j + WR[o], araw = a0j + AR[o];
            const float d = __expf(-0.6065306597126334f * sigmoidf_(wraw)), a = sigmoidf_(araw);
            float kk = ks_[i] * kkj; const float n2 = wave_sum2(kk * kk); kk = kk * __builtin_amdgcn_rsqf(fmaxf(n2, 1e-24f));
            const float kp = ks_[i] * (1.0f + (a - 1.0f) * kaj);
            cbv[i] = wave_sum2(rs[i] * kp * rkj);
            g *= d; gl[i] = g; kkv[i] = kk; kpv[i] = kp; bbv[i] = kk * a; }
          GP[w * 64 + lane] = g; }
        lds_barrier();
        { LAS unsigned char* CB_ = LB + cc * CH_BYTES;
          LAS bf16_t *AT = (LAS bf16_t*)(CB_ + CH_AT), *RT = (LAS bf16_t*)(CB_ + CH_RT), *KT = (LAS bf16_t*)(CB_ + CH_KT), *BT = (LAS bf16_t*)(CB_ + CH_BT),
                     *KH = (LAS bf16_t*)(CB_ + CH_KH), *NBH = (LAS bf16_t*)(CB_ + CH_NB), *VT = (LAS bf16_t*)(CB_ + CH_VT);
          const float g0 = GP[(2 * cc) * 64 + lane], g1 = GP[(2 * cc + 1) * 64 + lane], gC = g0 * g1, pre = hc ? g0 : 1.0f;
          if (hc == 0) ((LAS float*)(CB_ + CH_GC))[lane] = gC;
#pragma unroll
          for (int i = 0; i < 8; ++i) { const int tl = 8 * hc + i;
            const float gam = pre * gl[i], gprev = (i == 0) ? pre : pre * gl[i - 1], ig = __builtin_amdgcn_rcpf(gam), gr = gC * ig;
            AT[tl * TWS + lane] = f2bf(kkv[i] * gprev); RT[tl * TWS + lane] = f2bf(rs[i] * gam); KT[tl * TWS + lane] = f2bf(kpv[i] * ig); BT[tl * TWS + lane] = f2bf(bbv[i] * ig);
            KH[lane * 20 + tl] = f2bf(kpv[i] * gr); NBH[lane * 20 + tl] = f2bf(-bbv[i] * gr); VT[lane * 20 + tl] = f2bf(vs[i]); } }
        lds_barrier();
        { const __amdgpu_buffer_rsrc_t rs_ = __builtin_amdgcn_make_buffer_rsrc((void*)slot, 0, (int)SLOT_BYTES, 0x00020000);
#pragma unroll
          for (int i = 0; i < 9; ++i) { const int L_ = c.tid * 16 + i * 8192, ch = L_ / 18432, off = L_ - ch * 18432;
              __builtin_amdgcn_raw_buffer_store_b128(*(const LAS u32x4*)(LB + ch * CH_BYTES + off), rs_, (unsigned)L_, 0, 16); }
          if (c.tid < 64) __builtin_amdgcn_raw_buffer_store_b128(*(const LAS u32x4*)(LB + (c.tid >> 4) * CH_BYTES + CH_GC + (c.tid & 15) * 16), rs_, (unsigned)(SLOT_IMG + c.tid * 16), 0, 16);
#pragma unroll
          for (int i = 0; i < 8; ++i) if (lane == i) __hip_atomic_store((unsigned*)(slot + SLOT_IMG + 1024) + w * 8 + i, __float_as_uint(cbv[i]), __ATOMIC_RELAXED, __HIP_MEMORY_SCOPE_AGENT); }
        __syncthreads();
        if (c.tid == 0) __hip_atomic_store(ready, (gblk >> 1) + 1, __ATOMIC_RELAXED, __HIP_MEMORY_SCOPE_AGENT);
    }
}

struct RwSlot { u32x4 img[9]; u32x4 gc; float cb; };
__device__ __forceinline__ void rw_load_slot(RwSlot& R, const unsigned char* slot, int tid, int w, int lane) {
#pragma unroll
    for (int i = 0; i < 9; ++i) R.img[i] = *(const u32x4*)(slot + tid * 16 + i * 8192);
    R.gc = *(const u32x4*)(slot + SLOT_IMG + (tid & 63) * 16);
    R.cb = ((const float*)(slot + SLOT_IMG + 1024))[w * 8 + (lane & 7)];
}

__device__ void rwkv_consumer(const Ctx& c, int l, int bh) {
    const Params& P = *c.P; const int b = bh >> 3, hd = bh & 7, lane = c.lane, w = c.wave, cj = hd * 64 + lane, fr = lane & 15, fq = lane >> 4;
    LAS unsigned char* LB = c.lds;
    LAS float* YY = (LAS float*)(LB + RW_YY);
    bf16_t* g3 = (bf16_t*)(c.ws + OFF_G3);
    const unsigned* ready = (const unsigned*)(c.ws + OFF_BAR + 256) + bh * 128; unsigned* consumed = (unsigned*)(c.ws + OFF_BAR + 256 + 64 * 256) + bh * 64;
    bf16_t* zrw = (bf16_t*)(c.ws + OFF_ZRW); float* cbg = (float*)(c.ws + OFF_CBG);
    const unsigned char* ring = c.ws + OFF_RING + (size_t)bh * RING_SLOTS * SLOT_BYTES;
    f32x4 Macc[4];
#pragma unroll
    for (int i = 0; i < 4; ++i) Macc[i] = (f32x4){0.f, 0.f, 0.f, 0.f};
    RwSlot cur;
    { const unsigned g0 = (unsigned)(l * RW_NBLK);
      if (c.tid == 0) { spin_until_ge(ready + 64 * (g0 & 1), (g0 >> 1) + 1); spin_until_ge(ready + 64 * ((g0 + 1) & 1), ((g0 + 1) >> 1) + 1); __builtin_amdgcn_fence(__ATOMIC_ACQUIRE, "agent"); }
      __syncthreads();
      rw_load_slot(cur, ring + (size_t)(g0 % RING_SLOTS) * SLOT_BYTES, c.tid, w, lane); }
    for (int blk = 0; blk < RW_NBLK; ++blk) {
        const unsigned gblk = (unsigned)(l * RW_NBLK + blk); const size_t t0 = (size_t)b * SEQ + blk * 64;
        float cbv[8];
#pragma unroll
        for (int i = 0; i < 9; ++i) { const int L_ = c.tid * 16 + i * 8192, ch = L_ / 18432, off = L_ - ch * 18432; *(LAS u32x4*)(LB + ch * CH_BYTES + off) = cur.img[i]; }
        if (c.tid < 64) *(LAS u32x4*)(LB + (c.tid >> 4) * CH_BYTES + CH_GC + (c.tid & 15) * 16) = cur.gc;
#pragma unroll
        for (int i = 0; i < 8; ++i) cbv[i] = __builtin_bit_cast(float, __builtin_amdgcn_readlane(__builtin_bit_cast(int, cur.cb), i));
        lds_barrier();
        if (c.tid == 0) __hip_atomic_store(consumed, gblk + 1, __ATOMIC_RELAXED, __HIP_MEMORY_SCOPE_AGENT);
        if (blk + 1 < RW_NBLK) rw_load_slot(cur, ring + (size_t)((gblk + 1) % RING_SLOTS) * SLOT_BYTES, c.tid, w, lane);
        if (w < 4 && true) { LAS unsigned char* CB_ = LB + w * CH_BYTES;
          const LAS bf16_t *AT = (const LAS bf16_t*)(CB_ + CH_AT), *RT = (const LAS bf16_t*)(CB_ + CH_RT), *KT = (const LAS bf16_t*)(CB_ + CH_KT), *BT = (const LAS bf16_t*)(CB_ + CH_BT);
          f32x4 lab = (f32x4){0.f, 0.f, 0.f, 0.f}, lak = lab, lrk = lab, lrb = lab;
#pragma unroll
          for (int ks = 0; ks < 2; ++ks) { const int o = fr * TWS + 32 * ks + 8 * fq;
            const bf16x8 af = *(const LAS bf16x8*)(AT + o), rf = *(const LAS bf16x8*)(RT + o), kf = *(const LAS bf16x8*)(KT + o), bf = *(const LAS bf16x8*)(BT + o);
            lab = __builtin_amdgcn_mfma_f32_16x16x32_bf16(af, bf, lab, 0, 0, 0); lak = __builtin_amdgcn_mfma_f32_16x16x32_bf16(af, kf, lak, 0, 0, 0);
            lrk = __builtin_amdgcn_mfma_f32_16x16x32_bf16(rf, kf, lrk, 0, 0, 0); lrb = __builtin_amdgcn_mfma_f32_16x16x32_bf16(rf, bf, lrb, 0, 0, 0); }
          LAS float *LAB = (LAS float*)(CB_ + CH_LAB), *LAK = (LAS float*)(CB_ + CH_LAK); LAS bf16_t *LRK = (LAS bf16_t*)(CB_ + CH_LRK), *NLRB = (LAS bf16_t*)(CB_ + CH_NLRB);
#pragma unroll
          for (int r = 0; r < 4; ++r) { const int t = 4 * fq + r, s_ = fr; const bool lo_ = t > s_, le_ = t >= s_;
            LAB[t * 16 + s_] = lo_ ? lab[r] : 0.0f; LAK[t * 16 + s_] = lo_ ? lak[r] : 0.0f;
            LRK[t * 24 + s_] = f2bf(le_ ? lrk[r] : 0.0f); NLRB[t * 24 + s_] = f2bf(le_ ? -lrb[r] : 0.0f); } }
        lds_barrier();
        { const int ch6 = w & 3; LAS unsigned char* CB_ = LB + ch6 * CH_BYTES;
          const LAS bf16_t* AT = (const LAS bf16_t*)(CB_ + CH_AT); const LAS float *LAB = (const LAS float*)(CB_ + CH_LAB), *LAK = (const LAS float*)(CB_ + CH_LAK);
          LAS bf16_t *WI = (LAS bf16_t*)(CB_ + CH_KT), *GI = (LAS bf16_t*)(CB_ + CH_GI);
          float xv[16];
          if (w < 4) {
#pragma unroll
            for (int t = 0; t < 16; ++t) xv[t] = bf2f(AT[t * TWS + lane]);
          } else {
#pragma unroll
            for (int t = 0; t < 16; ++t) xv[t] = LAK[t * 16 + fr];
          }
          f32x4 nx[4];
#pragma unroll
          for (int q = 0; q < 4; ++q) nx[q] = *(const LAS f32x4*)(LAB + 16 + 4 * q);
#pragma unroll
          for (int t = 1; t < 16; ++t) { float xa = xv[t]; f32x4 lr[4];
#pragma unroll
            for (int q = 0; q < 4; ++q) lr[q] = nx[q];
            if (t < 15) {
#pragma unroll
              for (int q = 0; q < 4; ++q) if (4 * q < t + 1) nx[q] = *(const LAS f32x4*)(LAB + (t + 1) * 16 + 4 * q); }
            float xb = 0.0f;
#pragma unroll
            for (int q = 0; q < 4; ++q) if (4 * q < t) {
#pragma unroll
              for (int e = 0; e < 4; ++e) if (4 * q + e < t) { if (e & 1) xb -= lr[q][e] * xv[4 * q + e]; else xa -= lr[q][e] * xv[4 * q + e]; } }
            xa += xb;
            xv[t] = xa; asm volatile("" : "+v"(xv[t]), "+v"(nx[0]), "+v"(nx[1]), "+v"(nx[2]), "+v"(nx[3]) :: "memory"); }
          if (w < 4) {
#pragma unroll
            for (int t = 0; t < 16; ++t) WI[t * TWS + lane] = f2bf(xv[t]);
          } else if (lane < 16) {
#pragma unroll
            for (int t = 0; t < 16; ++t) GI[t * 24 + lane] = f2bf(xv[t]);
          } }
        lds_barrier();
        if (w == 4 && lane == 0 && blk + 2 < RW_NBLK) { const unsigned gn = gblk + 2; spin_until_ge(ready + 64 * (gn & 1), (gn >> 1) + 1); __builtin_amdgcn_fence(__ATOMIC_ACQUIRE, "agent"); }
        if (w < 4 && true) {
#pragma unroll
          for (int ch = 0; ch < 4; ++ch) { LAS unsigned char* CB_ = LB + ch * CH_BYTES;
            const LAS bf16_t *RT = (const LAS bf16_t*)(CB_ + CH_RT), *WI = (const LAS bf16_t*)(CB_ + CH_KT), *KH = (const LAS bf16_t*)(CB_ + CH_KH), *NBH = (const LAS bf16_t*)(CB_ + CH_NB),
                             *VT = (const LAS bf16_t*)(CB_ + CH_VT), *LRK = (const LAS bf16_t*)(CB_ + CH_LRK), *NLRB = (const LAS bf16_t*)(CB_ + CH_NLRB), *GI = (const LAS bf16_t*)(CB_ + CH_GI);
            const LAS float* GC = (const LAS float*)(CB_ + CH_GC);
            bf16x8 Mb[2], Wp[2], Rp[2];
#pragma unroll
            for (int ks = 0; ks < 2; ++ks) { Mb[ks] = cat4(pk4(Macc[2 * ks]), pk4(Macc[2 * ks + 1]));
              Wp[ks] = cat4(*(const LAS bf16x4*)(WI + fr * TWS + 32 * ks + 4 * fq), *(const LAS bf16x4*)(WI + fr * TWS + 32 * ks + 16 + 4 * fq));
              Rp[ks] = cat4(*(const LAS bf16x4*)(RT + fr * TWS + 32 * ks + 4 * fq), *(const LAS bf16x4*)(RT + fr * TWS + 32 * ks + 16 + 4 * fq)); }
            const bf16x8 Vb = cat4z(*(const LAS bf16x4*)(VT + (16 * w + fr) * 20 + 4 * fq));
            const bf16x8 Gp = cat4z(*(const LAS bf16x4*)(GI + fr * 24 + 4 * fq)), Lrkp = cat4z(*(const LAS bf16x4*)(LRK + fr * 24 + 4 * fq)), Nlrbp = cat4z(*(const LAS bf16x4*)(NLRB + fr * 24 + 4 * fq));
            f32x4 U = (f32x4){0.f, 0.f, 0.f, 0.f};
            U = __builtin_amdgcn_mfma_f32_16x16x32_bf16(Wp[0], Mb[0], U, 0, 0, 0); U = __builtin_amdgcn_mfma_f32_16x16x32_bf16(Wp[1], Mb[1], U, 0, 0, 0); U = __builtin_amdgcn_mfma_f32_16x16x32_bf16(Gp, Vb, U, 0, 0, 0);
            const bf16x8 Ub = cat4z(pk4(U));
            f32x4 Y = (f32x4){0.f, 0.f, 0.f, 0.f};
            Y = __builtin_amdgcn_mfma_f32_16x16x32_bf16(Rp[0], Mb[0], Y, 0, 0, 0); Y = __builtin_amdgcn_mfma_f32_16x16x32_bf16(Rp[1], Mb[1], Y, 0, 0, 0);
            Y = __builtin_amdgcn_mfma_f32_16x16x32_bf16(Lrkp, Vb, Y, 0, 0, 0); Y = __builtin_amdgcn_mfma_f32_16x16x32_bf16(Nlrbp, Ub, Y, 0, 0, 0);
#pragma unroll
            for (int r = 0; r < 4; ++r) YY[(16 * ch + 4 * fq + r) * 64 + 16 * w + fr] = Y[r];
#pragma unroll
            for (int mt = 0; mt < 4; ++mt) { const f32x4 gc = *(const LAS f32x4*)(GC + 16 * mt + 4 * fq); f32x4 m = Macc[mt] * gc;
              const bf16x8 khp = cat4z(*(const LAS bf16x4*)(KH + (16 * mt + fr) * 20 + 4 * fq)), nbp = cat4z(*(const LAS bf16x4*)(NBH + (16 * mt + fr) * 20 + 4 * fq));
              m = __builtin_amdgcn_mfma_f32_16x16x32_bf16(khp, Vb, m, 0, 0, 0); m = __builtin_amdgcn_mfma_f32_16x16x32_bf16(nbp, Ub, m, 0, 0, 0); Macc[mt] = m; } } }
        lds_barrier();
#pragma unroll
        for (int i = 0; i < 8; ++i) { const int tok = w * 8 + i;
            zrw[(t0 + tok) * ZRW_LD + cj] = f2bf(YY[tok * 64 + lane]);
            if (lane == i) cbg[(t0 + tok) * 8 + hd] = cbv[i]; }
    }
}

__device__ void phase_rwkv_fin(const Ctx& c, int l) {
    const Params& P = *c.P; const bf16_t* zrw = (const bf16_t*)(c.ws + OFF_ZRW); bf16_t* g3 = (bf16_t*)(c.ws + OFF_G3); const float* cbg = (const float*)(c.ws + OFF_CBG);
    const int gw = blockIdx.x * 8 + c.wave, nw = gridDim.x * 8, lane = c.lane;
    for (int item = gw; item < (T / 128) * 8; item += nw) {
        const int hd = item & 7, tg = item >> 3, cj = hd * 64 + lane; const size_t tb = (size_t)tg * 128;
        const float mu_v = P.in[4][(size_t)l * 1664 + 1024 + cj], lnw = P.in[12][l * BW + cj], lnb = P.in[13][l * BW + cj];
        float vprev = ((tb & (SEQ - 1)) == 0) ? 0.0f : bf2f(zrw[(tb - 1) * ZRW_LD + 1024 + cj]);
        for (int t4 = 0; t4 < 128; t4 += 8) {
            float y[8], vv[8], gt[8], cb[8];
#pragma unroll
            for (int i = 0; i < 8; ++i) { const size_t t = tb + t4 + i; y[i] = bf2f(zrw[t * ZRW_LD + cj]); vv[i] = bf2f(zrw[t * ZRW_LD + 1024 + cj]); gt[i] = bf2f(g3[t * G3_LD + cj]); cb[i] = cbg[t * 8 + hd]; }
#pragma unroll
            for (int i = 0; i < 8; ++i) { const size_t t = tb + t4 + i;
                const float vs = vv[i] + mu_v * (vprev - vv[i]); vprev = vv[i];
                const float mean = wave_sum2(y[i]) * (1.0f / 64.0f), ey2 = wave_sum2(y[i] * y[i]) * (1.0f / 64.0f), var = fmaxf(ey2 - mean * mean, 0.0f);
                const float yn = (y[i] - mean) * rsqrtf(var + 64e-5f) * lnw + lnb + cb[i] * vs;
                g3[t * G3_LD + cj] = f2bf(yn * siluf_(gt[i])); }
        }
    }
}

constexpr int RW_WGS = 96;
template <int l, int sp>
__device__ __forceinline__ void run_sub(const Ctx& c, const Params& P, float* ssbase, int G, int cb, unsigned* bar2, unsigned& bar2_target) {
    unsigned char* ws = c.ws;
    if constexpr (sp == 0) {
        if (l == 0) phase_s5_consts(c);
        pg8::Gemm g{(const bf16_t*)(ws + OFF_XN), (const bf16_t*)(ws + OFF_WIN) + (size_t)l * DINP * D, D, D, D}; pg8::Sched S; S.init(T, DINP, G, cb);
        EpiZ E{(bf16_t*)(ws + OFF_ZRW), (bf16_t*)(ws + OFF_G3), (bf16_t*)(ws + OFF_XL), (bf16_t*)(ws + OFF_AS)};
        pg8::gemm_phase(c.lds, g, S, E);
    } else if constexpr (sp == 1) {
        if (cb < 32) rwkv_consumer(c, l, cb); else if (cb < RW_WGS) rwkv_producer(c, l, (cb - 32) & 31, (cb - 32) >> 5);
        else {
            Ctx c2 = c; c2.vb = cb - RW_WGS; c2.vG = G - RW_WGS; const int G2 = G - RW_WGS, cb2 = cb - RW_WGS;
            phase_lru_conv(c2, l);
            { pg8::Gemm g{(const bf16_t*)(ws + OFF_AS), (const bf16_t*)(ws + OFF_S5E) + (size_t)l * 32 * 256 * 256, AS_LD, 256, 256}; pg8::Sched S; S.init(AS_ROWS, 256, G2, cb2, 8);
              EpiE E{(float*)(ws + OFF_E)};
              pg8::gemm_phase(c.lds, g, S, E); }
            grid_bar(bar2, bar2_target, (unsigned)G2);
            phase_s5_carry(c2, l);
            { pg8::Gemm g{(const bf16_t*)(ws + OFF_XC), (const bf16_t*)(ws + OFF_WLRU) + (size_t)l * 1024 * BW, BW, BW, BW}; pg8::Sched S; S.init(T, 1024, G2, cb2);
              EpiLru E{(const bf16_t*)(ws + OFF_XC), P.in[27] + l * BW, P.in[29] + l * BW, P.in[30] + l * BW, (bf16_t*)(ws + OFF_LRUAB)};
              pg8::gemm_phase(c.lds, g, S, E); }
            grid_bar(bar2, bar2_target, (unsigned)G2);
            { pg8::Gemm g{(const bf16_t*)(ws + OFF_AS), (const bf16_t*)(ws + OFF_S5Y) + (size_t)l * 32 * 256 * AS_LD, AS_LD, AS_LD, AS_LD}; pg8::Sched S; S.init(AS_ROWS, 256, G2, cb2, 8);
              EpiY E{(const bf16_t*)(ws + OFF_AS), P.in[21] + l * BW, (bf16_t*)(ws + OFF_ZGS)};
              pg8::gemm_phase(c.lds, g, S, E); }
            phase_lru_scan(c2, 0);
            grid_bar(bar2, bar2_target, (unsigned)G2);
            { pg8::Gemm g{(const bf16_t*)(ws + OFF_ZGS), (const bf16_t*)(ws + OFF_WGLU) + (size_t)l * BW * BW, BW, BW, BW}; pg8::Sched S; S.init(T, BW, G2, cb2);
              EpiGlu E{(const bf16_t*)(ws + OFF_ZGS), P.in[23] + l * BW, (bf16_t*)(ws + OFF_G3)};
              pg8::gemm_phase(c.lds, g, S, E); }
            phase_lru_scan(c2, 1);
            { pg8::Gemm g{(const bf16_t*)(ws + OFF_PB) + (size_t)l * T * DPLE, (const bf16_t*)(ws + OFF_WPLE) + (size_t)l * D * DPLE, DPLE, DPLE, DPLE}; pg8::Sched S; S.init(T, D, G2, cb2);
              EpiPle E{(bf16_t*)(ws + OFF_PW), ssbase + (size_t)l * T};
              pg8::gemm_phase(c.lds, g, S, E); }
        }
    } else if constexpr (sp == 2) {
        phase_rwkv_fin(c, l);
    } else if constexpr (sp == 5) {
        { pg8::Gemm g{(const bf16_t*)(ws + OFF_G3), (const bf16_t*)(ws + OFF_WOUT) + (size_t)l * D * DMIX, DMIX, DMIX, DMIX}; pg8::Sched S; S.init(T, D, G, cb);
          EpiOut E{l == 0 ? P.in[0] : (const float*)P.out, P.out, (bf16_t*)(ws + OFF_H1B)};
          pg8::gemm_phase(c.lds, g, S, E); }
    } else if constexpr (sp == 6) {
        pg8::Gemm g{(const bf16_t*)(ws + OFF_H1B), (const bf16_t*)(ws + OFF_WG) + (size_t)l * D * D, D, D, D}; pg8::Sched S; S.init(T, D, G, cb);
        EpiGate E{P.out, (const bf16_t*)(ws + OFF_PW), ssbase + (size_t)l * T, P.in[33] + l * D, ssbase + (size_t)(2 + l) * T};
        pg8::gemm_phase(c.lds, g, S, E);
    } else {
        phase_norm(c, ssbase + (size_t)(2 + l) * T, l == 0 ? P.in[2] + D : P.in[35], l == 1);
    }
}

constexpr int NPHASE = 1 + 6 * 2;
__global__ void __launch_bounds__(512) hymba_fwd(Params P) {
    extern __shared__ __attribute__((aligned(16))) unsigned char lds_raw[];
    Ctx c; c.P = &P; c.ws = P.ws; c.lds = (LAS unsigned char*)lds_raw; c.ldsg = lds_raw; c.tid = threadIdx.x; c.lane = c.tid & 63; c.wave = __builtin_amdgcn_readfirstlane(c.tid >> 6);
    c.gtid = (size_t)blockIdx.x * 512 + c.tid; c.gsz = (size_t)gridDim.x * 512; c.vb = blockIdx.x; c.vG = gridDim.x;
    unsigned char* ws = P.ws; const int G = gridDim.x, cb = blockIdx.x;
    float* ssbase = (float*)(ws + OFF_SS);
    const int lo = P.ph_lo, hi = P.ph_hi;
    unsigned* barw = (unsigned*)(ws + OFF_BAR); unsigned bar_target = 0; unsigned* bar2 = barw + 32; unsigned bar2_target = 0;
#define PHASE(k, ...) if (((MK_PH_MASK >> (k)) & 1) && lo <= (k) && (k) < hi) { __VA_ARGS__; if ((k) + 1 < hi) { if ((k) == 0) { __threadfence(); cg::this_grid().sync(); } else grid_bar(barw, bar_target, (unsigned)G); } }
    PHASE(0, phase_prep(c))
#define RS(L_, SP_) run_sub<L_, SP_>(c, P, ssbase, G, cb, bar2, bar2_target)
    PHASE(1, RS(0, 0)) PHASE(2, RS(0, 1)) PHASE(3, RS(0, 2)) PHASE(4, RS(0, 5)) PHASE(5, RS(0, 6)) PHASE(6, RS(0, 7))
    PHASE(7, RS(1, 0)) PHASE(8, RS(1, 1)) PHASE(9, RS(1, 2)) PHASE(10, RS(1, 5)) PHASE(11, RS(1, 6)) PHASE(12, RS(1, 7))
#undef RS
#undef PHASE
}

extern "C" void kernel_launch(void* const* d_in, const int* in_sizes, int n_in, void* d_out, int out_size, void* d_ws, size_t ws_size, hipStream_t stream) {
    static int grid = 0;
    if (grid == 0) {
        if (n_in != 36 || out_size != T * D || ws_size < WS_END2) { fprintf(stderr, "kernel_launch: unexpected shapes (n_in %d out %d ws %zu need %zu)\n", n_in, out_size, ws_size, (size_t)WS_END); grid = -1; return; }
        int dev = 0, cus = 0, per_cu = 0;
        hipGetDevice(&dev); hipDeviceGetAttribute(&cus, hipDeviceAttributeMultiprocessorCount, dev);
        hipFuncSetAttribute((const void*)hymba_fwd, hipFuncAttributeMaxDynamicSharedMemorySize, LDS_BYTES);
        hipOccupancyMaxActiveBlocksPerMultiprocessor(&per_cu, (const void*)hymba_fwd, 512, LDS_BYTES);
        if (per_cu < 1) per_cu = 1;
        grid = cus * per_cu; if (grid > 256) grid = 256;
        (void)hipGetLastError();
    }
    if (grid < 0) return;
    (void)hipMemsetAsync((char*)d_ws + OFF_BAR, 0, CTL_BYTES, stream);
    Params p{};
    for (int i = 0; i < 36; ++i) p.in[i] = (const float*)d_in[i];
    p.out = (float*)d_out; p.ws = (unsigned char*)d_ws;
#if MK_PER_PHASE
    for (int ph = 0; ph < NPHASE; ++ph) { p.ph_lo = ph; p.ph_hi = ph + 1; hipLaunchKernelGGL(hymba_fwd, dim3(grid), dim3(512), LDS_BYTES, stream, p); }
#else
    p.ph_lo = 0; p.ph_hi = NPHASE;
    void* args[] = {&p};
    hipError_t e = hipLaunchCooperativeKernel((const void*)hymba_fwd, dim3(grid), dim3(512), args, LDS_BYTES, stream);
    if (e != hipSuccess) fprintf(stderr, "cooperative launch failed: %s (grid %d)\n", hipGetErrorString(e), grid);
#endif
}
```

```cpp
#include <hip/hip_runtime.h>
#include <hip/hip_cooperative_groups.h>
#include <cstdio>
namespace cg = cooperative_groups;

#ifndef MK_PER_PHASE
#define MK_PER_PHASE 0
#endif

#ifndef MK_PH_MASK
#define MK_PH_MASK 0x1fff
#endif
#ifndef MK_DUP
#define MK_DUP 0
#endif
#ifndef RW_OFF
#define RW_OFF 0
#endif
#ifndef MK_OFF
#define MK_OFF 0
#endif
#define LAS __attribute__((address_space(3)))
typedef unsigned short bf16_t;
typedef short bf16x8 __attribute__((ext_vector_type(8)));
typedef float f32x4 __attribute__((ext_vector_type(4)));
typedef unsigned u32x4 __attribute__((ext_vector_type(4)));
typedef unsigned u32x2 __attribute__((ext_vector_type(2)));

constexpr int T = 32768, D = 1024, SEQ = 8192, NB = 4, BW = 512;
constexpr int DIN = 4224, DINP = 4352, DMIX = 1536, DPLE = 256;
constexpr int ZRW_LD = 1792, G3_LD = 1536, AS_LD = 384, AS_ROWS = 65536;
constexpr int LDS_BYTES = 155648;

constexpr size_t al256(size_t x) { return (x + 255) & ~(size_t)255; }
constexpr size_t SZ_WIN = (size_t)2 * DINP * D * 2, SZ_WOUT = (size_t)2 * D * DMIX * 2, SZ_WG = (size_t)2 * D * D * 2, SZ_WPLE = (size_t)2 * D * DPLE * 2,
                 SZ_WGLU = (size_t)2 * BW * BW * 2, SZ_WLRU = (size_t)2 * 1024 * BW * 2, SZ_S5Y = (size_t)2 * 32 * 256 * AS_LD * 2, SZ_S5E = (size_t)2 * 32 * 256 * 256 * 2,
                 SZ_TBL = (size_t)2 * 32 * 64 * 18 * 8, SZ_PB = (size_t)2 * T * DPLE * 2, SZ_XN = (size_t)T * D * 2, SZ_ZRW = (size_t)T * ZRW_LD * 2, SZ_G3 = (size_t)T * G3_LD * 2,
                 SZ_XL = (size_t)T * BW * 2, SZ_AS = (size_t)AS_ROWS * AS_LD * 2, SZ_LRUAB = (size_t)T * 1024 * 2, SZ_AGG = (size_t)NB * 128 * 1024 * 4, SZ_SS = (size_t)4 * T * 4;
constexpr size_t OFF_WIN = 0, OFF_WOUT = OFF_WIN + SZ_WIN, OFF_WG = OFF_WOUT + SZ_WOUT, OFF_WPLE = OFF_WG + SZ_WG, OFF_WGLU = OFF_WPLE + SZ_WPLE, OFF_WLRU = OFF_WGLU + SZ_WGLU,
                 OFF_S5Y = OFF_WLRU + SZ_WLRU, OFF_S5E = OFF_S5Y + SZ_S5Y, OFF_TBL = OFF_S5E + SZ_S5E, OFF_PB = al256(OFF_TBL + SZ_TBL), OFF_XN = OFF_PB + SZ_PB,
                 OFF_ZRW = OFF_XN + SZ_XN, OFF_G3 = OFF_ZRW + SZ_ZRW, OFF_XL = OFF_G3 + SZ_G3, OFF_AS = OFF_XL + SZ_XL, OFF_LRUAB = OFF_AS + SZ_AS, OFF_AGG = OFF_LRUAB + SZ_LRUAB,
                 OFF_SS = OFF_AGG + SZ_AGG, WS_END = OFF_SS + SZ_SS;
constexpr size_t OFF_BAR = WS_END, CTL_BYTES = 256 + 96 * 256;
constexpr size_t RING_SLOTS = 3, SLOT_IMG = 4 * 18432, SLOT_BYTES = SLOT_IMG + 4 * 256 + 256;
constexpr size_t OFF_RING = OFF_BAR + CTL_BYTES, OFF_CBG = OFF_RING + 32 * RING_SLOTS * SLOT_BYTES, WS_END2 = OFF_CBG + (size_t)T * 8 * 4;
constexpr size_t OFF_E = OFF_XN, OFF_XC = OFF_XN + (size_t)AS_ROWS * 128 * 4, OFF_H1B = OFF_ZRW, OFF_PW = OFF_XN, OFF_ZGS = OFF_XL;
static_assert(OFF_XC + (size_t)T * BW * 2 <= OFF_ZRW, "alias overflow");

struct Params {
    const float* in[36];
    float* out;
    unsigned char* ws;
    int ph_lo, ph_hi;
};

__device__ __forceinline__ float bf2f(bf16_t v) { return __uint_as_float(((unsigned)v) << 16); }
__device__ __forceinline__ bf16_t f2bf_sw(float f) { unsigned u = __float_as_uint(f); u += 0x7FFFu + ((u >> 16) & 1u); return (bf16_t)(u >> 16); }
typedef float f32x2_ __attribute__((ext_vector_type(2)));
typedef __bf16 b16x2_ __attribute__((ext_vector_type(2)));
__device__ __forceinline__ unsigned cvt_pk_bf16(float lo, float hi) { const f32x2_ v = {lo, hi}; return __builtin_bit_cast(unsigned, __builtin_convertvector(v, b16x2_)); }
__device__ __forceinline__ bf16_t f2bf(float f) { return (bf16_t)cvt_pk_bf16(f, f); }
__device__ __forceinline__ float lo16(unsigned u) { return __uint_as_float(u << 16); }
__device__ __forceinline__ float hi16(unsigned u) { return __uint_as_float(u & 0xffff0000u); }
__device__ __forceinline__ float sigmoidf_(float x) { return __builtin_amdgcn_rcpf(1.0f + __expf(-x)); }
__device__ __forceinline__ float siluf_(float x) { return x * sigmoidf_(x); }
__device__ __forceinline__ float softplusf_(float x) { return fmaxf(x, 0.0f) + log1pf(__expf(-fabsf(x))); }
__device__ __forceinline__ float gelu_tanh(float x) { const float u2 = 1.5957691216057308f * (x + 0.044715f * x * x * x); return x * sigmoidf_(u2); }
__device__ __forceinline__ float wave_sum(float v) {
#pragma unroll
    for (int o = 32; o > 0; o >>= 1) v += __shfl_xor(v, o);
    return v;
}
__device__ __forceinline__ void unpack8(const u32x4 w, float (&f)[8]) {
    f[0] = lo16(w.x); f[1] = hi16(w.x); f[2] = lo16(w.y); f[3] = hi16(w.y); f[4] = lo16(w.z); f[5] = hi16(w.z); f[6] = lo16(w.w); f[7] = hi16(w.w);
}
__device__ __forceinline__ u32x4 pack8(const float (&f)[8]) {
    u32x4 w; w.x = cvt_pk_bf16(f[0], f[1]); w.y = cvt_pk_bf16(f[2], f[3]); w.z = cvt_pk_bf16(f[4], f[5]); w.w = cvt_pk_bf16(f[6], f[7]); return w;
}


__device__ __forceinline__ void grid_bar(unsigned* ctr, unsigned& target, unsigned nblk) {
    __syncthreads();
    if (threadIdx.x == 0) {
        target += nblk;
        __builtin_amdgcn_fence(__ATOMIC_RELEASE, "agent");
        __hip_atomic_fetch_add(ctr, 1u, __ATOMIC_RELAXED, __HIP_MEMORY_SCOPE_AGENT);
        while (__hip_atomic_load(ctr, __ATOMIC_RELAXED, __HIP_MEMORY_SCOPE_AGENT) < target) __builtin_amdgcn_s_sleep(1);
        __builtin_amdgcn_fence(__ATOMIC_ACQUIRE, "agent");
    }
    __syncthreads();
}

namespace pg8 {
constexpr int BM = 256, BK = 64, HALF = 128, HTB = HALF * BK * 2, STAGE_BYTES = 8 * HTB, NXCD = 8, WGM = 8;
__host__ __device__ __forceinline__ int lds_byte(int r, int c) { const int st = (r >> 4) * 2 + (c >> 5), rr = r & 15, cc = c & 31, ob = rr * 64 + cc * 2; return st * 1024 + (ob ^ (((ob >> 9) & 1) << 5)); }
__host__ __device__ __forceinline__ void stage_rc(int b, int& R, int& C) { const int st = b / 1024, sb = b % 1024, swz = sb ^ (((sb >> 9) & 1) << 5); R = (st >> 1) * 16 + swz / 64; C = (st & 1) * 32 + (swz % 64) / 2; }
__host__ __device__ __forceinline__ int perm32(int rho) { const int n = rho >> 4, i = rho & 15; return 8 * (i >> 2) + 4 * n + (i & 3); }

struct Unit { int pm, pn, pb; };
struct Gemm { const bf16_t* A; const bf16_t* Bt; int lda, ldb, K; };

struct Sched {
    int nM, nN, nwg, G, c, grp;
    __device__ void init(int M, int N, int G_, int c_, int grp_ = 0) { nM = M / BM; nN = N / BM; nwg = nM * nN; G = G_; c = c_; grp = grp_; }
    __device__ bool next(int i, Unit& u) const {
        const long L = (long)i * G + c; if (L >= nwg) return false;
        int wgid = (int)L; { const int q = nwg / NXCD, r = nwg % NXCD, xcd = wgid % NXCD, off = wgid / NXCD; wgid = (xcd < r ? xcd * (q + 1) : r * (q + 1) + (xcd - r) * q) + off; }
        const int nig = WGM * nN, gid = wgid / nig, fm = gid * WGM, gsz = (nM - fm) < WGM ? (nM - fm) : WGM;
        u.pm = fm + ((wgid % nig) % gsz); u.pn = (wgid % nig) / gsz; u.pb = grp ? (u.pm / grp) * nN + u.pn : u.pn; return true;
    }
};

template <class Epi>
__device__ __forceinline__ void gemm_phase(LAS unsigned char* lds, const Gemm g, const Sched& S, const Epi& E) {
    const int tid = threadIdx.x, wid = __builtin_amdgcn_readfirstlane(tid >> 6), lane = tid & 63, wr = wid >> 2, wc = wid & 3, fr = lane & 15, fq = lane >> 4;
    const int K = g.K, nt = K / BK;
    unsigned voffA[2], voffB[2];
#pragma unroll
    for (int i = 0; i < 2; ++i) { int R, C; stage_rc(tid * 16 + i * 8192, R, C); const int Rb = Epi::PERM ? ((R & ~31) + perm32(R & 31)) : R;
        voffA[i] = (unsigned)(R * g.lda + C) * 2u; voffB[i] = (unsigned)(Rb * g.ldb + C) * 2u; }
    const size_t kstep = (size_t)(BK * 2);
    const size_t hstepA = (size_t)HALF * g.lda * 2, hstepB = (size_t)HALF * g.ldb * 2;
    const size_t tstepA = 2 * hstepA, tstepB = 2 * hstepB;
    const unsigned ldsw = (unsigned)wid * 1024u;
    const int aoff = lds_byte(wr * 64 + fr, fq * 8), boff = lds_byte(wc * 32 + fr, fq * 8);
#define PG8_SA(b, h) (((b) * 2 + (h)) * HTB)
#define PG8_SB(b, h) ((4 + (b) * 2 + (h)) * HTB)
#define PG8_STAGE(bufoff, gbase, voff) do { _Pragma("unroll") for (int _i = 0; _i < 2; ++_i) \
        __builtin_amdgcn_global_load_lds((const unsigned*)((const char*)(gbase) + (voff)[_i]), (LAS unsigned*)(lds + (bufoff) + ldsw + _i * 8192), 16, 0, 0); } while (0)
#define PG8_LDA(dst, b, h) do { _Pragma("unroll") for (int m = 0; m < 4; ++m) _Pragma("unroll") for (int k = 0; k < 2; ++k) dst[m][k] = *(const LAS bf16x8*)(lds + PG8_SA(b, h) + aoff + m * 2048 + k * 1024); } while (0)
#define PG8_LDB(dst, b, h) do { _Pragma("unroll") for (int n = 0; n < 2; ++n) _Pragma("unroll") for (int k = 0; k < 2; ++k) dst[n][k] = *(const LAS bf16x8*)(lds + PG8_SB(b, h) + boff + n * 2048 + k * 1024); } while (0)
#define PG8_MMA(ai, bj, At, Bt) do { __builtin_amdgcn_s_setprio(1); _Pragma("unroll") for (int m = 0; m < 4; ++m) _Pragma("unroll") for (int n = 0; n < 2; ++n) _Pragma("unroll") for (int k = 0; k < 2; ++k) \
        acc[ai][bj][m][n] = __builtin_amdgcn_mfma_f32_16x16x32_bf16(Bt[n][k], At[m][k], acc[ai][bj][m][n], 0, 0, 0); __builtin_amdgcn_s_setprio(0); } while (0)
#define PG8_WAIT_V(n) asm volatile("s_waitcnt vmcnt(" #n ")" ::: "memory")
#define PG8_WAIT_L(n) asm volatile("s_waitcnt lgkmcnt(" #n ")" ::: "memory")
#define PG8_BAR __builtin_amdgcn_s_barrier()
#define PG8_SCHED __builtin_amdgcn_sched_barrier(0)
    Unit cur, nxt; int ui = 0;
    if (!S.next(0, cur)) return;
    f32x4 acc[2][2][4][2];
#pragma unroll
    for (int a = 0; a < 2; ++a)
#pragma unroll
        for (int b = 0; b < 2; ++b)
#pragma unroll
            for (int m = 0; m < 4; ++m)
#pragma unroll
                for (int n = 0; n < 2; ++n) acc[a][b][m][n] = (f32x4){0.f, 0.f, 0.f, 0.f};
    bf16x8 At[4][2], B0[2][2], B1[2][2];
    const char* cA = (const char*)g.A + (size_t)cur.pm * tstepA; const char* cB = (const char*)g.Bt + (size_t)cur.pb * tstepB;
    PG8_STAGE(PG8_SB(0, 0), cB, voffB); PG8_STAGE(PG8_SA(0, 0), cA, voffA); PG8_STAGE(PG8_SB(0, 1), cB + hstepB, voffB); PG8_STAGE(PG8_SA(0, 1), cA + hstepA, voffA);
    if (wr == 1) PG8_BAR;
    PG8_WAIT_V(4); PG8_BAR;
    PG8_STAGE(PG8_SB(1, 0), cB + kstep, voffB); PG8_STAGE(PG8_SA(1, 0), cA + kstep, voffA); PG8_STAGE(PG8_SB(1, 1), cB + hstepB + kstep, voffB);
    PG8_WAIT_V(6); PG8_BAR;
    for (;;) {
        const bool has_next = S.next(ui + 1, nxt);
        const char* nA = has_next ? (const char*)g.A + (size_t)nxt.pm * tstepA : cA; const char* nB = has_next ? (const char*)g.Bt + (size_t)nxt.pb * tstepB : cB;
#pragma unroll 1
        for (int t = 0; t < nt; t += 2) {
            const bool last = (t == nt - 2);
            const char* a1 = cA + (size_t)(t + 1) * kstep;
            const char* a2 = last ? nA : cA + (size_t)(t + 2) * kstep; const char* b2 = last ? nB : cB + (size_t)(t + 2) * kstep;
            const char* a3 = a2 + kstep; const char* b3 = b2 + kstep;
            PG8_LDB(B0, 0, 0); PG8_SCHED; PG8_LDA(At, 0, 0); PG8_STAGE(PG8_SA(1, 1), a1 + hstepA, voffA);
            PG8_WAIT_L(8); PG8_BAR; PG8_WAIT_L(0); PG8_MMA(0, 0, At, B0); PG8_BAR; PG8_SCHED;
            PG8_LDB(B1, 0, 1); PG8_STAGE(PG8_SB(0, 0), b2, voffB);
            PG8_BAR; PG8_WAIT_L(0); PG8_MMA(0, 1, At, B1); PG8_BAR;
            PG8_LDA(At, 0, 1); PG8_STAGE(PG8_SA(0, 0), a2, voffA);
            PG8_BAR; PG8_WAIT_L(0); PG8_MMA(1, 0, At, B0); PG8_BAR; PG8_SCHED;
            PG8_STAGE(PG8_SB(0, 1), b2 + hstepB, voffB);
            PG8_WAIT_V(6); PG8_BAR; PG8_MMA(1, 1, At, B1); PG8_BAR;
            PG8_LDB(B0, 1, 0); PG8_SCHED; PG8_LDA(At, 1, 0); PG8_STAGE(PG8_SA(0, 1), a2 + hstepA, voffA);
            PG8_WAIT_L(8); PG8_BAR; PG8_WAIT_L(0); PG8_MMA(0, 0, At, B0); PG8_BAR; PG8_SCHED;
            PG8_LDB(B1, 1, 1); PG8_STAGE(PG8_SB(1, 0), b3, voffB);
            PG8_BAR; PG8_WAIT_L(0); PG8_MMA(0, 1, At, B1); PG8_BAR;
            PG8_LDA(At, 1, 1); PG8_STAGE(PG8_SA(1, 0), a3, voffA);
            PG8_BAR; PG8_WAIT_L(0); PG8_MMA(1, 0, At, B0); PG8_BAR; PG8_SCHED;
            PG8_STAGE(PG8_SB(1, 1), b3 + hstepB, voffB);
            PG8_WAIT_V(6); PG8_BAR; PG8_MMA(1, 1, At, B1); PG8_BAR;
        }
        { int fr_ = fr, fq_ = fq; asm volatile("" : "+v"(fr_), "+v"(fq_)); E(acc, cur, wr, wc, fr_, fq_); }
        if (!has_next) break;
#pragma unroll
        for (int a = 0; a < 2; ++a)
#pragma unroll
            for (int b = 0; b < 2; ++b)
#pragma unroll
                for (int m = 0; m < 4; ++m)
#pragma unroll
                    for (int n = 0; n < 2; ++n) acc[a][b][m][n] = (f32x4){0.f, 0.f, 0.f, 0.f};
        cur = nxt; cA = nA; cB = nB; ++ui;
    }
    PG8_WAIT_V(0);
    if (wr == 0) PG8_BAR;
    PG8_BAR;
#undef PG8_SA
#undef PG8_SB
#undef PG8_STAGE
#undef PG8_LDA
#undef PG8_LDB
#undef PG8_MMA
#undef PG8_WAIT_V
#undef PG8_WAIT_L
#undef PG8_BAR
#undef PG8_SCHED
}
}
using pg8::Unit; using pg8::HALF;
typedef const f32x4 (&AccRef)[2][2][4][2];

struct EpiZ {
    static constexpr bool PERM = true;
    bf16_t *zrw, *g3, *xl, *as;
    __device__ __forceinline__ void operator()(AccRef acc, const Unit& u, int wr, int wc, int fr, int fq) const {
        const int row0 = u.pm * 256 + wr * 64 + fr, colt = wc * 32 + 8 * fq, pn = u.pn;
        if (pn == 9 || pn == 10) {
#pragma unroll
            for (int ai = 0; ai < 2; ++ai)
#pragma unroll
                for (int m = 0; m < 4; ++m) { const int row = row0 + ai * HALF + m * 16; const int b = row >> 13, l = row & 8191;
#pragma unroll
                    for (int bj = 0; bj < 2; ++bj) { const int c = (pn - 9) * 256 + bj * HALF + colt; const int g = c >> 4, h0 = c & 15;
                        const size_t asrow = (size_t)g * 2048 + b * 512 + (l >> 4);
                        const f32x4 v0 = acc[ai][bj][m][0], v1 = acc[ai][bj][m][1];
                        u32x4 w; w.x = cvt_pk_bf16(v0[0], v0[1]); w.y = cvt_pk_bf16(v0[2], v0[3]); w.z = cvt_pk_bf16(v1[0], v1[1]); w.w = cvt_pk_bf16(v1[2], v1[3]);
                        *(u32x4*)(as + asrow * AS_LD + (l & 15) * 16 + h0) = w; } }
            return;
        }
        bf16_t* base; int ld, c0;
        if (pn < 7) { base = zrw; ld = ZRW_LD; c0 = pn * 256; }
        else if (pn < 9) { base = g3; ld = G3_LD; c0 = (pn - 7) * 256; }
        else if (pn < 13) { base = g3; ld = G3_LD; c0 = 512 + (pn - 11) * 256; }
        else if (pn < 15) { base = xl; ld = BW; c0 = (pn - 13) * 256; }
        else { base = g3; ld = G3_LD; c0 = 1024 + (pn - 15) * 256; }
#pragma unroll
        for (int ai = 0; ai < 2; ++ai)
#pragma unroll
            for (int m = 0; m < 4; ++m) { bf16_t* rowp = base + (size_t)(row0 + ai * HALF + m * 16) * ld + c0 + colt;
#pragma unroll
                for (int bj = 0; bj < 2; ++bj) { const f32x4 v0 = acc[ai][bj][m][0], v1 = acc[ai][bj][m][1];
                    u32x4 w; w.x = cvt_pk_bf16(v0[0], v0[1]); w.y = cvt_pk_bf16(v0[2], v0[3]); w.z = cvt_pk_bf16(v1[0], v1[1]); w.w = cvt_pk_bf16(v1[2], v1[3]);
                    *(u32x4*)(rowp + bj * HALF) = w; } }
    }
};
struct EpiPle {
    static constexpr bool PERM = true;
    bf16_t* pw; float* ss;
    __device__ __forceinline__ void operator()(AccRef acc, const Unit& u, int wr, int wc, int fr, int fq) const {
        const int row0 = u.pm * 256 + wr * 64 + fr, col0 = u.pn * 256 + wc * 32 + 8 * fq;
#pragma unroll
        for (int ai = 0; ai < 2; ++ai)
#pragma unroll
            for (int m = 0; m < 4; ++m) { const int row = row0 + ai * HALF + m * 16; bf16_t* rowp = pw + (size_t)row * D + col0; float s = 0.f;
#pragma unroll
                for (int bj = 0; bj < 2; ++bj) { const f32x4 v0 = acc[ai][bj][m][0], v1 = acc[ai][bj][m][1];
                    s += v0[0] * v0[0] + v0[1] * v0[1] + v0[2] * v0[2] + v0[3] * v0[3] + v1[0] * v1[0] + v1[1] * v1[1] + v1[2] * v1[2] + v1[3] * v1[3];
                    u32x4 w; w.x = cvt_pk_bf16(v0[0], v0[1]); w.y = cvt_pk_bf16(v0[2], v0[3]); w.z = cvt_pk_bf16(v1[0], v1[1]); w.w = cvt_pk_bf16(v1[2], v1[3]);
                    *(u32x4*)(rowp + bj * HALF) = w; }
                s += __shfl_xor(s, 16); s += __shfl_xor(s, 32);
                if (fq == 0) unsafeAtomicAdd(ss + row, s);
                asm volatile("" ::: "memory"); }
    }
};
struct EpiE {
    static constexpr bool PERM = false;
    float* e;
    __device__ __forceinline__ void operator()(AccRef acc, const Unit& u, int wr, int wc, int fr, int fq) const {
        const int row0 = u.pm * 256 + wr * 64 + fr, col0 = wc * 32 + 4 * fq;
#pragma unroll
        for (int ai = 0; ai < 2; ++ai)
#pragma unroll
            for (int m = 0; m < 4; ++m) { float* rowp = e + (size_t)(row0 + ai * HALF + m * 16) * 128 + col0;
#pragma unroll
                for (int n = 0; n < 2; ++n) *(f32x4*)(rowp + n * 16) = acc[ai][0][m][n]; }
    }
};
struct EpiY {
    static constexpr bool PERM = true;
    const bf16_t* as; const float* dvec; bf16_t* zgs;
    __device__ __forceinline__ void operator()(AccRef acc, const Unit& u, int wr, int wc, int fr, int fq) const {
        const int row0 = u.pm * 256 + wr * 64 + fr, colt = wc * 32 + 8 * fq, g = u.pm >> 3, h0 = (8 * fq) & 15;
        const f32x4 d0 = *(const f32x4*)(dvec + g * 16 + h0), d1 = *(const f32x4*)(dvec + g * 16 + h0 + 4);
#pragma unroll
        for (int ai = 0; ai < 2; ++ai)
#pragma unroll
            for (int m = 0; m < 4; ++m) { const int row = row0 + ai * HALF + m * 16; const int b = (row >> 9) & 3, ch = row & 511;
#pragma unroll
                for (int bj = 0; bj < 2; ++bj) { const int c = bj * HALF + colt, tt = c >> 4;
                    float uu[8]; unpack8(*(const u32x4*)(as + (size_t)row * AS_LD + c), uu);
                    const f32x4 v0 = acc[ai][bj][m][0], v1 = acc[ai][bj][m][1];
                    float o[8];
#pragma unroll
                    for (int j = 0; j < 4; ++j) { o[j] = gelu_tanh(v0[j] + d0[j] * uu[j]); o[4 + j] = gelu_tanh(v1[j] + d1[j] * uu[4 + j]); }
                    const size_t tok = (size_t)b * SEQ + ch * 16 + tt;
                    *(u32x4*)(zgs + tok * BW + g * 16 + h0) = pack8(o); }
                asm volatile("" ::: "memory"); }
    }
};
struct EpiGlu {
    static constexpr bool PERM = true;
    const bf16_t* zgs; const float* bias; bf16_t* g3;
    __device__ __forceinline__ void operator()(AccRef acc, const Unit& u, int wr, int wc, int fr, int fq) const {
        const int row0 = u.pm * 256 + wr * 64 + fr, col0 = u.pn * 256 + wc * 32 + 8 * fq;
#pragma unroll
        for (int ai = 0; ai < 2; ++ai)
#pragma unroll
            for (int m = 0; m < 4; ++m) { const size_t row = (size_t)(row0 + ai * HALF + m * 16);
#pragma unroll
                for (int bj = 0; bj < 2; ++bj) { const int c = col0 + bj * HALF;
                    float z[8], gt[8]; unpack8(*(const u32x4*)(zgs + row * BW + c), z); bf16_t* gp = g3 + row * G3_LD + 512 + c; unpack8(*(const u32x4*)gp, gt);
                    const f32x4 b0 = *(const f32x4*)(bias + c), b1 = *(const f32x4*)(bias + c + 4);
                    const f32x4 v0 = acc[ai][bj][m][0], v1 = acc[ai][bj][m][1];
                    float o[8];
#pragma unroll
                    for (int j = 0; j < 4; ++j) { o[j] = z[j] * sigmoidf_(v0[j] + b0[j]) * siluf_(gt[j]); o[4 + j] = z[4 + j] * sigmoidf_(v1[j] + b1[j]) * siluf_(gt[4 + j]); }
                    *(u32x4*)gp = pack8(o); } }
    }
};
struct EpiLru {
    static constexpr bool PERM = true;
    const bf16_t* xc; const float *ba, *bx, *lam; bf16_t* ab;
    __device__ __forceinline__ void operator()(AccRef acc, const Unit& u, int wr, int wc, int fr, int fq) const {
        const int row0 = u.pm * 256 + wr * 64 + fr, ch = u.pn * 128 + wc * 32 + 8 * fq;
        float bav[8], bxv[8], spl[8];
#pragma unroll
        for (int j = 0; j < 8; ++j) { bav[j] = ba[ch + j]; bxv[j] = bx[ch + j]; spl[j] = -8.0f * softplusf_(-lam[ch + j]); }
#pragma unroll
        for (int ai = 0; ai < 2; ++ai)
#pragma unroll
            for (int m = 0; m < 4; ++m) { const size_t row = (size_t)(row0 + ai * HALF + m * 16);
                float x[8]; unpack8(*(const u32x4*)(xc + row * BW + ch), x);
                float la[8], bb[8];
#pragma unroll
                for (int j = 0; j < 8; ++j) { const float za = acc[ai][0][m][j >> 2][j & 3], zx = acc[ai][1][m][j >> 2][j & 3];
                    const float r = sigmoidf_(za + bav[j]), ig = sigmoidf_(zx + bxv[j]);
                    const float l_a = spl[j] * r; la[j] = l_a;
                    bb[j] = sqrtf(fmaxf(-expm1f(2.0f * l_a), 0.0f)) * (ig * x[j]); }
                *(u32x4*)(ab + row * 1024 + ch) = pack8(la); *(u32x4*)(ab + row * 1024 + 512 + ch) = pack8(bb); }
    }
};
struct EpiOut {
    static constexpr bool PERM = true;
    const float* hin; float* h; bf16_t* h1b;
    __device__ __forceinline__ void operator()(AccRef acc, const Unit& u, int wr, int wc, int fr, int fq) const {
        const int row0 = u.pm * 256 + wr * 64 + fr, col0 = u.pn * 256 + wc * 32 + 8 * fq;
#pragma unroll
        for (int ai = 0; ai < 2; ++ai)
#pragma unroll
            for (int m = 0; m < 4; ++m) { const size_t off = (size_t)(row0 + ai * HALF + m * 16) * D + col0;
#pragma unroll
                for (int bj = 0; bj < 2; ++bj) { const size_t o = off + bj * HALF;
                    const f32x4 v0 = *(const f32x4*)(hin + o) + acc[ai][bj][m][0], v1 = *(const f32x4*)(hin + o + 4) + acc[ai][bj][m][1];
                    *(f32x4*)(h + o) = v0; *(f32x4*)(h + o + 4) = v1;
                    u32x4 w; w.x = cvt_pk_bf16(v0[0], v0[1]); w.y = cvt_pk_bf16(v0[2], v0[3]); w.z = cvt_pk_bf16(v1[0], v1[1]); w.w = cvt_pk_bf16(v1[2], v1[3]); *(u32x4*)(h1b + o) = w; }
                asm volatile("" ::: "memory"); }
    }
};
struct EpiGate {
    static constexpr bool PERM = true;
    float* h; const bf16_t* pw; const float* ssp; const float* gple; float* ssh;
    __device__ __forceinline__ void operator()(AccRef acc, const Unit& u, int wr, int wc, int fr, int fq) const {
        const int row0 = u.pm * 256 + wr * 64 + fr, col0 = u.pn * 256 + wc * 32 + 8 * fq;
        f32x4 gv[2][2];
#pragma unroll
        for (int bj = 0; bj < 2; ++bj)
#pragma unroll
            for (int n = 0; n < 2; ++n) gv[bj][n] = *(const f32x4*)(gple + col0 + bj * HALF + 4 * n);
#pragma unroll
        for (int ai = 0; ai < 2; ++ai)
#pragma unroll
            for (int m = 0; m < 4; ++m) { const int row = row0 + ai * HALF + m * 16; const size_t off = (size_t)row * D + col0;
                const float rs = rsqrtf(ssp[row] * (1.0f / 1024.0f) + 1e-6f); float s = 0.f;
#pragma unroll
                for (int bj = 0; bj < 2; ++bj) { const size_t o = off + bj * HALF; float pv[8]; unpack8(*(const u32x4*)(pw + o), pv);
#pragma unroll
                    for (int n = 0; n < 2; ++n) { const f32x4 a = acc[ai][bj][m][n]; f32x4 v = *(const f32x4*)(h + o + 4 * n);
#pragma unroll
                        for (int j = 0; j < 4; ++j) { v[j] += pv[4 * n + j] * rs * gv[bj][n][j] * sigmoidf_(a[j]); s += v[j] * v[j]; }
                        *(f32x4*)(h + o + 4 * n) = v; } }
                s += __shfl_xor(s, 16); s += __shfl_xor(s, 32);
                if (fq == 0) unsafeAtomicAdd(ssh + row, s); }
    }
};

struct Ctx { const Params* P; unsigned char* ws; LAS unsigned char* lds; unsigned char* ldsg; int tid, lane, wave; size_t gtid, gsz; int vb, vG; };

template <class Map>
__device__ void transpose_w(const Ctx& c, const float* src, bf16_t* dst, int K, int Nsrc, int Npad, Map map) {
    const int K8 = K / 8; const size_t total = (size_t)2 * Npad * K8;
    for (size_t idx = c.gtid; idx < total; idx += c.gsz) {
        const int n = (int)(idx % Npad); const int k8 = (int)((idx / Npad) % K8); const int l = (int)(idx / ((size_t)Npad * K8));
        const int s = map(n); float f[8];
#pragma unroll
        for (int i = 0; i < 8; ++i) f[i] = (s >= 0) ? src[((size_t)l * K + k8 * 8 + i) * Nsrc + s] : 0.0f;
        *(u32x4*)(dst + ((size_t)l * Npad + n) * K + k8 * 8) = pack8(f);
    }
}

__device__ __forceinline__ void s5_lam_pow(const Params& P, int l, int g, int p, int n, float& re, float& im) {
    const float are = P.in[14][(l * 32 + g) * 64 + p], aim = P.in[15][(l * 32 + g) * 64 + p], dt = __expf(P.in[16][l * 32 + g]);
    const float mag = __expf(are * dt * (float)n);
    double rev = (double)aim * (double)dt * (double)n * 0.15915494309189535; rev -= rint(rev);
    const float ang = (float)(rev * 6.283185307179586);
    re = mag * cosf(ang); im = mag * sinf(ang);
}

__device__ void phase_prep(const Ctx& c) {
    const Params& P = *c.P; unsigned char* ws = c.ws;
    transpose_w(c, P.in[3], (bf16_t*)(ws + OFF_WIN), D, DIN, DINP, [](int n) { return n < 1664 ? n : (n < 1792 ? -1 : n - 128); });
    transpose_w(c, P.in[31], (bf16_t*)(ws + OFF_WOUT), DMIX, D, D, [](int n) { return n; });
    transpose_w(c, P.in[34], (bf16_t*)(ws + OFF_WG), D, D, D, [](int n) { return n; });
    transpose_w(c, P.in[32], (bf16_t*)(ws + OFF_WPLE), DPLE, D, D, [](int n) { return n; });
    transpose_w(c, P.in[22], (bf16_t*)(ws + OFF_WGLU), BW, BW, BW, [](int n) { return n; });
    { bf16_t* dst = (bf16_t*)(ws + OFF_WLRU);
      for (size_t idx = c.gtid; idx < (size_t)2 * 1024 * 64; idx += c.gsz) {
          const int n = (int)(idx & 1023), k8 = (int)((idx >> 10) & 63), l = (int)(idx >> 16);
          const int pn = n >> 8, rr = n & 255, ch = 128 * pn + (rr & 127), which = rr >> 7, hb = ch >> 6, j = ch & 63, k0 = k8 * 8;
          const float* W = which ? P.in[28] : P.in[26]; float f[8];
#pragma unroll
          for (int i = 0; i < 8; ++i) f[i] = ((k0 >> 6) == hb) ? W[(((size_t)l * 8 + hb) * 64 + (k0 & 63) + i) * 64 + j] : 0.0f;
          *(u32x4*)(dst + ((size_t)l * 1024 + n) * BW + k0) = pack8(f); } }
    { float* tbl = (float*)(ws + OFF_TBL);
      for (size_t idx = c.gtid; idx < (size_t)2 * 32 * 64 * 18; idx += c.gsz) {
          const int n = (int)(idx % 18), lgp = (int)(idx / 18), p = lgp & 63, g = (lgp >> 6) & 31, l = lgp >> 11; float re, im;
          if (n < 17) s5_lam_pow(P, l, g, p, n, re, im);
          else { float lr, li; s5_lam_pow(P, l, g, p, 1, lr, li); const float ar = P.in[14][(l * 32 + g) * 64 + p], ai = P.in[15][(l * 32 + g) * 64 + p];
                 const float cr = lr - 1.0f, ci = li, den = 1.0f / (ar * ar + ai * ai); re = (cr * ar + ci * ai) * den; im = (ci * ar - cr * ai) * den; }
          tbl[idx * 2] = re; tbl[idx * 2 + 1] = im; } }
    { const float* x = P.in[0]; const float* gg = P.in[2]; bf16_t* xn = (bf16_t*)(ws + OFF_XN);
      const int stride = gridDim.x * 8;
      for (int row0 = blockIdx.x * 8 + c.wave; row0 < T; row0 += 2 * stride) {
          f32x4 v[2][4]; float sq[2]; bool ok[2];
#pragma unroll
          for (int r = 0; r < 2; ++r) { const int row = row0 + r * stride; ok[r] = row < T; const int rr = ok[r] ? row : row0; sq[r] = 0.f;
#pragma unroll
              for (int i = 0; i < 4; ++i) { v[r][i] = *(const f32x4*)(x + (size_t)rr * D + i * 256 + c.lane * 4); sq[r] += v[r][i][0] * v[r][i][0] + v[r][i][1] * v[r][i][1] + v[r][i][2] * v[r][i][2] + v[r][i][3] * v[r][i][3]; } }
#pragma unroll
          for (int r = 0; r < 2; ++r) { if (!ok[r]) continue; const int row = row0 + r * stride; const float rs = rsqrtf(wave_sum(sq[r]) * (1.0f / 1024.0f) + 1e-6f);
#pragma unroll
              for (int i = 0; i < 4; ++i) { const f32x4 gv = *(const f32x4*)(gg + i * 256 + c.lane * 4); u32x2 w; w.x = cvt_pk_bf16(v[r][i][0] * rs * gv[0], v[r][i][1] * rs * gv[1]); w.y = cvt_pk_bf16(v[r][i][2] * rs * gv[2], v[r][i][3] * rs * gv[3]);
                  *(u32x2*)(xn + (size_t)row * D + i * 256 + c.lane * 4) = w; } } } }
    { float* ss = (float*)(ws + OFF_SS); for (size_t i = c.gtid; i < (size_t)4 * T; i += c.gsz) ss[i] = 0.0f; }
    { const float* p = P.in[1]; bf16_t* pb = (bf16_t*)(ws + OFF_PB);
      for (size_t i = c.gtid; i < (size_t)2 * T * DPLE / 8; i += c.gsz) { const f32x4 a = *(const f32x4*)(p + i * 8), b = *(const f32x4*)(p + i * 8 + 4);
          u32x4 w; w.x = cvt_pk_bf16(a[0], a[1]); w.y = cvt_pk_bf16(a[2], a[3]); w.z = cvt_pk_bf16(b[0], b[1]); w.w = cvt_pk_bf16(b[2], b[3]); *(u32x4*)(pb + i * 8) = w; } }
}

__device__ void phase_s5_consts(const Ctx& c) {
    const Params& P = *c.P; unsigned char* ws = c.ws;
    const float* tbl = (const float*)(ws + OFF_TBL); bf16_t* by = (bf16_t*)(ws + OFF_S5Y); bf16_t* be = (bf16_t*)(ws + OFF_S5E);
    const float *bre = P.in[17], *bim = P.in[18], *cre = P.in[19], *cim = P.in[20];
    for (size_t idx = c.gtid; idx < (size_t)2 * 32 * 16 * 256; idx += c.gsz) {
        const int hp = (int)(idx & 15), h = (int)((idx >> 4) & 15), tau = (int)((idx >> 8) & 15), g = (int)((idx >> 12) & 31), l = (int)(idx >> 17);
        const int lg = l * 32 + g; float s = 0.f;
        for (int p = 0; p < 64; ++p) { const float* tp = tbl + ((size_t)(lg * 64 + p) * 18) * 2;
            const float pr = tp[tau * 2], pi = tp[tau * 2 + 1], qr = tp[34], qi = tp[35];
            const float br = bre[((size_t)lg * 64 + p) * 16 + hp], bi = bim[((size_t)lg * 64 + p) * 16 + hp];
            const float bbr = qr * br - qi * bi, bbi = qr * bi + qi * br;
            const float zr = pr * bbr - pi * bbi, zi = pr * bbi + pi * bbr;
            const float cr = cre[((size_t)lg * 16 + h) * 64 + p], ci = cim[((size_t)lg * 16 + h) * 64 + p];
            s += cr * zr - ci * zi; }
        const bf16_t kv = f2bf(s); bf16_t* base = by + (size_t)lg * 256 * AS_LD;
        for (int s0 = 0; s0 + tau < 16; ++s0) { const int t = s0 + tau;
            base[(size_t)(t * 16 + h) * AS_LD + s0 * 16 + hp] = kv;
            if (tau > 0) base[(size_t)(s0 * 16 + h) * AS_LD + t * 16 + hp] = 0; }
    }
    for (size_t idx = c.gtid; idx < (size_t)2 * 32 * 256 * 64; idx += c.gsz) {
        const int p = (int)(idx & 63), th = (int)((idx >> 6) & 255), lg = (int)(idx >> 14); const int t = th >> 4, h = th & 15;
        const float* tp = tbl + ((size_t)(lg * 64 + p) * 18) * 2; const float pr = tp[(t + 1) * 2], pi = tp[(t + 1) * 2 + 1];
        const float cr = cre[((size_t)lg * 16 + h) * 64 + p], ci = cim[((size_t)lg * 16 + h) * 64 + p];
        bf16_t* rowp = by + ((size_t)lg * 256 + th) * AS_LD; rowp[256 + p] = f2bf(cr * pr - ci * pi); rowp[320 + p] = f2bf(-(cr * pi + ci * pr));
    }
    for (size_t idx = c.gtid; idx < (size_t)2 * 32 * 256 * 256; idx += c.gsz) {
        const int col = (int)(idx & 255), n = (int)((idx >> 8) & 255), lg = (int)(idx >> 16); float v = 0.f;
        if (n < 128) { const int p = n & 63, s0 = col >> 4, hp = col & 15; const float* tp = tbl + ((size_t)(lg * 64 + p) * 18) * 2;
            const float pr = tp[(15 - s0) * 2], pi = tp[(15 - s0) * 2 + 1], qr = tp[34], qi = tp[35];
            const float br = bre[((size_t)lg * 64 + p) * 16 + hp], bi = bim[((size_t)lg * 64 + p) * 16 + hp];
            const float bbr = qr * br - qi * bi, bbi = qr * bi + qi * br;
            v = (n < 64) ? (pr * bbr - pi * bbi) : (pr * bbi + pi * bbr); }
        be[idx] = f2bf(v);
    }
}

__device__ void phase_lru_conv(const Ctx& c, int l) {
    const Params& P = *c.P; const bf16_t* xl = (const bf16_t*)(c.ws + OFF_XL); bf16_t* xc = (bf16_t*)(c.ws + OFF_XC);
    const float* cw = P.in[24] + (size_t)l * 4 * BW; const float* cb = P.in[25] + (size_t)l * BW;
    for (size_t idx = (size_t)c.vb * 512 + c.tid; idx < (size_t)T * 64; idx += (size_t)c.vG * 512) {
        const int c8 = (int)(idx & 63) * 8; const int row = (int)(idx >> 6), lpos = row & (SEQ - 1);
        float o[8];
#pragma unroll
        for (int i = 0; i < 8; ++i) o[i] = cb[c8 + i];
#pragma unroll
        for (int j = 0; j < 4; ++j) { if (lpos - 3 + j >= 0) { float x[8]; unpack8(*(const u32x4*)(xl + (size_t)(row - 3 + j) * BW + c8), x);
#pragma unroll
                for (int i = 0; i < 8; ++i) o[i] += x[i] * cw[j * BW + c8 + i]; } }
        *(u32x4*)(xc + (size_t)row * BW + c8) = pack8(o);
    }
}

__device__ void phase_s5_carry(const Ctx& c, int l) {
    if (c.wave != 0 || c.vb >= 128) return;
    const int g = c.vb >> 2, b = c.vb & 3, p = c.lane;
    float lr, li; s5_lam_pow(*c.P, l, g, p, 16, lr, li);
    const float* e = (const float*)(c.ws + OFF_E); bf16_t* as = (bf16_t*)(c.ws + OFF_AS);
    const size_t base = (size_t)g * 2048 + b * 512; float xr = 0.f, xi = 0.f;
    for (int c0 = 0; c0 < 512; c0 += 32) {
        float er[32], ei[32];
#pragma unroll
        for (int i = 0; i < 32; ++i) { er[i] = e[(base + c0 + i) * 128 + p]; ei[i] = e[(base + c0 + i) * 128 + 64 + p]; }
#pragma unroll
        for (int i = 0; i < 32; ++i) { bf16_t* rowp = as + (base + c0 + i) * AS_LD; rowp[256 + p] = f2bf(xr); rowp[320 + p] = f2bf(xi);
            const float nr = lr * xr - li * xi + er[i], ni = lr * xi + li * xr + ei[i]; xr = nr; xi = ni; }
    }
}

__device__ void phase_lru_scan(const Ctx& c, int pass) {
    const bf16_t* ab = (const bf16_t*)(c.ws + OFF_LRUAB); float* agg = (float*)(c.ws + OFF_AGG); bf16_t* g3 = (bf16_t*)(c.ws + OFF_G3);
    const int ch = c.tid;
    for (int unit = c.vb; unit < NB * 128; unit += c.vG) {
        const int b = unit >> 7, ck = unit & 127; const size_t t0 = (size_t)b * SEQ + ck * 64;
        float h = 0.f, sl = 0.f;
        if (pass == 1) {
            for (int i0 = 0; i0 < ck; i0 += 16) { float sl_[16], he_[16];
#pragma unroll
                for (int j = 0; j < 16; ++j) { const int ii = (i0 + j < ck) ? i0 + j : ck - 1; const float* a = agg + ((size_t)(b * 128 + ii)) * 1024; sl_[j] = a[ch]; he_[j] = a[512 + ch]; }
#pragma unroll
                for (int j = 0; j < 16; ++j) if (i0 + j < ck) h = __expf(sl_[j]) * h + he_[j]; }
        }
        for (int t8 = 0; t8 < 64; t8 += 16) {
            float la[16], bb[16], gt[16];
#pragma unroll
            for (int i = 0; i < 16; ++i) { la[i] = bf2f(ab[(t0 + t8 + i) * 1024 + ch]); bb[i] = bf2f(ab[(t0 + t8 + i) * 1024 + 512 + ch]); if (pass == 1) gt[i] = bf2f(g3[(t0 + t8 + i) * G3_LD + 1024 + ch]); }
#pragma unroll
            for (int i = 0; i < 16; ++i) { h = __expf(la[i]) * h + bb[i]; sl += la[i];
                if (pass == 1) g3[(t0 + t8 + i) * G3_LD + 1024 + ch] = f2bf(h * siluf_(gt[i])); }
        }
        if (pass == 0) { float* a = agg + ((size_t)(b * 128 + ck)) * 1024; a[ch] = sl; a[512 + ch] = h; }
    }
}

__device__ void phase_norm(const Ctx& c, const float* ss, const float* gg, int fin) {
    float* h = c.P->out; bf16_t* xn = (bf16_t*)(c.ws + OFF_XN);
    const int stride = gridDim.x * 8;
    f32x4 gv[4];
#pragma unroll
    for (int i = 0; i < 4; ++i) gv[i] = *(const f32x4*)(gg + i * 256 + c.lane * 4);
    for (int row0 = blockIdx.x * 8 + c.wave; row0 < T; row0 += 4 * stride) {
        f32x4 v[4][4]; float rs[4]; bool ok[4];
#pragma unroll
        for (int r = 0; r < 4; ++r) { const int row = row0 + r * stride; ok[r] = row < T; const int rr = ok[r] ? row : row0; rs[r] = ss[rr];
#pragma unroll
            for (int i = 0; i < 4; ++i) v[r][i] = *(const f32x4*)(h + (size_t)rr * D + i * 256 + c.lane * 4); }
#pragma unroll
        for (int r = 0; r < 4; ++r) { if (!ok[r]) continue; const int row = row0 + r * stride; const float sc = rsqrtf(rs[r] * (1.0f / 1024.0f) + 1e-6f);
#pragma unroll
            for (int i = 0; i < 4; ++i) { const size_t o = (size_t)row * D + i * 256 + c.lane * 4; const f32x4 q = v[r][i] * sc * gv[i];
                if (fin) *(f32x4*)(h + o) = q; else { u32x2 w; w.x = cvt_pk_bf16(q[0], q[1]); w.y = cvt_pk_bf16(q[2], q[3]); *(u32x2*)(xn + o) = w; } } }
    }
}

typedef float f32x2 __attribute__((ext_vector_type(2)));
template <int CTRL> __device__ __forceinline__ float dpp_mov(float v) { return __builtin_bit_cast(float, __builtin_amdgcn_update_dpp(0, __builtin_bit_cast(int, v), CTRL, 0xf, 0xf, true)); }
__device__ __forceinline__ float row16_sum(float v) { v += dpp_mov<0xB1>(v); v += dpp_mov<0x4E>(v); v += dpp_mov<0x124>(v); v += dpp_mov<0x128>(v); return v; }
__device__ __forceinline__ float wave_sum2(float v) { v = row16_sum(v); const int vi = __builtin_bit_cast(int, v); const float a = __builtin_bit_cast(float, __builtin_amdgcn_readlane(vi, 0)), b = __builtin_bit_cast(float, __builtin_amdgcn_readlane(vi, 16)), c2 = __builtin_bit_cast(float, __builtin_amdgcn_readlane(vi, 32)), d = __builtin_bit_cast(float, __builtin_amdgcn_readlane(vi, 48)); return (a + b) + (c2 + d); }
__device__ __forceinline__ float oct_sum(float v) { v += dpp_mov<0xB1>(v); v += dpp_mov<0x4E>(v); v += dpp_mov<0x141>(v); return v; }
constexpr int RW_NBLK = 128, TWS = 72;

struct RwRows { unsigned zr[5], zk[5], zv[5], zw[5], za[5]; };
__device__ __forceinline__ float rw_get(const unsigned (&a)[5], int i) { return (i & 1) ? hi16(a[i >> 1]) : lo16(a[i >> 1]); }
__device__ __forceinline__ void rw_load_rows(RwRows& R, const bf16_t* zrw, int b, int blk, int w, int lane, int cj) {
#pragma unroll
    for (int p = 0; p < 5; ++p) { unsigned r_[2] = {0, 0}, k_[2] = {0, 0}, v_[2] = {0, 0}, w_[2] = {0, 0}, a_[2] = {0, 0};
#pragma unroll
        for (int h = 0; h < 2; ++h) { const int i = 2 * p + h; if (i < 9) { const int lp = blk * 64 + w * 8 - 1 + i; const bool ok = lp >= 0; const bf16_t* rp = zrw + ((size_t)b * SEQ + (ok ? lp : 0)) * ZRW_LD;
            const unsigned m = ok ? 0xffffu : 0u;
            r_[h] = rp[cj] & m; k_[h] = rp[512 + cj] & m; v_[h] = rp[1024 + cj] & m; w_[h] = rp[1536 + lane] & m; a_[h] = rp[1600 + lane] & m; } }
        R.zr[p] = r_[0] | (r_[1] << 16); R.zk[p] = k_[0] | (k_[1] << 16); R.zv[p] = v_[0] | (v_[1] << 16); R.zw[p] = w_[0] | (w_[1] << 16); R.za[p] = a_[0] | (a_[1] << 16); }
}

constexpr int CH_AT = 0, CH_RT = 2304, CH_KT = 4608, CH_BT = 6912, CH_KH = 9216, CH_NB = 12288, CH_VT = 15360, CH_LRK = 18432, CH_NLRB = 19200, CH_GI = 19968,
              CH_LAB = 20736, CH_LAK = 21760, CH_GC = 22784, CH_BYTES = 23040;
constexpr int RW_YY = 4 * CH_BYTES, RW_TW = RW_YY + 16384, RW_AD = RW_TW + 64 * TWS * 2, RW_AR = RW_TW  , RW_GP = RW_AD + 64 * TWS * 2,
              RW_W2 = RW_GP + 2048, RW_A2 = RW_W2 + 64 * TWS * 2, RW_CT = RW_A2 + 64 * TWS * 2, RW_END = RW_CT + 12 * 64 * 4;
static_assert(RW_END <= LDS_BYTES, "rwkv lds");
__device__ __forceinline__ void lds_barrier() { asm volatile("s_waitcnt lgkmcnt(0)\n\ts_barrier" ::: "memory"); }
typedef short bf16x4 __attribute__((ext_vector_type(4)));
__device__ __forceinline__ bf16x8 cat4(bf16x4 lo, bf16x4 hi) { return __builtin_shufflevector(lo, hi, 0, 1, 2, 3, 4, 5, 6, 7); }
__device__ __forceinline__ bf16x8 cat4z(bf16x4 lo) { const bf16x4 z = {0, 0, 0, 0}; return __builtin_shufflevector(lo, z, 0, 1, 2, 3, 4, 5, 6, 7); }
__device__ __forceinline__ bf16x4 pk4(f32x4 v) { u32x2 w; w.x = cvt_pk_bf16(v[0], v[1]); w.y = cvt_pk_bf16(v[2], v[3]); return __builtin_bit_cast(bf16x4, w); }

__device__ void phase_rwkv(const Ctx& c, int l, int blk_lo, int blk_hi, bool dry = false) {
    if (blockIdx.x >= 32) return;
    const Params& P = *c.P; const int b = blockIdx.x >> 3, hd = blockIdx.x & 7, lane = c.lane, w = c.wave, cj = hd * 64 + lane, fr = lane & 15, fq = lane >> 4;
    LAS unsigned char* LB = c.lds;
    LAS float* YY = (LAS float*)(LB + RW_YY); LAS float* WR = YY; LAS float* AR = (LAS float*)(LB + RW_AR); LAS float* GP = (LAS float*)(LB + RW_GP);
    LAS bf16_t* TWb = (LAS bf16_t*)(LB + RW_TW); LAS bf16_t* ADb = (LAS bf16_t*)(LB + RW_AD);
    const bf16_t* zrw = (const bf16_t*)(c.ws + OFF_ZRW); bf16_t* g3 = (bf16_t*)(c.ws + OFF_G3);
    LAS float* CT = (LAS float*)(LB + RW_CT);
    if (c.tid < 64) { const float* mu = P.in[4] + (size_t)l * 1664; const int j = hd * 64 + c.tid;
        CT[0 * 64 + c.tid] = mu[j]; CT[1 * 64 + c.tid] = mu[512 + j]; CT[2 * 64 + c.tid] = mu[1024 + j]; CT[3 * 64 + c.tid] = mu[1536 + c.tid]; CT[4 * 64 + c.tid] = mu[1600 + c.tid];
        CT[5 * 64 + c.tid] = P.in[5][l * BW + j]; CT[6 * 64 + c.tid] = P.in[7][l * BW + j]; CT[7 * 64 + c.tid] = P.in[9][l * BW + j]; CT[8 * 64 + c.tid] = P.in[10][l * BW + j];
        CT[9 * 64 + c.tid] = P.in[11][l * BW + j]; CT[10 * 64 + c.tid] = P.in[12][l * BW + j]; CT[11 * 64 + c.tid] = P.in[13][l * BW + j]; }
    const int mt_ = w >> 1, nh = w & 1;
    LAS bf16_t* W2I = (LAS bf16_t*)(LB + RW_W2); LAS bf16_t* A2I = (LAS bf16_t*)(LB + RW_A2);
    for (int i = c.tid; i < 4096; i += 512) { const int k = i >> 6, j = i & 63; W2I[j * TWS + k] = f2bf(P.in[6][((size_t)l * 64 + k) * BW + hd * 64 + j]); A2I[j * TWS + k] = f2bf(P.in[8][((size_t)l * 64 + k) * BW + hd * 64 + j]); }
    __syncthreads();
    f32x4 Macc[4];
#pragma unroll
    for (int i = 0; i < 4; ++i) Macc[i] = (f32x4){0.f, 0.f, 0.f, 0.f};
    const int cc = w >> 1, hc = w & 1;
    RwRows cur;
    rw_load_rows(cur, zrw, b, blk_lo, w, lane, cj);
    for (int blk = blk_lo; blk < blk_hi; ++blk) {
        const size_t t0 = (size_t)b * SEQ + blk * 64;
        float rs[8], ks_[8], vs[8];
        const float mu_r = CT[lane], mu_k = CT[64 + lane], mu_v = CT[128 + lane], mu_w = CT[192 + lane], mu_a = CT[256 + lane];
#pragma unroll
        for (int i = 0; i < 8; ++i) { const int tok = w * 8 + i;
            { const float r0 = rw_get(cur.zr, i), r1 = rw_get(cur.zr, i + 1), k0 = rw_get(cur.zk, i), k1 = rw_get(cur.zk, i + 1), v0 = rw_get(cur.zv, i), v1 = rw_get(cur.zv, i + 1);
              rs[i] = r1 + mu_r * (r0 - r1); ks_[i] = k1 + mu_k * (k0 - k1); vs[i] = v1 + mu_v * (v0 - v1); }
            const float w0_ = rw_get(cur.zw, i), w1_ = rw_get(cur.zw, i + 1), a0_ = rw_get(cur.za, i), a1_ = rw_get(cur.za, i + 1);
            const float wds = w1_ + mu_w * (w0_ - w1_), ads = a1_ + mu_a * (a0_ - a1_);
            const float e2 = __expf(2.0f * wds); const float th = 1.0f - 2.0f * __builtin_amdgcn_rcpf(e2 + 1.0f);
            TWb[tok * TWS + lane] = f2bf(th); ADb[tok * TWS + lane] = f2bf(ads); }
        if (blk + 1 < RW_NBLK) rw_load_rows(cur, zrw, b, blk + 1, w, lane, cj);
        unsigned gtp[4];
#pragma unroll
        for (int i = 0; i < 4; ++i) gtp[i] = (unsigned)g3[(t0 + w * 8 + 2 * i) * G3_LD + cj] | ((unsigned)g3[(t0 + w * 8 + 2 * i + 1) * G3_LD + cj] << 16);
        lds_barrier();
        { bf16x8 atw[2], aad[2];
#pragma unroll
          for (int ks = 0; ks < 2; ++ks) { atw[ks] = *(const LAS bf16x8*)(TWb + (16 * mt_ + fr) * TWS + 32 * ks + 8 * fq); aad[ks] = *(const LAS bf16x8*)(ADb + (16 * mt_ + fr) * TWS + 32 * ks + 8 * fq); }
          f32x4 cw[2], ca[2];
#pragma unroll
          for (int n2 = 0; n2 < 2; ++n2) { cw[n2] = (f32x4){0.f, 0.f, 0.f, 0.f}; ca[n2] = cw[n2];
#pragma unroll
              for (int ks = 0; ks < 2; ++ks) { const int bo = (32 * nh + 16 * n2 + fr) * TWS + 32 * ks + 8 * fq;
                  cw[n2] = __builtin_amdgcn_mfma_f32_16x16x32_bf16(atw[ks], *(const LAS bf16x8*)(W2I + bo), cw[n2], 0, 0, 0); ca[n2] = __builtin_amdgcn_mfma_f32_16x16x32_bf16(aad[ks], *(const LAS bf16x8*)(A2I + bo), ca[n2], 0, 0, 0); } }
          lds_barrier();
#pragma unroll
          for (int n2 = 0; n2 < 2; ++n2)
#pragma unroll
              for (int r = 0; r < 4; ++r) { const int o = (16 * mt_ + 4 * fq + r) * 64 + 32 * nh + 16 * n2 + fr; WR[o] = cw[n2][r]; AR[o] = ca[n2][r]; } }
        lds_barrier();
        float kkv[8], kpv[8], bbv[8], gl[8], cbv[8];
        { float g = 1.0f; const float w0j = CT[320 + lane], a0j = CT[384 + lane], kkj = CT[448 + lane], kaj = CT[512 + lane], rkj = CT[576 + lane];
#pragma unroll
          for (int i = 0; i < 8; ++i) { const int o = (w * 8 + i) * 64 + lane;
            const float wraw = w0j + WR[o], araw = a0j + AR[o];
            const float d = __expf(-0.6065306597126334f * sigmoidf_(wraw)), a = sigmoidf_(araw);
            float kk = ks_[i] * kkj; const float n2 = wave_sum2(kk * kk); kk = kk * __builtin_amdgcn_rsqf(fmaxf(n2, 1e-24f));
            const float kp = ks_[i] * (1.0f + (a - 1.0f) * kaj);
            cbv[i] = wave_sum2(rs[i] * kp * rkj);
            g *= d; gl[i] = g; kkv[i] = kk; kpv[i] = kp; bbv[i] = kk * a; }
          GP[w * 64 + lane] = g; }
        lds_barrier();
        { LAS unsigned char* CB_ = LB + cc * CH_BYTES;
          LAS bf16_t *AT = (LAS bf16_t*)(CB_ + CH_AT), *RT = (LAS bf16_t*)(CB_ + CH_RT), *KT = (LAS bf16_t*)(CB_ + CH_KT), *BT = (LAS bf16_t*)(CB_ + CH_BT),
                     *KH = (LAS bf16_t*)(CB_ + CH_KH), *NBH = (LAS bf16_t*)(CB_ + CH_NB), *VT = (LAS bf16_t*)(CB_ + CH_VT);
          const float g0 = GP[(2 * cc) * 64 + lane], g1 = GP[(2 * cc + 1) * 64 + lane], gC = g0 * g1, pre = hc ? g0 : 1.0f;
          if (hc == 0) ((LAS float*)(CB_ + CH_GC))[lane] = gC;
#pragma unroll
          for (int i = 0; i < 8; ++i) { const int tl = 8 * hc + i;
            const float gam = pre * gl[i], gprev = (i == 0) ? pre : pre * gl[i - 1], ig = __builtin_amdgcn_rcpf(gam), gr = gC * ig;
            AT[tl * TWS + lane] = f2bf(kkv[i] * gprev); RT[tl * TWS + lane] = f2bf(rs[i] * gam); KT[tl * TWS + lane] = f2bf(kpv[i] * ig); BT[tl * TWS + lane] = f2bf(bbv[i] * ig);
            KH[lane * 24 + tl] = f2bf(kpv[i] * gr); NBH[lane * 24 + tl] = f2bf(-bbv[i] * gr); VT[lane * 24 + tl] = f2bf(vs[i]); } }
        lds_barrier();
        if (w < 4 && !(RW_OFF & 4)) { LAS unsigned char* CB_ = LB + w * CH_BYTES;
          const LAS bf16_t *AT = (const LAS bf16_t*)(CB_ + CH_AT), *RT = (const LAS bf16_t*)(CB_ + CH_RT), *KT = (const LAS bf16_t*)(CB_ + CH_KT), *BT = (const LAS bf16_t*)(CB_ + CH_BT);
          f32x4 lab = (f32x4){0.f, 0.f, 0.f, 0.f}, lak = lab, lrk = lab, lrb = lab;
#pragma unroll
          for (int ks = 0; ks < 2; ++ks) { const int o = fr * TWS + 32 * ks + 8 * fq;
            const bf16x8 af = *(const LAS bf16x8*)(AT + o), rf = *(const LAS bf16x8*)(RT + o), kf = *(const LAS bf16x8*)(KT + o), bf = *(const LAS bf16x8*)(BT + o);
            lab = __builtin_amdgcn_mfma_f32_16x16x32_bf16(af, bf, lab, 0, 0, 0); lak = __builtin_amdgcn_mfma_f32_16x16x32_bf16(af, kf, lak, 0, 0, 0);
            lrk = __builtin_amdgcn_mfma_f32_16x16x32_bf16(rf, kf, lrk, 0, 0, 0); lrb = __builtin_amdgcn_mfma_f32_16x16x32_bf16(rf, bf, lrb, 0, 0, 0); }
          LAS float *LAB = (LAS float*)(CB_ + CH_LAB), *LAK = (LAS float*)(CB_ + CH_LAK); LAS bf16_t *LRK = (LAS bf16_t*)(CB_ + CH_LRK), *NLRB = (LAS bf16_t*)(CB_ + CH_NLRB);
#pragma unroll
          for (int r = 0; r < 4; ++r) { const int t = 4 * fq + r, s_ = fr; const bool lo_ = t > s_, le_ = t >= s_;
            LAB[t * 16 + s_] = lo_ ? lab[r] : 0.0f; LAK[t * 16 + s_] = lo_ ? lak[r] : 0.0f;
            LRK[t * 24 + s_] = f2bf(le_ ? lrk[r] : 0.0f); NLRB[t * 24 + s_] = f2bf(le_ ? -lrb[r] : 0.0f); } }
        lds_barrier();
        { const int ch6 = w & 3; LAS unsigned char* CB_ = LB + ch6 * CH_BYTES;
          const LAS bf16_t* AT = (const LAS bf16_t*)(CB_ + CH_AT); const LAS float *LAB = (const LAS float*)(CB_ + CH_LAB), *LAK = (const LAS float*)(CB_ + CH_LAK);
          LAS bf16_t *WI = (LAS bf16_t*)(CB_ + CH_KT), *GI = (LAS bf16_t*)(CB_ + CH_GI);
          float xv[16];
          if (w < 4) {
#pragma unroll
            for (int t = 0; t < 16; ++t) xv[t] = bf2f(AT[t * TWS + lane]);
          } else {
#pragma unroll
            for (int t = 0; t < 16; ++t) xv[t] = LAK[t * 16 + fr];
          }
#pragma unroll
          for (int t = 1; t < 16; ++t) { float xa = xv[t];
#pragma unroll
            for (int q = 0; q < 4; ++q) if (4 * q < t) { const f32x4 lr = *(const LAS f32x4*)(LAB + t * 16 + 4 * q);
#pragma unroll
              for (int e = 0; e < 4; ++e) if (4 * q + e < t) xa -= lr[e] * xv[4 * q + e]; }
            xv[t] = xa; asm volatile("" : "+v"(xv[t]) :: "memory"); }
          if (w < 4) {
#pragma unroll
            for (int t = 0; t < 16; ++t) WI[t * TWS + lane] = f2bf(xv[t]);
          } else if (lane < 16) {
#pragma unroll
            for (int t = 0; t < 16; ++t) GI[t * 24 + lane] = f2bf(xv[t]);
          } }
        lds_barrier();
        if (w < 4 && !(RW_OFF & 2)) {
#pragma unroll 1
          for (int ch = 0; ch < 4; ++ch) { LAS unsigned char* CB_ = LB + ch * CH_BYTES;
            const LAS bf16_t *RT = (const LAS bf16_t*)(CB_ + CH_RT), *WI = (const LAS bf16_t*)(CB_ + CH_KT), *KH = (const LAS bf16_t*)(CB_ + CH_KH), *NBH = (const LAS bf16_t*)(CB_ + CH_NB),
                             *VT = (const LAS bf16_t*)(CB_ + CH_VT), *LRK = (const LAS bf16_t*)(CB_ + CH_LRK), *NLRB = (const LAS bf16_t*)(CB_ + CH_NLRB), *GI = (const LAS bf16_t*)(CB_ + CH_GI);
            const LAS float* GC = (const LAS float*)(CB_ + CH_GC);
            bf16x8 Mb[2], Wp[2], Rp[2];
#pragma unroll
            for (int ks = 0; ks < 2; ++ks) { Mb[ks] = cat4(pk4(Macc[2 * ks]), pk4(Macc[2 * ks + 1]));
              Wp[ks] = cat4(*(const LAS bf16x4*)(WI + fr * TWS + 32 * ks + 4 * fq), *(const LAS bf16x4*)(WI + fr * TWS + 32 * ks + 16 + 4 * fq));
              Rp[ks] = cat4(*(const LAS bf16x4*)(RT + fr * TWS + 32 * ks + 4 * fq), *(const LAS bf16x4*)(RT + fr * TWS + 32 * ks + 16 + 4 * fq)); }
            const bf16x8 Vb = cat4z(*(const LAS bf16x4*)(VT + (16 * w + fr) * 24 + 4 * fq));
            const bf16x8 Gp = cat4z(*(const LAS bf16x4*)(GI + fr * 24 + 4 * fq)), Lrkp = cat4z(*(const LAS bf16x4*)(LRK + fr * 24 + 4 * fq)), Nlrbp = cat4z(*(const LAS bf16x4*)(NLRB + fr * 24 + 4 * fq));
            f32x4 U = (f32x4){0.f, 0.f, 0.f, 0.f};
            U = __builtin_amdgcn_mfma_f32_16x16x32_bf16(Wp[0], Mb[0], U, 0, 0, 0); U = __builtin_amdgcn_mfma_f32_16x16x32_bf16(Wp[1], Mb[1], U, 0, 0, 0); U = __builtin_amdgcn_mfma_f32_16x16x32_bf16(Gp, Vb, U, 0, 0, 0);
            const bf16x8 Ub = cat4z(pk4(U));
            f32x4 Y = (f32x4){0.f, 0.f, 0.f, 0.f};
            Y = __builtin_amdgcn_mfma_f32_16x16x32_bf16(Rp[0], Mb[0], Y, 0, 0, 0); Y = __builtin_amdgcn_mfma_f32_16x16x32_bf16(Rp[1], Mb[1], Y, 0, 0, 0);
            Y = __builtin_amdgcn_mfma_f32_16x16x32_bf16(Lrkp, Vb, Y, 0, 0, 0); Y = __builtin_amdgcn_mfma_f32_16x16x32_bf16(Nlrbp, Ub, Y, 0, 0, 0);
#pragma unroll
            for (int r = 0; r < 4; ++r) YY[(16 * ch + 4 * fq + r) * 64 + 16 * w + fr] = Y[r];
#pragma unroll
            for (int mt = 0; mt < 4; ++mt) { const f32x4 gc = *(const LAS f32x4*)(GC + 16 * mt + 4 * fq); f32x4 m = Macc[mt] * gc;
              const bf16x8 khp = cat4z(*(const LAS bf16x4*)(KH + (16 * mt + fr) * 24 + 4 * fq)), nbp = cat4z(*(const LAS bf16x4*)(NBH + (16 * mt + fr) * 24 + 4 * fq));
              m = __builtin_amdgcn_mfma_f32_16x16x32_bf16(khp, Vb, m, 0, 0, 0); m = __builtin_amdgcn_mfma_f32_16x16x32_bf16(nbp, Ub, m, 0, 0, 0); Macc[mt] = m; } } }
        lds_barrier();
        const float lnw = CT[640 + lane], lnb = CT[704 + lane];
#pragma unroll
        for (int i = 0; i < 8; ++i) {
            const int tok = w * 8 + i; const float y = YY[tok * 64 + lane];
            const float mean = wave_sum2(y) * (1.0f / 64.0f), dl = y - mean, var = wave_sum2(dl * dl) * (1.0f / 64.0f);
            const float yn = dl * rsqrtf(var + 64e-5f) * lnw + lnb + cbv[i] * vs[i];
            const float gti = (i & 1) ? hi16(gtp[i >> 1]) : lo16(gtp[i >> 1]);
            if (!dry) g3[(t0 + tok) * G3_LD + cj] = f2bf(yn * siluf_(gti));
        }
        lds_barrier();
    }
}

__device__ __forceinline__ void spin_until_ge(const unsigned* flag, unsigned want) {
    unsigned it = 0;
    while (__hip_atomic_load(flag, __ATOMIC_RELAXED, __HIP_MEMORY_SCOPE_AGENT) < want) { __builtin_amdgcn_s_sleep(2); if (++it > (1u << 17)) break; }
}
__device__ __forceinline__ unsigned pk2bf(float lo, float hi) { return cvt_pk_bf16(lo, hi); }

__device__ void rwkv_producer(const Ctx& c, int l, int bh, int par) {
    const Params& P = *c.P; const int b = bh >> 3, hd = bh & 7, lane = c.lane, w = c.wave, cj = hd * 64 + lane, fr = lane & 15, fq = lane >> 4;
    LAS unsigned char* LB = c.lds;
    LAS float* WR = (LAS float*)LB; LAS float* AR = (LAS float*)(LB + RW_AR);
    LAS bf16_t* TWb = (LAS bf16_t*)(LB + RW_TW); LAS bf16_t* ADb = (LAS bf16_t*)(LB + RW_AD);
    const bf16_t* zrw = (const bf16_t*)(c.ws + OFF_ZRW);
    unsigned* ready = (unsigned*)(c.ws + OFF_BAR + 256) + (bh * 2 + par) * 64; const unsigned* consumed = (const unsigned*)(c.ws + OFF_BAR + 256 + 64 * 256) + bh * 64;
    unsigned char* ring = c.ws + OFF_RING + (size_t)bh * RING_SLOTS * SLOT_BYTES;
    LAS float* CT = (LAS float*)(LB + RW_CT);
    if (c.tid < 64) { const float* mu = P.in[4] + (size_t)l * 1664; const int j = hd * 64 + c.tid;
        CT[0 * 64 + c.tid] = mu[j]; CT[1 * 64 + c.tid] = mu[512 + j]; CT[2 * 64 + c.tid] = mu[1024 + j]; CT[3 * 64 + c.tid] = mu[1536 + c.tid]; CT[4 * 64 + c.tid] = mu[1600 + c.tid];
        CT[5 * 64 + c.tid] = P.in[5][l * BW + j]; CT[6 * 64 + c.tid] = P.in[7][l * BW + j]; CT[7 * 64 + c.tid] = P.in[9][l * BW + j]; CT[8 * 64 + c.tid] = P.in[10][l * BW + j];
        CT[9 * 64 + c.tid] = P.in[11][l * BW + j]; }
    const int mt_ = w >> 1, nh = w & 1;
    LAS bf16_t* W2I = (LAS bf16_t*)(LB + RW_W2); LAS bf16_t* A2I = (LAS bf16_t*)(LB + RW_A2);
    for (int i = c.tid; i < 4096; i += 512) { const int k = i >> 6, j = i & 63; W2I[j * TWS + k] = f2bf(P.in[6][((size_t)l * 64 + k) * BW + hd * 64 + j]); A2I[j * TWS + k] = f2bf(P.in[8][((size_t)l * 64 + k) * BW + hd * 64 + j]); }
    __syncthreads();
    RwRows cur;
    rw_load_rows(cur, zrw, b, par, w, lane, cj);
    for (int blk = par; blk < RW_NBLK; blk += 2) {
        const unsigned gblk = (unsigned)(l * RW_NBLK + blk);
        float rs[8], ks_[8], vs[8];
        const float mu_r = CT[lane], mu_k = CT[64 + lane], mu_v = CT[128 + lane], mu_w = CT[192 + lane], mu_a = CT[256 + lane];
#pragma unroll
        for (int i = 0; i < 8; ++i) { const int tok = w * 8 + i;
            { const float r0 = rw_get(cur.zr, i), r1 = rw_get(cur.zr, i + 1), k0 = rw_get(cur.zk, i), k1 = rw_get(cur.zk, i + 1), v0 = rw_get(cur.zv, i), v1 = rw_get(cur.zv, i + 1);
              rs[i] = r1 + mu_r * (r0 - r1); ks_[i] = k1 + mu_k * (k0 - k1); vs[i] = v1 + mu_v * (v0 - v1); }
            const float w0_ = rw_get(cur.zw, i), w1_ = rw_get(cur.zw, i + 1), a0_ = rw_get(cur.za, i), a1_ = rw_get(cur.za, i + 1);
            const float wds = w1_ + mu_w * (w0_ - w1_), ads = a1_ + mu_a * (a0_ - a1_);
            const float e2 = __expf(2.0f * wds); const float th = 1.0f - 2.0f * __builtin_amdgcn_rcpf(e2 + 1.0f);
            TWb[tok * TWS + lane] = f2bf(th); ADb[tok * TWS + lane] = f2bf(ads); }
        if (blk + 2 < RW_NBLK) rw_load_rows(cur, zrw, b, blk + 2, w, lane, cj);
        lds_barrier();
        { bf16x8 atw[2], aad[2];
#pragma unroll
          for (int ks = 0; ks < 2; ++ks) { atw[ks] = *(const LAS bf16x8*)(TWb + (16 * mt_ + fr) * TWS + 32 * ks + 8 * fq); aad[ks] = *(const LAS bf16x8*)(ADb + (16 * mt_ + fr) * TWS + 32 * ks + 8 * fq); }
          f32x4 cw[2], ca[2];
#pragma unroll
          for (int n2 = 0; n2 < 2; ++n2) { cw[n2] = (f32x4){0.f, 0.f, 0.f, 0.f}; ca[n2] = cw[n2];
#pragma unroll
              for (int ks = 0; ks < 2; ++ks) { const int bo = (32 * nh + 16 * n2 + fr) * TWS + 32 * ks + 8 * fq;
                  cw[n2] = __builtin_amdgcn_mfma_f32_16x16x32_bf16(atw[ks], *(const LAS bf16x8*)(W2I + bo), cw[n2], 0, 0, 0); ca[n2] = __builtin_amdgcn_mfma_f32_16x16x32_bf16(aad[ks], *(const LAS bf16x8*)(A2I + bo), ca[n2], 0, 0, 0); } }
          lds_barrier();
#pragma unroll
          for (int n2 = 0; n2 < 2; ++n2)
#pragma unroll
              for (int r = 0; r < 4; ++r) { const int o = (16 * mt_ + 4 * fq + r) * 64 + 32 * nh + 16 * n2 + fr; WR[o] = cw[n2][r]; AR[o] = ca[n2][r]; } }
        if (c.tid == 0 && gblk >= RING_SLOTS) spin_until_ge(consumed, gblk - RING_SLOTS + 1);
        lds_barrier();
        unsigned char* slot = ring + (size_t)(gblk % RING_SLOTS) * SLOT_BYTES;
        LAS float* GP = (LAS float*)(LB + RW_GP); const int cc = w >> 1, hc = w & 1;
        float kkv[8], kpv[8], bbv[8], gl[8], cbv[8];
        { const float w0j = CT[320 + lane], a0j = CT[384 + lane], kkj = CT[448 + lane], kaj = CT[512 + lane], rkj = CT[576 + lane]; float g = 1.0f;
#pragma unroll
          for (int i = 0; i < 8; ++i) { const int o = (w * 8 + i) * 64 + lane;
            const float wraw = w0j + WR[o], araw = a0j + AR[o];
            const float d = __expf(-0.6065306597126334f * sigmoidf_(wraw)), a = sigmoidf_(araw);
            float kk = ks_[i] * kkj; const float n2 = wave_sum2(kk * kk); kk = kk * __builtin_amdgcn_rsqf(fmaxf(n2, 1e-24f));
            const float kp = ks_[i] * (1.0f + (a - 1.0f) * kaj);
            cbv[i] = wave_sum2(rs[i] * kp * rkj);
            g *= d; gl[i] = g; kkv[i] = kk; kpv[i] = kp; bbv[i] = kk * a; }
          GP[w * 64 + lane] = g; }
        lds_barrier();
        { LAS unsigned char* CB_ = LB + cc * CH_BYTES;
          LAS bf16_t *AT = (LAS bf16_t*)(CB_ + CH_AT), *RT = (LAS bf16_t*)(CB_ + CH_RT), *KT = (LAS bf16_t*)(CB_ + CH_KT), *BT = (LAS bf16_t*)(CB_ + CH_BT),
                     *KH = (LAS bf16_t*)(CB_ + CH_KH), *NBH = (LAS bf16_t*)(CB_ + CH_NB), *VT = (LAS bf16_t*)(CB_ + CH_VT);
          const float g0 = GP[(2 * cc) * 64 + lane], g1 = GP[(2 * cc + 1) * 64 + lane], gC = g0 * g1, pre = hc ? g0 : 1.0f;
          if (hc == 0) ((LAS float*)(CB_ + CH_GC))[lane] = gC;
#pragma unroll
          for (int i = 0; i < 8; ++i) { const int tl = 8 * hc + i;
            const float gam = pre * gl[i], gprev = (i == 0) ? pre : pre * gl[i - 1], ig = __builtin_amdgcn_rcpf(gam), gr = gC * ig;
            AT[tl * TWS + lane] = f2bf(kkv[i] * gprev); RT[tl * TWS + lane] = f2bf(rs[i] * gam); KT[tl * TWS + lane] = f2bf(kpv[i] * ig); BT[tl * TWS + lane] = f2bf(bbv[i] * ig);
            KH[lane * 20 + tl] = f2bf(kpv[i] * gr); NBH[lane * 20 + tl] = f2bf(-bbv[i] * gr); VT[lane * 20 + tl] = f2bf(vs[i]); } }
        lds_barrier();
        { const __amdgpu_buffer_rsrc_t rs_ = __builtin_amdgcn_make_buffer_rsrc((void*)slot, 0, (int)SLOT_BYTES, 0x00020000);
#pragma unroll
          for (int i = 0; i < 9; ++i) { const int L_ = c.tid * 16 + i * 8192, ch = L_ / 18432, off = L_ - ch * 18432;
              __builtin_amdgcn_raw_buffer_store_b128(*(const LAS u32x4*)(LB + ch * CH_BYTES + off), rs_, (unsigned)L_, 0, 16); }
          if (c.tid < 64) __builtin_amdgcn_raw_buffer_store_b128(*(const LAS u32x4*)(LB + (c.tid >> 4) * CH_BYTES + CH_GC + (c.tid & 15) * 16), rs_, (unsigned)(SLOT_IMG + c.tid * 16), 0, 16);
#pragma unroll
          for (int i = 0; i < 8; ++i) if (lane == i) __hip_atomic_store((unsigned*)(slot + SLOT_IMG + 1024) + w * 8 + i, __float_as_uint(cbv[i]), __ATOMIC_RELAXED, __HIP_MEMORY_SCOPE_AGENT); }
        __syncthreads();
        if (c.tid == 0) __hip_atomic_store(ready, (gblk >> 1) + 1, __ATOMIC_RELAXED, __HIP_MEMORY_SCOPE_AGENT);
    }
}

struct RwSlot { u32x4 img[9]; u32x4 gc; float cb; };
__device__ __forceinline__ void rw_load_slot(RwSlot& R, const unsigned char* slot, int tid, int w, int lane) {
#pragma unroll
    for (int i = 0; i < 9; ++i) R.img[i] = *(const u32x4*)(slot + tid * 16 + i * 8192);
    R.gc = *(const u32x4*)(slot + SLOT_IMG + (tid & 63) * 16);
    R.cb = ((const float*)(slot + SLOT_IMG + 1024))[w * 8 + (lane & 7)];
}

__device__ void rwkv_consumer(const Ctx& c, int l, int bh) {
    const Params& P = *c.P; const int b = bh >> 3, hd = bh & 7, lane = c.lane, w = c.wave, cj = hd * 64 + lane, fr = lane & 15, fq = lane >> 4;
    LAS unsigned char* LB = c.lds;
    LAS float* YY = (LAS float*)(LB + RW_YY);
    bf16_t* g3 = (bf16_t*)(c.ws + OFF_G3);
    const unsigned* ready = (const unsigned*)(c.ws + OFF_BAR + 256) + bh * 128; unsigned* consumed = (unsigned*)(c.ws + OFF_BAR + 256 + 64 * 256) + bh * 64;
    bf16_t* zrw = (bf16_t*)(c.ws + OFF_ZRW); float* cbg = (float*)(c.ws + OFF_CBG);
    const unsigned char* ring = c.ws + OFF_RING + (size_t)bh * RING_SLOTS * SLOT_BYTES;
    f32x4 Macc[4];
#pragma unroll
    for (int i = 0; i < 4; ++i) Macc[i] = (f32x4){0.f, 0.f, 0.f, 0.f};
    RwSlot cur;
    { const unsigned g0 = (unsigned)(l * RW_NBLK);
      if (c.tid == 0) { spin_until_ge(ready + 64 * (g0 & 1), (g0 >> 1) + 1); spin_until_ge(ready + 64 * ((g0 + 1) & 1), ((g0 + 1) >> 1) + 1); __builtin_amdgcn_fence(__ATOMIC_ACQUIRE, "agent"); }
      __syncthreads();
      rw_load_slot(cur, ring + (size_t)(g0 % RING_SLOTS) * SLOT_BYTES, c.tid, w, lane); }
    for (int blk = 0; blk < RW_NBLK; ++blk) {
        const unsigned gblk = (unsigned)(l * RW_NBLK + blk); const size_t t0 = (size_t)b * SEQ + blk * 64;
        const float cb_own = cur.cb;
#pragma unroll
        for (int i = 0; i < 9; ++i) { const int L_ = c.tid * 16 + i * 8192, ch = L_ / 18432, off = L_ - ch * 18432; *(LAS u32x4*)(LB + ch * CH_BYTES + off) = cur.img[i]; }
        if (c.tid < 64) *(LAS u32x4*)(LB + (c.tid >> 4) * CH_BYTES + CH_GC + (c.tid & 15) * 16) = cur.gc;
        lds_barrier();
        if (c.tid == 0) __hip_atomic_store(consumed, gblk + 1, __ATOMIC_RELAXED, __HIP_MEMORY_SCOPE_AGENT);
        if (blk + 1 < RW_NBLK) rw_load_slot(cur, ring + (size_t)((gblk + 1) % RING_SLOTS) * SLOT_BYTES, c.tid, w, lane);
        if (w < 4 && true) { LAS unsigned char* CB_ = LB + w * CH_BYTES;
          const LAS bf16_t *AT = (const LAS bf16_t*)(CB_ + CH_AT), *RT = (const LAS bf16_t*)(CB_ + CH_RT), *KT = (const LAS bf16_t*)(CB_ + CH_KT), *BT = (const LAS bf16_t*)(CB_ + CH_BT);
          f32x4 lab = (f32x4){0.f, 0.f, 0.f, 0.f}, lak = lab, lrk = lab, lrb = lab;
#pragma unroll
          for (int ks = 0; ks < 2; ++ks) { const int o = fr * TWS + 32 * ks + 8 * fq;
            const bf16x8 af = *(const LAS bf16x8*)(AT + o), rf = *(const LAS bf16x8*)(RT + o), kf = *(const LAS bf16x8*)(KT + o), bf = *(const LAS bf16x8*)(BT + o);
            lab = __builtin_amdgcn_mfma_f32_16x16x32_bf16(af, bf, lab, 0, 0, 0); lak = __builtin_amdgcn_mfma_f32_16x16x32_bf16(af, kf, lak, 0, 0, 0);
            lrk = __builtin_amdgcn_mfma_f32_16x16x32_bf16(rf, kf, lrk, 0, 0, 0); lrb = __builtin_amdgcn_mfma_f32_16x16x32_bf16(rf, bf, lrb, 0, 0, 0); }
          LAS float *LAB = (LAS float*)(CB_ + CH_LAB), *LAK = (LAS float*)(CB_ + CH_LAK); LAS bf16_t *LRK = (LAS bf16_t*)(CB_ + CH_LRK), *NLRB = (LAS bf16_t*)(CB_ + CH_NLRB);
#pragma unroll
          for (int r = 0; r < 4; ++r) { const int t = 4 * fq + r, s_ = fr; const bool lo_ = t > s_, le_ = t >= s_;
            LAB[t * 16 + s_] = lo_ ? lab[r] : 0.0f; LAK[t * 16 + s_] = lo_ ? lak[r] : 0.0f;
            LRK[t * 24 + s_] = f2bf(le_ ? lrk[r] : 0.0f); NLRB[t * 24 + s_] = f2bf(le_ ? -lrb[r] : 0.0f); } }
        lds_barrier();
        { const int ch6 = w & 3; LAS unsigned char* CB_ = LB + ch6 * CH_BYTES;
          const LAS bf16_t* AT = (const LAS bf16_t*)(CB_ + CH_AT); const LAS float *LAB = (const LAS float*)(CB_ + CH_LAB), *LAK = (const LAS float*)(CB_ + CH_LAK);
          LAS bf16_t *WI = (LAS bf16_t*)(CB_ + CH_KT), *GI = (LAS bf16_t*)(CB_ + CH_GI);
          float xv[16];
          if (w < 4) {
#pragma unroll
            for (int t = 0; t < 16; ++t) xv[t] = bf2f(AT[t * TWS + lane]);
          } else {
#pragma unroll
            for (int t = 0; t < 16; ++t) xv[t] = LAK[t * 16 + fr];
          }
          f32x4 nx[4];
#pragma unroll
          for (int q = 0; q < 4; ++q) nx[q] = *(const LAS f32x4*)(LAB + 16 + 4 * q);
#pragma unroll
          for (int t = 1; t < 16; ++t) { float xa = xv[t]; f32x4 lr[4];
#pragma unroll
            for (int q = 0; q < 4; ++q) lr[q] = nx[q];
            if (t < 15) {
#pragma unroll
              for (int q = 0; q < 4; ++q) if (4 * q < t + 1) nx[q] = *(const LAS f32x4*)(LAB + (t + 1) * 16 + 4 * q); }
            float xb = 0.0f;
#pragma unroll
            for (int q = 0; q < 4; ++q) if (4 * q < t) {
#pragma unroll
              for (int e = 0; e < 4; ++e) if (4 * q + e < t) { if (e & 1) xb -= lr[q][e] * xv[4 * q + e]; else xa -= lr[q][e] * xv[4 * q + e]; } }
            xa += xb;
            xv[t] = xa; asm volatile("" : "+v"(xv[t]), "+v"(nx[0]), "+v"(nx[1]), "+v"(nx[2]), "+v"(nx[3]) :: "memory"); }
          if (w < 4) {
#pragma unroll
            for (int t = 0; t < 16; ++t) WI[t * TWS + lane] = f2bf(xv[t]);
          } else if (lane < 16) {
#pragma unroll
            for (int t = 0; t < 16; ++t) GI[t * 24 + lane] = f2bf(xv[t]);
          } }
        lds_barrier();
        if (w == 4 && lane == 0 && blk + 2 < RW_NBLK) { const unsigned gn = gblk + 2; spin_until_ge(ready + 64 * (gn & 1), (gn >> 1) + 1); __builtin_amdgcn_fence(__ATOMIC_ACQUIRE, "agent"); }
        if (w < 4 && true) {
#pragma unroll
          for (int ch = 0; ch < 4; ++ch) { LAS unsigned char* CB_ = LB + ch * CH_BYTES;
            const LAS bf16_t *RT = (const LAS bf16_t*)(CB_ + CH_RT), *WI = (const LAS bf16_t*)(CB_ + CH_KT), *KH = (const LAS bf16_t*)(CB_ + CH_KH), *NBH = (const LAS bf16_t*)(CB_ + CH_NB),
                             *VT = (const LAS bf16_t*)(CB_ + CH_VT), *LRK = (const LAS bf16_t*)(CB_ + CH_LRK), *NLRB = (const LAS bf16_t*)(CB_ + CH_NLRB), *GI = (const LAS bf16_t*)(CB_ + CH_GI);
            const LAS float* GC = (const LAS float*)(CB_ + CH_GC);
            bf16x8 Mb[2], Wp[2], Rp[2];
#pragma unroll
            for (int ks = 0; ks < 2; ++ks) { Mb[ks] = cat4(pk4(Macc[2 * ks]), pk4(Macc[2 * ks + 1]));
              Wp[ks] = cat4(*(const LAS bf16x4*)(WI + fr * TWS + 32 * ks + 4 * fq), *(const LAS bf16x4*)(WI + fr * TWS + 32 * ks + 16 + 4 * fq));
              Rp[ks] = cat4(*(const LAS bf16x4*)(RT + fr * TWS + 32 * ks + 4 * fq), *(const LAS bf16x4*)(RT + fr * TWS + 32 * ks + 16 + 4 * fq)); }
            const bf16x8 Vb = cat4z(*(const LAS bf16x4*)(VT + (16 * w + fr) * 20 + 4 * fq));
            const bf16x8 Gp = cat4z(*(const LAS bf16x4*)(GI + fr * 24 + 4 * fq)), Lrkp = cat4z(*(const LAS bf16x4*)(LRK + fr * 24 + 4 * fq)), Nlrbp = cat4z(*(const LAS bf16x4*)(NLRB + fr * 24 + 4 * fq));
            f32x4 U = (f32x4){0.f, 0.f, 0.f, 0.f};
            U = __builtin_amdgcn_mfma_f32_16x16x32_bf16(Wp[0], Mb[0], U, 0, 0, 0); U = __builtin_amdgcn_mfma_f32_16x16x32_bf16(Wp[1], Mb[1], U, 0, 0, 0); U = __builtin_amdgcn_mfma_f32_16x16x32_bf16(Gp, Vb, U, 0, 0, 0);
            const bf16x8 Ub = cat4z(pk4(U));
            f32x4 Y = (f32x4){0.f, 0.f, 0.f, 0.f};
            Y = __builtin_amdgcn_mfma_f32_16x16x32_bf16(Rp[0], Mb[0], Y, 0, 0, 0); Y = __builtin_amdgcn_mfma_f32_16x16x32_bf16(Rp[1], Mb[1], Y, 0, 0, 0);
            Y = __builtin_amdgcn_mfma_f32_16x16x32_bf16(Lrkp, Vb, Y, 0, 0, 0); Y = __builtin_amdgcn_mfma_f32_16x16x32_bf16(Nlrbp, Ub, Y, 0, 0, 0);
#pragma unroll
            for (int r = 0; r < 4; ++r) YY[(16 * ch + 4 * fq + r) * 64 + 16 * w + fr] = Y[r];
#pragma unroll
            for (int mt = 0; mt < 4; ++mt) { const f32x4 gc = *(const LAS f32x4*)(GC + 16 * mt + 4 * fq); f32x4 m = Macc[mt] * gc;
              const bf16x8 khp = cat4z(*(const LAS bf16x4*)(KH + (16 * mt + fr) * 20 + 4 * fq)), nbp = cat4z(*(const LAS bf16x4*)(NBH + (16 * mt + fr) * 20 + 4 * fq));
              m = __builtin_amdgcn_mfma_f32_16x16x32_bf16(khp, Vb, m, 0, 0, 0); m = __builtin_amdgcn_mfma_f32_16x16x32_bf16(nbp, Ub, m, 0, 0, 0); Macc[mt] = m; } } }
        lds_barrier();
        { const int tok = c.tid >> 3, c8 = (c.tid & 7) * 8;
          const f32x4 y0 = *(const LAS f32x4*)(YY + tok * 64 + c8), y1 = *(const LAS f32x4*)(YY + tok * 64 + c8 + 4);
          u32x4 wv; wv.x = cvt_pk_bf16(y0[0], y0[1]); wv.y = cvt_pk_bf16(y0[2], y0[3]); wv.z = cvt_pk_bf16(y1[0], y1[1]); wv.w = cvt_pk_bf16(y1[2], y1[3]);
          *(u32x4*)(zrw + (t0 + tok) * ZRW_LD + hd * 64 + c8) = wv;
          if (lane < 8) cbg[(t0 + w * 8 + lane) * 8 + hd] = cb_own; }
    }
}

__device__ void phase_rwkv_fin(const Ctx& c, int l) {
    const Params& P = *c.P; const bf16_t* zrw = (const bf16_t*)(c.ws + OFF_ZRW); bf16_t* g3 = (bf16_t*)(c.ws + OFF_G3); const float* cbg = (const float*)(c.ws + OFF_CBG);
    const int gw = blockIdx.x * 8 + c.wave, nw = gridDim.x * 8, lane = c.lane;
    for (int item = gw; item < (T / 128) * 8; item += nw) {
        const int hd = item & 7, tg = item >> 3, cj = hd * 64 + lane; const size_t tb = (size_t)tg * 128;
        const float mu_v = P.in[4][(size_t)l * 1664 + 1024 + cj], lnw = P.in[12][l * BW + cj], lnb = P.in[13][l * BW + cj];
        float vprev = ((tb & (SEQ - 1)) == 0) ? 0.0f : bf2f(zrw[(tb - 1) * ZRW_LD + 1024 + cj]);
        for (int t4 = 0; t4 < 128; t4 += 8) {
            float y[8], vv[8], gt[8], cb[8];
#pragma unroll
            for (int i = 0; i < 8; ++i) { const size_t t = tb + t4 + i; y[i] = bf2f(zrw[t * ZRW_LD + cj]); vv[i] = bf2f(zrw[t * ZRW_LD + 1024 + cj]); gt[i] = bf2f(g3[t * G3_LD + cj]); cb[i] = cbg[t * 8 + hd]; }
#pragma unroll
            for (int i = 0; i < 8; ++i) { const size_t t = tb + t4 + i;
                const float vs = vv[i] + mu_v * (vprev - vv[i]); vprev = vv[i];
                const float mean = wave_sum2(y[i]) * (1.0f / 64.0f), ey2 = wave_sum2(y[i] * y[i]) * (1.0f / 64.0f), var = fmaxf(ey2 - mean * mean, 0.0f);
                const float yn = (y[i] - mean) * rsqrtf(var + 64e-5f) * lnw + lnb + cb[i] * vs;
                g3[t * G3_LD + cj] = f2bf(yn * siluf_(gt[i])); }
        }
    }
}

constexpr int RW_WGS = 96;
template <int l, int sp>
__device__ __forceinline__ void run_sub(const Ctx& c, const Params& P, float* ssbase, int G, int cb, unsigned* bar2, unsigned& bar2_target) {
    unsigned char* ws = c.ws;
    if constexpr (sp == 0) {
        if (l == 0) phase_s5_consts(c);
        pg8::Gemm g{(const bf16_t*)(ws + OFF_XN), (const bf16_t*)(ws + OFF_WIN) + (size_t)l * DINP * D, D, D, D}; pg8::Sched S; S.init(T, DINP, G, cb);
        EpiZ E{(bf16_t*)(ws + OFF_ZRW), (bf16_t*)(ws + OFF_G3), (bf16_t*)(ws + OFF_XL), (bf16_t*)(ws + OFF_AS)};
        pg8::gemm_phase(c.lds, g, S, E);
    } else if constexpr (sp == 1) {
        if (cb < 32) rwkv_consumer(c, l, cb); else if (cb < RW_WGS) rwkv_producer(c, l, (cb - 32) & 31, (cb - 32) >> 5);
        else {
            Ctx c2 = c; c2.vb = cb - RW_WGS; c2.vG = G - RW_WGS; const int G2 = G - RW_WGS, cb2 = cb - RW_WGS;
            phase_lru_conv(c2, l);
            { pg8::Gemm g{(const bf16_t*)(ws + OFF_AS), (const bf16_t*)(ws + OFF_S5E) + (size_t)l * 32 * 256 * 256, AS_LD, 256, 256}; pg8::Sched S; S.init(AS_ROWS, 256, G2, cb2, 8);
              EpiE E{(float*)(ws + OFF_E)};
              pg8::gemm_phase(c.lds, g, S, E); }
            grid_bar(bar2, bar2_target, (unsigned)G2);
            phase_s5_carry(c2, l);
            { pg8::Gemm g{(const bf16_t*)(ws + OFF_XC), (const bf16_t*)(ws + OFF_WLRU) + (size_t)l * 1024 * BW, BW, BW, BW}; pg8::Sched S; S.init(T, 1024, G2, cb2);
              EpiLru E{(const bf16_t*)(ws + OFF_XC), P.in[27] + l * BW, P.in[29] + l * BW, P.in[30] + l * BW, (bf16_t*)(ws + OFF_LRUAB)};
              pg8::gemm_phase(c.lds, g, S, E); }
            grid_bar(bar2, bar2_target, (unsigned)G2);
            { pg8::Gemm g{(const bf16_t*)(ws + OFF_AS), (const bf16_t*)(ws + OFF_S5Y) + (size_t)l * 32 * 256 * AS_LD, AS_LD, AS_LD, AS_LD}; pg8::Sched S; S.init(AS_ROWS, 256, G2, cb2, 8);
              EpiY E{(const bf16_t*)(ws + OFF_AS), P.in[21] + l * BW, (bf16_t*)(ws + OFF_ZGS)};
              pg8::gemm_phase(c.lds, g, S, E); }
            phase_lru_scan(c2, 0);
            grid_bar(bar2, bar2_target, (unsigned)G2);
            { pg8::Gemm g{(const bf16_t*)(ws + OFF_ZGS), (const bf16_t*)(ws + OFF_WGLU) + (size_t)l * BW * BW, BW, BW, BW}; pg8::Sched S; S.init(T, BW, G2, cb2);
              EpiGlu E{(const bf16_t*)(ws + OFF_ZGS), P.in[23] + l * BW, (bf16_t*)(ws + OFF_G3)};
              pg8::gemm_phase(c.lds, g, S, E); }
            phase_lru_scan(c2, 1);
            { pg8::Gemm g{(const bf16_t*)(ws + OFF_PB) + (size_t)l * T * DPLE, (const bf16_t*)(ws + OFF_WPLE) + (size_t)l * D * DPLE, DPLE, DPLE, DPLE}; pg8::Sched S; S.init(T, D, G2, cb2);
              EpiPle E{(bf16_t*)(ws + OFF_PW), ssbase + (size_t)l * T};
              pg8::gemm_phase(c.lds, g, S, E); }
        }
    } else if constexpr (sp == 2) {
        phase_rwkv_fin(c, l);
    } else if constexpr (sp == 5) {
        { pg8::Gemm g{(const bf16_t*)(ws + OFF_G3), (const bf16_t*)(ws + OFF_WOUT) + (size_t)l * D * DMIX, DMIX, DMIX, DMIX}; pg8::Sched S; S.init(T, D, G, cb);
          EpiOut E{l == 0 ? P.in[0] : (const float*)P.out, P.out, (bf16_t*)(ws + OFF_H1B)};
          pg8::gemm_phase(c.lds, g, S, E); }
    } else if constexpr (sp == 6) {
        pg8::Gemm g{(const bf16_t*)(ws + OFF_H1B), (const bf16_t*)(ws + OFF_WG) + (size_t)l * D * D, D, D, D}; pg8::Sched S; S.init(T, D, G, cb);
        EpiGate E{P.out, (const bf16_t*)(ws + OFF_PW), ssbase + (size_t)l * T, P.in[33] + l * D, ssbase + (size_t)(2 + l) * T};
        pg8::gemm_phase(c.lds, g, S, E);
    } else {
        phase_norm(c, ssbase + (size_t)(2 + l) * T, l == 0 ? P.in[2] + D : P.in[35], l == 1);
    }
}

constexpr int NPHASE = 1 + 6 * 2;
__global__ void __launch_bounds__(512) hymba_fwd(Params P) {
    extern __shared__ __attribute__((aligned(16))) unsigned char lds_raw[];
    Ctx c; c.P = &P; c.ws = P.ws; c.lds = (LAS unsigned char*)lds_raw; c.ldsg = lds_raw; c.tid = threadIdx.x; c.lane = c.tid & 63; c.wave = __builtin_amdgcn_readfirstlane(c.tid >> 6);
    c.gtid = (size_t)blockIdx.x * 512 + c.tid; c.gsz = (size_t)gridDim.x * 512; c.vb = blockIdx.x; c.vG = gridDim.x;
    unsigned char* ws = P.ws; const int G = gridDim.x, cb = blockIdx.x;
    float* ssbase = (float*)(ws + OFF_SS);
    const int lo = P.ph_lo, hi = P.ph_hi;
    unsigned* barw = (unsigned*)(ws + OFF_BAR); unsigned bar_target = 0; unsigned* bar2 = barw + 32; unsigned bar2_target = 0;
#define PHASE(k, ...) if (((MK_PH_MASK >> (k)) & 1) && lo <= (k) && (k) < hi) { __VA_ARGS__; if ((k) + 1 < hi) { if ((k) == 0) { __threadfence(); cg::this_grid().sync(); } else grid_bar(barw, bar_target, (unsigned)G); } }
    PHASE(0, phase_prep(c))
#define RS(L_, SP_) run_sub<L_, SP_>(c, P, ssbase, G, cb, bar2, bar2_target)
    PHASE(1, RS(0, 0)) PHASE(2, RS(0, 1)) PHASE(3, RS(0, 2)) PHASE(4, RS(0, 5)) PHASE(5, RS(0, 6)) PHASE(6, RS(0, 7))
    PHASE(7, RS(1, 0)) PHASE(8, RS(1, 1)) PHASE(9, RS(1, 2)) PHASE(10, RS(1, 5)) PHASE(11, RS(1, 6)) PHASE(12, RS(1, 7))
#undef RS
#undef PHASE
}

extern "C" void kernel_launch(void* const* d_in, const int* in_sizes, int n_in, void* d_out, int out_size, void* d_ws, size_t ws_size, hipStream_t stream) {
    static int grid = 0;
    if (grid == 0) {
        if (n_in != 36 || out_size != T * D || ws_size < WS_END2) { fprintf(stderr, "kernel_launch: unexpected shapes (n_in %d out %d ws %zu need %zu)\n", n_in, out_size, ws_size, (size_t)WS_END); grid = -1; return; }
        int dev = 0, cus = 0, per_cu = 0;
        hipGetDevice(&dev); hipDeviceGetAttribute(&cus, hipDeviceAttributeMultiprocessorCount, dev);
        hipFuncSetAttribute((const void*)hymba_fwd, hipFuncAttributeMaxDynamicSharedMemorySize, LDS_BYTES);
        hipOccupancyMaxActiveBlocksPerMultiprocessor(&per_cu, (const void*)hymba_fwd, 512, LDS_BYTES);
        if (per_cu < 1) per_cu = 1;
        grid = cus * per_cu; if (grid > 256) grid = 256;
        (void)hipGetLastError();
    }
    if (grid < 0) return;
    (void)hipMemsetAsync((char*)d_ws + OFF_BAR, 0, CTL_BYTES, stream);
    Params p{};
    for (int i = 0; i < 36; ++i) p.in[i] = (const float*)d_in[i];
    p.out = (float*)d_out; p.ws = (unsigned char*)d_ws;
#if MK_PER_PHASE
    for (int ph = 0; ph < NPHASE; ++ph) { p.ph_lo = ph; p.ph_hi = ph + 1; hipLaunchKernelGGL(hymba_fwd, dim3(grid), dim3(512), LDS_BYTES, stream, p); }
#else
    p.ph_lo = 0; p.ph_hi = NPHASE;
    void* args[] = {&p};
    hipError_t e = hipLaunchCooperativeKernel((const void*)hymba_fwd, dim3(grid), dim3(512), args, LDS_BYTES, stream);
    if (e != hipSuccess) fprintf(stderr, "cooperative launch failed: %s (grid %d)\n", hipGetErrorString(e), grid);
#endif
}
```

```cpp
#include <hip/hip_runtime.h>
#include <hip/hip_cooperative_groups.h>
#include <cstdio>
namespace cg = cooperative_groups;

#ifndef MK_PER_PHASE
#define MK_PER_PHASE 0
#endif

#ifndef MK_PH_MASK
#define MK_PH_MASK 0x1fff
#endif
#ifndef MK_DUP
#define MK_DUP 0
#endif
#ifndef RW_OFF
#define RW_OFF 0
#endif
#ifndef MK_OFF
#define MK_OFF 0
#endif
#define LAS __attribute__((address_space(3)))
typedef unsigned short bf16_t;
typedef short bf16x8 __attribute__((ext_vector_type(8)));
typedef float f32x4 __attribute__((ext_vector_type(4)));
typedef unsigned u32x4 __attribute__((ext_vector_type(4)));
typedef unsigned u32x2 __attribute__((ext_vector_type(2)));

constexpr int T = 32768, D = 1024, SEQ = 8192, NB = 4, BW = 512;
constexpr int DIN = 4224, DINP = 4352, DMIX = 1536, DPLE = 256;
constexpr int ZRW_LD = 1792, G3_LD = 1536, AS_LD = 384, AS_ROWS = 65536;
constexpr int LDS_BYTES = 155648;

constexpr size_t al256(size_t x) { return (x + 255) & ~(size_t)255; }
constexpr size_t SZ_WIN = (size_t)2 * DINP * D * 2, SZ_WOUT = (size_t)2 * D * DMIX * 2, SZ_WG = (size_t)2 * D * D * 2, SZ_WPLE = (size_t)2 * D * DPLE * 2,
                 SZ_WGLU = (size_t)2 * BW * BW * 2, SZ_WLRU = (size_t)2 * 1024 * BW * 2, SZ_S5Y = (size_t)2 * 32 * 256 * AS_LD * 2, SZ_S5E = (size_t)2 * 32 * 256 * 256 * 2,
                 SZ_TBL = (size_t)2 * 32 * 64 * 18 * 8, SZ_PB = (size_t)2 * T * DPLE * 2, SZ_XN = (size_t)T * D * 2, SZ_ZRW = (size_t)T * ZRW_LD * 2, SZ_G3 = (size_t)T * G3_LD * 2,
                 SZ_XL = (size_t)T * BW * 2, SZ_AS = (size_t)AS_ROWS * AS_LD * 2, SZ_LRUAB = (size_t)T * 1024 * 2, SZ_AGG = (size_t)NB * 128 * 1024 * 4, SZ_SS = (size_t)4 * T * 4;
constexpr size_t OFF_WIN = 0, OFF_WOUT = OFF_WIN + SZ_WIN, OFF_WG = OFF_WOUT + SZ_WOUT, OFF_WPLE = OFF_WG + SZ_WG, OFF_WGLU = OFF_WPLE + SZ_WPLE, OFF_WLRU = OFF_WGLU + SZ_WGLU,
                 OFF_S5Y = OFF_WLRU + SZ_WLRU, OFF_S5E = OFF_S5Y + SZ_S5Y, OFF_TBL = OFF_S5E + SZ_S5E, OFF_PB = al256(OFF_TBL + SZ_TBL), OFF_XN = OFF_PB + SZ_PB,
                 OFF_ZRW = OFF_XN + SZ_XN, OFF_G3 = OFF_ZRW + SZ_ZRW, OFF_XL = OFF_G3 + SZ_G3, OFF_AS = OFF_XL + SZ_XL, OFF_LRUAB = OFF_AS + SZ_AS, OFF_AGG = OFF_LRUAB + SZ_LRUAB,
                 OFF_SS = OFF_AGG + SZ_AGG, WS_END = OFF_SS + SZ_SS;
constexpr size_t OFF_BAR = WS_END, CTL_BYTES = 256 + 96 * 256;
constexpr size_t RING_SLOTS = 3, SLOT_IMG = 4 * 18432, SLOT_BYTES = SLOT_IMG + 4 * 256 + 256;
constexpr size_t OFF_RING = OFF_BAR + CTL_BYTES, OFF_CBG = OFF_RING + 32 * RING_SLOTS * SLOT_BYTES, WS_END2 = OFF_CBG + (size_t)T * 8 * 4;
constexpr size_t OFF_E = OFF_XN, OFF_XC = OFF_XN + (size_t)AS_ROWS * 128 * 4, OFF_H1B = OFF_ZRW, OFF_PW = OFF_XN, OFF_ZGS = OFF_XL;
static_assert(OFF_XC + (size_t)T * BW * 2 <= OFF_ZRW, "alias overflow");

struct Params {
    const float* in[36];
    float* out;
    unsigned char* ws;
    int ph_lo, ph_hi;
};

__device__ __forceinline__ float bf2f(bf16_t v) { return __uint_as_float(((unsigned)v) << 16); }
__device__ __forceinline__ bf16_t f2bf_sw(float f) { unsigned u = __float_as_uint(f); u += 0x7FFFu + ((u >> 16) & 1u); return (bf16_t)(u >> 16); }
typedef float f32x2_ __attribute__((ext_vector_type(2)));
typedef __bf16 b16x2_ __attribute__((ext_vector_type(2)));
__device__ __forceinline__ unsigned cvt_pk_bf16(float lo, float hi) { const f32x2_ v = {lo, hi}; return __builtin_bit_cast(unsigned, __builtin_convertvector(v, b16x2_)); }
__device__ __forceinline__ bf16_t f2bf(float f) { return (bf16_t)cvt_pk_bf16(f, f); }
__device__ __forceinline__ float lo16(unsigned u) { return __uint_as_float(u << 16); }
__device__ __forceinline__ float hi16(unsigned u) { return __uint_as_float(u & 0xffff0000u); }
__device__ __forceinline__ float sigmoidf_(float x) { return __builtin_amdgcn_rcpf(1.0f + __expf(-x)); }
__device__ __forceinline__ float siluf_(float x) { return x * sigmoidf_(x); }
__device__ __forceinline__ float softplusf_(float x) { return fmaxf(x, 0.0f) + log1pf(__expf(-fabsf(x))); }
__device__ __forceinline__ float gelu_tanh(float x) { const float u2 = 1.5957691216057308f * (x + 0.044715f * x * x * x); return x * sigmoidf_(u2); }
__device__ __forceinline__ float wave_sum(float v) {
#pragma unroll
    for (int o = 32; o > 0; o >>= 1) v += __shfl_xor(v, o);
    return v;
}
__device__ __forceinline__ void unpack8(const u32x4 w, float (&f)[8]) {
    f[0] = lo16(w.x); f[1] = hi16(w.x); f[2] = lo16(w.y); f[3] = hi16(w.y); f[4] = lo16(w.z); f[5] = hi16(w.z); f[6] = lo16(w.w); f[7] = hi16(w.w);
}
__device__ __forceinline__ u32x4 pack8(const float (&f)[8]) {
    u32x4 w; w.x = cvt_pk_bf16(f[0], f[1]); w.y = cvt_pk_bf16(f[2], f[3]); w.z = cvt_pk_bf16(f[4], f[5]); w.w = cvt_pk_bf16(f[6], f[7]); return w;
}


__device__ __forceinline__ void grid_bar(unsigned* ctr, unsigned& target, unsigned nblk) {
    __syncthreads();
    if (threadIdx.x == 0) {
        target += nblk;
        __builtin_amdgcn_fence(__ATOMIC_RELEASE, "agent");
        __hip_atomic_fetch_add(ctr, 1u, __ATOMIC_RELAXED, __HIP_MEMORY_SCOPE_AGENT);
        while (__hip_atomic_load(ctr, __ATOMIC_RELAXED, __HIP_MEMORY_SCOPE_AGENT) < target) __builtin_amdgcn_s_sleep(1);
        __builtin_amdgcn_fence(__ATOMIC_ACQUIRE, "agent");
    }
    __syncthreads();
}

namespace pg8 {
constexpr int BM = 256, BK = 64, HALF = 128, HTB = HALF * BK * 2, STAGE_BYTES = 8 * HTB, NXCD = 8, WGM = 8;
__host__ __device__ __forceinline__ int lds_byte(int r, int c) { const int st = (r >> 4) * 2 + (c >> 5), rr = r & 15, cc = c & 31, ob = rr * 64 + cc * 2; return st * 1024 + (ob ^ (((ob >> 9) & 1) << 5)); }
__host__ __device__ __forceinline__ void stage_rc(int b, int& R, int& C) { const int st = b / 1024, sb = b % 1024, swz = sb ^ (((sb >> 9) & 1) << 5); R = (st >> 1) * 16 + swz / 64; C = (st & 1) * 32 + (swz % 64) / 2; }
__host__ __device__ __forceinline__ int perm32(int rho) { const int n = rho >> 4, i = rho & 15; return 8 * (i >> 2) + 4 * n + (i & 3); }

struct Unit { int pm, pn, pb; };
struct Gemm { const bf16_t* A; const bf16_t* Bt; int lda, ldb, K; };

struct Sched {
    int nM, nN, nwg, G, c, grp;
    __device__ void init(int M, int N, int G_, int c_, int grp_ = 0) { nM = M / BM; nN = N / BM; nwg = nM * nN; G = G_; c = c_; grp = grp_; }
    __device__ bool next(int i, Unit& u) const {
        const long L = (long)i * G + c; if (L >= nwg) return false;
        int wgid = (int)L; { const int q = nwg / NXCD, r = nwg % NXCD, xcd = wgid % NXCD, off = wgid / NXCD; wgid = (xcd < r ? xcd * (q + 1) : r * (q + 1) + (xcd - r) * q) + off; }
        const int nig = WGM * nN, gid = wgid / nig, fm = gid * WGM, gsz = (nM - fm) < WGM ? (nM - fm) : WGM;
        u.pm = fm + ((wgid % nig) % gsz); u.pn = (wgid % nig) / gsz; u.pb = grp ? (u.pm / grp) * nN + u.pn : u.pn; return true;
    }
};

template <class Epi>
__device__ __forceinline__ void gemm_phase(LAS unsigned char* lds, const Gemm g, const Sched& S, const Epi& E) {
    const int tid = threadIdx.x, wid = __builtin_amdgcn_readfirstlane(tid >> 6), lane = tid & 63, wr = wid >> 2, wc = wid & 3, fr = lane & 15, fq = lane >> 4;
    const int K = g.K, nt = K / BK;
    unsigned voffA[2], voffB[2];
#pragma unroll
    for (int i = 0; i < 2; ++i) { int R, C; stage_rc(tid * 16 + i * 8192, R, C); const int Rb = Epi::PERM ? ((R & ~31) + perm32(R & 31)) : R;
        voffA[i] = (unsigned)(R * g.lda + C) * 2u; voffB[i] = (unsigned)(Rb * g.ldb + C) * 2u; }
    const size_t kstep = (size_t)(BK * 2);
    const size_t hstepA = (size_t)HALF * g.lda * 2, hstepB = (size_t)HALF * g.ldb * 2;
    const size_t tstepA = 2 * hstepA, tstepB = 2 * hstepB;
    const unsigned ldsw = (unsigned)wid * 1024u;
    const int aoff = lds_byte(wr * 64 + fr, fq * 8), boff = lds_byte(wc * 32 + fr, fq * 8);
#define PG8_SA(b, h) (((b) * 2 + (h)) * HTB)
#define PG8_SB(b, h) ((4 + (b) * 2 + (h)) * HTB)
#define PG8_STAGE(bufoff, gbase, voff) do { _Pragma("unroll") for (int _i = 0; _i < 2; ++_i) \
        __builtin_amdgcn_global_load_lds((const unsigned*)((const char*)(gbase) + (voff)[_i]), (LAS unsigned*)(lds + (bufoff) + ldsw + _i * 8192), 16, 0, 0); } while (0)
#define PG8_LDA(dst, b, h) do { _Pragma("unroll") for (int m = 0; m < 4; ++m) _Pragma("unroll") for (int k = 0; k < 2; ++k) dst[m][k] = *(const LAS bf16x8*)(lds + PG8_SA(b, h) + aoff + m * 2048 + k * 1024); } while (0)
#define PG8_LDB(dst, b, h) do { _Pragma("unroll") for (int n = 0; n < 2; ++n) _Pragma("unroll") for (int k = 0; k < 2; ++k) dst[n][k] = *(const LAS bf16x8*)(lds + PG8_SB(b, h) + boff + n * 2048 + k * 1024); } while (0)
#define PG8_MMA(ai, bj, At, Bt) do { __builtin_amdgcn_s_setprio(1); _Pragma("unroll") for (int m = 0; m < 4; ++m) _Pragma("unroll") for (int n = 0; n < 2; ++n) _Pragma("unroll") for (int k = 0; k < 2; ++k) \
        acc[ai][bj][m][n] = __builtin_amdgcn_mfma_f32_16x16x32_bf16(Bt[n][k], At[m][k], acc[ai][bj][m][n], 0, 0, 0); __builtin_amdgcn_s_setprio(0); } while (0)
#define PG8_WAIT_V(n) asm volatile("s_waitcnt vmcnt(" #n ")" ::: "memory")
#define PG8_WAIT_L(n) asm volatile("s_waitcnt lgkmcnt(" #n ")" ::: "memory")
#define PG8_BAR __builtin_amdgcn_s_barrier()
#define PG8_SCHED __builtin_amdgcn_sched_barrier(0)
    Unit cur, nxt; int ui = 0;
    if (!S.next(0, cur)) return;
    f32x4 acc[2][2][4][2];
#pragma unroll
    for (int a = 0; a < 2; ++a)
#pragma unroll
        for (int b = 0; b < 2; ++b)
#pragma unroll
            for (int m = 0; m < 4; ++m)
#pragma unroll
                for (int n = 0; n < 2; ++n) acc[a][b][m][n] = (f32x4){0.f, 0.f, 0.f, 0.f};
    bf16x8 At[4][2], B0[2][2], B1[2][2];
    const char* cA = (const char*)g.A + (size_t)cur.pm * tstepA; const char* cB = (const char*)g.Bt + (size_t)cur.pb * tstepB;
    PG8_STAGE(PG8_SB(0, 0), cB, voffB); PG8_STAGE(PG8_SA(0, 0), cA, voffA); PG8_STAGE(PG8_SB(0, 1), cB + hstepB, voffB); PG8_STAGE(PG8_SA(0, 1), cA + hstepA, voffA);
    if (wr == 1) PG8_BAR;
    PG8_WAIT_V(4); PG8_BAR;
    PG8_STAGE(PG8_SB(1, 0), cB + kstep, voffB); PG8_STAGE(PG8_SA(1, 0), cA + kstep, voffA); PG8_STAGE(PG8_SB(1, 1), cB + hstepB + kstep, voffB);
    PG8_WAIT_V(6); PG8_BAR;
    for (;;) {
        const bool has_next = S.next(ui + 1, nxt);
        const char* nA = has_next ? (const char*)g.A + (size_t)nxt.pm * tstepA : cA; const char* nB = has_next ? (const char*)g.Bt + (size_t)nxt.pb * tstepB : cB;
#pragma unroll 1
        for (int t = 0; t < nt; t += 2) {
            const bool last = (t == nt - 2);
            const char* a1 = cA + (size_t)(t + 1) * kstep;
            const char* a2 = last ? nA : cA + (size_t)(t + 2) * kstep; const char* b2 = last ? nB : cB + (size_t)(t + 2) * kstep;
            const char* a3 = a2 + kstep; const char* b3 = b2 + kstep;
            PG8_LDB(B0, 0, 0); PG8_SCHED; PG8_LDA(At, 0, 0); PG8_STAGE(PG8_SA(1, 1), a1 + hstepA, voffA);
            PG8_WAIT_L(8); PG8_BAR; PG8_WAIT_L(0); PG8_MMA(0, 0, At, B0); PG8_BAR; PG8_SCHED;
            PG8_LDB(B1, 0, 1); PG8_STAGE(PG8_SB(0, 0), b2, voffB);
            PG8_BAR; PG8_WAIT_L(0); PG8_MMA(0, 1, At, B1); PG8_BAR;
            PG8_LDA(At, 0, 1); PG8_STAGE(PG8_SA(0, 0), a2, voffA);
            PG8_BAR; PG8_WAIT_L(0); PG8_MMA(1, 0, At, B0); PG8_BAR; PG8_SCHED;
            PG8_STAGE(PG8_SB(0, 1), b2 + hstepB, voffB);
            PG8_WAIT_V(6); PG8_BAR; PG8_MMA(1, 1, At, B1); PG8_BAR;
            PG8_LDB(B0, 1, 0); PG8_SCHED; PG8_LDA(At, 1, 0); PG8_STAGE(PG8_SA(0, 1), a2 + hstepA, voffA);
            PG8_WAIT_L(8); PG8_BAR; PG8_WAIT_L(0); PG8_MMA(0, 0, At, B0); PG8_BAR; PG8_SCHED;
            PG8_LDB(B1, 1, 1); PG8_STAGE(PG8_SB(1, 0), b3, voffB);
            PG8_BAR; PG8_WAIT_L(0); PG8_MMA(0, 1, At, B1); PG8_BAR;
            PG8_LDA(At, 1, 1); PG8_STAGE(PG8_SA(1, 0), a3, voffA);
            PG8_BAR; PG8_WAIT_L(0); PG8_MMA(1, 0, At, B0); PG8_BAR; PG8_SCHED;
            PG8_STAGE(PG8_SB(1, 1), b3 + hstepB, voffB);
            PG8_WAIT_V(6); PG8_BAR; PG8_MMA(1, 1, At, B1); PG8_BAR;
        }
        { int fr_ = fr, fq_ = fq; asm volatile("" : "+v"(fr_), "+v"(fq_)); E(acc, cur, wr, wc, fr_, fq_); }
        if (!has_next) break;
#pragma unroll
        for (int a = 0; a < 2; ++a)
#pragma unroll
            for (int b = 0; b < 2; ++b)
#pragma unroll
                for (int m = 0; m < 4; ++m)
#pragma unroll
                    for (int n = 0; n < 2; ++n) acc[a][b][m][n] = (f32x4){0.f, 0.f, 0.f, 0.f};
        cur = nxt; cA = nA; cB = nB; ++ui;
    }
    PG8_WAIT_V(0);
    if (wr == 0) PG8_BAR;
    PG8_BAR;
#undef PG8_SA
#undef PG8_SB
#undef PG8_STAGE
#undef PG8_LDA
#undef PG8_LDB
#undef PG8_MMA
#undef PG8_WAIT_V
#undef PG8_WAIT_L
#undef PG8_BAR
#undef PG8_SCHED
}
}
using pg8::Unit; using pg8::HALF;
typedef const f32x4 (&AccRef)[2][2][4][2];

struct EpiZ {
    static constexpr bool PERM = true;
    bf16_t *zrw, *g3, *xl, *as;
    __device__ __forceinline__ void operator()(AccRef acc, const Unit& u, int wr, int wc, int fr, int fq) const {
        const int row0 = u.pm * 256 + wr * 64 + fr, colt = wc * 32 + 8 * fq, pn = u.pn;
        if (pn == 9 || pn == 10) {
#pragma unroll
            for (int ai = 0; ai < 2; ++ai)
#pragma unroll
                for (int m = 0; m < 4; ++m) { const int row = row0 + ai * HALF + m * 16; const int b = row >> 13, l = row & 8191;
#pragma unroll
                    for (int bj = 0; bj < 2; ++bj) { const int c = (pn - 9) * 256 + bj * HALF + colt; const int g = c >> 4, h0 = c & 15;
                        const size_t asrow = (size_t)g * 2048 + b * 512 + (l >> 4);
                        const f32x4 v0 = acc[ai][bj][m][0], v1 = acc[ai][bj][m][1];
                        u32x4 w; w.x = cvt_pk_bf16(v0[0], v0[1]); w.y = cvt_pk_bf16(v0[2], v0[3]); w.z = cvt_pk_bf16(v1[0], v1[1]); w.w = cvt_pk_bf16(v1[2], v1[3]);
                        *(u32x4*)(as + asrow * AS_LD + (l & 15) * 16 + h0) = w; } }
            return;
        }
        bf16_t* base; int ld, c0;
        if (pn < 7) { base = zrw; ld = ZRW_LD; c0 = pn * 256; }
        else if (pn < 9) { base = g3; ld = G3_LD; c0 = (pn - 7) * 256; }
        else if (pn < 13) { base = g3; ld = G3_LD; c0 = 512 + (pn - 11) * 256; }
        else if (pn < 15) { base = xl; ld = BW; c0 = (pn - 13) * 256; }
        else { base = g3; ld = G3_LD; c0 = 1024 + (pn - 15) * 256; }
#pragma unroll
        for (int ai = 0; ai < 2; ++ai)
#pragma unroll
            for (int m = 0; m < 4; ++m) { bf16_t* rowp = base + (size_t)(row0 + ai * HALF + m * 16) * ld + c0 + colt;
#pragma unroll
                for (int bj = 0; bj < 2; ++bj) { const f32x4 v0 = acc[ai][bj][m][0], v1 = acc[ai][bj][m][1];
                    u32x4 w; w.x = cvt_pk_bf16(v0[0], v0[1]); w.y = cvt_pk_bf16(v0[2], v0[3]); w.z = cvt_pk_bf16(v1[0], v1[1]); w.w = cvt_pk_bf16(v1[2], v1[3]);
                    *(u32x4*)(rowp + bj * HALF) = w; } }
    }
};
struct EpiPle {
    static constexpr bool PERM = true;
    bf16_t* pw; float* ss;
    __device__ __forceinline__ void operator()(AccRef acc, const Unit& u, int wr, int wc, int fr, int fq) const {
        const int row0 = u.pm * 256 + wr * 64 + fr, col0 = u.pn * 256 + wc * 32 + 8 * fq;
#pragma unroll
        for (int ai = 0; ai < 2; ++ai)
#pragma unroll
            for (int m = 0; m < 4; ++m) { const int row = row0 + ai * HALF + m * 16; bf16_t* rowp = pw + (size_t)row * D + col0; float s = 0.f;
#pragma unroll
                for (int bj = 0; bj < 2; ++bj) { const f32x4 v0 = acc[ai][bj][m][0], v1 = acc[ai][bj][m][1];
                    s += v0[0] * v0[0] + v0[1] * v0[1] + v0[2] * v0[2] + v0[3] * v0[3] + v1[0] * v1[0] + v1[1] * v1[1] + v1[2] * v1[2] + v1[3] * v1[3];
                    u32x4 w; w.x = cvt_pk_bf16(v0[0], v0[1]); w.y = cvt_pk_bf16(v0[2], v0[3]); w.z = cvt_pk_bf16(v1[0], v1[1]); w.w = cvt_pk_bf16(v1[2], v1[3]);
                    *(u32x4*)(rowp + bj * HALF) = w; }
                s += __shfl_xor(s, 16); s += __shfl_xor(s, 32);
                if (fq == 0) unsafeAtomicAdd(ss + row, s);
                asm volatile("" ::: "memory"); }
    }
};
struct EpiE {
    static constexpr bool PERM = false;
    float* e;
    __device__ __forceinline__ void operator()(AccRef acc, const Unit& u, int wr, int wc, int fr, int fq) const {
        const int row0 = u.pm * 256 + wr * 64 + fr, col0 = wc * 32 + 4 * fq;
#pragma unroll
        for (int ai = 0; ai < 2; ++ai)
#pragma unroll
            for (int m = 0; m < 4; ++m) { float* rowp = e + (size_t)(row0 + ai * HALF + m * 16) * 128 + col0;
#pragma unroll
                for (int n = 0; n < 2; ++n) *(f32x4*)(rowp + n * 16) = acc[ai][0][m][n]; }
    }
};
struct EpiY {
    static constexpr bool PERM = true;
    const bf16_t* as; const float* dvec; bf16_t* zgs;
    __device__ __forceinline__ void operator()(AccRef acc, const Unit& u, int wr, int wc, int fr, int fq) const {
        const int row0 = u.pm * 256 + wr * 64 + fr, colt = wc * 32 + 8 * fq, g = u.pm >> 3, h0 = (8 * fq) & 15;
        const f32x4 d0 = *(const f32x4*)(dvec + g * 16 + h0), d1 = *(const f32x4*)(dvec + g * 16 + h0 + 4);
#pragma unroll
        for (int ai = 0; ai < 2; ++ai)
#pragma unroll
            for (int m = 0; m < 4; ++m) { const int row = row0 + ai * HALF + m * 16; const int b = (row >> 9) & 3, ch = row & 511;
#pragma unroll
                for (int bj = 0; bj < 2; ++bj) { const int c = bj * HALF + colt, tt = c >> 4;
                    float uu[8]; unpack8(*(const u32x4*)(as + (size_t)row * AS_LD + c), uu);
                    const f32x4 v0 = acc[ai][bj][m][0], v1 = acc[ai][bj][m][1];
                    float o[8];
#pragma unroll
                    for (int j = 0; j < 4; ++j) { o[j] = gelu_tanh(v0[j] + d0[j] * uu[j]); o[4 + j] = gelu_tanh(v1[j] + d1[j] * uu[4 + j]); }
                    const size_t tok = (size_t)b * SEQ + ch * 16 + tt;
                    *(u32x4*)(zgs + tok * BW + g * 16 + h0) = pack8(o); }
                asm volatile("" ::: "memory"); }
    }
};
struct EpiGlu {
    static constexpr bool PERM = true;
    const bf16_t* zgs; const float* bias; bf16_t* g3;
    __device__ __forceinline__ void operator()(AccRef acc, const Unit& u, int wr, int wc, int fr, int fq) const {
        const int row0 = u.pm * 256 + wr * 64 + fr, col0 = u.pn * 256 + wc * 32 + 8 * fq;
#pragma unroll
        for (int ai = 0; ai < 2; ++ai)
#pragma unroll
            for (int m = 0; m < 4; ++m) { const size_t row = (size_t)(row0 + ai * HALF + m * 16);
#pragma unroll
                for (int bj = 0; bj < 2; ++bj) { const int c = col0 + bj * HALF;
                    float z[8], gt[8]; unpack8(*(const u32x4*)(zgs + row * BW + c), z); bf16_t* gp = g3 + row * G3_LD + 512 + c; unpack8(*(const u32x4*)gp, gt);
                    const f32x4 b0 = *(const f32x4*)(bias + c), b1 = *(const f32x4*)(bias + c + 4);
                    const f32x4 v0 = acc[ai][bj][m][0], v1 = acc[ai][bj][m][1];
                    float o[8];
#pragma unroll
                    for (int j = 0; j < 4; ++j) { o[j] = z[j] * sigmoidf_(v0[j] + b0[j]) * siluf_(gt[j]); o[4 + j] = z[4 + j] * sigmoidf_(v1[j] + b1[j]) * siluf_(gt[4 + j]); }
                    *(u32x4*)gp = pack8(o); } }
    }
};
struct EpiLru {
    static constexpr bool PERM = true;
    const bf16_t* xc; const float *ba, *bx, *lam; bf16_t* ab;
    __device__ __forceinline__ void operator()(AccRef acc, const Unit& u, int wr, int wc, int fr, int fq) const {
        const int row0 = u.pm * 256 + wr * 64 + fr, ch = u.pn * 128 + wc * 32 + 8 * fq;
        float bav[8], bxv[8], spl[8];
#pragma unroll
        for (int j = 0; j < 8; ++j) { bav[j] = ba[ch + j]; bxv[j] = bx[ch + j]; spl[j] = -8.0f * softplusf_(-lam[ch + j]); }
#pragma unroll
        for (int ai = 0; ai < 2; ++ai)
#pragma unroll
            for (int m = 0; m < 4; ++m) { const size_t row = (size_t)(row0 + ai * HALF + m * 16);
                float x[8]; unpack8(*(const u32x4*)(xc + row * BW + ch), x);
                float la[8], bb[8];
#pragma unroll
                for (int j = 0; j < 8; ++j) { const float za = acc[ai][0][m][j >> 2][j & 3], zx = acc[ai][1][m][j >> 2][j & 3];
                    const float r = sigmoidf_(za + bav[j]), ig = sigmoidf_(zx + bxv[j]);
                    const float l_a = spl[j] * r; la[j] = l_a;
                    bb[j] = sqrtf(fmaxf(-expm1f(2.0f * l_a), 0.0f)) * (ig * x[j]); }
                *(u32x4*)(ab + row * 1024 + ch) = pack8(la); *(u32x4*)(ab + row * 1024 + 512 + ch) = pack8(bb); }
    }
};
struct EpiOut {
    static constexpr bool PERM = true;
    const float* hin; float* h; bf16_t* h1b;
    __device__ __forceinline__ void operator()(AccRef acc, const Unit& u, int wr, int wc, int fr, int fq) const {
        const int row0 = u.pm * 256 + wr * 64 + fr, col0 = u.pn * 256 + wc * 32 + 8 * fq;
#pragma unroll
        for (int ai = 0; ai < 2; ++ai)
#pragma unroll
            for (int m = 0; m < 4; ++m) { const size_t off = (size_t)(row0 + ai * HALF + m * 16) * D + col0;
#pragma unroll
                for (int bj = 0; bj < 2; ++bj) { const size_t o = off + bj * HALF;
                    const f32x4 v0 = *(const f32x4*)(hin + o) + acc[ai][bj][m][0], v1 = *(const f32x4*)(hin + o + 4) + acc[ai][bj][m][1];
                    *(f32x4*)(h + o) = v0; *(f32x4*)(h + o + 4) = v1;
                    u32x4 w; w.x = cvt_pk_bf16(v0[0], v0[1]); w.y = cvt_pk_bf16(v0[2], v0[3]); w.z = cvt_pk_bf16(v1[0], v1[1]); w.w = cvt_pk_bf16(v1[2], v1[3]); *(u32x4*)(h1b + o) = w; }
                asm volatile("" ::: "memory"); }
    }
};
struct EpiGate {
    static constexpr bool PERM = true;
    float* h; const bf16_t* pw; const float* ssp; const float* gple; float* ssh;
    __device__ __forceinline__ void operator()(AccRef acc, const Unit& u, int wr, int wc, int fr, int fq) const {
        const int row0 = u.pm * 256 + wr * 64 + fr, col0 = u.pn * 256 + wc * 32 + 8 * fq;
        f32x4 gv[2][2];
#pragma unroll
        for (int bj = 0; bj < 2; ++bj)
#pragma unroll
            for (int n = 0; n < 2; ++n) gv[bj][n] = *(const f32x4*)(gple + col0 + bj * HALF + 4 * n);
#pragma unroll
        for (int ai = 0; ai < 2; ++ai)
#pragma unroll
            for (int m = 0; m < 4; ++m) { const int row = row0 + ai * HALF + m * 16; const size_t off = (size_t)row * D + col0;
                const float rs = rsqrtf(ssp[row] * (1.0f / 1024.0f) + 1e-6f); float s = 0.f;
#pragma unroll
                for (int bj = 0; bj < 2; ++bj) { const size_t o = off + bj * HALF; float pv[8]; unpack8(*(const u32x4*)(pw + o), pv);
#pragma unroll
                    for (int n = 0; n < 2; ++n) { const f32x4 a = acc[ai][bj][m][n]; f32x4 v = *(const f32x4*)(h + o + 4 * n);
#pragma unroll
                        for (int j = 0; j < 4; ++j) { v[j] += pv[4 * n + j] * rs * gv[bj][n][j] * sigmoidf_(a[j]); s += v[j] * v[j]; }
                        *(f32x4*)(h + o + 4 * n) = v; } }
                s += __shfl_xor(s, 16); s += __shfl_xor(s, 32);
                if (fq == 0) unsafeAtomicAdd(ssh + row, s); }
    }
};

struct Ctx { const Params* P; unsigned char* ws; LAS unsigned char* lds; unsigned char* ldsg; int tid, lane, wave; size_t gtid, gsz; int vb, vG; };

template <class Map>
__device__ void transpose_w(const Ctx& c, const float* src, bf16_t* dst, int K, int Nsrc, int Npad, Map map) {
    const int K8 = K / 8; const size_t total = (size_t)2 * Npad * K8;
    for (size_t idx = c.gtid; idx < total; idx += c.gsz) {
        const int n = (int)(idx % Npad); const int k8 = (int)((idx / Npad) % K8); const int l = (int)(idx / ((size_t)Npad * K8));
        const int s = map(n); float f[8];
#pragma unroll
        for (int i = 0; i < 8; ++i) f[i] = (s >= 0) ? src[((size_t)l * K + k8 * 8 + i) * Nsrc + s] : 0.0f;
        *(u32x4*)(dst + ((size_t)l * Npad + n) * K + k8 * 8) = pack8(f);
    }
}

__device__ __forceinline__ void s5_lam_pow(const Params& P, int l, int g, int p, int n, float& re, float& im) {
    const float are = P.in[14][(l * 32 + g) * 64 + p], aim = P.in[15][(l * 32 + g) * 64 + p], dt = __expf(P.in[16][l * 32 + g]);
    const float mag = __expf(are * dt * (float)n);
    double rev = (double)aim * (double)dt * (double)n * 0.15915494309189535; rev -= rint(rev);
    const float ang = (float)(rev * 6.283185307179586);
    re = mag * cosf(ang); im = mag * sinf(ang);
}

__device__ void phase_prep(const Ctx& c) {
    const Params& P = *c.P; unsigned char* ws = c.ws;
    transpose_w(c, P.in[3], (bf16_t*)(ws + OFF_WIN), D, DIN, DINP, [](int n) { return n < 1664 ? n : (n < 1792 ? -1 : n - 128); });
    transpose_w(c, P.in[31], (bf16_t*)(ws + OFF_WOUT), DMIX, D, D, [](int n) { return n; });
    transpose_w(c, P.in[34], (bf16_t*)(ws + OFF_WG), D, D, D, [](int n) { return n; });
    transpose_w(c, P.in[32], (bf16_t*)(ws + OFF_WPLE), DPLE, D, D, [](int n) { return n; });
    transpose_w(c, P.in[22], (bf16_t*)(ws + OFF_WGLU), BW, BW, BW, [](int n) { return n; });
    { bf16_t* dst = (bf16_t*)(ws + OFF_WLRU);
      for (size_t idx = c.gtid; idx < (size_t)2 * 1024 * 64; idx += c.gsz) {
          const int n = (int)(idx & 1023), k8 = (int)((idx >> 10) & 63), l = (int)(idx >> 16);
          const int pn = n >> 8, rr = n & 255, ch = 128 * pn + (rr & 127), which = rr >> 7, hb = ch >> 6, j = ch & 63, k0 = k8 * 8;
          const float* W = which ? P.in[28] : P.in[26]; float f[8];
#pragma unroll
          for (int i = 0; i < 8; ++i) f[i] = ((k0 >> 6) == hb) ? W[(((size_t)l * 8 + hb) * 64 + (k0 & 63) + i) * 64 + j] : 0.0f;
          *(u32x4*)(dst + ((size_t)l * 1024 + n) * BW + k0) = pack8(f); } }
    { float* tbl = (float*)(ws + OFF_TBL);
      for (size_t idx = c.gtid; idx < (size_t)2 * 32 * 64 * 18; idx += c.gsz) {
          const int n = (int)(idx % 18), lgp = (int)(idx / 18), p = lgp & 63, g = (lgp >> 6) & 31, l = lgp >> 11; float re, im;
          if (n < 17) s5_lam_pow(P, l, g, p, n, re, im);
          else { float lr, li; s5_lam_pow(P, l, g, p, 1, lr, li); const float ar = P.in[14][(l * 32 + g) * 64 + p], ai = P.in[15][(l * 32 + g) * 64 + p];
                 const float cr = lr - 1.0f, ci = li, den = 1.0f / (ar * ar + ai * ai); re = (cr * ar + ci * ai) * den; im = (ci * ar - cr * ai) * den; }
          tbl[idx * 2] = re; tbl[idx * 2 + 1] = im; } }
    { const float* x = P.in[0]; const float* gg = P.in[2]; bf16_t* xn = (bf16_t*)(ws + OFF_XN);
      const int stride = gridDim.x * 8;
      for (int row0 = blockIdx.x * 8 + c.wave; row0 < T; row0 += 2 * stride) {
          f32x4 v[2][4]; float sq[2]; bool ok[2];
#pragma unroll
          for (int r = 0; r < 2; ++r) { const int row = row0 + r * stride; ok[r] = row < T; const int rr = ok[r] ? row : row0; sq[r] = 0.f;
#pragma unroll
              for (int i = 0; i < 4; ++i) { v[r][i] = *(const f32x4*)(x + (size_t)rr * D + i * 256 + c.lane * 4); sq[r] += v[r][i][0] * v[r][i][0] + v[r][i][1] * v[r][i][1] + v[r][i][2] * v[r][i][2] + v[r][i][3] * v[r][i][3]; } }
#pragma unroll
          for (int r = 0; r < 2; ++r) { if (!ok[r]) continue; const int row = row0 + r * stride; const float rs = rsqrtf(wave_sum(sq[r]) * (1.0f / 1024.0f) + 1e-6f);
#pragma unroll
              for (int i = 0; i < 4; ++i) { const f32x4 gv = *(const f32x4*)(gg + i * 256 + c.lane * 4); u32x2 w; w.x = cvt_pk_bf16(v[r][i][0] * rs * gv[0], v[r][i][1] * rs * gv[1]); w.y = cvt_pk_bf16(v[r][i][2] * rs * gv[2], v[r][i][3] * rs * gv[3]);
                  *(u32x2*)(xn + (size_t)row * D + i * 256 + c.lane * 4) = w; } } } }
    { float* ss = (float*)(ws + OFF_SS); for (size_t i = c.gtid; i < (size_t)4 * T; i += c.gsz) ss[i] = 0.0f; }
    { const float* p = P.in[1]; bf16_t* pb = (bf16_t*)(ws + OFF_PB);
      for (size_t i = c.gtid; i < (size_t)2 * T * DPLE / 8; i += c.gsz) { const f32x4 a = *(const f32x4*)(p + i * 8), b = *(const f32x4*)(p + i * 8 + 4);
          u32x4 w; w.x = cvt_pk_bf16(a[0], a[1]); w.y = cvt_pk_bf16(a[2], a[3]); w.z = cvt_pk_bf16(b[0], b[1]); w.w = cvt_pk_bf16(b[2], b[3]); *(u32x4*)(pb + i * 8) = w; } }
}

__device__ void phase_s5_consts(const Ctx& c) {
    const Params& P = *c.P; unsigned char* ws = c.ws;
    const float* tbl = (const float*)(ws + OFF_TBL); bf16_t* by = (bf16_t*)(ws + OFF_S5Y); bf16_t* be = (bf16_t*)(ws + OFF_S5E);
    const float *bre = P.in[17], *bim = P.in[18], *cre = P.in[19], *cim = P.in[20];
    for (size_t idx = c.gtid; idx < (size_t)2 * 32 * 16 * 256; idx += c.gsz) {
        const int hp = (int)(idx & 15), h = (int)((idx >> 4) & 15), tau = (int)((idx >> 8) & 15), g = (int)((idx >> 12) & 31), l = (int)(idx >> 17);
        const int lg = l * 32 + g; float s = 0.f;
        for (int p = 0; p < 64; ++p) { const float* tp = tbl + ((size_t)(lg * 64 + p) * 18) * 2;
            const float pr = tp[tau * 2], pi = tp[tau * 2 + 1], qr = tp[34], qi = tp[35];
            const float br = bre[((size_t)lg * 64 + p) * 16 + hp], bi = bim[((size_t)lg * 64 + p) * 16 + hp];
            const float bbr = qr * br - qi * bi, bbi = qr * bi + qi * br;
            const float zr = pr * bbr - pi * bbi, zi = pr * bbi + pi * bbr;
            const float cr = cre[((size_t)lg * 16 + h) * 64 + p], ci = cim[((size_t)lg * 16 + h) * 64 + p];
            s += cr * zr - ci * zi; }
        const bf16_t kv = f2bf(s); bf16_t* base = by + (size_t)lg * 256 * AS_LD;
        for (int s0 = 0; s0 + tau < 16; ++s0) { const int t = s0 + tau;
            base[(size_t)(t * 16 + h) * AS_LD + s0 * 16 + hp] = kv;
            if (tau > 0) base[(size_t)(s0 * 16 + h) * AS_LD + t * 16 + hp] = 0; }
    }
    for (size_t idx = c.gtid; idx < (size_t)2 * 32 * 256 * 64; idx += c.gsz) {
        const int p = (int)(idx & 63), th = (int)((idx >> 6) & 255), lg = (int)(idx >> 14); const int t = th >> 4, h = th & 15;
        const float* tp = tbl + ((size_t)(lg * 64 + p) * 18) * 2; const float pr = tp[(t + 1) * 2], pi = tp[(t + 1) * 2 + 1];
        const float cr = cre[((size_t)lg * 16 + h) * 64 + p], ci = cim[((size_t)lg * 16 + h) * 64 + p];
        bf16_t* rowp = by + ((size_t)lg * 256 + th) * AS_LD; rowp[256 + p] = f2bf(cr * pr - ci * pi); rowp[320 + p] = f2bf(-(cr * pi + ci * pr));
    }
    for (size_t idx = c.gtid; idx < (size_t)2 * 32 * 256 * 256; idx += c.gsz) {
        const int col = (int)(idx & 255), n = (int)((idx >> 8) & 255), lg = (int)(idx >> 16); float v = 0.f;
        if (n < 128) { const int p = n & 63, s0 = col >> 4, hp = col & 15; const float* tp = tbl + ((size_t)(lg * 64 + p) * 18) * 2;
            const float pr = tp[(15 - s0) * 2], pi = tp[(15 - s0) * 2 + 1], qr = tp[34], qi = tp[35];
            const float br = bre[((size_t)lg * 64 + p) * 16 + hp], bi = bim[((size_t)lg * 64 + p) * 16 + hp];
            const float bbr = qr * br - qi * bi, bbi = qr * bi + qi * br;
            v = (n < 64) ? (pr * bbr - pi * bbi) : (pr * bbi + pi * bbr); }
        be[idx] = f2bf(v);
    }
}

__device__ void phase_lru_conv(const Ctx& c, int l) {
    const Params& P = *c.P; const bf16_t* xl = (const bf16_t*)(c.ws + OFF_XL); bf16_t* xc = (bf16_t*)(c.ws + OFF_XC);
    const float* cw = P.in[24] + (size_t)l * 4 * BW; const float* cb = P.in[25] + (size_t)l * BW;
    for (size_t idx = (size_t)c.vb * 512 + c.tid; idx < (size_t)T * 64; idx += (size_t)c.vG * 512) {
        const int c8 = (int)(idx & 63) * 8; const int row = (int)(idx >> 6), lpos = row & (SEQ - 1);
        float o[8];
#pragma unroll
        for (int i = 0; i < 8; ++i) o[i] = cb[c8 + i];
#pragma unroll
        for (int j = 0; j < 4; ++j) { if (lpos - 3 + j >= 0) { float x[8]; unpack8(*(const u32x4*)(xl + (size_t)(row - 3 + j) * BW + c8), x);
#pragma unroll
                for (int i = 0; i < 8; ++i) o[i] += x[i] * cw[j * BW + c8 + i]; } }
        *(u32x4*)(xc + (size_t)row * BW + c8) = pack8(o);
    }
}

__device__ void phase_s5_carry(const Ctx& c, int l) {
    if (c.wave != 0 || c.vb >= 128) return;
    const int g = c.vb >> 2, b = c.vb & 3, p = c.lane;
    float lr, li; s5_lam_pow(*c.P, l, g, p, 16, lr, li);
    const float* e = (const float*)(c.ws + OFF_E); bf16_t* as = (bf16_t*)(c.ws + OFF_AS);
    const size_t base = (size_t)g * 2048 + b * 512; float xr = 0.f, xi = 0.f;
    for (int c0 = 0; c0 < 512; c0 += 32) {
        float er[32], ei[32];
#pragma unroll
        for (int i = 0; i < 32; ++i) { er[i] = e[(base + c0 + i) * 128 + p]; ei[i] = e[(base + c0 + i) * 128 + 64 + p]; }
#pragma unroll
        for (int i = 0; i < 32; ++i) { bf16_t* rowp = as + (base + c0 + i) * AS_LD; rowp[256 + p] = f2bf(xr); rowp[320 + p] = f2bf(xi);
            const float nr = lr * xr - li * xi + er[i], ni = lr * xi + li * xr + ei[i]; xr = nr; xi = ni; }
    }
}

__device__ void phase_lru_scan(const Ctx& c, int pass) {
    const bf16_t* ab = (const bf16_t*)(c.ws + OFF_LRUAB); float* agg = (float*)(c.ws + OFF_AGG); bf16_t* g3 = (bf16_t*)(c.ws + OFF_G3);
    const int ch = c.tid;
    for (int unit = c.vb; unit < NB * 128; unit += c.vG) {
        const int b = unit >> 7, ck = unit & 127; const size_t t0 = (size_t)b * SEQ + ck * 64;
        float h = 0.f, sl = 0.f;
        if (pass == 1) {
            for (int i0 = 0; i0 < ck; i0 += 16) { float sl_[16], he_[16];
#pragma unroll
                for (int j = 0; j < 16; ++j) { const int ii = (i0 + j < ck) ? i0 + j : ck - 1; const float* a = agg + ((size_t)(b * 128 + ii)) * 1024; sl_[j] = a[ch]; he_[j] = a[512 + ch]; }
#pragma unroll
                for (int j = 0; j < 16; ++j) if (i0 + j < ck) h = __expf(sl_[j]) * h + he_[j]; }
        }
        for (int t8 = 0; t8 < 64; t8 += 16) {
            float la[16], bb[16], gt[16];
#pragma unroll
            for (int i = 0; i < 16; ++i) { la[i] = bf2f(ab[(t0 + t8 + i) * 1024 + ch]); bb[i] = bf2f(ab[(t0 + t8 + i) * 1024 + 512 + ch]); if (pass == 1) gt[i] = bf2f(g3[(t0 + t8 + i) * G3_LD + 1024 + ch]); }
#pragma unroll
            for (int i = 0; i < 16; ++i) { h = __expf(la[i]) * h + bb[i]; sl += la[i];
                if (pass == 1) g3[(t0 + t8 + i) * G3_LD + 1024 + ch] = f2bf(h * siluf_(gt[i])); }
        }
        if (pass == 0) { float* a = agg + ((size_t)(b * 128 + ck)) * 1024; a[ch] = sl; a[512 + ch] = h; }
    }
}

__device__ void phase_norm(const Ctx& c, const float* ss, const float* gg, int fin) {
    float* h = c.P->out; bf16_t* xn = (bf16_t*)(c.ws + OFF_XN);
    const int stride = gridDim.x * 8;
    f32x4 gv[4];
#pragma unroll
    for (int i = 0; i < 4; ++i) gv[i] = *(const f32x4*)(gg + i * 256 + c.lane * 4);
    for (int row0 = blockIdx.x * 8 + c.wave; row0 < T; row0 += 4 * stride) {
        f32x4 v[4][4]; float rs[4]; bool ok[4];
#pragma unroll
        for (int r = 0; r < 4; ++r) { const int row = row0 + r * stride; ok[r] = row < T; const int rr = ok[r] ? row : row0; rs[r] = ss[rr];
#pragma unroll
            for (int i = 0; i < 4; ++i) v[r][i] = *(const f32x4*)(h + (size_t)rr * D + i * 256 + c.lane * 4); }
#pragma unroll
        for (int r = 0; r < 4; ++r) { if (!ok[r]) continue; const int row = row0 + r * stride; const float sc = rsqrtf(rs[r] * (1.0f / 1024.0f) + 1e-6f);
#pragma unroll
            for (int i = 0; i < 4; ++i) { const size_t o = (size_t)row * D + i * 256 + c.lane * 4; const f32x4 q = v[r][i] * sc * gv[i];
                if (fin) *(f32x4*)(h + o) = q; else { u32x2 w; w.x = cvt_pk_bf16(q[0], q[1]); w.y = cvt_pk_bf16(q[2], q[3]); *(u32x2*)(xn + o) = w; } } }
    }
}

typedef float f32x2 __attribute__((ext_vector_type(2)));
template <int CTRL> __device__ __forceinline__ float dpp_mov(float v) { return __builtin_bit_cast(float, __builtin_amdgcn_update_dpp(0, __builtin_bit_cast(int, v), CTRL, 0xf, 0xf, true)); }
__device__ __forceinline__ float row16_sum(float v) { v += dpp_mov<0xB1>(v); v += dpp_mov<0x4E>(v); v += dpp_mov<0x124>(v); v += dpp_mov<0x128>(v); return v; }
__device__ __forceinline__ float wave_sum2(float v) { v = row16_sum(v); const int vi = __builtin_bit_cast(int, v); const float a = __builtin_bit_cast(float, __builtin_amdgcn_readlane(vi, 0)), b = __builtin_bit_cast(float, __builtin_amdgcn_readlane(vi, 16)), c2 = __builtin_bit_cast(float, __builtin_amdgcn_readlane(vi, 32)), d = __builtin_bit_cast(float, __builtin_amdgcn_readlane(vi, 48)); return (a + b) + (c2 + d); }
__device__ __forceinline__ float oct_sum(float v) { v += dpp_mov<0xB1>(v); v += dpp_mov<0x4E>(v); v += dpp_mov<0x141>(v); return v; }
constexpr int RW_NBLK = 128, TWS = 72;

struct RwRows { unsigned zr[5], zk[5], zv[5], zw[5], za[5]; };
__device__ __forceinline__ float rw_get(const unsigned (&a)[5], int i) { return (i & 1) ? hi16(a[i >> 1]) : lo16(a[i >> 1]); }
__device__ __forceinline__ void rw_load_rows(RwRows& R, const bf16_t* zrw, int b, int blk, int w, int lane, int cj) {
#pragma unroll
    for (int p = 0; p < 5; ++p) { unsigned r_[2] = {0, 0}, k_[2] = {0, 0}, v_[2] = {0, 0}, w_[2] = {0, 0}, a_[2] = {0, 0};
#pragma unroll
        for (int h = 0; h < 2; ++h) { const int i = 2 * p + h; if (i < 9) { const int lp = blk * 64 + w * 8 - 1 + i; const bool ok = lp >= 0; const bf16_t* rp = zrw + ((size_t)b * SEQ + (ok ? lp : 0)) * ZRW_LD;
            const unsigned m = ok ? 0xffffu : 0u;
            r_[h] = rp[cj] & m; k_[h] = rp[512 + cj] & m; v_[h] = rp[1024 + cj] & m; w_[h] = rp[1536 + lane] & m; a_[h] = rp[1600 + lane] & m; } }
        R.zr[p] = r_[0] | (r_[1] << 16); R.zk[p] = k_[0] | (k_[1] << 16); R.zv[p] = v_[0] | (v_[1] << 16); R.zw[p] = w_[0] | (w_[1] << 16); R.za[p] = a_[0] | (a_[1] << 16); }
}

constexpr int CH_AT = 0, CH_RT = 2304, CH_KT = 4608, CH_BT = 6912, CH_KH = 9216, CH_NB = 12288, CH_VT = 15360, CH_LRK = 18432, CH_NLRB = 19200, CH_GI = 19968,
              CH_LAB = 20736, CH_LAK = 21760, CH_GC = 22784, CH_BYTES = 23040;
constexpr int RW_YY = 4 * CH_BYTES, RW_TW = RW_YY + 16384, RW_AD = RW_TW + 64 * TWS * 2, RW_AR = RW_TW  , RW_GP = RW_AD + 64 * TWS * 2,
              RW_W2 = RW_GP + 2048, RW_A2 = RW_W2 + 64 * TWS * 2, RW_CT = RW_A2 + 64 * TWS * 2, RW_END = RW_CT + 12 * 64 * 4;
static_assert(RW_END <= LDS_BYTES, "rwkv lds");
__device__ __forceinline__ void lds_barrier() { asm volatile("s_waitcnt lgkmcnt(0)\n\ts_barrier" ::: "memory"); }
typedef short bf16x4 __attribute__((ext_vector_type(4)));
__device__ __forceinline__ bf16x8 cat4(bf16x4 lo, bf16x4 hi) { return __builtin_shufflevector(lo, hi, 0, 1, 2, 3, 4, 5, 6, 7); }
__device__ __forceinline__ bf16x8 cat4z(bf16x4 lo) { const bf16x4 z = {0, 0, 0, 0}; return __builtin_shufflevector(lo, z, 0, 1, 2, 3, 4, 5, 6, 7); }
__device__ __forceinline__ bf16x4 pk4(f32x4 v) { u32x2 w; w.x = cvt_pk_bf16(v[0], v[1]); w.y = cvt_pk_bf16(v[2], v[3]); return __builtin_bit_cast(bf16x4, w); }

__device__ void phase_rwkv(const Ctx& c, int l, int blk_lo, int blk_hi, bool dry = false) {
    if (blockIdx.x >= 32) return;
    const Params& P = *c.P; const int b = blockIdx.x >> 3, hd = blockIdx.x & 7, lane = c.lane, w = c.wave, cj = hd * 64 + lane, fr = lane & 15, fq = lane >> 4;
    LAS unsigned char* LB = c.lds;
    LAS float* YY = (LAS float*)(LB + RW_YY); LAS float* WR = YY; LAS float* AR = (LAS float*)(LB + RW_AR); LAS float* GP = (LAS float*)(LB + RW_GP);
    LAS bf16_t* TWb = (LAS bf16_t*)(LB + RW_TW); LAS bf16_t* ADb = (LAS bf16_t*)(LB + RW_AD);
    const bf16_t* zrw = (const bf16_t*)(c.ws + OFF_ZRW); bf16_t* g3 = (bf16_t*)(c.ws + OFF_G3);
    LAS float* CT = (LAS float*)(LB + RW_CT);
    if (c.tid < 64) { const float* mu = P.in[4] + (size_t)l * 1664; const int j = hd * 64 + c.tid;
        CT[0 * 64 + c.tid] = mu[j]; CT[1 * 64 + c.tid] = mu[512 + j]; CT[2 * 64 + c.tid] = mu[1024 + j]; CT[3 * 64 + c.tid] = mu[1536 + c.tid]; CT[4 * 64 + c.tid] = mu[1600 + c.tid];
        CT[5 * 64 + c.tid] = P.in[5][l * BW + j]; CT[6 * 64 + c.tid] = P.in[7][l * BW + j]; CT[7 * 64 + c.tid] = P.in[9][l * BW + j]; CT[8 * 64 + c.tid] = P.in[10][l * BW + j];
        CT[9 * 64 + c.tid] = P.in[11][l * BW + j]; CT[10 * 64 + c.tid] = P.in[12][l * BW + j]; CT[11 * 64 + c.tid] = P.in[13][l * BW + j]; }
    const int mt_ = w >> 1, nh = w & 1;
    LAS bf16_t* W2I = (LAS bf16_t*)(LB + RW_W2); LAS bf16_t* A2I = (LAS bf16_t*)(LB + RW_A2);
    for (int i = c.tid; i < 4096; i += 512) { const int k = i >> 6, j = i & 63; W2I[j * TWS + k] = f2bf(P.in[6][((size_t)l * 64 + k) * BW + hd * 64 + j]); A2I[j * TWS + k] = f2bf(P.in[8][((size_t)l * 64 + k) * BW + hd * 64 + j]); }
    __syncthreads();
    f32x4 Macc[4];
#pragma unroll
    for (int i = 0; i < 4; ++i) Macc[i] = (f32x4){0.f, 0.f, 0.f, 0.f};
    const int cc = w >> 1, hc = w & 1;
    RwRows cur;
    rw_load_rows(cur, zrw, b, blk_lo, w, lane, cj);
    for (int blk = blk_lo; blk < blk_hi; ++blk) {
        const size_t t0 = (size_t)b * SEQ + blk * 64;
        float rs[8], ks_[8], vs[8];
        const float mu_r = CT[lane], mu_k = CT[64 + lane], mu_v = CT[128 + lane], mu_w = CT[192 + lane], mu_a = CT[256 + lane];
#pragma unroll
        for (int i = 0; i < 8; ++i) { const int tok = w * 8 + i;
            { const float r0 = rw_get(cur.zr, i), r1 = rw_get(cur.zr, i + 1), k0 = rw_get(cur.zk, i), k1 = rw_get(cur.zk, i + 1), v0 = rw_get(cur.zv, i), v1 = rw_get(cur.zv, i + 1);
              rs[i] = r1 + mu_r * (r0 - r1); ks_[i] = k1 + mu_k * (k0 - k1); vs[i] = v1 + mu_v * (v0 - v1); }
            const float w0_ = rw_get(cur.zw, i), w1_ = rw_get(cur.zw, i + 1), a0_ = rw_get(cur.za, i), a1_ = rw_get(cur.za, i + 1);
            const float wds = w1_ + mu_w * (w0_ - w1_), ads = a1_ + mu_a * (a0_ - a1_);
            const float e2 = __expf(2.0f * wds); const float th = 1.0f - 2.0f * __builtin_amdgcn_rcpf(e2 + 1.0f);
            TWb[tok * TWS + lane] = f2bf(th); ADb[tok * TWS + lane] = f2bf(ads); }
        if (blk + 1 < RW_NBLK) rw_load_rows(cur, zrw, b, blk + 1, w, lane, cj);
        unsigned gtp[4];
#pragma unroll
        for (int i = 0; i < 4; ++i) gtp[i] = (unsigned)g3[(t0 + w * 8 + 2 * i) * G3_LD + cj] | ((unsigned)g3[(t0 + w * 8 + 2 * i + 1) * G3_LD + cj] << 16);
        lds_barrier();
        { bf16x8 atw[2], aad[2];
#pragma unroll
          for (int ks = 0; ks < 2; ++ks) { atw[ks] = *(const LAS bf16x8*)(TWb + (16 * mt_ + fr) * TWS + 32 * ks + 8 * fq); aad[ks] = *(const LAS bf16x8*)(ADb + (16 * mt_ + fr) * TWS + 32 * ks + 8 * fq); }
          f32x4 cw[2], ca[2];
#pragma unroll
          for (int n2 = 0; n2 < 2; ++n2) { cw[n2] = (f32x4){0.f, 0.f, 0.f, 0.f}; ca[n2] = cw[n2];
#pragma unroll
              for (int ks = 0; ks < 2; ++ks) { const int bo = (32 * nh + 16 * n2 + fr) * TWS + 32 * ks + 8 * fq;
                  cw[n2] = __builtin_amdgcn_mfma_f32_16x16x32_bf16(atw[ks], *(const LAS bf16x8*)(W2I + bo), cw[n2], 0, 0, 0); ca[n2] = __builtin_amdgcn_mfma_f32_16x16x32_bf16(aad[ks], *(const LAS bf16x8*)(A2I + bo), ca[n2], 0, 0, 0); } }
          lds_barrier();
#pragma unroll
          for (int n2 = 0; n2 < 2; ++n2)
#pragma unroll
              for (int r = 0; r < 4; ++r) { const int o = (16 * mt_ + 4 * fq + r) * 64 + 32 * nh + 16 * n2 + fr; WR[o] = cw[n2][r]; AR[o] = ca[n2][r]; } }
        lds_barrier();
        float kkv[8], kpv[8], bbv[8], gl[8], cbv[8];
        { float g = 1.0f; const float w0j = CT[320 + lane], a0j = CT[384 + lane], kkj = CT[448 + lane], kaj = CT[512 + lane], rkj = CT[576 + lane];
#pragma unroll
          for (int i = 0; i < 8; ++i) { const int o = (w * 8 + i) * 64 + lane;
            const float wraw = w0j + WR[o], araw = a0j + AR[o];
            const float d = __expf(-0.6065306597126334f * sigmoidf_(wraw)), a = sigmoidf_(araw);
            float kk = ks_[i] * kkj; const float n2 = wave_sum2(kk * kk); kk = kk * __builtin_amdgcn_rsqf(fmaxf(n2, 1e-24f));
            const float kp = ks_[i] * (1.0f + (a - 1.0f) * kaj);
            cbv[i] = wave_sum2(rs[i] * kp * rkj);
            g *= d; gl[i] = g; kkv[i] = kk; kpv[i] = kp; bbv[i] = kk * a; }
          GP[w * 64 + lane] = g; }
        lds_barrier();
        { LAS unsigned char* CB_ = LB + cc * CH_BYTES;
          LAS bf16_t *AT = (LAS bf16_t*)(CB_ + CH_AT), *RT = (LAS bf16_t*)(CB_ + CH_RT), *KT = (LAS bf16_t*)(CB_ + CH_KT), *BT = (LAS bf16_t*)(CB_ + CH_BT),
                     *KH = (LAS bf16_t*)(CB_ + CH_KH), *NBH = (LAS bf16_t*)(CB_ + CH_NB), *VT = (LAS bf16_t*)(CB_ + CH_VT);
          const float g0 = GP[(2 * cc) * 64 + lane], g1 = GP[(2 * cc + 1) * 64 + lane], gC = g0 * g1, pre = hc ? g0 : 1.0f;
          if (hc == 0) ((LAS float*)(CB_ + CH_GC))[lane] = gC;
#pragma unroll
          for (int i = 0; i < 8; ++i) { const int tl = 8 * hc + i;
            const float gam = pre * gl[i], gprev = (i == 0) ? pre : pre * gl[i - 1], ig = __builtin_amdgcn_rcpf(gam), gr = gC * ig;
            AT[tl * TWS + lane] = f2bf(kkv[i] * gprev); RT[tl * TWS + lane] = f2bf(rs[i] * gam); KT[tl * TWS + lane] = f2bf(kpv[i] * ig); BT[tl * TWS + lane] = f2bf(bbv[i] * ig);
            KH[lane * 24 + tl] = f2bf(kpv[i] * gr); NBH[lane * 24 + tl] = f2bf(-bbv[i] * gr); VT[lane * 24 + tl] = f2bf(vs[i]); } }
        lds_barrier();
        if (w < 4 && !(RW_OFF & 4)) { LAS unsigned char* CB_ = LB + w * CH_BYTES;
          const LAS bf16_t *AT = (const LAS bf16_t*)(CB_ + CH_AT), *RT = (const LAS bf16_t*)(CB_ + CH_RT), *KT = (const LAS bf16_t*)(CB_ + CH_KT), *BT = (const LAS bf16_t*)(CB_ + CH_BT);
          f32x4 lab = (f32x4){0.f, 0.f, 0.f, 0.f}, lak = lab, lrk = lab, lrb = lab;
#pragma unroll
          for (int ks = 0; ks < 2; ++ks) { const int o = fr * TWS + 32 * ks + 8 * fq;
            const bf16x8 af = *(const LAS bf16x8*)(AT + o), rf = *(const LAS bf16x8*)(RT + o), kf = *(const LAS bf16x8*)(KT + o), bf = *(const LAS bf16x8*)(BT + o);
            lab = __builtin_amdgcn_mfma_f32_16x16x32_bf16(af, bf, lab, 0, 0, 0); lak = __builtin_amdgcn_mfma_f32_16x16x32_bf16(af, kf, lak, 0, 0, 0);
            lrk = __builtin_amdgcn_mfma_f32_16x16x32_bf16(rf, kf, lrk, 0, 0, 0); lrb = __builtin_amdgcn_mfma_f32_16x16x32_bf16(rf, bf, lrb, 0, 0, 0); }
          LAS float *LAB = (LAS float*)(CB_ + CH_LAB), *LAK = (LAS float*)(CB_ + CH_LAK); LAS bf16_t *LRK = (LAS bf16_t*)(CB_ + CH_LRK), *NLRB = (LAS bf16_t*)(CB_ + CH_NLRB);
#pragma unroll
          for (int r = 0; r < 4; ++r) { const int t = 4 * fq + r, s_ = fr; const bool lo_ = t > s_, le_ = t >= s_;
            LAB[t * 16 + s_] = lo_ ? lab[r] : 0.0f; LAK[t * 16 + s_] = lo_ ? lak[r] : 0.0f;
            LRK[t * 24 + s_] = f2bf(le_ ? lrk[r] : 0.0f); NLRB[t * 24 + s_] = f2bf(le_ ? -lrb[r] : 0.0f); } }
        lds_barrier();
        { const int ch6 = w & 3; LAS unsigned char* CB_ = LB + ch6 * CH_BYTES;
          const LAS bf16_t* AT = (const LAS bf16_t*)(CB_ + CH_AT); const LAS float *LAB = (const LAS float*)(CB_ + CH_LAB), *LAK = (const LAS float*)(CB_ + CH_LAK);
          LAS bf16_t *WI = (LAS bf16_t*)(CB_ + CH_KT), *GI = (LAS bf16_t*)(CB_ + CH_GI);
          float xv[16];
          if (w < 4) {
#pragma unroll
            for (int t = 0; t < 16; ++t) xv[t] = bf2f(AT[t * TWS + lane]);
          } else {
#pragma unroll
            for (int t = 0; t < 16; ++t) xv[t] = LAK[t * 16 + fr];
          }
#pragma unroll
          for (int t = 1; t < 16; ++t) { float xa = xv[t];
#pragma unroll
            for (int q = 0; q < 4; ++q) if (4 * q < t) { const f32x4 lr = *(const LAS f32x4*)(LAB + t * 16 + 4 * q);
#pragma unroll
              for (int e = 0; e < 4; ++e) if (4 * q + e < t) xa -= lr[e] * xv[4 * q + e]; }
            xv[t] = xa; asm volatile("" : "+v"(xv[t]) :: "memory"); }
          if (w < 4) {
#pragma unroll
            for (int t = 0; t < 16; ++t) WI[t * TWS + lane] = f2bf(xv[t]);
          } else if (lane < 16) {
#pragma unroll
            for (int t = 0; t < 16; ++t) GI[t * 24 + lane] = f2bf(xv[t]);
          } }
        lds_barrier();
        if (w < 4 && !(RW_OFF & 2)) {
#pragma unroll 1
          for (int ch = 0; ch < 4; ++ch) { LAS unsigned char* CB_ = LB + ch * CH_BYTES;
            const LAS bf16_t *RT = (const LAS bf16_t*)(CB_ + CH_RT), *WI = (const LAS bf16_t*)(CB_ + CH_KT), *KH = (const LAS bf16_t*)(CB_ + CH_KH), *NBH = (const LAS bf16_t*)(CB_ + CH_NB),
                             *VT = (const LAS bf16_t*)(CB_ + CH_VT), *LRK = (const LAS bf16_t*)(CB_ + CH_LRK), *NLRB = (const LAS bf16_t*)(CB_ + CH_NLRB), *GI = (const LAS bf16_t*)(CB_ + CH_GI);
            const LAS float* GC = (const LAS float*)(CB_ + CH_GC);
            bf16x8 Mb[2], Wp[2], Rp[2];
#pragma unroll
            for (int ks = 0; ks < 2; ++ks) { Mb[ks] = cat4(pk4(Macc[2 * ks]), pk4(Macc[2 * ks + 1]));
              Wp[ks] = cat4(*(const LAS bf16x4*)(WI + fr * TWS + 32 * ks + 4 * fq), *(const LAS bf16x4*)(WI + fr * TWS + 32 * ks + 16 + 4 * fq));
              Rp[ks] = cat4(*(const LAS bf16x4*)(RT + fr * TWS + 32 * ks + 4 * fq), *(const LAS bf16x4*)(RT + fr * TWS + 32 * ks + 16 + 4 * fq)); }
            const bf16x8 Vb = cat4z(*(const LAS bf16x4*)(VT + (16 * w + fr) * 24 + 4 * fq));
            const bf16x8 Gp = cat4z(*(const LAS bf16x4*)(GI + fr * 24 + 4 * fq)), Lrkp = cat4z(*(const LAS bf16x4*)(LRK + fr * 24 + 4 * fq)), Nlrbp = cat4z(*(const LAS bf16x4*)(NLRB + fr * 24 + 4 * fq));
            f32x4 U = (f32x4){0.f, 0.f, 0.f, 0.f};
            U = __builtin_amdgcn_mfma_f32_16x16x32_bf16(Wp[0], Mb[0], U, 0, 0, 0); U = __builtin_amdgcn_mfma_f32_16x16x32_bf16(Wp[1], Mb[1], U, 0, 0, 0); U = __builtin_amdgcn_mfma_f32_16x16x32_bf16(Gp, Vb, U, 0, 0, 0);
            const bf16x8 Ub = cat4z(pk4(U));
            f32x4 Y = (f32x4){0.f, 0.f, 0.f, 0.f};
            Y = __builtin_amdgcn_mfma_f32_16x16x32_bf16(Rp[0], Mb[0], Y, 0, 0, 0); Y = __builtin_amdgcn_mfma_f32_16x16x32_bf16(Rp[1], Mb[1], Y, 0, 0, 0);
            Y = __builtin_amdgcn_mfma_f32_16x16x32_bf16(Lrkp, Vb, Y, 0, 0, 0); Y = __builtin_amdgcn_mfma_f32_16x16x32_bf16(Nlrbp, Ub, Y, 0, 0, 0);
#pragma unroll
            for (int r = 0; r < 4; ++r) YY[(16 * ch + 4 * fq + r) * 64 + 16 * w + fr] = Y[r];
#pragma unroll
            for (int mt = 0; mt < 4; ++mt) { const f32x4 gc = *(const LAS f32x4*)(GC + 16 * mt + 4 * fq); f32x4 m = Macc[mt] * gc;
              const bf16x8 khp = cat4z(*(const LAS bf16x4*)(KH + (16 * mt + fr) * 24 + 4 * fq)), nbp = cat4z(*(const LAS bf16x4*)(NBH + (16 * mt + fr) * 24 + 4 * fq));
              m = __builtin_amdgcn_mfma_f32_16x16x32_bf16(khp, Vb, m, 0, 0, 0); m = __builtin_amdgcn_mfma_f32_16x16x32_bf16(nbp, Ub, m, 0, 0, 0); Macc[mt] = m; } } }
        lds_barrier();
        const float lnw = CT[640 + lane], lnb = CT[704 + lane];
#pragma unroll
        for (int i = 0; i < 8; ++i) {
            const int tok = w * 8 + i; const float y = YY[tok * 64 + lane];
            const float mean = wave_sum2(y) * (1.0f / 64.0f), dl = y - mean, var = wave_sum2(dl * dl) * (1.0f / 64.0f);
            const float yn = dl * rsqrtf(var + 64e-5f) * lnw + lnb + cbv[i] * vs[i];
            const float gti = (i & 1) ? hi16(gtp[i >> 1]) : lo16(gtp[i >> 1]);
            if (!dry) g3[(t0 + tok) * G3_LD + cj] = f2bf(yn * siluf_(gti));
        }
        lds_barrier();
    }
}

__device__ __forceinline__ void spin_until_ge(const unsigned* flag, unsigned want) {
    unsigned it = 0;
    while (__hip_atomic_load(flag, __ATOMIC_RELAXED, __HIP_MEMORY_SCOPE_AGENT) < want) { __builtin_amdgcn_s_sleep(2); if (++it > (1u << 17)) break; }
}
__device__ __forceinline__ unsigned pk2bf(float lo, float hi) { return cvt_pk_bf16(lo, hi); }

__device__ void rwkv_producer(const Ctx& c, int l, int bh, int par) {
    const Params& P = *c.P; const int b = bh >> 3, hd = bh & 7, lane = c.lane, w = c.wave, cj = hd * 64 + lane, fr = lane & 15, fq = lane >> 4;
    LAS unsigned char* LB = c.lds;
    LAS float* WR = (LAS float*)LB; LAS float* AR = (LAS float*)(LB + RW_AR);
    LAS bf16_t* TWb = (LAS bf16_t*)(LB + RW_TW); LAS bf16_t* ADb = (LAS bf16_t*)(LB + RW_AD);
    const bf16_t* zrw = (const bf16_t*)(c.ws + OFF_ZRW);
    unsigned* ready = (unsigned*)(c.ws + OFF_BAR + 256) + (bh * 2 + par) * 64; const unsigned* consumed = (const unsigned*)(c.ws + OFF_BAR + 256 + 64 * 256) + bh * 64;
    unsigned char* ring = c.ws + OFF_RING + (size_t)bh * RING_SLOTS * SLOT_BYTES;
    LAS float* CT = (LAS float*)(LB + RW_CT);
    if (c.tid < 64) { const float* mu = P.in[4] + (size_t)l * 1664; const int j = hd * 64 + c.tid;
        CT[0 * 64 + c.tid] = mu[j]; CT[1 * 64 + c.tid] = mu[512 + j]; CT[2 * 64 + c.tid] = mu[1024 + j]; CT[3 * 64 + c.tid] = mu[1536 + c.tid]; CT[4 * 64 + c.tid] = mu[1600 + c.tid];
        CT[5 * 64 + c.tid] = P.in[5][l * BW + j]; CT[6 * 64 + c.tid] = P.in[7][l * BW + j]; CT[7 * 64 + c.tid] = P.in[9][l * BW + j]; CT[8 * 64 + c.tid] = P.in[10][l * BW + j];
        CT[9 * 64 + c.tid] = P.in[11][l * BW + j]; }
    const int mt_ = w >> 1, nh = w & 1;
    LAS bf16_t* W2I = (LAS bf16_t*)(LB + RW_W2); LAS bf16_t* A2I = (LAS bf16_t*)(LB + RW_A2);
    for (int i = c.tid; i < 4096; i += 512) { const int k = i >> 6, j = i & 63; W2I[j * TWS + k] = f2bf(P.in[6][((size_t)l * 64 + k) * BW + hd * 64 + j]); A2I[j * TWS + k] = f2bf(P.in[8][((size_t)l * 64 + k) * BW + hd * 64 + j]); }
    __syncthreads();
    RwRows cur;
    rw_load_rows(cur, zrw, b, par, w, lane, cj);
    for (int blk = par; blk < RW_NBLK; blk += 2) {
        const unsigned gblk = (unsigned)(l * RW_NBLK + blk);
        float rs[8], ks_[8], vs[8];
        const float mu_r = CT[lane], mu_k = CT[64 + lane], mu_v = CT[128 + lane], mu_w = CT[192 + lane], mu_a = CT[256 + lane];
#pragma unroll
        for (int i = 0; i < 8; ++i) { const int tok = w * 8 + i;
            { const float r0 = rw_get(cur.zr, i), r1 = rw_get(cur.zr, i + 1), k0 = rw_get(cur.zk, i), k1 = rw_get(cur.zk, i + 1), v0 = rw_get(cur.zv, i), v1 = rw_get(cur.zv, i + 1);
              rs[i] = r1 + mu_r * (r0 - r1); ks_[i] = k1 + mu_k * (k0 - k1); vs[i] = v1 + mu_v * (v0 - v1); }
            const float w0_ = rw_get(cur.zw, i), w1_ = rw_get(cur.zw, i + 1), a0_ = rw_get(cur.za, i), a1_ = rw_get(cur.za, i + 1);
            const float wds = w1_ + mu_w * (w0_ - w1_), ads = a1_ + mu_a * (a0_ - a1_);
            const float e2 = __expf(2.0f * wds); const float th = 1.0f - 2.0f * __builtin_amdgcn_rcpf(e2 + 1.0f);
            TWb[tok * TWS + lane] = f2bf(th); ADb[tok * TWS + lane] = f2bf(ads); }
        if (blk + 2 < RW_NBLK) rw_load_rows(cur, zrw, b, blk + 2, w, lane, cj);
        lds_barrier();
        { bf16x8 atw[2], aad[2];
#pragma unroll
          for (int ks = 0; ks < 2; ++ks) { atw[ks] = *(const LAS bf16x8*)(TWb + (16 * mt_ + fr) * TWS + 32 * ks + 8 * fq); aad[ks] = *(const LAS bf16x8*)(ADb + (16 * mt_ + fr) * TWS + 32 * ks + 8 * fq); }
          f32x4 cw[2], ca[2];
#pragma unroll
          for (int n2 = 0; n2 < 2; ++n2) { cw[n2] = (f32x4){0.f, 0.f, 0.f, 0.f}; ca[n2] = cw[n2];
#pragma unroll
              for (int ks = 0; ks < 2; ++ks) { const int bo = (32 * nh + 16 * n2 + fr) * TWS + 32 * ks + 8 * fq;
                  cw[n2] = __builtin_amdgcn_mfma_f32_16x16x32_bf16(atw[ks], *(const LAS bf16x8*)(W2I + bo), cw[n2], 0, 0, 0); ca[n2] = __builtin_amdgcn_mfma_f32_16x16x32_bf16(aad[ks], *(const LAS bf16x8*)(A2I + bo), ca[n2], 0, 0, 0); } }
          lds_barrier();
#pragma unroll
          for (int n2 = 0; n2 < 2; ++n2)
#pragma unroll
              for (int r = 0; r < 4; ++r) { const int o = (16 * mt_ + 4 * fq + r) * 64 + 32 * nh + 16 * n2 + fr; WR[o] = cw[n2][r]; AR[o] = ca[n2][r]; } }
        if (c.tid == 0 && gblk >= RING_SLOTS) spin_until_ge(consumed, gblk - RING_SLOTS + 1);
        lds_barrier();
        unsigned char* slot = ring + (size_t)(gblk % RING_SLOTS) * SLOT_BYTES;
        LAS float* GP = (LAS float*)(LB + RW_GP); const int cc = w >> 1, hc = w & 1;
        float kkv[8], kpv[8], bbv[8], gl[8], cbv[8];
        { const float w0j = CT[320 + lane], a0j = CT[384 + lane], kkj = CT[448 + lane], kaj = CT[512 + lane], rkj = CT[576 + lane]; float g = 1.0f;
#pragma unroll
          for (int i = 0; i < 8; ++i) { const int o = (w * 8 + i) * 64 + lane;
            const float wraw = w0j + WR[o], araw = a0j + AR[o];
            const float d = __expf(-0.6065306597126334f * sigmoidf_(wraw)), a = sigmoidf_(araw);
            float kk = ks_[i] * kkj; const float n2 = wave_sum2(kk * kk); kk = kk * __builtin_amdgcn_rsqf(fmaxf(n2, 1e-24f));
            const float kp = ks_[i] * (1.0f + (a - 1.0f) * kaj);
            cbv[i] = wave_sum2(rs[i] * kp * rkj);
            g *= d; gl[i] = g; kkv[i] = kk; kpv[i] = kp; bbv[i] = kk * a; }
          GP[w * 64 + lane] = g; }
        lds_barrier();
        { LAS unsigned char* CB_ = LB + cc * CH_BYTES;
          LAS bf16_t *AT = (LAS bf16_t*)(CB_ + CH_AT), *RT = (LAS bf16_t*)(CB_ + CH_RT), *KT = (LAS bf16_t*)(CB_ + CH_KT), *BT = (LAS bf16_t*)(CB_ + CH_BT),
                     *KH = (LAS bf16_t*)(CB_ + CH_KH), *NBH = (LAS bf16_t*)(CB_ + CH_NB), *VT = (LAS bf16_t*)(CB_ + CH_VT);
          const float g0 = GP[(2 * cc) * 64 + lane], g1 = GP[(2 * cc + 1) * 64 + lane], gC = g0 * g1, pre = hc ? g0 : 1.0f;
          if (hc == 0) ((LAS float*)(CB_ + CH_GC))[lane] = gC;
          float khv[8], nbv[8];
#pragma unroll
          for (int i = 0; i < 8; ++i) { const int tl = 8 * hc + i;
            const float gam = pre * gl[i], gprev = (i == 0) ? pre : pre * gl[i - 1], ig = __builtin_amdgcn_rcpf(gam), gr = gC * ig;
            AT[tl * TWS + lane] = f2bf(kkv[i] * gprev); RT[tl * TWS + lane] = f2bf(rs[i] * gam); KT[tl * TWS + lane] = f2bf(kpv[i] * ig); BT[tl * TWS + lane] = f2bf(bbv[i] * ig);
            khv[i] = kpv[i] * gr; nbv[i] = -bbv[i] * gr; }
#pragma unroll
          for (int p = 0; p < 4; ++p) { const int o = lane * 20 + 8 * hc + 2 * p;
            *(LAS unsigned*)(KH + o) = cvt_pk_bf16(khv[2 * p], khv[2 * p + 1]); *(LAS unsigned*)(NBH + o) = cvt_pk_bf16(nbv[2 * p], nbv[2 * p + 1]); *(LAS unsigned*)(VT + o) = cvt_pk_bf16(vs[2 * p], vs[2 * p + 1]); } }
        lds_barrier();
        { const __amdgpu_buffer_rsrc_t rs_ = __builtin_amdgcn_make_buffer_rsrc((void*)slot, 0, (int)SLOT_BYTES, 0x00020000);
#pragma unroll
          for (int i = 0; i < 9; ++i) { const int L_ = c.tid * 16 + i * 8192, ch = L_ / 18432, off = L_ - ch * 18432;
              __builtin_amdgcn_raw_buffer_store_b128(*(const LAS u32x4*)(LB + ch * CH_BYTES + off), rs_, (unsigned)L_, 0, 16); }
          if (c.tid < 64) __builtin_amdgcn_raw_buffer_store_b128(*(const LAS u32x4*)(LB + (c.tid >> 4) * CH_BYTES + CH_GC + (c.tid & 15) * 16), rs_, (unsigned)(SLOT_IMG + c.tid * 16), 0, 16);
#pragma unroll
          for (int i = 0; i < 8; ++i) if (lane == i) __hip_atomic_store((unsigned*)(slot + SLOT_IMG + 1024) + w * 8 + i, __float_as_uint(cbv[i]), __ATOMIC_RELAXED, __HIP_MEMORY_SCOPE_AGENT); }
        __syncthreads();
        if (c.tid == 0) __hip_atomic_store(ready, (gblk >> 1) + 1, __ATOMIC_RELAXED, __HIP_MEMORY_SCOPE_AGENT);
    }
}

struct RwSlot { u32x4 img[9]; u32x4 gc; float cb; };
__device__ __forceinline__ void rw_load_slot(RwSlot& R, const unsigned char* slot, int tid, int w, int lane) {
#pragma unroll
    for (int i = 0; i < 9; ++i) R.img[i] = *(const u32x4*)(slot + tid * 16 + i * 8192);
    R.gc = *(const u32x4*)(slot + SLOT_IMG + (tid & 63) * 16);
    R.cb = ((const float*)(slot + SLOT_IMG + 1024))[w * 8 + (lane & 7)];
}

__device__ void rwkv_consumer(const Ctx& c, int l, int bh) {
    const Params& P = *c.P; const int b = bh >> 3, hd = bh & 7, lane = c.lane, w = c.wave, cj = hd * 64 + lane, fr = lane & 15, fq = lane >> 4;
    LAS unsigned char* LB = c.lds;
    LAS float* YY = (LAS float*)(LB + RW_YY);
    bf16_t* g3 = (bf16_t*)(c.ws + OFF_G3);
    const unsigned* ready = (const unsigned*)(c.ws + OFF_BAR + 256) + bh * 128; unsigned* consumed = (unsigned*)(c.ws + OFF_BAR + 256 + 64 * 256) + bh * 64;
    bf16_t* zrw = (bf16_t*)(c.ws + OFF_ZRW); float* cbg = (float*)(c.ws + OFF_CBG);
    const unsigned char* ring = c.ws + OFF_RING + (size_t)bh * RING_SLOTS * SLOT_BYTES;
    f32x4 Macc[4];
#pragma unroll
    for (int i = 0; i < 4; ++i) Macc[i] = (f32x4){0.f, 0.f, 0.f, 0.f};
    RwSlot cur;
    { const unsigned g0 = (unsigned)(l * RW_NBLK);
      if (c.tid == 0) { spin_until_ge(ready + 64 * (g0 & 1), (g0 >> 1) + 1); spin_until_ge(ready + 64 * ((g0 + 1) & 1), ((g0 + 1) >> 1) + 1); __builtin_amdgcn_fence(__ATOMIC_ACQUIRE, "agent"); }
      __syncthreads();
      rw_load_slot(cur, ring + (size_t)(g0 % RING_SLOTS) * SLOT_BYTES, c.tid, w, lane); }
    for (int blk = 0; blk < RW_NBLK; ++blk) {
        const unsigned gblk = (unsigned)(l * RW_NBLK + blk); const size_t t0 = (size_t)b * SEQ + blk * 64;
        const float cb_own = cur.cb;
#pragma unroll
        for (int i = 0; i < 9; ++i) { const int L_ = c.tid * 16 + i * 8192, ch = L_ / 18432, off = L_ - ch * 18432; *(LAS u32x4*)(LB + ch * CH_BYTES + off) = cur.img[i]; }
        if (c.tid < 64) *(LAS u32x4*)(LB + (c.tid >> 4) * CH_BYTES + CH_GC + (c.tid & 15) * 16) = cur.gc;
        lds_barrier();
        if (c.tid == 0) __hip_atomic_store(consumed, gblk + 1, __ATOMIC_RELAXED, __HIP_MEMORY_SCOPE_AGENT);
        if (blk + 1 < RW_NBLK) rw_load_slot(cur, ring + (size_t)((gblk + 1) % RING_SLOTS) * SLOT_BYTES, c.tid, w, lane);
        if (w < 4 && true) { LAS unsigned char* CB_ = LB + w * CH_BYTES;
          const LAS bf16_t *AT = (const LAS bf16_t*)(CB_ + CH_AT), *RT = (const LAS bf16_t*)(CB_ + CH_RT), *KT = (const LAS bf16_t*)(CB_ + CH_KT), *BT = (const LAS bf16_t*)(CB_ + CH_BT);
          f32x4 lab = (f32x4){0.f, 0.f, 0.f, 0.f}, lak = lab, lrk = lab, lrb = lab;
#pragma unroll
          for (int ks = 0; ks < 2; ++ks) { const int o = fr * TWS + 32 * ks + 8 * fq;
            const bf16x8 af = *(const LAS bf16x8*)(AT + o), rf = *(const LAS bf16x8*)(RT + o), kf = *(const LAS bf16x8*)(KT + o), bf = *(const LAS bf16x8*)(BT + o);
            lab = __builtin_amdgcn_mfma_f32_16x16x32_bf16(af, bf, lab, 0, 0, 0); lak = __builtin_amdgcn_mfma_f32_16x16x32_bf16(af, kf, lak, 0, 0, 0);
            lrk = __builtin_amdgcn_mfma_f32_16x16x32_bf16(rf, kf, lrk, 0, 0, 0); lrb = __builtin_amdgcn_mfma_f32_16x16x32_bf16(rf, bf, lrb, 0, 0, 0); }
          LAS float *LAB = (LAS float*)(CB_ + CH_LAB), *LAK = (LAS float*)(CB_ + CH_LAK); LAS bf16_t *LRK = (LAS bf16_t*)(CB_ + CH_LRK), *NLRB = (LAS bf16_t*)(CB_ + CH_NLRB);
#pragma unroll
          for (int r = 0; r < 4; ++r) { const int t = 4 * fq + r, s_ = fr; const bool lo_ = t > s_, le_ = t >= s_;
            LAB[t * 16 + s_] = lo_ ? lab[r] : 0.0f; LAK[t * 16 + s_] = lo_ ? lak[r] : 0.0f;
            LRK[t * 24 + s_] = f2bf(le_ ? lrk[r] : 0.0f); NLRB[t * 24 + s_] = f2bf(le_ ? -lrb[r] : 0.0f); } }
        lds_barrier();
        { const int ch6 = w & 3; LAS unsigned char* CB_ = LB + ch6 * CH_BYTES;
          const LAS bf16_t* AT = (const LAS bf16_t*)(CB_ + CH_AT); const LAS float *LAB = (const LAS float*)(CB_ + CH_LAB), *LAK = (const LAS float*)(CB_ + CH_LAK);
          LAS bf16_t *WI = (LAS bf16_t*)(CB_ + CH_KT), *GI = (LAS bf16_t*)(CB_ + CH_GI);
          float xv[16];
          if (w < 4) {
#pragma unroll
            for (int t = 0; t < 16; ++t) xv[t] = bf2f(AT[t * TWS + lane]);
          } else {
#pragma unroll
            for (int t = 0; t < 16; ++t) xv[t] = LAK[t * 16 + fr];
          }
          f32x4 nx[4];
#pragma unroll
          for (int q = 0; q < 4; ++q) nx[q] = *(const LAS f32x4*)(LAB + 16 + 4 * q);
#pragma unroll
          for (int t = 1; t < 16; ++t) { float xa = xv[t]; f32x4 lr[4];
#pragma unroll
            for (int q = 0; q < 4; ++q) lr[q] = nx[q];
            if (t < 15) {
#pragma unroll
              for (int q = 0; q < 4; ++q) if (4 * q < t + 1) nx[q] = *(const LAS f32x4*)(LAB + (t + 1) * 16 + 4 * q); }
            float xb = 0.0f;
#pragma unroll
            for (int q = 0; q < 4; ++q) if (4 * q < t) {
#pragma unroll
              for (int e = 0; e < 4; ++e) if (4 * q + e < t) { if (e & 1) xb -= lr[q][e] * xv[4 * q + e]; else xa -= lr[q][e] * xv[4 * q + e]; } }
            xa += xb;
            xv[t] = xa; asm volatile("" : "+v"(xv[t]), "+v"(nx[0]), "+v"(nx[1]), "+v"(nx[2]), "+v"(nx[3]) :: "memory"); }
          if (w < 4) {
#pragma unroll
            for (int t = 0; t < 16; ++t) WI[t * TWS + lane] = f2bf(xv[t]);
          } else if (lane < 16) {
#pragma unroll
            for (int t = 0; t < 16; ++t) GI[t * 24 + lane] = f2bf(xv[t]);
          } }
        lds_barrier();
        if (w == 4 && lane == 0 && blk + 2 < RW_NBLK) { const unsigned gn = gblk + 2; spin_until_ge(ready + 64 * (gn & 1), (gn >> 1) + 1); __builtin_amdgcn_fence(__ATOMIC_ACQUIRE, "agent"); }
        if (w < 4 && true) {
#pragma unroll
          for (int ch = 0; ch < 4; ++ch) { LAS unsigned char* CB_ = LB + ch * CH_BYTES;
            const LAS bf16_t *RT = (const LAS bf16_t*)(CB_ + CH_RT), *WI = (const LAS bf16_t*)(CB_ + CH_KT), *KH = (const LAS bf16_t*)(CB_ + CH_KH), *NBH = (const LAS bf16_t*)(CB_ + CH_NB),
                             *VT = (const LAS bf16_t*)(CB_ + CH_VT), *LRK = (const LAS bf16_t*)(CB_ + CH_LRK), *NLRB = (const LAS bf16_t*)(CB_ + CH_NLRB), *GI = (const LAS bf16_t*)(CB_ + CH_GI);
            const LAS float* GC = (const LAS float*)(CB_ + CH_GC);
            bf16x8 Mb[2], Wp[2], Rp[2];
#pragma unroll
            for (int ks = 0; ks < 2; ++ks) { Mb[ks] = cat4(pk4(Macc[2 * ks]), pk4(Macc[2 * ks + 1]));
              Wp[ks] = cat4(*(const LAS bf16x4*)(WI + fr * TWS + 32 * ks + 4 * fq), *(const LAS bf16x4*)(WI + fr * TWS + 32 * ks + 16 + 4 * fq));
              Rp[ks] = cat4(*(const LAS bf16x4*)(RT + fr * TWS + 32 * ks + 4 * fq), *(const LAS bf16x4*)(RT + fr * TWS + 32 * ks + 16 + 4 * fq)); }
            const bf16x8 Vb = cat4z(*(const LAS bf16x4*)(VT + (16 * w + fr) * 20 + 4 * fq));
            const bf16x8 Gp = cat4z(*(const LAS bf16x4*)(GI + fr * 24 + 4 * fq)), Lrkp = cat4z(*(const LAS bf16x4*)(LRK + fr * 24 + 4 * fq)), Nlrbp = cat4z(*(const LAS bf16x4*)(NLRB + fr * 24 + 4 * fq));
            f32x4 U = (f32x4){0.f, 0.f, 0.f, 0.f};
            U = __builtin_amdgcn_mfma_f32_16x16x32_bf16(Wp[0], Mb[0], U, 0, 0, 0); U = __builtin_amdgcn_mfma_f32_16x16x32_bf16(Wp[1], Mb[1], U, 0, 0, 0); U = __builtin_amdgcn_mfma_f32_16x16x32_bf16(Gp, Vb, U, 0, 0, 0);
            const bf16x8 Ub = cat4z(pk4(U));
            f32x4 Y = (f32x4){0.f, 0.f, 0.f, 0.f};
            Y = __builtin_amdgcn_mfma_f32_16x16x32_bf16(Rp[0], Mb[0], Y, 0, 0, 0); Y = __builtin_amdgcn_mfma_f32_16x16x32_bf16(Rp[1], Mb[1], Y, 0, 0, 0);
            Y = __builtin_amdgcn_mfma_f32_16x16x32_bf16(Lrkp, Vb, Y, 0, 0, 0); Y = __builtin_amdgcn_mfma_f32_16x16x32_bf16(Nlrbp, Ub, Y, 0, 0, 0);
#pragma unroll
            for (int r = 0; r < 4; ++r) YY[(16 * ch + 4 * fq + r) * 64 + 16 * w + fr] = Y[r];
#pragma unroll
            for (int mt = 0; mt < 4; ++mt) { const f32x4 gc = *(const LAS f32x4*)(GC + 16 * mt + 4 * fq); f32x4 m = Macc[mt] * gc;
              const bf16x8 khp = cat4z(*(const LAS bf16x4*)(KH + (16 * mt + fr) * 20 + 4 * fq)), nbp = cat4z(*(const LAS bf16x4*)(NBH + (16 * mt + fr) * 20 + 4 * fq));
              m = __builtin_amdgcn_mfma_f32_16x16x32_bf16(khp, Vb, m, 0, 0, 0); m = __builtin_amdgcn_mfma_f32_16x16x32_bf16(nbp, Ub, m, 0, 0, 0); Macc[mt] = m; } } }
        lds_barrier();
        { const int tok = c.tid >> 3, c8 = (c.tid & 7) * 8;
          const f32x4 y0 = *(const LAS f32x4*)(YY + tok * 64 + c8), y1 = *(const LAS f32x4*)(YY + tok * 64 + c8 + 4);
          u32x4 wv; wv.x = cvt_pk_bf16(y0[0], y0[1]); wv.y = cvt_pk_bf16(y0[2], y0[3]); wv.z = cvt_pk_bf16(y1[0], y1[1]); wv.w = cvt_pk_bf16(y1[2], y1[3]);
          *(u32x4*)(zrw + (t0 + tok) * ZRW_LD + hd * 64 + c8) = wv;
          if (lane < 8) cbg[(t0 + w * 8 + lane) * 8 + hd] = cb_own; }
    }
}

__device__ void phase_rwkv_fin(const Ctx& c, int l) {
    const Params& P = *c.P; const bf16_t* zrw = (const bf16_t*)(c.ws + OFF_ZRW); bf16_t* g3 = (bf16_t*)(c.ws + OFF_G3); const float* cbg = (const float*)(c.ws + OFF_CBG);
    const int gw = blockIdx.x * 8 + c.wave, nw = gridDim.x * 8, lane = c.lane;
    for (int item = gw; item < (T / 128) * 8; item += nw) {
        const int hd = item & 7, tg = item >> 3, cj = hd * 64 + lane; const size_t tb = (size_t)tg * 128;
        const float mu_v = P.in[4][(size_t)l * 1664 + 1024 + cj], lnw = P.in[12][l * BW + cj], lnb = P.in[13][l * BW + cj];
        float vprev = ((tb & (SEQ - 1)) == 0) ? 0.0f : bf2f(zrw[(tb - 1) * ZRW_LD + 1024 + cj]);
        for (int t4 = 0; t4 < 128; t4 += 8) {
            float y[8], vv[8], gt[8], cb[8];
#pragma unroll
            for (int i = 0; i < 8; ++i) { const size_t t = tb + t4 + i; y[i] = bf2f(zrw[t * ZRW_LD + cj]); vv[i] = bf2f(zrw[t * ZRW_LD + 1024 + cj]); gt[i] = bf2f(g3[t * G3_LD + cj]); cb[i] = cbg[t * 8 + hd]; }
#pragma unroll
            for (int i = 0; i < 8; ++i) { const size_t t = tb + t4 + i;
                const float vs = vv[i] + mu_v * (vprev - vv[i]); vprev = vv[i];
                const float mean = wave_sum2(y[i]) * (1.0f / 64.0f), ey2 = wave_sum2(y[i] * y[i]) * (1.0f / 64.0f), var = fmaxf(ey2 - mean * mean, 0.0f);
                const float yn = (y[i] - mean) * rsqrtf(var + 64e-5f) * lnw + lnb + cb[i] * vs;
                g3[t * G3_LD + cj] = f2bf(yn * siluf_(gt[i])); }
        }
    }
}

constexpr int RW_WGS = 96;
template <int l, int sp>
__device__ __forceinline__ void run_sub(const Ctx& c, const Params& P, float* ssbase, int G, int cb, unsigned* bar2, unsigned& bar2_target) {
    unsigned char* ws = c.ws;
    if constexpr (sp == 0) {
        if (l == 0) phase_s5_consts(c);
        pg8::Gemm g{(const bf16_t*)(ws + OFF_XN), (const bf16_t*)(ws + OFF_WIN) + (size_t)l * DINP * D, D, D, D}; pg8::Sched S; S.init(T, DINP, G, cb);
        EpiZ E{(bf16_t*)(ws + OFF_ZRW), (bf16_t*)(ws + OFF_G3), (bf16_t*)(ws + OFF_XL), (bf16_t*)(ws + OFF_AS)};
        pg8::gemm_phase(c.lds, g, S, E);
    } else if constexpr (sp == 1) {
        if (cb < 32) rwkv_consumer(c, l, cb); else if (cb < RW_WGS) rwkv_producer(c, l, (cb - 32) & 31, (cb - 32) >> 5);
        else {
            Ctx c2 = c; c2.vb = cb - RW_WGS; c2.vG = G - RW_WGS; const int G2 = G - RW_WGS, cb2 = cb - RW_WGS;
            phase_lru_conv(c2, l);
            { pg8::Gemm g{(const bf16_t*)(ws + OFF_AS), (const bf16_t*)(ws + OFF_S5E) + (size_t)l * 32 * 256 * 256, AS_LD, 256, 256}; pg8::Sched S; S.init(AS_ROWS, 256, G2, cb2, 8);
              EpiE E{(float*)(ws + OFF_E)};
              pg8::gemm_phase(c.lds, g, S, E); }
            grid_bar(bar2, bar2_target, (unsigned)G2);
            phase_s5_carry(c2, l);
            { pg8::Gemm g{(const bf16_t*)(ws + OFF_XC), (const bf16_t*)(ws + OFF_WLRU) + (size_t)l * 1024 * BW, BW, BW, BW}; pg8::Sched S; S.init(T, 1024, G2, cb2);
              EpiLru E{(const bf16_t*)(ws + OFF_XC), P.in[27] + l * BW, P.in[29] + l * BW, P.in[30] + l * BW, (bf16_t*)(ws + OFF_LRUAB)};
              pg8::gemm_phase(c.lds, g, S, E); }
            grid_bar(bar2, bar2_target, (unsigned)G2);
            { pg8::Gemm g{(const bf16_t*)(ws + OFF_AS), (const bf16_t*)(ws + OFF_S5Y) + (size_t)l * 32 * 256 * AS_LD, AS_LD, AS_LD, AS_LD}; pg8::Sched S; S.init(AS_ROWS, 256, G2, cb2, 8);
              EpiY E{(const bf16_t*)(ws + OFF_AS), P.in[21] + l * BW, (bf16_t*)(ws + OFF_ZGS)};
              pg8::gemm_phase(c.lds, g, S, E); }
            phase_lru_scan(c2, 0);
            grid_bar(bar2, bar2_target, (unsigned)G2);
            { pg8::Gemm g{(const bf16_t*)(ws + OFF_ZGS), (const bf16_t*)(ws + OFF_WGLU) + (size_t)l * BW * BW, BW, BW, BW}; pg8::Sched S; S.init(T, BW, G2, cb2);
              EpiGlu E{(const bf16_t*)(ws + OFF_ZGS), P.in[23] + l * BW, (bf16_t*)(ws + OFF_G3)};
              pg8::gemm_phase(c.lds, g, S, E); }
            phase_lru_scan(c2, 1);
            { pg8::Gemm g{(const bf16_t*)(ws + OFF_PB) + (size_t)l * T * DPLE, (const bf16_t*)(ws + OFF_WPLE) + (size_t)l * D * DPLE, DPLE, DPLE, DPLE}; pg8::Sched S; S.init(T, D, G2, cb2);
              EpiPle E{(bf16_t*)(ws + OFF_PW), ssbase + (size_t)l * T};
              pg8::gemm_phase(c.lds, g, S, E); }
        }
    } else if constexpr (sp == 2) {
        phase_rwkv_fin(c, l);
    } else if constexpr (sp == 5) {
        { pg8::Gemm g{(const bf16_t*)(ws + OFF_G3), (const bf16_t*)(ws + OFF_WOUT) + (size_t)l * D * DMIX, DMIX, DMIX, DMIX}; pg8::Sched S; S.init(T, D, G, cb);
          EpiOut E{l == 0 ? P.in[0] : (const float*)P.out, P.out, (bf16_t*)(ws + OFF_H1B)};
          pg8::gemm_phase(c.lds, g, S, E); }
    } else if constexpr (sp == 6) {
        pg8::Gemm g{(const bf16_t*)(ws + OFF_H1B), (const bf16_t*)(ws + OFF_WG) + (size_t)l * D * D, D, D, D}; pg8::Sched S; S.init(T, D, G, cb);
        EpiGate E{P.out, (const bf16_t*)(ws + OFF_PW), ssbase + (size_t)l * T, P.in[33] + l * D, ssbase + (size_t)(2 + l) * T};
        pg8::gemm_phase(c.lds, g, S, E);
    } else {
        phase_norm(c, ssbase + (size_t)(2 + l) * T, l == 0 ? P.in[2] + D : P.in[35], l == 1);
    }
}

constexpr int NPHASE = 1 + 6 * 2;
__global__ void __launch_bounds__(512) hymba_fwd(Params P) {
    extern __shared__ __attribute__((aligned(16))) unsigned char lds_raw[];
    Ctx c; c.P = &P; c.ws = P.ws; c.lds = (LAS unsigned char*)lds_raw; c.ldsg = lds_raw; c.tid = threadIdx.x; c.lane = c.tid & 63; c.wave = __builtin_amdgcn_readfirstlane(c.tid >> 6);
    c.gtid = (size_t)blockIdx.x * 512 + c.tid; c.gsz = (size_t)gridDim.x * 512; c.vb = blockIdx.x; c.vG = gridDim.x;
    unsigned char* ws = P.ws; const int G = gridDim.x, cb = blockIdx.x;
    float* ssbase = (float*)(ws + OFF_SS);
    const int lo = P.ph_lo, hi = P.ph_hi;
    unsigned* barw = (unsigned*)(ws + OFF_BAR); unsigned bar_target = 0; unsigned* bar2 = barw + 32; unsigned bar2_target = 0;
#define PHASE(k, ...) if (((MK_PH_MASK >> (k)) & 1) && lo <= (k) && (k) < hi) { __VA_ARGS__; if ((k) + 1 < hi) { if ((k) == 0) { __threadfence(); cg::this_grid().sync(); } else grid_bar(barw, bar_target, (unsigned)G); } }
    PHASE(0, phase_prep(c))
#define RS(L_, SP_) run_sub<L_, SP_>(c, P, ssbase, G, cb, bar2, bar2_target)
    PHASE(1, RS(0, 0)) PHASE(2, RS(0, 1)) PHASE(3, RS(0, 2)) PHASE(4, RS(0, 5)) PHASE(5, RS(0, 6)) PHASE(6, RS(0, 7))
    PHASE(7, RS(1, 0)) PHASE(8, RS(1, 1)) PHASE(9, RS(1, 2)) PHASE(10, RS(1, 5)) PHASE(11, RS(1, 6)) PHASE(12, RS(1, 7))
#undef RS
#undef PHASE
}

extern "C" void kernel_launch(void* const* d_in, const int* in_sizes, int n_in, void* d_out, int out_size, void* d_ws, size_t ws_size, hipStream_t stream) {
    static int grid = 0;
    if (grid == 0) {
        if (n_in != 36 || out_size != T * D || ws_size < WS_END2) { fprintf(stderr, "kernel_launch: unexpected shapes (n_in %d out %d ws %zu need %zu)\n", n_in, out_size, ws_size, (size_t)WS_END); grid = -1; return; }
        int dev = 0, cus = 0, per_cu = 0;
        hipGetDevice(&dev); hipDeviceGetAttribute(&cus, hipDeviceAttributeMultiprocessorCount, dev);
        hipFuncSetAttribute((const void*)hymba_fwd, hipFuncAttributeMaxDynamicSharedMemorySize, LDS_BYTES);
        hipOccupancyMaxActiveBlocksPerMultiprocessor(&per_cu, (const void*)hymba_fwd, 512, LDS_BYTES);
        if (per_cu < 1) per_cu = 1;
        grid = cus * per_cu; if (grid > 256) grid = 256;
        (void)hipGetLastError();
    }
    if (grid < 0) return;
    (void)hipMemsetAsync((char*)d_ws + OFF_BAR, 0, CTL_BYTES, stream);
    Params p{};
    for (int i = 0; i < 36; ++i) p.in[i] = (const float*)d_in[i];
    p.out = (float*)d_out; p.ws = (unsigned char*)d_ws;
#if MK_PER_PHASE
    for (int ph = 0; ph < NPHASE; ++ph) { p.ph_lo = ph; p.ph_hi = ph + 1; hipLaunchKernelGGL(hymba_fwd, dim3(grid), dim3(512), LDS_BYTES, stream, p); }
#else
    p.ph_lo = 0; p.ph_hi = NPHASE;
    void* args[] = {&p};
    hipError_t e = hipLaunchCooperativeKernel((const void*)hymba_fwd, dim3(grid), dim3(512), args, LDS_BYTES, stream);
    if (e != hipSuccess) fprintf(stderr, "cooperative launch failed: %s (grid %d)\n", hipGetErrorString(e), grid);
#endif
}
```

```cpp
#include <hip/hip_runtime.h>
#include <hip/hip_cooperative_groups.h>
#include <cstdio>
namespace cg = cooperative_groups;

#ifndef MK_PER_PHASE
#define MK_PER_PHASE 0
#endif

#ifndef MK_PH_MASK
#define MK_PH_MASK 0x1fff
#endif
#ifndef MK_DUP
#define MK_DUP 0
#endif
#ifndef RW_OFF
#define RW_OFF 0
#endif
#ifndef MK_OFF
#define MK_OFF 0
#endif
#define LAS __attribute__((address_space(3)))
typedef unsigned short bf16_t;
typedef short bf16x8 __attribute__((ext_vector_type(8)));
typedef float f32x4 __attribute__((ext_vector_type(4)));
typedef unsigned u32x4 __attribute__((ext_vector_type(4)));
typedef unsigned u32x2 __attribute__((ext_vector_type(2)));

constexpr int T = 32768, D = 1024, SEQ = 8192, NB = 4, BW = 512;
constexpr int DIN = 4224, DINP = 4352, DMIX = 1536, DPLE = 256;
constexpr int ZRW_LD = 1792, G3_LD = 1536, AS_LD = 384, AS_ROWS = 65536;
constexpr int LDS_BYTES = 155648;

constexpr size_t al256(size_t x) { return (x + 255) & ~(size_t)255; }
constexpr size_t SZ_WIN = (size_t)2 * DINP * D * 2, SZ_WOUT = (size_t)2 * D * DMIX * 2, SZ_WG = (size_t)2 * D * D * 2, SZ_WPLE = (size_t)2 * D * DPLE * 2,
                 SZ_WGLU = (size_t)2 * BW * BW * 2, SZ_WLRU = (size_t)2 * 1024 * BW * 2, SZ_S5Y = (size_t)2 * 32 * 256 * AS_LD * 2, SZ_S5E = (size_t)2 * 32 * 256 * 256 * 2,
                 SZ_TBL = (size_t)2 * 32 * 64 * 18 * 8, SZ_PB = (size_t)2 * T * DPLE * 2, SZ_XN = (size_t)T * D * 2, SZ_ZRW = (size_t)T * ZRW_LD * 2, SZ_G3 = (size_t)T * G3_LD * 2,
                 SZ_XL = (size_t)T * BW * 2, SZ_AS = (size_t)AS_ROWS * AS_LD * 2, SZ_LRUAB = (size_t)T * 1024 * 2, SZ_AGG = (size_t)NB * 128 * 1024 * 4, SZ_SS = (size_t)4 * T * 4;
constexpr size_t OFF_WIN = 0, OFF_WOUT = OFF_WIN + SZ_WIN, OFF_WG = OFF_WOUT + SZ_WOUT, OFF_WPLE = OFF_WG + SZ_WG, OFF_WGLU = OFF_WPLE + SZ_WPLE, OFF_WLRU = OFF_WGLU + SZ_WGLU,
                 OFF_S5Y = OFF_WLRU + SZ_WLRU, OFF_S5E = OFF_S5Y + SZ_S5Y, OFF_TBL = OFF_S5E + SZ_S5E, OFF_PB = al256(OFF_TBL + SZ_TBL), OFF_XN = OFF_PB + SZ_PB,
                 OFF_ZRW = OFF_XN + SZ_XN, OFF_G3 = OFF_ZRW + SZ_ZRW, OFF_XL = OFF_G3 + SZ_G3, OFF_AS = OFF_XL + SZ_XL, OFF_LRUAB = OFF_AS + SZ_AS, OFF_AGG = OFF_LRUAB + SZ_LRUAB,
                 OFF_SS = OFF_AGG + SZ_AGG, WS_END = OFF_SS + SZ_SS;
constexpr size_t OFF_BAR = WS_END, CTL_BYTES = 256 + 96 * 256;
constexpr size_t RING_SLOTS = 3, SLOT_IMG = 4 * 18432, SLOT_BYTES = SLOT_IMG + 4 * 256 + 256;
constexpr size_t OFF_RING = OFF_BAR + CTL_BYTES, OFF_CBG = OFF_RING + 32 * RING_SLOTS * SLOT_BYTES, WS_END2 = OFF_CBG + (size_t)T * 8 * 4;
constexpr size_t OFF_E = OFF_XN, OFF_XC = OFF_XN + (size_t)AS_ROWS * 128 * 4, OFF_H1B = OFF_ZRW, OFF_PW = OFF_XN, OFF_ZGS = OFF_XL;
static_assert(OFF_XC + (size_t)T * BW * 2 <= OFF_ZRW, "alias overflow");

struct Params {
    const float* in[36];
    float* out;
    unsigned char* ws;
    int ph_lo, ph_hi;
};

__device__ __forceinline__ float bf2f(bf16_t v) { return __uint_as_float(((unsigned)v) << 16); }
__device__ __forceinline__ bf16_t f2bf_sw(float f) { unsigned u = __float_as_uint(f); u += 0x7FFFu + ((u >> 16) & 1u); return (bf16_t)(u >> 16); }
typedef float f32x2_ __attribute__((ext_vector_type(2)));
typedef __bf16 b16x2_ __attribute__((ext_vector_type(2)));
__device__ __forceinline__ unsigned cvt_pk_bf16(float lo, float hi) { const f32x2_ v = {lo, hi}; return __builtin_bit_cast(unsigned, __builtin_convertvector(v, b16x2_)); }
__device__ __forceinline__ bf16_t f2bf(float f) { return (bf16_t)cvt_pk_bf16(f, f); }
__device__ __forceinline__ float lo16(unsigned u) { return __uint_as_float(u << 16); }
__device__ __forceinline__ float hi16(unsigned u) { return __uint_as_float(u & 0xffff0000u); }
__device__ __forceinline__ float sigmoidf_(float x) { return __builtin_amdgcn_rcpf(1.0f + __expf(-x)); }
__device__ __forceinline__ float siluf_(float x) { return x * sigmoidf_(x); }
__device__ __forceinline__ float softplusf_(float x) { return fmaxf(x, 0.0f) + log1pf(__expf(-fabsf(x))); }
__device__ __forceinline__ float gelu_tanh(float x) { const float u2 = 1.5957691216057308f * (x + 0.044715f * x * x * x); return x * sigmoidf_(u2); }
__device__ __forceinline__ float wave_sum(float v) {
#pragma unroll
    for (int o = 32; o > 0; o >>= 1) v += __shfl_xor(v, o);
    return v;
}
__device__ __forceinline__ void unpack8(const u32x4 w, float (&f)[8]) {
    f[0] = lo16(w.x); f[1] = hi16(w.x); f[2] = lo16(w.y); f[3] = hi16(w.y); f[4] = lo16(w.z); f[5] = hi16(w.z); f[6] = lo16(w.w); f[7] = hi16(w.w);
}
__device__ __forceinline__ u32x4 pack8(const float (&f)[8]) {
    u32x4 w; w.x = cvt_pk_bf16(f[0], f[1]); w.y = cvt_pk_bf16(f[2], f[3]); w.z = cvt_pk_bf16(f[4], f[5]); w.w = cvt_pk_bf16(f[6], f[7]); return w;
}


__device__ __forceinline__ void grid_bar(unsigned* ctr, unsigned& target, unsigned nblk) {
    __syncthreads();
    if (threadIdx.x == 0) {
        target += nblk;
        __builtin_amdgcn_fence(__ATOMIC_RELEASE, "agent");
        __hip_atomic_fetch_add(ctr, 1u, __ATOMIC_RELAXED, __HIP_MEMORY_SCOPE_AGENT);
        while (__hip_atomic_load(ctr, __ATOMIC_RELAXED, __HIP_MEMORY_SCOPE_AGENT) < target) __builtin_amdgcn_s_sleep(1);
        __builtin_amdgcn_fence(__ATOMIC_ACQUIRE, "agent");
    }
    __syncthreads();
}

namespace pg8 {
constexpr int BM = 256, BK = 64, HALF = 128, HTB = HALF * BK * 2, STAGE_BYTES = 8 * HTB, NXCD = 8, WGM = 8;
__host__ __device__ __forceinline__ int lds_byte(int r, int c) { const int st = (r >> 4) * 2 + (c >> 5), rr = r & 15, cc = c & 31, ob = rr * 64 + cc * 2; return st * 1024 + (ob ^ (((ob >> 9) & 1) << 5)); }
__host__ __device__ __forceinline__ void stage_rc(int b, int& R, int& C) { const int st = b / 1024, sb = b % 1024, swz = sb ^ (((sb >> 9) & 1) << 5); R = (st >> 1) * 16 + swz / 64; C = (st & 1) * 32 + (swz % 64) / 2; }
__host__ __device__ __forceinline__ int perm32(int rho) { const int n = rho >> 4, i = rho & 15; return 8 * (i >> 2) + 4 * n + (i & 3); }

struct Unit { int pm, pn, pb; };
struct Gemm { const bf16_t* A; const bf16_t* Bt; int lda, ldb, K; };

struct Sched {
    int nM, nN, nwg, G, c, grp;
    __device__ void init(int M, int N, int G_, int c_, int grp_ = 0) { nM = M / BM; nN = N / BM; nwg = nM * nN; G = G_; c = c_; grp = grp_; }
    __device__ bool next(int i, Unit& u) const {
        const long L = (long)i * G + c; if (L >= nwg) return false;
        int wgid = (int)L; { const int q = nwg / NXCD, r = nwg % NXCD, xcd = wgid % NXCD, off = wgid / NXCD; wgid = (xcd < r ? xcd * (q + 1) : r * (q + 1) + (xcd - r) * q) + off; }
        const int nig = WGM * nN, gid = wgid / nig, fm = gid * WGM, gsz = (nM - fm) < WGM ? (nM - fm) : WGM;
        u.pm = fm + ((wgid % nig) % gsz); u.pn = (wgid % nig) / gsz; u.pb = grp ? (u.pm / grp) * nN + u.pn : u.pn; return true;
    }
};

template <class Epi>
__device__ __forceinline__ void gemm_phase(LAS unsigned char* lds, const Gemm g, const Sched& S, const Epi& E) {
    const int tid = threadIdx.x, wid = __builtin_amdgcn_readfirstlane(tid >> 6), lane = tid & 63, wr = wid >> 2, wc = wid & 3, fr = lane & 15, fq = lane >> 4;
    const int K = g.K, nt = K / BK;
    unsigned voffA[2], voffB[2];
#pragma unroll
    for (int i = 0; i < 2; ++i) { int R, C; stage_rc(tid * 16 + i * 8192, R, C); const int Rb = Epi::PERM ? ((R & ~31) + perm32(R & 31)) : R;
        voffA[i] = (unsigned)(R * g.lda + C) * 2u; voffB[i] = (unsigned)(Rb * g.ldb + C) * 2u; }
    const size_t kstep = (size_t)(BK * 2);
    const size_t hstepA = (size_t)HALF * g.lda * 2, hstepB = (size_t)HALF * g.ldb * 2;
    const size_t tstepA = 2 * hstepA, tstepB = 2 * hstepB;
    const unsigned ldsw = (unsigned)wid * 1024u;
    const int aoff = lds_byte(wr * 64 + fr, fq * 8), boff = lds_byte(wc * 32 + fr, fq * 8);
#define PG8_SA(b, h) (((b) * 2 + (h)) * HTB)
#define PG8_SB(b, h) ((4 + (b) * 2 + (h)) * HTB)
#define PG8_STAGE(bufoff, gbase, voff) do { _Pragma("unroll") for (int _i = 0; _i < 2; ++_i) \
        __builtin_amdgcn_global_load_lds((const unsigned*)((const char*)(gbase) + (voff)[_i]), (LAS unsigned*)(lds + (bufoff) + ldsw + _i * 8192), 16, 0, 0); } while (0)
#define PG8_LDA(dst, b, h) do { _Pragma("unroll") for (int m = 0; m < 4; ++m) _Pragma("unroll") for (int k = 0; k < 2; ++k) dst[m][k] = *(const LAS bf16x8*)(lds + PG8_SA(b, h) + aoff + m * 2048 + k * 1024); } while (0)
#define PG8_LDB(dst, b, h) do { _Pragma("unroll") for (int n = 0; n < 2; ++n) _Pragma("unroll") for (int k = 0; k < 2; ++k) dst[n][k] = *(const LAS bf16x8*)(lds + PG8_SB(b, h) + boff + n * 2048 + k * 1024); } while (0)
#define PG8_MMA(ai, bj, At, Bt) do { __builtin_amdgcn_s_setprio(1); _Pragma("unroll") for (int m = 0; m < 4; ++m) _Pragma("unroll") for (int n = 0; n < 2; ++n) _Pragma("unroll") for (int k = 0; k < 2; ++k) \
        acc[ai][bj][m][n] = __builtin_amdgcn_mfma_f32_16x16x32_bf16(Bt[n][k], At[m][k], acc[ai][bj][m][n], 0, 0, 0); __builtin_amdgcn_s_setprio(0); } while (0)
#define PG8_WAIT_V(n) asm volatile("s_waitcnt vmcnt(" #n ")" ::: "memory")
#define PG8_WAIT_L(n) asm volatile("s_waitcnt lgkmcnt(" #n ")" ::: "memory")
#define PG8_BAR __builtin_amdgcn_s_barrier()
#define PG8_SCHED __builtin_amdgcn_sched_barrier(0)
    Unit cur, nxt; int ui = 0;
    if (!S.next(0, cur)) return;
    f32x4 acc[2][2][4][2];
#pragma unroll
    for (int a = 0; a < 2; ++a)
#pragma unroll
        for (int b = 0; b < 2; ++b)
#pragma unroll
            for (int m = 0; m < 4; ++m)
#pragma unroll
                for (int n = 0; n < 2; ++n) acc[a][b][m][n] = (f32x4){0.f, 0.f, 0.f, 0.f};
    bf16x8 At[4][2], B0[2][2], B1[2][2];
    const char* cA = (const char*)g.A + (size_t)cur.pm * tstepA; const char* cB = (const char*)g.Bt + (size_t)cur.pb * tstepB;
    PG8_STAGE(PG8_SB(0, 0), cB, voffB); PG8_STAGE(PG8_SA(0, 0), cA, voffA); PG8_STAGE(PG8_SB(0, 1), cB + hstepB, voffB); PG8_STAGE(PG8_SA(0, 1), cA + hstepA, voffA);
    if (wr == 1) PG8_BAR;
    PG8_WAIT_V(4); PG8_BAR;
    PG8_STAGE(PG8_SB(1, 0), cB + kstep, voffB); PG8_STAGE(PG8_SA(1, 0), cA + kstep, voffA); PG8_STAGE(PG8_SB(1, 1), cB + hstepB + kstep, voffB);
    PG8_WAIT_V(6); PG8_BAR;
    for (;;) {
        const bool has_next = S.next(ui + 1, nxt);
        const char* nA = has_next ? (const char*)g.A + (size_t)nxt.pm * tstepA : cA; const char* nB = has_next ? (const char*)g.Bt + (size_t)nxt.pb * tstepB : cB;
#pragma unroll 1
        for (int t = 0; t < nt; t += 2) {
            const bool last = (t == nt - 2);
            const char* a1 = cA + (size_t)(t + 1) * kstep;
            const char* a2 = last ? nA : cA + (size_t)(t + 2) * kstep; const char* b2 = last ? nB : cB + (size_t)(t + 2) * kstep;
            const char* a3 = a2 + kstep; const char* b3 = b2 + kstep;
            PG8_LDB(B0, 0, 0); PG8_SCHED; PG8_LDA(At, 0, 0); PG8_STAGE(PG8_SA(1, 1), a1 + hstepA, voffA);
            PG8_WAIT_L(8); PG8_BAR; PG8_WAIT_L(0); PG8_MMA(0, 0, At, B0); PG8_BAR; PG8_SCHED;
            PG8_LDB(B1, 0, 1); PG8_STAGE(PG8_SB(0, 0), b2, voffB);
            PG8_BAR; PG8_WAIT_L(0); PG8_MMA(0, 1, At, B1); PG8_BAR;
            PG8_LDA(At, 0, 1); PG8_STAGE(PG8_SA(0, 0), a2, voffA);
            PG8_BAR; PG8_WAIT_L(0); PG8_MMA(1, 0, At, B0); PG8_BAR; PG8_SCHED;
            PG8_STAGE(PG8_SB(0, 1), b2 + hstepB, voffB);
            PG8_WAIT_V(6); PG8_BAR; PG8_MMA(1, 1, At, B1); PG8_BAR;
            PG8_LDB(B0, 1, 0); PG8_SCHED; PG8_LDA(At, 1, 0); PG8_STAGE(PG8_SA(0, 1), a2 + hstepA, voffA);
            PG8_WAIT_L(8); PG8_BAR; PG8_WAIT_L(0); PG8_MMA(0, 0, At, B0); PG8_BAR; PG8_SCHED;
            PG8_LDB(B1, 1, 1); PG8_STAGE(PG8_SB(1, 0), b3, voffB);
            PG8_BAR; PG8_WAIT_L(0); PG8_MMA(0, 1, At, B1); PG8_BAR;
            PG8_LDA(At, 1, 1); PG8_STAGE(PG8_SA(1, 0), a3, voffA);
            PG8_BAR; PG8_WAIT_L(0); PG8_MMA(1, 0, At, B0); PG8_BAR; PG8_SCHED;
            PG8_STAGE(PG8_SB(1, 1), b3 + hstepB, voffB);
            PG8_WAIT_V(6); PG8_BAR; PG8_MMA(1, 1, At, B1); PG8_BAR;
        }
        { int fr_ = fr, fq_ = fq; asm volatile("" : "+v"(fr_), "+v"(fq_)); E(acc, cur, wr, wc, fr_, fq_); }
        if (!has_next) break;
#pragma unroll
        for (int a = 0; a < 2; ++a)
#pragma unroll
            for (int b = 0; b < 2; ++b)
#pragma unroll
                for (int m = 0; m < 4; ++m)
#pragma unroll
                    for (int n = 0; n < 2; ++n) acc[a][b][m][n] = (f32x4){0.f, 0.f, 0.f, 0.f};
        cur = nxt; cA = nA; cB = nB; ++ui;
    }
    PG8_WAIT_V(0);
    if (wr == 0) PG8_BAR;
    PG8_BAR;
#undef PG8_SA
#undef PG8_SB
#undef PG8_STAGE
#undef PG8_LDA
#undef PG8_LDB
#undef PG8_MMA
#undef PG8_WAIT_V
#undef PG8_WAIT_L
#undef PG8_BAR
#undef PG8_SCHED
}
}
using pg8::Unit; using pg8::HALF;
typedef const f32x4 (&AccRef)[2][2][4][2];

struct EpiZ {
    static constexpr bool PERM = true;
    bf16_t *zrw, *g3, *xl, *as;
    __device__ __forceinline__ void operator()(AccRef acc, const Unit& u, int wr, int wc, int fr, int fq) const {
        const int row0 = u.pm * 256 + wr * 64 + fr, colt = wc * 32 + 8 * fq, pn = u.pn;
        if (pn == 9 || pn == 10) {
#pragma unroll
            for (int ai = 0; ai < 2; ++ai)
#pragma unroll
                for (int m = 0; m < 4; ++m) { const int row = row0 + ai * HALF + m * 16; const int b = row >> 13, l = row & 8191;
#pragma unroll
                    for (int bj = 0; bj < 2; ++bj) { const int c = (pn - 9) * 256 + bj * HALF + colt; const int g = c >> 4, h0 = c & 15;
                        const size_t asrow = (size_t)g * 2048 + b * 512 + (l >> 4);
                        const f32x4 v0 = acc[ai][bj][m][0], v1 = acc[ai][bj][m][1];
                        u32x4 w; w.x = cvt_pk_bf16(v0[0], v0[1]); w.y = cvt_pk_bf16(v0[2], v0[3]); w.z = cvt_pk_bf16(v1[0], v1[1]); w.w = cvt_pk_bf16(v1[2], v1[3]);
                        *(u32x4*)(as + asrow * AS_LD + (l & 15) * 16 + h0) = w; } }
            return;
        }
        bf16_t* base; int ld, c0;
        if (pn < 7) { base = zrw; ld = ZRW_LD; c0 = pn * 256; }
        else if (pn < 9) { base = g3; ld = G3_LD; c0 = (pn - 7) * 256; }
        else if (pn < 13) { base = g3; ld = G3_LD; c0 = 512 + (pn - 11) * 256; }
        else if (pn < 15) { base = xl; ld = BW; c0 = (pn - 13) * 256; }
        else { base = g3; ld = G3_LD; c0 = 1024 + (pn - 15) * 256; }
#pragma unroll
        for (int ai = 0; ai < 2; ++ai)
#pragma unroll
            for (int m = 0; m < 4; ++m) { bf16_t* rowp = base + (size_t)(row0 + ai * HALF + m * 16) * ld + c0 + colt;
#pragma unroll
                for (int bj = 0; bj < 2; ++bj) { const f32x4 v0 = acc[ai][bj][m][0], v1 = acc[ai][bj][m][1];
                    u32x4 w; w.x = cvt_pk_bf16(v0[0], v0[1]); w.y = cvt_pk_bf16(v0[2], v0[3]); w.z = cvt_pk_bf16(v1[0], v1[1]); w.w = cvt_pk_bf16(v1[2], v1[3]);
                    *(u32x4*)(rowp + bj * HALF) = w; } }
    }
};
struct EpiPle {
    static constexpr bool PERM = true;
    bf16_t* pw; float* ss;
    __device__ __forceinline__ void operator()(AccRef acc, const Unit& u, int wr, int wc, int fr, int fq) const {
        const int row0 = u.pm * 256 + wr * 64 + fr, col0 = u.pn * 256 + wc * 32 + 8 * fq;
#pragma unroll
        for (int ai = 0; ai < 2; ++ai)
#pragma unroll
            for (int m = 0; m < 4; ++m) { const int row = row0 + ai * HALF + m * 16; bf16_t* rowp = pw + (size_t)row * D + col0; float s = 0.f;
#pragma unroll
                for (int bj = 0; bj < 2; ++bj) { const f32x4 v0 = acc[ai][bj][m][0], v1 = acc[ai][bj][m][1];
                    s += v0[0] * v0[0] + v0[1] * v0[1] + v0[2] * v0[2] + v0[3] * v0[3] + v1[0] * v1[0] + v1[1] * v1[1] + v1[2] * v1[2] + v1[3] * v1[3];
                    u32x4 w; w.x = cvt_pk_bf16(v0[0], v0[1]); w.y = cvt_pk_bf16(v0[2], v0[3]); w.z = cvt_pk_bf16(v1[0], v1[1]); w.w = cvt_pk_bf16(v1[2], v1[3]);
                    *(u32x4*)(rowp + bj * HALF) = w; }
                s += __shfl_xor(s, 16); s += __shfl_xor(s, 32);
                if (fq == 0) unsafeAtomicAdd(ss + row, s);
                asm volatile("" ::: "memory"); }
    }
};
struct EpiE {
    static constexpr bool PERM = false;
    float* e;
    __device__ __forceinline__ void operator()(AccRef acc, const Unit& u, int wr, int wc, int fr, int fq) const {
        const int row0 = u.pm * 256 + wr * 64 + fr, col0 = wc * 32 + 4 * fq;
#pragma unroll
        for (int ai = 0; ai < 2; ++ai)
#pragma unroll
            for (int m = 0; m < 4; ++m) { float* rowp = e + (size_t)(row0 + ai * HALF + m * 16) * 128 + col0;
#pragma unroll
                for (int n = 0; n < 2; ++n) *(f32x4*)(rowp + n * 16) = acc[ai][0][m][n]; }
    }
};
struct EpiY {
    static constexpr bool PERM = true;
    const bf16_t* as; const float* dvec; bf16_t* zgs;
    __device__ __forceinline__ void operator()(AccRef acc, const Unit& u, int wr, int wc, int fr, int fq) const {
        const int row0 = u.pm * 256 + wr * 64 + fr, colt = wc * 32 + 8 * fq, g = u.pm >> 3, h0 = (8 * fq) & 15;
        const f32x4 d0 = *(const f32x4*)(dvec + g * 16 + h0), d1 = *(const f32x4*)(dvec + g * 16 + h0 + 4);
#pragma unroll
        for (int ai = 0; ai < 2; ++ai)
#pragma unroll
            for (int m = 0; m < 4; ++m) { const int row = row0 + ai * HALF + m * 16; const int b = (row >> 9) & 3, ch = row & 511;
#pragma unroll
                for (int bj = 0; bj < 2; ++bj) { const int c = bj * HALF + colt, tt = c >> 4;
                    float uu[8]; unpack8(*(const u32x4*)(as + (size_t)row * AS_LD + c), uu);
                    const f32x4 v0 = acc[ai][bj][m][0], v1 = acc[ai][bj][m][1];
                    float o[8];
#pragma unroll
                    for (int j = 0; j < 4; ++j) { o[j] = gelu_tanh(v0[j] + d0[j] * uu[j]); o[4 + j] = gelu_tanh(v1[j] + d1[j] * uu[4 + j]); }
                    const size_t tok = (size_t)b * SEQ + ch * 16 + tt;
                    *(u32x4*)(zgs + tok * BW + g * 16 + h0) = pack8(o); }
                asm volatile("" ::: "memory"); }
    }
};
struct EpiGlu {
    static constexpr bool PERM = true;
    const bf16_t* zgs; const float* bias; bf16_t* g3;
    __device__ __forceinline__ void operator()(AccRef acc, const Unit& u, int wr, int wc, int fr, int fq) const {
        const int row0 = u.pm * 256 + wr * 64 + fr, col0 = u.pn * 256 + wc * 32 + 8 * fq;
#pragma unroll
        for (int ai = 0; ai < 2; ++ai)
#pragma unroll
            for (int m = 0; m < 4; ++m) { const size_t row = (size_t)(row0 + ai * HALF + m * 16);
#pragma unroll
                for (int bj = 0; bj < 2; ++bj) { const int c = col0 + bj * HALF;
                    float z[8], gt[8]; unpack8(*(const u32x4*)(zgs + row * BW + c), z); bf16_t* gp = g3 + row * G3_LD + 512 + c; unpack8(*(const u32x4*)gp, gt);
                    const f32x4 b0 = *(const f32x4*)(bias + c), b1 = *(const f32x4*)(bias + c + 4);
                    const f32x4 v0 = acc[ai][bj][m][0], v1 = acc[ai][bj][m][1];
                    float o[8];
#pragma unroll
                    for (int j = 0; j < 4; ++j) { o[j] = z[j] * sigmoidf_(v0[j] + b0[j]) * siluf_(gt[j]); o[4 + j] = z[4 + j] * sigmoidf_(v1[j] + b1[j]) * siluf_(gt[4 + j]); }
                    *(u32x4*)gp = pack8(o); } }
    }
};
struct EpiLru {
    static constexpr bool PERM = true;
    const bf16_t* xc; const float *ba, *bx, *lam; bf16_t* ab;
    __device__ __forceinline__ void operator()(AccRef acc, const Unit& u, int wr, int wc, int fr, int fq) const {
        const int row0 = u.pm * 256 + wr * 64 + fr, ch = u.pn * 128 + wc * 32 + 8 * fq;
        float bav[8], bxv[8], spl[8];
#pragma unroll
        for (int j = 0; j < 8; ++j) { bav[j] = ba[ch + j]; bxv[j] = bx[ch + j]; spl[j] = -8.0f * softplusf_(-lam[ch + j]); }
#pragma unroll
        for (int ai = 0; ai < 2; ++ai)
#pragma unroll
            for (int m = 0; m < 4; ++m) { const size_t row = (size_t)(row0 + ai * HALF + m * 16);
                float x[8]; unpack8(*(const u32x4*)(xc + row * BW + ch), x);
                float la[8], bb[8];
#pragma unroll
                for (int j = 0; j < 8; ++j) { const float za = acc[ai][0][m][j >> 2][j & 3], zx = acc[ai][1][m][j >> 2][j & 3];
                    const float r = sigmoidf_(za + bav[j]), ig = sigmoidf_(zx + bxv[j]);
                    const float l_a = spl[j] * r; la[j] = l_a;
                    bb[j] = sqrtf(fmaxf(-expm1f(2.0f * l_a), 0.0f)) * (ig * x[j]); }
                *(u32x4*)(ab + row * 1024 + ch) = pack8(la); *(u32x4*)(ab + row * 1024 + 512 + ch) = pack8(bb); }
    }
};
struct EpiOut {
    static constexpr bool PERM = true;
    const float* hin; float* h; bf16_t* h1b;
    __device__ __forceinline__ void operator()(AccRef acc, const Unit& u, int wr, int wc, int fr, int fq) const {
        const int row0 = u.pm * 256 + wr * 64 + fr, col0 = u.pn * 256 + wc * 32 + 8 * fq;
#pragma unroll
        for (int ai = 0; ai < 2; ++ai)
#pragma unroll
            for (int m = 0; m < 4; ++m) { const size_t off = (size_t)(row0 + ai * HALF + m * 16) * D + col0;
#pragma unroll
                for (int bj = 0; bj < 2; ++bj) { const size_t o = off + bj * HALF;
                    const f32x4 v0 = *(const f32x4*)(hin + o) + acc[ai][bj][m][0], v1 = *(const f32x4*)(hin + o + 4) + acc[ai][bj][m][1];
                    *(f32x4*)(h + o) = v0; *(f32x4*)(h + o + 4) = v1;
                    u32x4 w; w.x = cvt_pk_bf16(v0[0], v0[1]); w.y = cvt_pk_bf16(v0[2], v0[3]); w.z = cvt_pk_bf16(v1[0], v1[1]); w.w = cvt_pk_bf16(v1[2], v1[3]); *(u32x4*)(h1b + o) = w; }
                asm volatile("" ::: "memory"); }
    }
};
struct EpiGate {
    static constexpr bool PERM = true;
    float* h; const bf16_t* pw; const float* ssp; const float* gple; float* ssh;
    __device__ __forceinline__ void operator()(AccRef acc, const Unit& u, int wr, int wc, int fr, int fq) const {
        const int row0 = u.pm * 256 + wr * 64 + fr, col0 = u.pn * 256 + wc * 32 + 8 * fq;
        f32x4 gv[2][2];
#pragma unroll
        for (int bj = 0; bj < 2; ++bj)
#pragma unroll
            for (int n = 0; n < 2; ++n) gv[bj][n] = *(const f32x4*)(gple + col0 + bj * HALF + 4 * n);
#pragma unroll
        for (int ai = 0; ai < 2; ++ai)
#pragma unroll
            for (int m = 0; m < 4; ++m) { const int row = row0 + ai * HALF + m * 16; const size_t off = (size_t)row * D + col0;
                const float rs = rsqrtf(ssp[row] * (1.0f / 1024.0f) + 1e-6f); float s = 0.f;
#pragma unroll
                for (int bj = 0; bj < 2; ++bj) { const size_t o = off + bj * HALF; float pv[8]; unpack8(*(const u32x4*)(pw + o), pv);
#pragma unroll
                    for (int n = 0; n < 2; ++n) { const f32x4 a = acc[ai][bj][m][n]; f32x4 v = *(const f32x4*)(h + o + 4 * n);
#pragma unroll
                        for (int j = 0; j < 4; ++j) { v[j] += pv[4 * n + j] * rs * gv[bj][n][j] * sigmoidf_(a[j]); s += v[j] * v[j]; }
                        *(f32x4*)(h + o + 4 * n) = v; } }
                s += __shfl_xor(s, 16); s += __shfl_xor(s, 32);
                if (fq == 0) unsafeAtomicAdd(ssh + row, s); }
    }
};

struct Ctx { const Params* P; unsigned char* ws; LAS unsigned char* lds; unsigned char* ldsg; int tid, lane, wave; size_t gtid, gsz; int vb, vG; };

template <class Map>
__device__ void transpose_w(const Ctx& c, const float* src, bf16_t* dst, int K, int Nsrc, int Npad, Map map) {
    const int K8 = K / 8; const size_t total = (size_t)2 * Npad * K8;
    for (size_t idx = c.gtid; idx < total; idx += c.gsz) {
        const int n = (int)(idx % Npad); const int k8 = (int)((idx / Npad) % K8); const int l = (int)(idx / ((size_t)Npad * K8));
        const int s = map(n); float f[8];
#pragma unroll
        for (int i = 0; i < 8; ++i) f[i] = (s >= 0) ? src[((size_t)l * K + k8 * 8 + i) * Nsrc + s] : 0.0f;
        *(u32x4*)(dst + ((size_t)l * Npad + n) * K + k8 * 8) = pack8(f);
    }
}

__device__ __forceinline__ void s5_lam_pow(const Params& P, int l, int g, int p, int n, float& re, float& im) {
    const float are = P.in[14][(l * 32 + g) * 64 + p], aim = P.in[15][(l * 32 + g) * 64 + p], dt = __expf(P.in[16][l * 32 + g]);
    const float mag = __expf(are * dt * (float)n);
    double rev = (double)aim * (double)dt * (double)n * 0.15915494309189535; rev -= rint(rev);
    const float ang = (float)(rev * 6.283185307179586);
    re = mag * cosf(ang); im = mag * sinf(ang);
}

__device__ void phase_prep(const Ctx& c) {
    const Params& P = *c.P; unsigned char* ws = c.ws;
    transpose_w(c, P.in[3], (bf16_t*)(ws + OFF_WIN), D, DIN, DINP, [](int n) { return n < 1664 ? n : (n < 1792 ? -1 : n - 128); });
    transpose_w(c, P.in[31], (bf16_t*)(ws + OFF_WOUT), DMIX, D, D, [](int n) { return n; });
    transpose_w(c, P.in[34], (bf16_t*)(ws + OFF_WG), D, D, D, [](int n) { return n; });
    transpose_w(c, P.in[32], (bf16_t*)(ws + OFF_WPLE), DPLE, D, D, [](int n) { return n; });
    transpose_w(c, P.in[22], (bf16_t*)(ws + OFF_WGLU), BW, BW, BW, [](int n) { return n; });
    { bf16_t* dst = (bf16_t*)(ws + OFF_WLRU);
      for (size_t idx = c.gtid; idx < (size_t)2 * 1024 * 64; idx += c.gsz) {
          const int n = (int)(idx & 1023), k8 = (int)((idx >> 10) & 63), l = (int)(idx >> 16);
          const int pn = n >> 8, rr = n & 255, ch = 128 * pn + (rr & 127), which = rr >> 7, hb = ch >> 6, j = ch & 63, k0 = k8 * 8;
          const float* W = which ? P.in[28] : P.in[26]; float f[8];
#pragma unroll
          for (int i = 0; i < 8; ++i) f[i] = ((k0 >> 6) == hb) ? W[(((size_t)l * 8 + hb) * 64 + (k0 & 63) + i) * 64 + j] : 0.0f;
          *(u32x4*)(dst + ((size_t)l * 1024 + n) * BW + k0) = pack8(f); } }
    { float* tbl = (float*)(ws + OFF_TBL);
      for (size_t idx = c.gtid; idx < (size_t)2 * 32 * 64 * 18; idx += c.gsz) {
          const int n = (int)(idx % 18), lgp = (int)(idx / 18), p = lgp & 63, g = (lgp >> 6) & 31, l = lgp >> 11; float re, im;
          if (n < 17) s5_lam_pow(P, l, g, p, n, re, im);
          else { float lr, li; s5_lam_pow(P, l, g, p, 1, lr, li); const float ar = P.in[14][(l * 32 + g) * 64 + p], ai = P.in[15][(l * 32 + g) * 64 + p];
                 const float cr = lr - 1.0f, ci = li, den = 1.0f / (ar * ar + ai * ai); re = (cr * ar + ci * ai) * den; im = (ci * ar - cr * ai) * den; }
          tbl[idx * 2] = re; tbl[idx * 2 + 1] = im; } }
    { const float* x = P.in[0]; const float* gg = P.in[2]; bf16_t* xn = (bf16_t*)(ws + OFF_XN);
      const int stride = gridDim.x * 8;
      for (int row0 = blockIdx.x * 8 + c.wave; row0 < T; row0 += 2 * stride) {
          f32x4 v[2][4]; float sq[2]; bool ok[2];
#pragma unroll
          for (int r = 0; r < 2; ++r) { const int row = row0 + r * stride; ok[r] = row < T; const int rr = ok[r] ? row : row0; sq[r] = 0.f;
#pragma unroll
              for (int i = 0; i < 4; ++i) { v[r][i] = *(const f32x4*)(x + (size_t)rr * D + i * 256 + c.lane * 4); sq[r] += v[r][i][0] * v[r][i][0] + v[r][i][1] * v[r][i][1] + v[r][i][2] * v[r][i][2] + v[r][i][3] * v[r][i][3]; } }
#pragma unroll
          for (int r = 0; r < 2; ++r) { if (!ok[r]) continue; const int row = row0 + r * stride; const float rs = rsqrtf(wave_sum(sq[r]) * (1.0f / 1024.0f) + 1e-6f);
#pragma unroll
              for (int i = 0; i < 4; ++i) { const f32x4 gv = *(const f32x4*)(gg + i * 256 + c.lane * 4); u32x2 w; w.x = cvt_pk_bf16(v[r][i][0] * rs * gv[0], v[r][i][1] * rs * gv[1]); w.y = cvt_pk_bf16(v[r][i][2] * rs * gv[2], v[r][i][3] * rs * gv[3]);
                  *(u32x2*)(xn + (size_t)row * D + i * 256 + c.lane * 4) = w; } } } }
    { float* ss = (float*)(ws + OFF_SS); for (size_t i = c.gtid; i < (size_t)4 * T; i += c.gsz) ss[i] = 0.0f; }
    { const float* p = P.in[1]; bf16_t* pb = (bf16_t*)(ws + OFF_PB);
      for (size_t i = c.gtid; i < (size_t)2 * T * DPLE / 8; i += c.gsz) { const f32x4 a = *(const f32x4*)(p + i * 8), b = *(const f32x4*)(p + i * 8 + 4);
          u32x4 w; w.x = cvt_pk_bf16(a[0], a[1]); w.y = cvt_pk_bf16(a[2], a[3]); w.z = cvt_pk_bf16(b[0], b[1]); w.w = cvt_pk_bf16(b[2], b[3]); *(u32x4*)(pb + i * 8) = w; } }
}

__device__ void phase_s5_consts(const Ctx& c) {
    const Params& P = *c.P; unsigned char* ws = c.ws;
    const float* tbl = (const float*)(ws + OFF_TBL); bf16_t* by = (bf16_t*)(ws + OFF_S5Y); bf16_t* be = (bf16_t*)(ws + OFF_S5E);
    const float *bre = P.in[17], *bim = P.in[18], *cre = P.in[19], *cim = P.in[20];
    for (size_t idx = c.gtid; idx < (size_t)2 * 32 * 16 * 256; idx += c.gsz) {
        const int hp = (int)(idx & 15), h = (int)((idx >> 4) & 15), tau = (int)((idx >> 8) & 15), g = (int)((idx >> 12) & 31), l = (int)(idx >> 17);
        const int lg = l * 32 + g; float s = 0.f;
        for (int p = 0; p < 64; ++p) { const float* tp = tbl + ((size_t)(lg * 64 + p) * 18) * 2;
            const float pr = tp[tau * 2], pi = tp[tau * 2 + 1], qr = tp[34], qi = tp[35];
            const float br = bre[((size_t)lg * 64 + p) * 16 + hp], bi = bim[((size_t)lg * 64 + p) * 16 + hp];
            const float bbr = qr * br - qi * bi, bbi = qr * bi + qi * br;
            const float zr = pr * bbr - pi * bbi, zi = pr * bbi + pi * bbr;
            const float cr = cre[((size_t)lg * 16 + h) * 64 + p], ci = cim[((size_t)lg * 16 + h) * 64 + p];
            s += cr * zr - ci * zi; }
        const bf16_t kv = f2bf(s); bf16_t* base = by + (size_t)lg * 256 * AS_LD;
        for (int s0 = 0; s0 + tau < 16; ++s0) { const int t = s0 + tau;
            base[(size_t)(t * 16 + h) * AS_LD + s0 * 16 + hp] = kv;
            if (tau > 0) base[(size_t)(s0 * 16 + h) * AS_LD + t * 16 + hp] = 0; }
    }
    for (size_t idx = c.gtid; idx < (size_t)2 * 32 * 256 * 64; idx += c.gsz) {
        const int p = (int)(idx & 63), th = (int)((idx >> 6) & 255), lg = (int)(idx >> 14); const int t = th >> 4, h = th & 15;
        const float* tp = tbl + ((size_t)(lg * 64 + p) * 18) * 2; const float pr = tp[(t + 1) * 2], pi = tp[(t + 1) * 2 + 1];
        const float cr = cre[((size_t)lg * 16 + h) * 64 + p], ci = cim[((size_t)lg * 16 + h) * 64 + p];
        bf16_t* rowp = by + ((size_t)lg * 256 + th) * AS_LD; rowp[256 + p] = f2bf(cr * pr - ci * pi); rowp[320 + p] = f2bf(-(cr * pi + ci * pr));
    }
    for (size_t idx = c.gtid; idx < (size_t)2 * 32 * 256 * 256; idx += c.gsz) {
        const int col = (int)(idx & 255), n = (int)((idx >> 8) & 255), lg = (int)(idx >> 16); float v = 0.f;
        if (n < 128) { const int p = n & 63, s0 = col >> 4, hp = col & 15; const float* tp = tbl + ((size_t)(lg * 64 + p) * 18) * 2;
            const float pr = tp[(15 - s0) * 2], pi = tp[(15 - s0) * 2 + 1], qr = tp[34], qi = tp[35];
            const float br = bre[((size_t)lg * 64 + p) * 16 + hp], bi = bim[((size_t)lg * 64 + p) * 16 + hp];
            const float bbr = qr * br - qi * bi, bbi = qr * bi + qi * br;
            v = (n < 64) ? (pr * bbr - pi * bbi) : (pr * bbi + pi * bbr); }
        be[idx] = f2bf(v);
    }
}

__device__ void phase_lru_conv(const Ctx& c, int l) {
    const Params& P = *c.P; const bf16_t* xl = (const bf16_t*)(c.ws + OFF_XL); bf16_t* xc = (bf16_t*)(c.ws + OFF_XC);
    const float* cw = P.in[24] + (size_t)l * 4 * BW; const float* cb = P.in[25] + (size_t)l * BW;
    for (size_t idx = (size_t)c.vb * 512 + c.tid; idx < (size_t)T * 64; idx += (size_t)c.vG * 512) {
        const int c8 = (int)(idx & 63) * 8; const int row = (int)(idx >> 6), lpos = row & (SEQ - 1);
        float o[8];
#pragma unroll
        for (int i = 0; i < 8; ++i) o[i] = cb[c8 + i];
#pragma unroll
        for (int j = 0; j < 4; ++j) { if (lpos - 3 + j >= 0) { float x[8]; unpack8(*(const u32x4*)(xl + (size_t)(row - 3 + j) * BW + c8), x);
#pragma unroll
                for (int i = 0; i < 8; ++i) o[i] += x[i] * cw[j * BW + c8 + i]; } }
        *(u32x4*)(xc + (size_t)row * BW + c8) = pack8(o);
    }
}

__device__ void phase_s5_carry(const Ctx& c, int l) {
    const int id = c.vb - (c.vG - 128);
    if (c.wave != 0 || id < 0) return;
    const int g = id >> 2, b = id & 3, p = c.lane;
    float lr, li; s5_lam_pow(*c.P, l, g, p, 16, lr, li);
    const float* e = (const float*)(c.ws + OFF_E); bf16_t* as = (bf16_t*)(c.ws + OFF_AS);
    const size_t base = (size_t)g * 2048 + b * 512; float xr = 0.f, xi = 0.f;
    for (int c0 = 0; c0 < 512; c0 += 32) {
        float er[32], ei[32];
#pragma unroll
        for (int i = 0; i < 32; ++i) { er[i] = e[(base + c0 + i) * 128 + p]; ei[i] = e[(base + c0 + i) * 128 + 64 + p]; }
#pragma unroll
        for (int i = 0; i < 32; ++i) { bf16_t* rowp = as + (base + c0 + i) * AS_LD; rowp[256 + p] = f2bf(xr); rowp[320 + p] = f2bf(xi);
            const float nr = lr * xr - li * xi + er[i], ni = lr * xi + li * xr + ei[i]; xr = nr; xi = ni; }
    }
}

__device__ void phase_lru_scan(const Ctx& c, int pass) {
    const bf16_t* ab = (const bf16_t*)(c.ws + OFF_LRUAB); float* agg = (float*)(c.ws + OFF_AGG); bf16_t* g3 = (bf16_t*)(c.ws + OFF_G3);
    const int ch = c.tid;
    for (int unit = c.vb; unit < NB * 128; unit += c.vG) {
        const int b = unit >> 7, ck = unit & 127; const size_t t0 = (size_t)b * SEQ + ck * 64;
        float h = 0.f, sl = 0.f;
        if (pass == 1) {
            for (int i0 = 0; i0 < ck; i0 += 16) { float sl_[16], he_[16];
#pragma unroll
                for (int j = 0; j < 16; ++j) { const int ii = (i0 + j < ck) ? i0 + j : ck - 1; const float* a = agg + ((size_t)(b * 128 + ii)) * 1024; sl_[j] = a[ch]; he_[j] = a[512 + ch]; }
#pragma unroll
                for (int j = 0; j < 16; ++j) if (i0 + j < ck) h = __expf(sl_[j]) * h + he_[j]; }
        }
        for (int t8 = 0; t8 < 64; t8 += 16) {
            float la[16], bb[16], gt[16];
#pragma unroll
            for (int i = 0; i < 16; ++i) { la[i] = bf2f(ab[(t0 + t8 + i) * 1024 + ch]); bb[i] = bf2f(ab[(t0 + t8 + i) * 1024 + 512 + ch]); if (pass == 1) gt[i] = bf2f(g3[(t0 + t8 + i) * G3_LD + 1024 + ch]); }
#pragma unroll
            for (int i = 0; i < 16; ++i) { h = __expf(la[i]) * h + bb[i]; sl += la[i];
                if (pass == 1) g3[(t0 + t8 + i) * G3_LD + 1024 + ch] = f2bf(h * siluf_(gt[i])); }
        }
        if (pass == 0) { float* a = agg + ((size_t)(b * 128 + ck)) * 1024; a[ch] = sl; a[512 + ch] = h; }
    }
}

__device__ void phase_norm(const Ctx& c, const float* ss, const float* gg, int fin) {
    float* h = c.P->out; bf16_t* xn = (bf16_t*)(c.ws + OFF_XN);
    const int stride = gridDim.x * 8;
    f32x4 gv[4];
#pragma unroll
    for (int i = 0; i < 4; ++i) gv[i] = *(const f32x4*)(gg + i * 256 + c.lane * 4);
    for (int row0 = blockIdx.x * 8 + c.wave; row0 < T; row0 += 4 * stride) {
        f32x4 v[4][4]; float rs[4]; bool ok[4];
#pragma unroll
        for (int r = 0; r < 4; ++r) { const int row = row0 + r * stride; ok[r] = row < T; const int rr = ok[r] ? row : row0; rs[r] = ss[rr];
#pragma unroll
            for (int i = 0; i < 4; ++i) v[r][i] = *(const f32x4*)(h + (size_t)rr * D + i * 256 + c.lane * 4); }
#pragma unroll
        for (int r = 0; r < 4; ++r) { if (!ok[r]) continue; const int row = row0 + r * stride; const float sc = rsqrtf(rs[r] * (1.0f / 1024.0f) + 1e-6f);
#pragma unroll
            for (int i = 0; i < 4; ++i) { const size_t o = (size_t)row * D + i * 256 + c.lane * 4; const f32x4 q = v[r][i] * sc * gv[i];
                if (fin) *(f32x4*)(h + o) = q; else { u32x2 w; w.x = cvt_pk_bf16(q[0], q[1]); w.y = cvt_pk_bf16(q[2], q[3]); *(u32x2*)(xn + o) = w; } } }
    }
}

typedef float f32x2 __attribute__((ext_vector_type(2)));
template <int CTRL> __device__ __forceinline__ float dpp_mov(float v) { return __builtin_bit_cast(float, __builtin_amdgcn_update_dpp(0, __builtin_bit_cast(int, v), CTRL, 0xf, 0xf, true)); }
__device__ __forceinline__ float row16_sum(float v) { v += dpp_mov<0xB1>(v); v += dpp_mov<0x4E>(v); v += dpp_mov<0x124>(v); v += dpp_mov<0x128>(v); return v; }
__device__ __forceinline__ float wave_sum2(float v) { v = row16_sum(v); const int vi = __builtin_bit_cast(int, v); const float a = __builtin_bit_cast(float, __builtin_amdgcn_readlane(vi, 0)), b = __builtin_bit_cast(float, __builtin_amdgcn_readlane(vi, 16)), c2 = __builtin_bit_cast(float, __builtin_amdgcn_readlane(vi, 32)), d = __builtin_bit_cast(float, __builtin_amdgcn_readlane(vi, 48)); return (a + b) + (c2 + d); }
__device__ __forceinline__ float oct_sum(float v) { v += dpp_mov<0xB1>(v); v += dpp_mov<0x4E>(v); v += dpp_mov<0x141>(v); return v; }
constexpr int RW_NBLK = 128, TWS = 72;

struct RwRows { unsigned zr[5], zk[5], zv[5], zw[5], za[5]; };
__device__ __forceinline__ float rw_get(const unsigned (&a)[5], int i) { return (i & 1) ? hi16(a[i >> 1]) : lo16(a[i >> 1]); }
__device__ __forceinline__ void rw_load_rows(RwRows& R, const bf16_t* zrw, int b, int blk, int w, int lane, int cj) {
#pragma unroll
    for (int p = 0; p < 5; ++p) { unsigned r_[2] = {0, 0}, k_[2] = {0, 0}, v_[2] = {0, 0}, w_[2] = {0, 0}, a_[2] = {0, 0};
#pragma unroll
        for (int h = 0; h < 2; ++h) { const int i = 2 * p + h; if (i < 9) { const int lp = blk * 64 + w * 8 - 1 + i; const bool ok = lp >= 0; const bf16_t* rp = zrw + ((size_t)b * SEQ + (ok ? lp : 0)) * ZRW_LD;
            const unsigned m = ok ? 0xffffu : 0u;
            r_[h] = rp[cj] & m; k_[h] = rp[512 + cj] & m; v_[h] = rp[1024 + cj] & m; w_[h] = rp[1536 + lane] & m; a_[h] = rp[1600 + lane] & m; } }
        R.zr[p] = r_[0] | (r_[1] << 16); R.zk[p] = k_[0] | (k_[1] << 16); R.zv[p] = v_[0] | (v_[1] << 16); R.zw[p] = w_[0] | (w_[1] << 16); R.za[p] = a_[0] | (a_[1] << 16); }
}

constexpr int CH_AT = 0, CH_RT = 2304, CH_KT = 4608, CH_BT = 6912, CH_KH = 9216, CH_NB = 12288, CH_VT = 15360, CH_LRK = 18432, CH_NLRB = 19200, CH_GI = 19968,
              CH_LAB = 20736, CH_LAK = 21760, CH_GC = 22784, CH_BYTES = 23040;
constexpr int RW_YY = 4 * CH_BYTES, RW_TW = RW_YY + 16384, RW_AD = RW_TW + 64 * TWS * 2, RW_AR = RW_TW  , RW_GP = RW_AD + 64 * TWS * 2,
              RW_W2 = RW_GP + 2048, RW_A2 = RW_W2 + 64 * TWS * 2, RW_CT = RW_A2 + 64 * TWS * 2, RW_END = RW_CT + 12 * 64 * 4;
static_assert(RW_END <= LDS_BYTES, "rwkv lds");
__device__ __forceinline__ void lds_barrier() { asm volatile("s_waitcnt lgkmcnt(0)\n\ts_barrier" ::: "memory"); }
typedef short bf16x4 __attribute__((ext_vector_type(4)));
__device__ __forceinline__ bf16x8 cat4(bf16x4 lo, bf16x4 hi) { return __builtin_shufflevector(lo, hi, 0, 1, 2, 3, 4, 5, 6, 7); }
__device__ __forceinline__ bf16x8 cat4z(bf16x4 lo) { const bf16x4 z = {0, 0, 0, 0}; return __builtin_shufflevector(lo, z, 0, 1, 2, 3, 4, 5, 6, 7); }
__device__ __forceinline__ bf16x4 pk4(f32x4 v) { u32x2 w; w.x = cvt_pk_bf16(v[0], v[1]); w.y = cvt_pk_bf16(v[2], v[3]); return __builtin_bit_cast(bf16x4, w); }

__device__ void phase_rwkv(const Ctx& c, int l, int blk_lo, int blk_hi, bool dry = false) {
    if (blockIdx.x >= 32) return;
    const Params& P = *c.P; const int b = blockIdx.x >> 3, hd = blockIdx.x & 7, lane = c.lane, w = c.wave, cj = hd * 64 + lane, fr = lane & 15, fq = lane >> 4;
    LAS unsigned char* LB = c.lds;
    LAS float* YY = (LAS float*)(LB + RW_YY); LAS float* WR = YY; LAS float* AR = (LAS float*)(LB + RW_AR); LAS float* GP = (LAS float*)(LB + RW_GP);
    LAS bf16_t* TWb = (LAS bf16_t*)(LB + RW_TW); LAS bf16_t* ADb = (LAS bf16_t*)(LB + RW_AD);
    const bf16_t* zrw = (const bf16_t*)(c.ws + OFF_ZRW); bf16_t* g3 = (bf16_t*)(c.ws + OFF_G3);
    LAS float* CT = (LAS float*)(LB + RW_CT);
    if (c.tid < 64) { const float* mu = P.in[4] + (size_t)l * 1664; const int j = hd * 64 + c.tid;
        CT[0 * 64 + c.tid] = mu[j]; CT[1 * 64 + c.tid] = mu[512 + j]; CT[2 * 64 + c.tid] = mu[1024 + j]; CT[3 * 64 + c.tid] = mu[1536 + c.tid]; CT[4 * 64 + c.tid] = mu[1600 + c.tid];
        CT[5 * 64 + c.tid] = P.in[5][l * BW + j]; CT[6 * 64 + c.tid] = P.in[7][l * BW + j]; CT[7 * 64 + c.tid] = P.in[9][l * BW + j]; CT[8 * 64 + c.tid] = P.in[10][l * BW + j];
        CT[9 * 64 + c.tid] = P.in[11][l * BW + j]; CT[10 * 64 + c.tid] = P.in[12][l * BW + j]; CT[11 * 64 + c.tid] = P.in[13][l * BW + j]; }
    const int mt_ = w >> 1, nh = w & 1;
    LAS bf16_t* W2I = (LAS bf16_t*)(LB + RW_W2); LAS bf16_t* A2I = (LAS bf16_t*)(LB + RW_A2);
    for (int i = c.tid; i < 4096; i += 512) { const int k = i >> 6, j = i & 63; W2I[j * TWS + k] = f2bf(P.in[6][((size_t)l * 64 + k) * BW + hd * 64 + j]); A2I[j * TWS + k] = f2bf(P.in[8][((size_t)l * 64 + k) * BW + hd * 64 + j]); }
    __syncthreads();
    f32x4 Macc[4];
#pragma unroll
    for (int i = 0; i < 4; ++i) Macc[i] = (f32x4){0.f, 0.f, 0.f, 0.f};
    const int cc = w >> 1, hc = w & 1;
    RwRows cur;
    rw_load_rows(cur, zrw, b, blk_lo, w, lane, cj);
    for (int blk = blk_lo; blk < blk_hi; ++blk) {
        const size_t t0 = (size_t)b * SEQ + blk * 64;
        float rs[8], ks_[8], vs[8];
        const float mu_r = CT[lane], mu_k = CT[64 + lane], mu_v = CT[128 + lane], mu_w = CT[192 + lane], mu_a = CT[256 + lane];
#pragma unroll
        for (int i = 0; i < 8; ++i) { const int tok = w * 8 + i;
            { const float r0 = rw_get(cur.zr, i), r1 = rw_get(cur.zr, i + 1), k0 = rw_get(cur.zk, i), k1 = rw_get(cur.zk, i + 1), v0 = rw_get(cur.zv, i), v1 = rw_get(cur.zv, i + 1);
              rs[i] = r1 + mu_r * (r0 - r1); ks_[i] = k1 + mu_k * (k0 - k1); vs[i] = v1 + mu_v * (v0 - v1); }
            const float w0_ = rw_get(cur.zw, i), w1_ = rw_get(cur.zw, i + 1), a0_ = rw_get(cur.za, i), a1_ = rw_get(cur.za, i + 1);
            const float wds = w1_ + mu_w * (w0_ - w1_), ads = a1_ + mu_a * (a0_ - a1_);
            const float e2 = __expf(2.0f * wds); const float th = 1.0f - 2.0f * __builtin_amdgcn_rcpf(e2 + 1.0f);
            TWb[tok * TWS + lane] = f2bf(th); ADb[tok * TWS + lane] = f2bf(ads); }
        if (blk + 1 < RW_NBLK) rw_load_rows(cur, zrw, b, blk + 1, w, lane, cj);
        unsigned gtp[4];
#pragma unroll
        for (int i = 0; i < 4; ++i) gtp[i] = (unsigned)g3[(t0 + w * 8 + 2 * i) * G3_LD + cj] | ((unsigned)g3[(t0 + w * 8 + 2 * i + 1) * G3_LD + cj] << 16);
        lds_barrier();
        { bf16x8 atw[2], aad[2];
#pragma unroll
          for (int ks = 0; ks < 2; ++ks) { atw[ks] = *(const LAS bf16x8*)(TWb + (16 * mt_ + fr) * TWS + 32 * ks + 8 * fq); aad[ks] = *(const LAS bf16x8*)(ADb + (16 * mt_ + fr) * TWS + 32 * ks + 8 * fq); }
          f32x4 cw[2], ca[2];
#pragma unroll
          for (int n2 = 0; n2 < 2; ++n2) { cw[n2] = (f32x4){0.f, 0.f, 0.f, 0.f}; ca[n2] = cw[n2];
#pragma unroll
              for (int ks = 0; ks < 2; ++ks) { const int bo = (32 * nh + 16 * n2 + fr) * TWS + 32 * ks + 8 * fq;
                  cw[n2] = __builtin_amdgcn_mfma_f32_16x16x32_bf16(atw[ks], *(const LAS bf16x8*)(W2I + bo), cw[n2], 0, 0, 0); ca[n2] = __builtin_amdgcn_mfma_f32_16x16x32_bf16(aad[ks], *(const LAS bf16x8*)(A2I + bo), ca[n2], 0, 0, 0); } }
          lds_barrier();
#pragma unroll
          for (int n2 = 0; n2 < 2; ++n2)
#pragma unroll
              for (int r = 0; r < 4; ++r) { const int o = (16 * mt_ + 4 * fq + r) * 64 + 32 * nh + 16 * n2 + fr; WR[o] = cw[n2][r]; AR[o] = ca[n2][r]; } }
        lds_barrier();
        float kkv[8], kpv[8], bbv[8], gl[8], cbv[8];
        { float g = 1.0f; const float w0j = CT[320 + lane], a0j = CT[384 + lane], kkj = CT[448 + lane], kaj = CT[512 + lane], rkj = CT[576 + lane];
#pragma unroll
          for (int i = 0; i < 8; ++i) { const int o = (w * 8 + i) * 64 + lane;
            const float wraw = w0j + WR[o], araw = a0j + AR[o];
            const float d = __expf(-0.6065306597126334f * sigmoidf_(wraw)), a = sigmoidf_(araw);
            float kk = ks_[i] * kkj; const float n2 = wave_sum2(kk * kk); kk = kk * __builtin_amdgcn_rsqf(fmaxf(n2, 1e-24f));
            const float kp = ks_[i] * (1.0f + (a - 1.0f) * kaj);
            cbv[i] = wave_sum2(rs[i] * kp * rkj);
            g *= d; gl[i] = g; kkv[i] = kk; kpv[i] = kp; bbv[i] = kk * a; }
          GP[w * 64 + lane] = g; }
        lds_barrier();
        { LAS unsigned char* CB_ = LB + cc * CH_BYTES;
          LAS bf16_t *AT = (LAS bf16_t*)(CB_ + CH_AT), *RT = (LAS bf16_t*)(CB_ + CH_RT), *KT = (LAS bf16_t*)(CB_ + CH_KT), *BT = (LAS bf16_t*)(CB_ + CH_BT),
                     *KH = (LAS bf16_t*)(CB_ + CH_KH), *NBH = (LAS bf16_t*)(CB_ + CH_NB), *VT = (LAS bf16_t*)(CB_ + CH_VT);
          const float g0 = GP[(2 * cc) * 64 + lane], g1 = GP[(2 * cc + 1) * 64 + lane], gC = g0 * g1, pre = hc ? g0 : 1.0f;
          if (hc == 0) ((LAS float*)(CB_ + CH_GC))[lane] = gC;
#pragma unroll
          for (int i = 0; i < 8; ++i) { const int tl = 8 * hc + i;
            const float gam = pre * gl[i], gprev = (i == 0) ? pre : pre * gl[i - 1], ig = __builtin_amdgcn_rcpf(gam), gr = gC * ig;
            AT[tl * TWS + lane] = f2bf(kkv[i] * gprev); RT[tl * TWS + lane] = f2bf(rs[i] * gam); KT[tl * TWS + lane] = f2bf(kpv[i] * ig); BT[tl * TWS + lane] = f2bf(bbv[i] * ig);
            KH[lane * 24 + tl] = f2bf(kpv[i] * gr); NBH[lane * 24 + tl] = f2bf(-bbv[i] * gr); VT[lane * 24 + tl] = f2bf(vs[i]); } }
        lds_barrier();
        if (w < 4 && !(RW_OFF & 4)) { LAS unsigned char* CB_ = LB + w * CH_BYTES;
          const LAS bf16_t *AT = (const LAS bf16_t*)(CB_ + CH_AT), *RT = (const LAS bf16_t*)(CB_ + CH_RT), *KT = (const LAS bf16_t*)(CB_ + CH_KT), *BT = (const LAS bf16_t*)(CB_ + CH_BT);
          f32x4 lab = (f32x4){0.f, 0.f, 0.f, 0.f}, lak = lab, lrk = lab, lrb = lab;
#pragma unroll
          for (int ks = 0; ks < 2; ++ks) { const int o = fr * TWS + 32 * ks + 8 * fq;
            const bf16x8 af = *(const LAS bf16x8*)(AT + o), rf = *(const LAS bf16x8*)(RT + o), kf = *(const LAS bf16x8*)(KT + o), bf = *(const LAS bf16x8*)(BT + o);
            lab = __builtin_amdgcn_mfma_f32_16x16x32_bf16(af, bf, lab, 0, 0, 0); lak = __builtin_amdgcn_mfma_f32_16x16x32_bf16(af, kf, lak, 0, 0, 0);
            lrk = __builtin_amdgcn_mfma_f32_16x16x32_bf16(rf, kf, lrk, 0, 0, 0); lrb = __builtin_amdgcn_mfma_f32_16x16x32_bf16(rf, bf, lrb, 0, 0, 0); }
          LAS float *LAB = (LAS float*)(CB_ + CH_LAB), *LAK = (LAS float*)(CB_ + CH_LAK); LAS bf16_t *LRK = (LAS bf16_t*)(CB_ + CH_LRK), *NLRB = (LAS bf16_t*)(CB_ + CH_NLRB);
#pragma unroll
          for (int r = 0; r < 4; ++r) { const int t = 4 * fq + r, s_ = fr; const bool lo_ = t > s_, le_ = t >= s_;
            LAB[t * 16 + s_] = lo_ ? lab[r] : 0.0f; LAK[t * 16 + s_] = lo_ ? lak[r] : 0.0f;
            LRK[t * 24 + s_] = f2bf(le_ ? lrk[r] : 0.0f); NLRB[t * 24 + s_] = f2bf(le_ ? -lrb[r] : 0.0f); } }
        lds_barrier();
        { const int ch6 = w & 3; LAS unsigned char* CB_ = LB + ch6 * CH_BYTES;
          const LAS bf16_t* AT = (const LAS bf16_t*)(CB_ + CH_AT); const LAS float *LAB = (const LAS float*)(CB_ + CH_LAB), *LAK = (const LAS float*)(CB_ + CH_LAK);
          LAS bf16_t *WI = (LAS bf16_t*)(CB_ + CH_KT), *GI = (LAS bf16_t*)(CB_ + CH_GI);
          float xv[16];
          if (w < 4) {
#pragma unroll
            for (int t = 0; t < 16; ++t) xv[t] = bf2f(AT[t * TWS + lane]);
          } else {
#pragma unroll
            for (int t = 0; t < 16; ++t) xv[t] = LAK[t * 16 + fr];
          }
#pragma unroll
          for (int t = 1; t < 16; ++t) { float xa = xv[t];
#pragma unroll
            for (int q = 0; q < 4; ++q) if (4 * q < t) { const f32x4 lr = *(const LAS f32x4*)(LAB + t * 16 + 4 * q);
#pragma unroll
              for (int e = 0; e < 4; ++e) if (4 * q + e < t) xa -= lr[e] * xv[4 * q + e]; }
            xv[t] = xa; asm volatile("" : "+v"(xv[t]) :: "memory"); }
          if (w < 4) {
#pragma unroll
            for (int t = 0; t < 16; ++t) WI[t * TWS + lane] = f2bf(xv[t]);
          } else if (lane < 16) {
#pragma unroll
            for (int t = 0; t < 16; ++t) GI[t * 24 + lane] = f2bf(xv[t]);
          } }
        lds_barrier();
        if (w < 4 && !(RW_OFF & 2)) {
#pragma unroll 1
          for (int ch = 0; ch < 4; ++ch) { LAS unsigned char* CB_ = LB + ch * CH_BYTES;
            const LAS bf16_t *RT = (const LAS bf16_t*)(CB_ + CH_RT), *WI = (const LAS bf16_t*)(CB_ + CH_KT), *KH = (const LAS bf16_t*)(CB_ + CH_KH), *NBH = (const LAS bf16_t*)(CB_ + CH_NB),
                             *VT = (const LAS bf16_t*)(CB_ + CH_VT), *LRK = (const LAS bf16_t*)(CB_ + CH_LRK), *NLRB = (const LAS bf16_t*)(CB_ + CH_NLRB), *GI = (const LAS bf16_t*)(CB_ + CH_GI);
            const LAS float* GC = (const LAS float*)(CB_ + CH_GC);
            bf16x8 Mb[2], Wp[2], Rp[2];
#pragma unroll
            for (int ks = 0; ks < 2; ++ks) { Mb[ks] = cat4(pk4(Macc[2 * ks]), pk4(Macc[2 * ks + 1]));
              Wp[ks] = cat4(*(const LAS bf16x4*)(WI + fr * TWS + 32 * ks + 4 * fq), *(const LAS bf16x4*)(WI + fr * TWS + 32 * ks + 16 + 4 * fq));
              Rp[ks] = cat4(*(const LAS bf16x4*)(RT + fr * TWS + 32 * ks + 4 * fq), *(const LAS bf16x4*)(RT + fr * TWS + 32 * ks + 16 + 4 * fq)); }
            const bf16x8 Vb = cat4z(*(const LAS bf16x4*)(VT + (16 * w + fr) * 24 + 4 * fq));
            const bf16x8 Gp = cat4z(*(const LAS bf16x4*)(GI + fr * 24 + 4 * fq)), Lrkp = cat4z(*(const LAS bf16x4*)(LRK + fr * 24 + 4 * fq)), Nlrbp = cat4z(*(const LAS bf16x4*)(NLRB + fr * 24 + 4 * fq));
            f32x4 U = (f32x4){0.f, 0.f, 0.f, 0.f};
            U = __builtin_amdgcn_mfma_f32_16x16x32_bf16(Wp[0], Mb[0], U, 0, 0, 0); U = __builtin_amdgcn_mfma_f32_16x16x32_bf16(Wp[1], Mb[1], U, 0, 0, 0); U = __builtin_amdgcn_mfma_f32_16x16x32_bf16(Gp, Vb, U, 0, 0, 0);
            const bf16x8 Ub = cat4z(pk4(U));
            f32x4 Y = (f32x4){0.f, 0.f, 0.f, 0.f};
            Y = __builtin_amdgcn_mfma_f32_16x16x32_bf16(Rp[0], Mb[0], Y, 0, 0, 0); Y = __builtin_amdgcn_mfma_f32_16x16x32_bf16(Rp[1], Mb[1], Y, 0, 0, 0);
            Y = __builtin_amdgcn_mfma_f32_16x16x32_bf16(Lrkp, Vb, Y, 0, 0, 0); Y = __builtin_amdgcn_mfma_f32_16x16x32_bf16(Nlrbp, Ub, Y, 0, 0, 0);
#pragma unroll
            for (int r = 0; r < 4; ++r) YY[(16 * ch + 4 * fq + r) * 64 + 16 * w + fr] = Y[r];
#pragma unroll
            for (int mt = 0; mt < 4; ++mt) { const f32x4 gc = *(const LAS f32x4*)(GC + 16 * mt + 4 * fq); f32x4 m = Macc[mt] * gc;
              const bf16x8 khp = cat4z(*(const LAS bf16x4*)(KH + (16 * mt + fr) * 24 + 4 * fq)), nbp = cat4z(*(const LAS bf16x4*)(NBH + (16 * mt + fr) * 24 + 4 * fq));
              m = __builtin_amdgcn_mfma_f32_16x16x32_bf16(khp, Vb, m, 0, 0, 0); m = __builtin_amdgcn_mfma_f32_16x16x32_bf16(nbp, Ub, m, 0, 0, 0); Macc[mt] = m; } } }
        lds_barrier();
        const float lnw = CT[640 + lane], lnb = CT[704 + lane];
#pragma unroll
        for (int i = 0; i < 8; ++i) {
            const int tok = w * 8 + i; const float y = YY[tok * 64 + lane];
            const float mean = wave_sum2(y) * (1.0f / 64.0f), dl = y - mean, var = wave_sum2(dl * dl) * (1.0f / 64.0f);
            const float yn = dl * rsqrtf(var + 64e-5f) * lnw + lnb + cbv[i] * vs[i];
            const float gti = (i & 1) ? hi16(gtp[i >> 1]) : lo16(gtp[i >> 1]);
            if (!dry) g3[(t0 + tok) * G3_LD + cj] = f2bf(yn * siluf_(gti));
        }
        lds_barrier();
    }
}

__device__ __forceinline__ void spin_until_ge(const unsigned* flag, unsigned want) {
    unsigned it = 0;
    while (__hip_atomic_load(flag, __ATOMIC_RELAXED, __HIP_MEMORY_SCOPE_AGENT) < want) { __builtin_amdgcn_s_sleep(2); if (++it > (1u << 17)) break; }
}
__device__ __forceinline__ unsigned pk2bf(float lo, float hi) { return cvt_pk_bf16(lo, hi); }

__device__ void rwkv_producer(const Ctx& c, int l, int bh, int par) {
    const Params& P = *c.P; const int b = bh >> 3, hd = bh & 7, lane = c.lane, w = c.wave, cj = hd * 64 + lane, fr = lane & 15, fq = lane >> 4;
    LAS unsigned char* LB = c.lds;
    LAS float* WR = (LAS float*)LB; LAS float* AR = (LAS float*)(LB + RW_AR);
    LAS bf16_t* TWb = (LAS bf16_t*)(LB + RW_TW); LAS bf16_t* ADb = (LAS bf16_t*)(LB + RW_AD);
    const bf16_t* zrw = (const bf16_t*)(c.ws + OFF_ZRW);
    unsigned* ready = (unsigned*)(c.ws + OFF_BAR + 256) + (bh * 2 + par) * 64; const unsigned* consumed = (const unsigned*)(c.ws + OFF_BAR + 256 + 64 * 256) + bh * 64;
    unsigned char* ring = c.ws + OFF_RING + (size_t)bh * RING_SLOTS * SLOT_BYTES;
    LAS float* CT = (LAS float*)(LB + RW_CT);
    if (c.tid < 64) { const float* mu = P.in[4] + (size_t)l * 1664; const int j = hd * 64 + c.tid;
        CT[0 * 64 + c.tid] = mu[j]; CT[1 * 64 + c.tid] = mu[512 + j]; CT[2 * 64 + c.tid] = mu[1024 + j]; CT[3 * 64 + c.tid] = mu[1536 + c.tid]; CT[4 * 64 + c.tid] = mu[1600 + c.tid];
        CT[5 * 64 + c.tid] = P.in[5][l * BW + j]; CT[6 * 64 + c.tid] = P.in[7][l * BW + j]; CT[7 * 64 + c.tid] = P.in[9][l * BW + j]; CT[8 * 64 + c.tid] = P.in[10][l * BW + j];
        CT[9 * 64 + c.tid] = P.in[11][l * BW + j]; }
    const int mt_ = w >> 1, nh = w & 1;
    LAS bf16_t* W2I = (LAS bf16_t*)(LB + RW_W2); LAS bf16_t* A2I = (LAS bf16_t*)(LB + RW_A2);
    for (int i = c.tid; i < 4096; i += 512) { const int k = i >> 6, j = i & 63; W2I[j * TWS + k] = f2bf(P.in[6][((size_t)l * 64 + k) * BW + hd * 64 + j]); A2I[j * TWS + k] = f2bf(P.in[8][((size_t)l * 64 + k) * BW + hd * 64 + j]); }
    __syncthreads();
    RwRows cur;
    rw_load_rows(cur, zrw, b, par, w, lane, cj);
    for (int blk = par; blk < RW_NBLK; blk += 2) {
        const unsigned gblk = (unsigned)(l * RW_NBLK + blk);
        float rs[8], ks_[8], vs[8];
        const float mu_r = CT[lane], mu_k = CT[64 + lane], mu_v = CT[128 + lane], mu_w = CT[192 + lane], mu_a = CT[256 + lane];
#pragma unroll
        for (int i = 0; i < 8; ++i) { const int tok = w * 8 + i;
            { const float r0 = rw_get(cur.zr, i), r1 = rw_get(cur.zr, i + 1), k0 = rw_get(cur.zk, i), k1 = rw_get(cur.zk, i + 1), v0 = rw_get(cur.zv, i), v1 = rw_get(cur.zv, i + 1);
              rs[i] = r1 + mu_r * (r0 - r1); ks_[i] = k1 + mu_k * (k0 - k1); vs[i] = v1 + mu_v * (v0 - v1); }
            const float w0_ = rw_get(cur.zw, i), w1_ = rw_get(cur.zw, i + 1), a0_ = rw_get(cur.za, i), a1_ = rw_get(cur.za, i + 1);
            const float wds = w1_ + mu_w * (w0_ - w1_), ads = a1_ + mu_a * (a0_ - a1_);
            const float e2 = __expf(2.0f * wds); const float th = 1.0f - 2.0f * __builtin_amdgcn_rcpf(e2 + 1.0f);
            TWb[tok * TWS + lane] = f2bf(th); ADb[tok * TWS + lane] = f2bf(ads); }
        if (blk + 2 < RW_NBLK) rw_load_rows(cur, zrw, b, blk + 2, w, lane, cj);
        lds_barrier();
        { bf16x8 atw[2], aad[2];
#pragma unroll
          for (int ks = 0; ks < 2; ++ks) { atw[ks] = *(const LAS bf16x8*)(TWb + (16 * mt_ + fr) * TWS + 32 * ks + 8 * fq); aad[ks] = *(const LAS bf16x8*)(ADb + (16 * mt_ + fr) * TWS + 32 * ks + 8 * fq); }
          f32x4 cw[2], ca[2];
#pragma unroll
          for (int n2 = 0; n2 < 2; ++n2) { cw[n2] = (f32x4){0.f, 0.f, 0.f, 0.f}; ca[n2] = cw[n2];
#pragma unroll
              for (int ks = 0; ks < 2; ++ks) { const int bo = (32 * nh + 16 * n2 + fr) * TWS + 32 * ks + 8 * fq;
                  cw[n2] = __builtin_amdgcn_mfma_f32_16x16x32_bf16(atw[ks], *(const LAS bf16x8*)(W2I + bo), cw[n2], 0, 0, 0); ca[n2] = __builtin_amdgcn_mfma_f32_16x16x32_bf16(aad[ks], *(const LAS bf16x8*)(A2I + bo), ca[n2], 0, 0, 0); } }
          lds_barrier();
#pragma unroll
          for (int n2 = 0; n2 < 2; ++n2)
#pragma unroll
              for (int r = 0; r < 4; ++r) { const int o = (16 * mt_ + 4 * fq + r) * 64 + 32 * nh + 16 * n2 + fr; WR[o] = cw[n2][r]; AR[o] = ca[n2][r]; } }
        if (c.tid == 0 && gblk >= RING_SLOTS) spin_until_ge(consumed, gblk - RING_SLOTS + 1);
        lds_barrier();
        unsigned char* slot = ring + (size_t)(gblk % RING_SLOTS) * SLOT_BYTES;
        LAS float* GP = (LAS float*)(LB + RW_GP); const int cc = w >> 1, hc = w & 1;
        float kkv[8], kpv[8], bbv[8], gl[8], cbv[8];
        { const float w0j = CT[320 + lane], a0j = CT[384 + lane], kkj = CT[448 + lane], kaj = CT[512 + lane], rkj = CT[576 + lane]; float g = 1.0f;
#pragma unroll
          for (int i = 0; i < 8; ++i) { const int o = (w * 8 + i) * 64 + lane;
            const float wraw = w0j + WR[o], araw = a0j + AR[o];
            const float d = __expf(-0.6065306597126334f * sigmoidf_(wraw)), a = sigmoidf_(araw);
            float kk = ks_[i] * kkj; const float n2 = wave_sum2(kk * kk); kk = kk * __builtin_amdgcn_rsqf(fmaxf(n2, 1e-24f));
            const float kp = ks_[i] * (1.0f + (a - 1.0f) * kaj);
            cbv[i] = wave_sum2(rs[i] * kp * rkj);
            g *= d; gl[i] = g; kkv[i] = kk; kpv[i] = kp; bbv[i] = kk * a; }
          GP[w * 64 + lane] = g; }
        lds_barrier();
        { LAS unsigned char* CB_ = LB + cc * CH_BYTES;
          LAS bf16_t *AT = (LAS bf16_t*)(CB_ + CH_AT), *RT = (LAS bf16_t*)(CB_ + CH_RT), *KT = (LAS bf16_t*)(CB_ + CH_KT), *BT = (LAS bf16_t*)(CB_ + CH_BT),
                     *KH = (LAS bf16_t*)(CB_ + CH_KH), *NBH = (LAS bf16_t*)(CB_ + CH_NB), *VT = (LAS bf16_t*)(CB_ + CH_VT);
          const float g0 = GP[(2 * cc) * 64 + lane], g1 = GP[(2 * cc + 1) * 64 + lane], gC = g0 * g1, pre = hc ? g0 : 1.0f;
          if (hc == 0) ((LAS float*)(CB_ + CH_GC))[lane] = gC;
          float khv[8], nbv[8];
#pragma unroll
          for (int i = 0; i < 8; ++i) { const int tl = 8 * hc + i;
            const float gam = pre * gl[i], gprev = (i == 0) ? pre : pre * gl[i - 1], ig = __builtin_amdgcn_rcpf(gam), gr = gC * ig;
            AT[tl * TWS + lane] = f2bf(kkv[i] * gprev); RT[tl * TWS + lane] = f2bf(rs[i] * gam); KT[tl * TWS + lane] = f2bf(kpv[i] * ig); BT[tl * TWS + lane] = f2bf(bbv[i] * ig);
            khv[i] = kpv[i] * gr; nbv[i] = -bbv[i] * gr; }
#pragma unroll
          for (int p = 0; p < 4; ++p) { const int o = lane * 20 + 8 * hc + 2 * p;
            *(LAS unsigned*)(KH + o) = cvt_pk_bf16(khv[2 * p], khv[2 * p + 1]); *(LAS unsigned*)(NBH + o) = cvt_pk_bf16(nbv[2 * p], nbv[2 * p + 1]); *(LAS unsigned*)(VT + o) = cvt_pk_bf16(vs[2 * p], vs[2 * p + 1]); } }
        lds_barrier();
        { const __amdgpu_buffer_rsrc_t rs_ = __builtin_amdgcn_make_buffer_rsrc((void*)slot, 0, (int)SLOT_BYTES, 0x00020000);
#pragma unroll
          for (int i = 0; i < 9; ++i) { const int L_ = c.tid * 16 + i * 8192, ch = L_ / 18432, off = L_ - ch * 18432;
              __builtin_amdgcn_raw_buffer_store_b128(*(const LAS u32x4*)(LB + ch * CH_BYTES + off), rs_, (unsigned)L_, 0, 16); }
          if (c.tid < 64) __builtin_amdgcn_raw_buffer_store_b128(*(const LAS u32x4*)(LB + (c.tid >> 4) * CH_BYTES + CH_GC + (c.tid & 15) * 16), rs_, (unsigned)(SLOT_IMG + c.tid * 16), 0, 16);
#pragma unroll
          for (int i = 0; i < 8; ++i) if (lane == i) __hip_atomic_store((unsigned*)(slot + SLOT_IMG + 1024) + w * 8 + i, __float_as_uint(cbv[i]), __ATOMIC_RELAXED, __HIP_MEMORY_SCOPE_AGENT); }
        __syncthreads();
        if (c.tid == 0) __hip_atomic_store(ready, (gblk >> 1) + 1, __ATOMIC_RELAXED, __HIP_MEMORY_SCOPE_AGENT);
    }
}

struct RwSlot { u32x4 img[9]; u32x4 gc; float cb; };
__device__ __forceinline__ void rw_load_slot(RwSlot& R, const unsigned char* slot, int tid, int w, int lane) {
#pragma unroll
    for (int i = 0; i < 9; ++i) R.img[i] = *(const u32x4*)(slot + tid * 16 + i * 8192);
    R.gc = *(const u32x4*)(slot + SLOT_IMG + (tid & 63) * 16);
    R.cb = ((const float*)(slot + SLOT_IMG + 1024))[w * 8 + (lane & 7)];
}

__device__ void rwkv_consumer(const Ctx& c, int l, int bh) {
    const Params& P = *c.P; const int b = bh >> 3, hd = bh & 7, lane = c.lane, w = c.wave, cj = hd * 64 + lane, fr = lane & 15, fq = lane >> 4;
    LAS unsigned char* LB = c.lds;
    LAS float* YY = (LAS float*)(LB + RW_YY);
    bf16_t* g3 = (bf16_t*)(c.ws + OFF_G3);
    const unsigned* ready = (const unsigned*)(c.ws + OFF_BAR + 256) + bh * 128; unsigned* consumed = (unsigned*)(c.ws + OFF_BAR + 256 + 64 * 256) + bh * 64;
    bf16_t* zrw = (bf16_t*)(c.ws + OFF_ZRW); float* cbg = (float*)(c.ws + OFF_CBG);
    const unsigned char* ring = c.ws + OFF_RING + (size_t)bh * RING_SLOTS * SLOT_BYTES;
    f32x4 Macc[4];
#pragma unroll
    for (int i = 0; i < 4; ++i) Macc[i] = (f32x4){0.f, 0.f, 0.f, 0.f};
    RwSlot cur;
    { const unsigned g0 = (unsigned)(l * RW_NBLK);
      if (c.tid == 0) { spin_until_ge(ready + 64 * (g0 & 1), (g0 >> 1) + 1); spin_until_ge(ready + 64 * ((g0 + 1) & 1), ((g0 + 1) >> 1) + 1); __builtin_amdgcn_fence(__ATOMIC_ACQUIRE, "agent"); }
      __syncthreads();
      rw_load_slot(cur, ring + (size_t)(g0 % RING_SLOTS) * SLOT_BYTES, c.tid, w, lane); }
    for (int blk = 0; blk < RW_NBLK; ++blk) {
        const unsigned gblk = (unsigned)(l * RW_NBLK + blk); const size_t t0 = (size_t)b * SEQ + blk * 64;
        const float cb_own = cur.cb;
#pragma unroll
        for (int i = 0; i < 9; ++i) { const int L_ = c.tid * 16 + i * 8192, ch = L_ / 18432, off = L_ - ch * 18432; *(LAS u32x4*)(LB + ch * CH_BYTES + off) = cur.img[i]; }
        if (c.tid < 64) *(LAS u32x4*)(LB + (c.tid >> 4) * CH_BYTES + CH_GC + (c.tid & 15) * 16) = cur.gc;
        lds_barrier();
        if (c.tid == 0) __hip_atomic_store(consumed, gblk + 1, __ATOMIC_RELAXED, __HIP_MEMORY_SCOPE_AGENT);
        if (blk + 1 < RW_NBLK) rw_load_slot(cur, ring + (size_t)((gblk + 1) % RING_SLOTS) * SLOT_BYTES, c.tid, w, lane);
        if (w < 4 && true) { LAS unsigned char* CB_ = LB + w * CH_BYTES;
          const LAS bf16_t *AT = (const LAS bf16_t*)(CB_ + CH_AT), *RT = (const LAS bf16_t*)(CB_ + CH_RT), *KT = (const LAS bf16_t*)(CB_ + CH_KT), *BT = (const LAS bf16_t*)(CB_ + CH_BT);
          f32x4 lab = (f32x4){0.f, 0.f, 0.f, 0.f}, lak = lab, lrk = lab, lrb = lab;
#pragma unroll
          for (int ks = 0; ks < 2; ++ks) { const int o = fr * TWS + 32 * ks + 8 * fq;
            const bf16x8 af = *(const LAS bf16x8*)(AT + o), rf = *(const LAS bf16x8*)(RT + o), kf = *(const LAS bf16x8*)(KT + o), bf = *(const LAS bf16x8*)(BT + o);
            lab = __builtin_amdgcn_mfma_f32_16x16x32_bf16(af, bf, lab, 0, 0, 0); lak = __builtin_amdgcn_mfma_f32_16x16x32_bf16(af, kf, lak, 0, 0, 0);
            lrk = __builtin_amdgcn_mfma_f32_16x16x32_bf16(rf, kf, lrk, 0, 0, 0); lrb = __builtin_amdgcn_mfma_f32_16x16x32_bf16(rf, bf, lrb, 0, 0, 0); }
          LAS float *LAB = (LAS float*)(CB_ + CH_LAB), *LAK = (LAS float*)(CB_ + CH_LAK); LAS bf16_t *LRK = (LAS bf16_t*)(CB_ + CH_LRK), *NLRB = (LAS bf16_t*)(CB_ + CH_NLRB);
#pragma unroll
          for (int r = 0; r < 4; ++r) { const int t = 4 * fq + r, s_ = fr; const bool lo_ = t > s_, le_ = t >= s_;
            LAB[t * 16 + s_] = lo_ ? lab[r] : 0.0f; LAK[t * 16 + s_] = lo_ ? lak[r] : 0.0f;
            LRK[t * 24 + s_] = f2bf(le_ ? lrk[r] : 0.0f); NLRB[t * 24 + s_] = f2bf(le_ ? -lrb[r] : 0.0f); } }
        lds_barrier();
        { const int ch6 = w & 3; LAS unsigned char* CB_ = LB + ch6 * CH_BYTES;
          const LAS bf16_t* AT = (const LAS bf16_t*)(CB_ + CH_AT); const LAS float *LAB = (const LAS float*)(CB_ + CH_LAB), *LAK = (const LAS float*)(CB_ + CH_LAK);
          LAS bf16_t *WI = (LAS bf16_t*)(CB_ + CH_KT), *GI = (LAS bf16_t*)(CB_ + CH_GI);
          float xv[16];
          if (w < 4) {
#pragma unroll
            for (int t = 0; t < 16; ++t) xv[t] = bf2f(AT[t * TWS + lane]);
          } else {
#pragma unroll
            for (int t = 0; t < 16; ++t) xv[t] = LAK[t * 16 + fr];
          }
          f32x4 nx[4];
#pragma unroll
          for (int q = 0; q < 4; ++q) nx[q] = *(const LAS f32x4*)(LAB + 16 + 4 * q);
#pragma unroll
          for (int t = 1; t < 16; ++t) { float xa = xv[t]; f32x4 lr[4];
#pragma unroll
            for (int q = 0; q < 4; ++q) lr[q] = nx[q];
            if (t < 15) {
#pragma unroll
              for (int q = 0; q < 4; ++q) if (4 * q < t + 1) nx[q] = *(const LAS f32x4*)(LAB + (t + 1) * 16 + 4 * q); }
            float xb = 0.0f;
#pragma unroll
            for (int q = 0; q < 4; ++q) if (4 * q < t) {
#pragma unroll
              for (int e = 0; e < 4; ++e) if (4 * q + e < t) { if (e & 1) xb -= lr[q][e] * xv[4 * q + e]; else xa -= lr[q][e] * xv[4 * q + e]; } }
            xa += xb;
            xv[t] = xa; asm volatile("" : "+v"(xv[t]), "+v"(nx[0]), "+v"(nx[1]), "+v"(nx[2]), "+v"(nx[3]) :: "memory"); }
          if (w < 4) {
#pragma unroll
            for (int t = 0; t < 16; ++t) WI[t * TWS + lane] = f2bf(xv[t]);
          } else if (lane < 16) {
#pragma unroll
            for (int t = 0; t < 16; ++t) GI[t * 24 + lane] = f2bf(xv[t]);
          } }
        lds_barrier();
        if (w == 4 && lane == 0 && blk + 2 < RW_NBLK) { const unsigned gn = gblk + 2; spin_until_ge(ready + 64 * (gn & 1), (gn >> 1) + 1); __builtin_amdgcn_fence(__ATOMIC_ACQUIRE, "agent"); }
        if (w < 4 && true) {
#pragma unroll
          for (int ch = 0; ch < 4; ++ch) { LAS unsigned char* CB_ = LB + ch * CH_BYTES;
            const LAS bf16_t *RT = (const LAS bf16_t*)(CB_ + CH_RT), *WI = (const LAS bf16_t*)(CB_ + CH_KT), *KH = (const LAS bf16_t*)(CB_ + CH_KH), *NBH = (const LAS bf16_t*)(CB_ + CH_NB),
                             *VT = (const LAS bf16_t*)(CB_ + CH_VT), *LRK = (const LAS bf16_t*)(CB_ + CH_LRK), *NLRB = (const LAS bf16_t*)(CB_ + CH_NLRB), *GI = (const LAS bf16_t*)(CB_ + CH_GI);
            const LAS float* GC = (const LAS float*)(CB_ + CH_GC);
            bf16x8 Mb[2], Wp[2], Rp[2];
#pragma unroll
            for (int ks = 0; ks < 2; ++ks) { Mb[ks] = cat4(pk4(Macc[2 * ks]), pk4(Macc[2 * ks + 1]));
              Wp[ks] = cat4(*(const LAS bf16x4*)(WI + fr * TWS + 32 * ks + 4 * fq), *(const LAS bf16x4*)(WI + fr * TWS + 32 * ks + 16 + 4 * fq));
              Rp[ks] = cat4(*(const LAS bf16x4*)(RT + fr * TWS + 32 * ks + 4 * fq), *(const LAS bf16x4*)(RT + fr * TWS + 32 * ks + 16 + 4 * fq)); }
            const bf16x8 Vb = cat4z(*(const LAS bf16x4*)(VT + (16 * w + fr) * 20 + 4 * fq));
            const bf16x8 Gp = cat4z(*(const LAS bf16x4*)(GI + fr * 24 + 4 * fq)), Lrkp = cat4z(*(const LAS bf16x4*)(LRK + fr * 24 + 4 * fq)), Nlrbp = cat4z(*(const LAS bf16x4*)(NLRB + fr * 24 + 4 * fq));
            f32x4 U = (f32x4){0.f, 0.f, 0.f, 0.f};
            U = __builtin_amdgcn_mfma_f32_16x16x32_bf16(Wp[0], Mb[0], U, 0, 0, 0); U = __builtin_amdgcn_mfma_f32_16x16x32_bf16(Wp[1], Mb[1], U, 0, 0, 0); U = __builtin_amdgcn_mfma_f32_16x16x32_bf16(Gp, Vb, U, 0, 0, 0);
            const bf16x8 Ub = cat4z(pk4(U));
            f32x4 Y = (f32x4){0.f, 0.f, 0.f, 0.f};
            Y = __builtin_amdgcn_mfma_f32_16x16x32_bf16(Rp[0], Mb[0], Y, 0, 0, 0); Y = __builtin_amdgcn_mfma_f32_16x16x32_bf16(Rp[1], Mb[1], Y, 0, 0, 0);
            Y = __builtin_amdgcn_mfma_f32_16x16x32_bf16(Lrkp, Vb, Y, 0, 0, 0); Y = __builtin_amdgcn_mfma_f32_16x16x32_bf16(Nlrbp, Ub, Y, 0, 0, 0);
#pragma unroll
            for (int r = 0; r < 4; ++r) YY[(16 * ch + 4 * fq + r) * 64 + 16 * w + fr] = Y[r];
#pragma unroll
            for (int mt = 0; mt < 4; ++mt) { const f32x4 gc = *(const LAS f32x4*)(GC + 16 * mt + 4 * fq); f32x4 m = Macc[mt] * gc;
              const bf16x8 khp = cat4z(*(const LAS bf16x4*)(KH + (16 * mt + fr) * 20 + 4 * fq)), nbp = cat4z(*(const LAS bf16x4*)(NBH + (16 * mt + fr) * 20 + 4 * fq));
              m = __builtin_amdgcn_mfma_f32_16x16x32_bf16(khp, Vb, m, 0, 0, 0); m = __builtin_amdgcn_mfma_f32_16x16x32_bf16(nbp, Ub, m, 0, 0, 0); Macc[mt] = m; } } }
        lds_barrier();
        { const int tok = c.tid >> 3, c8 = (c.tid & 7) * 8;
          const f32x4 y0 = *(const LAS f32x4*)(YY + tok * 64 + c8), y1 = *(const LAS f32x4*)(YY + tok * 64 + c8 + 4);
          u32x4 wv; wv.x = cvt_pk_bf16(y0[0], y0[1]); wv.y = cvt_pk_bf16(y0[2], y0[3]); wv.z = cvt_pk_bf16(y1[0], y1[1]); wv.w = cvt_pk_bf16(y1[2], y1[3]);
          *(u32x4*)(zrw + (t0 + tok) * ZRW_LD + hd * 64 + c8) = wv;
          if (lane < 8) cbg[(t0 + w * 8 + lane) * 8 + hd] = cb_own; }
    }
}

__device__ void phase_rwkv_fin(const Ctx& c, int l) {
    const Params& P = *c.P; const bf16_t* zrw = (const bf16_t*)(c.ws + OFF_ZRW); bf16_t* g3 = (bf16_t*)(c.ws + OFF_G3); const float* cbg = (const float*)(c.ws + OFF_CBG);
    const int gw = blockIdx.x * 8 + c.wave, nw = gridDim.x * 8, lane = c.lane;
    for (int item = gw; item < (T / 128) * 8; item += nw) {
        const int hd = item & 7, tg = item >> 3, cj = hd * 64 + lane; const size_t tb = (size_t)tg * 128;
        const float mu_v = P.in[4][(size_t)l * 1664 + 1024 + cj], lnw = P.in[12][l * BW + cj], lnb = P.in[13][l * BW + cj];
        float vprev = ((tb & (SEQ - 1)) == 0) ? 0.0f : bf2f(zrw[(tb - 1) * ZRW_LD + 1024 + cj]);
        for (int t4 = 0; t4 < 128; t4 += 8) {
            float y[8], vv[8], gt[8], cb[8];
#pragma unroll
            for (int i = 0; i < 8; ++i) { const size_t t = tb + t4 + i; y[i] = bf2f(zrw[t * ZRW_LD + cj]); vv[i] = bf2f(zrw[t * ZRW_LD + 1024 + cj]); gt[i] = bf2f(g3[t * G3_LD + cj]); cb[i] = cbg[t * 8 + hd]; }
#pragma unroll
            for (int i = 0; i < 8; ++i) { const size_t t = tb + t4 + i;
                const float vs = vv[i] + mu_v * (vprev - vv[i]); vprev = vv[i];
                const float mean = wave_sum2(y[i]) * (1.0f / 64.0f), ey2 = wave_sum2(y[i] * y[i]) * (1.0f / 64.0f), var = fmaxf(ey2 - mean * mean, 0.0f);
                const float yn = (y[i] - mean) * rsqrtf(var + 64e-5f) * lnw + lnb + cb[i] * vs;
                g3[t * G3_LD + cj] = f2bf(yn * siluf_(gt[i])); }
        }
    }
}

constexpr int RW_WGS = 96;
template <int l, int sp>
__device__ __forceinline__ void run_sub(const Ctx& c, const Params& P, float* ssbase, int G, int cb, unsigned* bar2, unsigned& bar2_target) {
    unsigned char* ws = c.ws;
    if constexpr (sp == 0) {
        if (l == 0) phase_s5_consts(c);
        pg8::Gemm g{(const bf16_t*)(ws + OFF_XN), (const bf16_t*)(ws + OFF_WIN) + (size_t)l * DINP * D, D, D, D}; pg8::Sched S; S.init(T, DINP, G, cb);
        EpiZ E{(bf16_t*)(ws + OFF_ZRW), (bf16_t*)(ws + OFF_G3), (bf16_t*)(ws + OFF_XL), (bf16_t*)(ws + OFF_AS)};
        pg8::gemm_phase(c.lds, g, S, E);
    } else if constexpr (sp == 1) {
        if (cb < 32) rwkv_consumer(c, l, cb); else if (cb < RW_WGS) rwkv_producer(c, l, (cb - 32) & 31, (cb - 32) >> 5);
        else {
            Ctx c2 = c; c2.vb = cb - RW_WGS; c2.vG = G - RW_WGS; const int G2 = G - RW_WGS, cb2 = cb - RW_WGS;
            phase_lru_conv(c2, l);
            { pg8::Gemm g{(const bf16_t*)(ws + OFF_AS), (const bf16_t*)(ws + OFF_S5E) + (size_t)l * 32 * 256 * 256, AS_LD, 256, 256}; pg8::Sched S; S.init(AS_ROWS, 256, G2, cb2, 8);
              EpiE E{(float*)(ws + OFF_E)};
              pg8::gemm_phase(c.lds, g, S, E); }
            grid_bar(bar2, bar2_target, (unsigned)G2);
            phase_s5_carry(c2, l);
            { pg8::Gemm g{(const bf16_t*)(ws + OFF_XC), (const bf16_t*)(ws + OFF_WLRU) + (size_t)l * 1024 * BW, BW, BW, BW}; pg8::Sched S; S.init(T, 1024, G2, cb2);
              EpiLru E{(const bf16_t*)(ws + OFF_XC), P.in[27] + l * BW, P.in[29] + l * BW, P.in[30] + l * BW, (bf16_t*)(ws + OFF_LRUAB)};
              pg8::gemm_phase(c.lds, g, S, E); }
            grid_bar(bar2, bar2_target, (unsigned)G2);
            { pg8::Gemm g{(const bf16_t*)(ws + OFF_AS), (const bf16_t*)(ws + OFF_S5Y) + (size_t)l * 32 * 256 * AS_LD, AS_LD, AS_LD, AS_LD}; pg8::Sched S; S.init(AS_ROWS, 256, G2, cb2, 8);
              EpiY E{(const bf16_t*)(ws + OFF_AS), P.in[21] + l * BW, (bf16_t*)(ws + OFF_ZGS)};
              pg8::gemm_phase(c.lds, g, S, E); }
            phase_lru_scan(c2, 0);
            grid_bar(bar2, bar2_target, (unsigned)G2);
            { pg8::Gemm g{(const bf16_t*)(ws + OFF_ZGS), (const bf16_t*)(ws + OFF_WGLU) + (size_t)l * BW * BW, BW, BW, BW}; pg8::Sched S; S.init(T, BW, G2, cb2);
              EpiGlu E{(const bf16_t*)(ws + OFF_ZGS), P.in[23] + l * BW, (bf16_t*)(ws + OFF_G3)};
              pg8::gemm_phase(c.lds, g, S, E); }
            phase_lru_scan(c2, 1);
            { pg8::Gemm g{(const bf16_t*)(ws + OFF_PB) + (size_t)l * T * DPLE, (const bf16_t*)(ws + OFF_WPLE) + (size_t)l * D * DPLE, DPLE, DPLE, DPLE}; pg8::Sched S; S.init(T, D, G2, cb2);
              EpiPle E{(bf16_t*)(ws + OFF_PW), ssbase + (size_t)l * T};
              pg8::gemm_phase(c.lds, g, S, E); }
        }
    } else if constexpr (sp == 2) {
        phase_rwkv_fin(c, l);
    } else if constexpr (sp == 5) {
        { pg8::Gemm g{(const bf16_t*)(ws + OFF_G3), (const bf16_t*)(ws + OFF_WOUT) + (size_t)l * D * DMIX, DMIX, DMIX, DMIX}; pg8::Sched S; S.init(T, D, G, cb);
          EpiOut E{l == 0 ? P.in[0] : (const float*)P.out, P.out, (bf16_t*)(ws + OFF_H1B)};
          pg8::gemm_phase(c.lds, g, S, E); }
    } else if constexpr (sp == 6) {
        pg8::Gemm g{(const bf16_t*)(ws + OFF_H1B), (const bf16_t*)(ws + OFF_WG) + (size_t)l * D * D, D, D, D}; pg8::Sched S; S.init(T, D, G, cb);
        EpiGate E{P.out, (const bf16_t*)(ws + OFF_PW), ssbase + (size_t)l * T, P.in[33] + l * D, ssbase + (size_t)(2 + l) * T};
        pg8::gemm_phase(c.lds, g, S, E);
    } else {
        phase_norm(c, ssbase + (size_t)(2 + l) * T, l == 0 ? P.in[2] + D : P.in[35], l == 1);
    }
}

constexpr int NPHASE = 1 + 6 * 2;
__global__ void __launch_bounds__(512) hymba_fwd(Params P) {
    extern __shared__ __attribute__((aligned(16))) unsigned char lds_raw[];
    Ctx c; c.P = &P; c.ws = P.ws; c.lds = (LAS unsigned char*)lds_raw; c.ldsg = lds_raw; c.tid = threadIdx.x; c.lane = c.tid & 63; c.wave = __builtin_amdgcn_readfirstlane(c.tid >> 6);
    c.gtid = (size_t)blockIdx.x * 512 + c.tid; c.gsz = (size_t)gridDim.x * 512; c.vb = blockIdx.x; c.vG = gridDim.x;
    unsigned char* ws = P.ws; const int G = gridDim.x, cb = blockIdx.x;
    float* ssbase = (float*)(ws + OFF_SS);
    const int lo = P.ph_lo, hi = P.ph_hi;
    unsigned* barw = (unsigned*)(ws + OFF_BAR); unsigned bar_target = 0; unsigned* bar2 = barw + 32; unsigned bar2_target = 0;
#define PHASE(k, ...) if (((MK_PH_MASK >> (k)) & 1) && lo <= (k) && (k) < hi) { __VA_ARGS__; if ((k) + 1 < hi) { if ((k) == 0) { __threadfence(); cg::this_grid().sync(); } else grid_bar(barw, bar_target, (unsigned)G); } }
    PHASE(0, phase_prep(c))
#define RS(L_, SP_) run_sub<L_, SP_>(c, P, ssbase, G, cb, bar2, bar2_target)
    PHASE(1, RS(0, 0)) PHASE(2, RS(0, 1)) PHASE(3, RS(0, 2)) PHASE(4, RS(0, 5)) PHASE(5, RS(0, 6)) PHASE(6, RS(0, 7))
    PHASE(7, RS(1, 0)) PHASE(8, RS(1, 1)) PHASE(9, RS(1, 2)) PHASE(10, RS(1, 5)) PHASE(11, RS(1, 6)) PHASE(12, RS(1, 7))
#undef RS
#undef PHASE
}

extern "C" void kernel_launch(void* const* d_in, const int* in_sizes, int n_in, void* d_out, int out_size, void* d_ws, size_t ws_size, hipStream_t stream) {
    static int grid = 0;
    if (grid == 0) {
        if (n_in != 36 || out_size != T * D || ws_size < WS_END2) { fprintf(stderr, "kernel_launch: unexpected shapes (n_in %d out %d ws %zu need %zu)\n", n_in, out_size, ws_size, (size_t)WS_END); grid = -1; return; }
        int dev = 0, cus = 0, per_cu = 0;
        hipGetDevice(&dev); hipDeviceGetAttribute(&cus, hipDeviceAttributeMultiprocessorCount, dev);
        hipFuncSetAttribute((const void*)hymba_fwd, hipFuncAttributeMaxDynamicSharedMemorySize, LDS_BYTES);
        hipOccupancyMaxActiveBlocksPerMultiprocessor(&per_cu, (const void*)hymba_fwd, 512, LDS_BYTES);
        if (per_cu < 1) per_cu = 1;
        grid = cus * per_cu; if (grid > 256) grid = 256;
        (void)hipGetLastError();
    }
    if (grid < 0) return;
    (void)hipMemsetAsync((char*)d_ws + OFF_BAR, 0, CTL_BYTES, stream);
    Params p{};
    for (int i = 0; i < 36; ++i) p.in[i] = (const float*)d_in[i];
    p.out = (float*)d_out; p.ws = (unsigned char*)d_ws;
#if MK_PER_PHASE
    for (int ph = 0; ph < NPHASE; ++ph) { p.ph_lo = ph; p.ph_hi = ph + 1; hipLaunchKernelGGL(hymba_fwd, dim3(grid), dim3(512), LDS_BYTES, stream, p); }
#else
    p.ph_lo = 0; p.ph_hi = NPHASE;
    void* args[] = {&p};
    hipError_t e = hipLaunchCooperativeKernel((const void*)hymba_fwd, dim3(grid), dim3(512), args, LDS_BYTES, stream);
    if (e != hipSuccess) fprintf(stderr, "cooperative launch failed: %s (grid %d)\n", hipGetErrorString(e), grid);
#endif
}
```
